# Optimizing an MI355X kernel written in HIP

```python
import math
import jax, jax.numpy as jnp
from jax import lax
import numpy as np

D_MODEL = 2048
BATCH = 2
SEQ = 4096
DEPTH = 1

CHUNK = 64
Q_BLOCK = 128
ROPE_THETA = 10000.0
NORM_EPS = 1e-6
NEG_INF = -1e30
D_MIX = D_MODEL
DIFF_WIDTH = D_MIX // 2
DIFF_HEADS = 8
DIFF_VDIM = DIFF_WIDTH // DIFF_HEADS
DIFF_QKDIM = DIFF_VDIM // 2
GLA_WIDTH = D_MIX - DIFF_WIDTH
GLA_HEADS = 4
GLA_VDIM = GLA_WIDTH // GLA_HEADS
GLA_KDIM = GLA_VDIM // 2
GLA_GATE_RANK = 16
GLA_TAU = 16.0
N_MEM = 256
CROSS_HEADS = 4
CROSS_HDIM = D_MODEL // CROSS_HEADS
N_GROUPS = 4
EXPERTS_PER_GROUP = 8
N_EXPERTS = N_GROUPS * EXPERTS_PER_GROUP
TOP_K = 2
D_EXPERT = D_MODEL // 4
EXPERT_BLOCK = 128
IN_SIZES = (DIFF_HEADS * 2 * DIFF_QKDIM, DIFF_HEADS * 2 * DIFF_QKDIM, DIFF_HEADS * DIFF_VDIM,
            GLA_HEADS * GLA_KDIM, GLA_HEADS * GLA_KDIM, GLA_HEADS * GLA_VDIM,
            GLA_GATE_RANK, GLA_WIDTH)
IN_COLS = sum(IN_SIZES)

kernel_name = 'hybrid_diffattn_gla_hmoe_block'


def _split_points():
    pts, acc = [], 0
    for s in IN_SIZES[:-1]:
        acc += s
        pts.append(acc)
    return pts


def rmsnorm(x, g):
    xf = x.astype(jnp.float32)
    y = xf * lax.rsqrt(jnp.mean(xf * xf, axis=-1, keepdims=True) + NORM_EPS)
    return (y * g.astype(jnp.float32)).astype(x.dtype)


def rope(t, positions):
    half = t.shape[-1] // 2
    freq = ROPE_THETA ** (-jnp.arange(half, dtype=jnp.float32) / half)
    ang = positions.astype(jnp.float32)[..., None] * freq
    cos = jnp.cos(ang)[:, :, None, None, :]
    sin = jnp.sin(ang)[:, :, None, None, :]
    tf = t.astype(jnp.float32)
    t1, t2 = tf[..., :half], tf[..., half:]
    return jnp.concatenate([t1 * cos - t2 * sin, t2 * cos + t1 * sin], axis=-1).astype(t.dtype)


def diff_attention(q, k, v, lam):
    B, S, H, _, Dh = q.shape
    Dv = v.shape[-1]
    nqb = S // Q_BLOCK
    qb = q.reshape(B, nqb, Q_BLOCK, H, 2, Dh).transpose(1, 0, 2, 3, 4, 5)
    key_chunk = jnp.arange(S) // CHUNK
    scale = Dh ** -0.5

    def block(args):
        qblk, b = args
        s = jnp.einsum('bqhcd,bkhcd->bhcqk', qblk, k).astype(jnp.float32) * scale
        q_chunk = (b * Q_BLOCK + jnp.arange(Q_BLOCK)) // CHUNK
        allowed = key_chunk[None, :] <= q_chunk[:, None]
        p = jax.nn.softmax(jnp.where(allowed, s, NEG_INF), axis=-1)
        a = p[:, :, 0] - lam * p[:, :, 1]
        return jnp.einsum('bhqk,bkhd->bqhd', a.astype(v.dtype), v)

    out = lax.map(block, (qb, jnp.arange(nqb)))
    return out.transpose(1, 0, 2, 3, 4).reshape(B, S, H, Dv)


def gla(q, k, v, log_a):
    B, S, H, Dk = q.shape
    Dv = v.shape[-1]
    NC = S // CHUNK
    qc = q.reshape(B, NC, CHUNK, H, Dk).astype(jnp.float32)
    kc = k.reshape(B, NC, CHUNK, H, Dk).astype(jnp.float32)
    vc = v.reshape(B, NC, CHUNK, H, Dv).astype(jnp.float32)
    cum = jnp.cumsum(log_a.reshape(B, NC, CHUNK, H, Dk).astype(jnp.float32), axis=2)
    cum_end = cum[:, :, -1:]
    k_dec = kc * jnp.exp(cum_end - cum)
    d_state = jnp.einsum('bnchk,bnchv->nbhkv', k_dec, vc)
    decay = jnp.exp(cum_end[:, :, 0]).transpose(1, 0, 2, 3)

    def step(s_prev, inp):
        dcy, ds = inp
        s_new = dcy[..., None] * s_prev + ds
        return s_new, s_new

    _, states = lax.scan(step, jnp.zeros((B, H, Dk, Dv), jnp.float32), (decay, d_state))
    o = jnp.einsum('bnchk,nbhkv->bnchv', qc * (Dk ** -0.5), states)
    return o.reshape(B, S, H, Dv).astype(q.dtype)


def cross_attention(xn, memn, w_cq, w_ckv, qg, kg, w_co):
    B, S, D = xn.shape
    M = memn.shape[1]
    q = rmsnorm((xn @ w_cq).reshape(B, S, CROSS_HEADS, CROSS_HDIM), qg)
    k, v = jnp.split(memn @ w_ckv, 2, axis=-1)
    k = rmsnorm(k.reshape(B, M, CROSS_HEADS, CROSS_HDIM), kg)
    v = v.reshape(B, M, CROSS_HEADS, CROSS_HDIM)
    s = jnp.einsum('bshd,bmhd->bhsm', q, k).astype(jnp.float32) * (CROSS_HDIM ** -0.5)
    p = jax.nn.softmax(s, axis=-1)
    o = jnp.einsum('bhsm,bmhd->bshd', p.astype(v.dtype), v).reshape(B, S, D)
    return o @ w_co


def hmoe(xn, w_rg, b_rg, w_re, b_re, w_gate, w_up, w_down):
    B, S, D = xn.shape
    T = B * S
    xt = xn.reshape(T, D)
    tok = jnp.arange(T)
    grp_logits = (xt @ w_rg).astype(jnp.float32) + b_rg.astype(jnp.float32)
    grp_prob = jax.nn.softmax(grp_logits, axis=-1)
    grp = jnp.argmax(grp_logits, axis=-1)
    grp_w = jnp.max(grp_prob, axis=-1, keepdims=True)
    exp_logits = ((xt @ w_re).astype(jnp.float32) + b_re.astype(jnp.float32)).reshape(T, N_GROUPS, EXPERTS_PER_GROUP)
    in_prob = jax.nn.softmax(exp_logits[tok, grp], axis=-1)
    top_p, top_i = lax.top_k(in_prob, TOP_K)
    gate = grp_w * top_p / jnp.sum(top_p, axis=-1, keepdims=True)
    expert = grp[:, None] * EXPERTS_PER_GROUP + top_i

    TK = T * TOP_K
    flat_e = expert.reshape(-1)
    flat_tok = jnp.repeat(tok.astype(jnp.int32), TOP_K)
    flat_w = gate.reshape(-1)
    order = jnp.argsort(flat_e)
    e_s, tok_s, w_s = flat_e[order], flat_tok[order], flat_w[order]
    counts = jnp.bincount(flat_e, length=N_EXPERTS)
    starts = jnp.cumsum(counts) - counts
    pcounts = ((counts + EXPERT_BLOCK - 1) // EXPERT_BLOCK) * EXPERT_BLOCK
    pends = jnp.cumsum(pcounts)
    pstarts = pends - pcounts
    dest = pstarts[e_s] + (jnp.arange(TK) - starts[e_s])
    NB = (TK + N_EXPERTS * (EXPERT_BLOCK - 1) + EXPERT_BLOCK - 1) // EXPERT_BLOCK
    P = NB * EXPERT_BLOCK
    buf_tok = jnp.full((P,), T, jnp.int32).at[dest].set(tok_s)
    buf_w = jnp.zeros((P,), jnp.float32).at[dest].set(w_s)
    blk_e = jnp.minimum(jnp.searchsorted(pends, jnp.arange(NB) * EXPERT_BLOCK, side='right'), N_EXPERTS - 1)
    x_pad = jnp.concatenate([xt, jnp.zeros((1, D), xt.dtype)], axis=0)
    xb = x_pad[buf_tok].reshape(NB, EXPERT_BLOCK, D)

    def expert_block(args):
        xblk, e = args
        hdn = jax.nn.silu(xblk @ w_gate[e]) * (xblk @ w_up[e])
        return hdn @ w_down[e]

    yb = lax.map(expert_block, (xb, blk_e)).reshape(P, D)
    y = jnp.zeros((T + 1, D), jnp.float32).at[buf_tok].add(yb.astype(jnp.float32) * buf_w[:, None])
    return y[:T].reshape(B, S, D).astype(xn.dtype)


def setup_inputs(seed: int = 0) -> dict:
    key = jax.random.key(seed)
    ks = jax.random.split(key, 32)
    f32 = jnp.float32
    L, D = DEPTH, D_MODEL

    def nrm(k, shape, scale):
        return jax.random.normal(k, shape, f32) * scale

    def gain(k, shape):
        return 1.0 + 0.05 * jax.random.normal(k, shape, f32)

    start = jax.random.randint(ks[2], (BATCH, 1), 0, 64, dtype=jnp.int32) * CHUNK
    positions = (start + jnp.arange(SEQ, dtype=jnp.int32)[None, :]).astype(jnp.int32)
    return {
        'x': nrm(ks[0], (BATCH, SEQ, D), 1.0),
        'mem': nrm(ks[1], (BATCH, N_MEM, D), 1.0),
        'positions': positions,
        'g_attn': gain(ks[3], (L, D)),
        'w_in': nrm(ks[4], (L, D, IN_COLS), D ** -0.5),
        'q_norm_g': gain(ks[5], (L, DIFF_QKDIM)),
        'k_norm_g': gain(ks[6], (L, DIFF_QKDIM)),
        'lambda_q1': nrm(ks[7], (L, DIFF_QKDIM), 0.1),
        'lambda_k1': nrm(ks[8], (L, DIFF_QKDIM), 0.1),
        'lambda_q2': nrm(ks[9], (L, DIFF_QKDIM), 0.1),
        'lambda_k2': nrm(ks[10], (L, DIFF_QKDIM), 0.1),
        'diff_subln_g': gain(ks[11], (L, DIFF_VDIM)),
        'gla_w_a2': nrm(ks[12], (L, GLA_GATE_RANK, GLA_HEADS * GLA_KDIM), GLA_GATE_RANK ** -0.5),
        'gla_b_a': nrm(ks[13], (L, GLA_HEADS * GLA_KDIM), 0.1),
        'gla_out_g': gain(ks[14], (L, GLA_VDIM)),
        'w_out': nrm(ks[15], (L, D_MIX, D), D_MIX ** -0.5),
        'g_cross': gain(ks[16], (L, D)),
        'g_mem': gain(ks[17], (L, D)),
        'w_cq': nrm(ks[18], (L, D, D), D ** -0.5),
        'w_ckv': nrm(ks[19], (L, D, 2 * D), D ** -0.5),
        'cq_norm_g': gain(ks[20], (L, CROSS_HDIM)),
        'ck_norm_g': gain(ks[21], (L, CROSS_HDIM)),
        'w_co': nrm(ks[22], (L, D, D), D ** -0.5),
        'g_ffn': gain(ks[23], (L, D)),
        'w_router_grp': nrm(ks[24], (L, D, N_GROUPS), D ** -0.5),
        'b_router_grp': nrm(ks[25], (L, N_GROUPS), 0.01),
        'w_router_exp': nrm(ks[26], (L, D, N_EXPERTS), D ** -0.5),
        'b_router_exp': nrm(ks[27], (L, N_EXPERTS), 0.01),
        'w_gate': nrm(ks[28], (L, N_EXPERTS, D, D_EXPERT), D ** -0.5),
        'w_up': nrm(ks[29], (L, N_EXPERTS, D, D_EXPERT), D ** -0.5),
        'w_down': nrm(ks[30], (L, N_EXPERTS, D_EXPERT, D), D_EXPERT ** -0.5),
    }


def reference(x, mem, positions, g_attn, w_in, q_norm_g, k_norm_g, lambda_q1, lambda_k1,
              lambda_q2, lambda_k2, diff_subln_g, gla_w_a2, gla_b_a, gla_out_g, w_out,
              g_cross, g_mem, w_cq, w_ckv, cq_norm_g, ck_norm_g, w_co, g_ffn,
              w_router_grp, b_router_grp, w_router_exp, b_router_exp, w_gate, w_up, w_down):
    B, S, D = x.shape
    h = x
    for l in range(DEPTH):
        n = rmsnorm(h, g_attn[l])
        dq, dk, dv, gq, gk, gv, g_lr, g_r = jnp.split(n @ w_in[l], _split_points(), axis=-1)
        dq = rope(rmsnorm(dq.reshape(B, S, DIFF_HEADS, 2, DIFF_QKDIM), q_norm_g[l]), positions)
        dk = rope(rmsnorm(dk.reshape(B, S, DIFF_HEADS, 2, DIFF_QKDIM), k_norm_g[l]), positions)
        dv = dv.reshape(B, S, DIFF_HEADS, DIFF_VDIM)
        lam_init = 0.8 - 0.6 * math.exp(-0.3 * l)
        lam = (jnp.exp(jnp.sum(lambda_q1[l] * lambda_k1[l]).astype(jnp.float32))
               - jnp.exp(jnp.sum(lambda_q2[l] * lambda_k2[l]).astype(jnp.float32)) + lam_init)
        d_out = diff_attention(dq, dk, dv, lam)
        d_out = rmsnorm(d_out, diff_subln_g[l]) * (1.0 - lam_init)

        log_a = jax.nn.log_sigmoid((g_lr @ gla_w_a2[l] + gla_b_a[l]).astype(jnp.float32)) / GLA_TAU
        g_out = gla(gq.reshape(B, S, GLA_HEADS, GLA_KDIM), gk.reshape(B, S, GLA_HEADS, GLA_KDIM),
                    gv.reshape(B, S, GLA_HEADS, GLA_VDIM), log_a.reshape(B, S, GLA_HEADS, GLA_KDIM))
        g_out = rmsnorm(g_out, gla_out_g[l]) * jax.nn.silu(g_r.reshape(B, S, GLA_HEADS, GLA_VDIM))

        mix = jnp.concatenate([d_out.reshape(B, S, DIFF_WIDTH), g_out.reshape(B, S, GLA_WIDTH)], axis=-1)
        h = h + mix @ w_out[l]

        h = h + cross_attention(rmsnorm(h, g_cross[l]), rmsnorm(mem, g_mem[l]),
                                w_cq[l], w_ckv[l], cq_norm_g[l], ck_norm_g[l], w_co[l])

        h = h + hmoe(rmsnorm(h, g_ffn[l]), w_router_grp[l], b_router_grp[l], w_router_exp[l],
                     b_router_exp[l], w_gate[l], w_up[l], w_down[l])
    return h
```

```cpp
#ifndef HOST_EMU
#include <hip/hip_runtime.h>
#else
#include <cstring>
struct EmuD3 { unsigned x, y, z; };
static EmuD3 blockIdx, threadIdx, blockDim, gridDim;
#define __global__ static
#define __device__ static
#define __host__
#define __forceinline__ inline
#define __launch_bounds__(...)
typedef int hipStream_t;
static inline int atomicAdd(int* p, int v) { int o = *p; *p += v; return o; }
static inline float atomicAdd(float* p, float v) { float o = *p; *p += v; return o; }
#endif
#include <cstdint>
#include <cstdio>
#include <cmath>

#ifndef CFG_D
#define CFG_D 2048
#define CFG_SEQ 4096
#define CFG_NMEM 256
#define CFG_ETILE 256
#endif
namespace cfg {
constexpr int D = CFG_D, B = 2, SEQ = CFG_SEQ, T = B * SEQ, CHUNK = 64, NC = SEQ / CHUNK;
constexpr int DH = 8, DVD = D / 16, DQK = D / 32;
constexpr int GH = 4, GVD = D / 8, GKD = D / 16, GRK = 16;
constexpr int NMEM = CFG_NMEM, CH = 4, CHD = D / 4;
constexpr int NE = 32, EPG = 8, NG = 4, DE = D / 4;
constexpr int ETILE = CFG_ETILE, PMAX = 2 * T + NE * ETILE, NTILE = PMAX / ETILE;
constexpr int NIN = 3 * D;
constexpr int IN_COLS = 3 * D + GRK;
constexpr int O_DQ = 0, O_DK = D / 2, O_DV = D, O_GQ = 3 * D / 2, O_GK = 7 * D / 4, O_GV = 2 * D, O_LR = 5 * D / 2, O_GR = 5 * D / 2 + GRK;
constexpr float EPS = 1e-6f;
constexpr float LOG2E = 1.4426950408889634f;
}
using namespace cfg;
typedef unsigned short bf16;

constexpr size_t al256(size_t x) { return (x + 255) & ~(size_t)255; }
constexpr size_t WS_CTL = 0, CTL_BYTES = 1u << 20;
constexpr size_t WS_WIN = WS_CTL + CTL_BYTES;
constexpr size_t WS_WLR = WS_WIN + al256((size_t)NIN * D * 2);
constexpr size_t WS_WOUT = WS_WLR + al256((size_t)GRK * D * 2);
constexpr size_t WS_WCQ = WS_WOUT + al256((size_t)D * D * 2);
constexpr size_t WS_WCKV = WS_WCQ + al256((size_t)D * D * 2);
constexpr size_t WS_WCO = WS_WCKV + al256((size_t)2 * D * D * 2);
constexpr size_t WS_WGU = WS_WCO + al256((size_t)D * D * 2);
constexpr size_t WS_WD = WS_WGU + al256((size_t)NE * 2 * DE * D * 2);
constexpr size_t WS_XN = WS_WD + al256((size_t)NE * D * DE * 2);
constexpr size_t WS_MEMN = WS_XN + al256((size_t)(T + 1) * D * 2);
constexpr size_t WS_SMALL = WS_MEMN + al256((size_t)B * NMEM * D * 2);
constexpr size_t SM_GLR = 0;
constexpr size_t SM_CQSS = SM_GLR + al256((size_t)T * GRK * 4);
constexpr size_t SM_EXPERT = SM_CQSS + al256((size_t)T * 8 * 4);
constexpr size_t SM_GATE = SM_EXPERT + al256((size_t)T * 2 * 4);
constexpr size_t SM_SLOTPOS = SM_GATE + al256((size_t)T * 2 * 4);
constexpr size_t SM_SLOTTOK = SM_SLOTPOS + al256((size_t)T * 2 * 4);
constexpr size_t SM_SLOTGATE = SM_SLOTTOK + al256((size_t)PMAX * 4);
constexpr size_t SM_ROPE = SM_SLOTGATE + al256((size_t)PMAX * 4);
constexpr size_t SM_CKV = SM_ROPE + al256((size_t)T * DQK * 4);
constexpr size_t SM_CK2 = SM_CKV + al256((size_t)B * NMEM * 2 * D * 2);
constexpr size_t SM_CVT = SM_CK2 + al256((size_t)B * NMEM * D * 2);
constexpr size_t SM_END = SM_CVT + al256((size_t)B * NMEM * D * 2);
constexpr size_t WS_B = WS_SMALL + al256(SM_END);
constexpr size_t B_DQ = 0, B_DK = B_DQ + (size_t)T * (D / 2) * 2, B_DV = B_DK + (size_t)T * (D / 2) * 2;
constexpr size_t B_GQ = B_DV + (size_t)T * (D / 2) * 2, B_GK = B_GQ + (size_t)T * (D / 4) * 2, B_GV = B_GK + (size_t)T * (D / 4) * 2, B_GR = B_GV + (size_t)T * (D / 2) * 2;
constexpr size_t B_END1 = B_GR + (size_t)T * (D / 2) * 2;
constexpr size_t B_CQ = 0, B_CO = B_CQ + (size_t)T * D * 2, B_HE = B_CO + (size_t)T * D * 2, B_END2 = B_HE + (size_t)PMAX * DE * 2;
constexpr size_t B_BYTES = al256(B_END1 > B_END2 ? B_END1 : B_END2);
constexpr size_t WS_C = WS_B + B_BYTES;
constexpr size_t WS_D = WS_C + al256((size_t)T * D * 2);
constexpr size_t WS_END = WS_D + al256((size_t)T * D * 3);

constexpr int CW_CNT = 64;
constexpr int CW_BASE = 128;
constexpr int CW_TILE_E = 256;
constexpr int CW_NTILES = 512;

__device__ __forceinline__ bf16 f2bf(float f) { unsigned u; memcpy(&u, &f, 4); u = (u + 0x7fffu + ((u >> 16) & 1u)) >> 16; return (bf16)u; }
__device__ __forceinline__ float bf2f(bf16 b) { unsigned u = ((unsigned)b) << 16; float f; memcpy(&f, &u, 4); return f; }
__device__ __forceinline__ float silu_f(float x) { return x / (1.f + expf(-x)); }
__device__ __forceinline__ size_t gtid() { return (size_t)blockIdx.x * blockDim.x + threadIdx.x; }
struct bf16x8s { bf16 v[8]; };

__global__ void nk_rmsnorm_rows(const float* x, const float* g, bf16* out, int rows, int d) {
    size_t r = gtid(); if (r >= (size_t)rows) return;
    const float* xr = x + r * d; float ss = 0.f;
    for (int i = 0; i < d; ++i) ss += xr[i] * xr[i];
    const float rs = 1.0f / sqrtf(ss / d + EPS);
    for (int i = 0; i < d; ++i) out[r * d + i] = f2bf(xr[i] * rs * g[i]);
}
__global__ void nk_zero_bf16(bf16* p, size_t n) { size_t i = gtid(); if (i < n) p[i] = 0; }
__global__ void nk_convT(const float* W, int ldw, int col0, bf16* WT, int N, int K) {
    size_t i = gtid(); if (i >= (size_t)N * K) return;
    const int n = (int)(i / K), k = (int)(i % K);
    WT[i] = f2bf(W[(size_t)k * ldw + col0 + n]);
}
constexpr int GUH = (DE >= 128) ? 128 : DE;
__global__ void nk_conv_gu(const float* Wg, const float* Wu, bf16* WGU) {
    size_t i = gtid(); if (i >= (size_t)NE * 2 * DE * D) return;
    const int k = (int)(i % D); const int r = (int)((i / D) % (2 * DE)); const int e = (int)(i / ((size_t)D * 2 * DE));
    const int pn = r / (2 * GUH), ii = r % (2 * GUH); const int j = pn * GUH + (ii % GUH);
    const float* W = (ii < GUH) ? Wg : Wu;
    WGU[i] = f2bf(W[((size_t)e * D + k) * DE + j]);
}
__global__ void nk_conv_d(const float* Wd, bf16* WD) {
    size_t i = gtid(); if (i >= (size_t)NE * D * DE) return;
    const int j = (int)(i % DE); const int n = (int)((i / DE) % D); const int e = (int)(i / ((size_t)D * DE));
    WD[i] = f2bf(Wd[((size_t)e * DE + j) * D + n]);
}
__global__ void nk_rope_table(const int* positions, float* tab) {
    size_t i = gtid(); constexpr int half = DQK / 2; if (i >= (size_t)T * half) return;
    const int t = (int)(i / half), j = (int)(i % half);
    const float freq = powf(10000.0f, -(float)j / (float)half);
    const float ang = (float)positions[t] * freq;
    tab[i * 2] = cosf(ang); tab[i * 2 + 1] = sinf(ang);
}

struct GemmP { const bf16* A; const bf16* Bt; int M, N, K, pad; float* f0; float* f1; bf16* b0; const float* x; };
template <int MODE> __device__ __forceinline__ void gemm_epi(const GemmP& p, int m, int n, float acc) {
    if constexpr (MODE == 0) {
        bf16* Bb = p.b0;
        if (n < D) { p.f0[(size_t)m * D + n] = acc; return; }
        if (n < O_GQ) { ((bf16*)((char*)Bb + B_DV))[(size_t)m * (D / 2) + (n - O_DV)] = f2bf(acc); return; }
        if (n < O_GK) { ((bf16*)((char*)Bb + B_GQ))[(size_t)m * (D / 4) + (n - O_GQ)] = f2bf(acc * (1.0f / sqrtf((float)GKD))); return; }
        if (n < O_GV) { ((bf16*)((char*)Bb + B_GK))[(size_t)m * (D / 4) + (n - O_GK)] = f2bf(acc); return; }
        if (n < O_LR) { ((bf16*)((char*)Bb + B_GV))[(size_t)m * (D / 2) + (n - O_GV)] = f2bf(acc); return; }
        ((bf16*)((char*)Bb + B_GR))[(size_t)m * (D / 2) + (n - O_LR)] = f2bf(acc);
    } else if constexpr (MODE == 1) { p.f0[(size_t)m * p.N + n] = p.x[(size_t)m * p.N + n] + acc;
    } else if constexpr (MODE == 2) { p.b0[(size_t)m * p.N + n] = f2bf(acc);
    } else if constexpr (MODE == 4) { p.f0[(size_t)m * p.N + n] += acc;
    } else { p.f0[(size_t)m * p.N + n] = acc; }
}
template <int MODE> __global__ void nk_gemm(GemmP p) {
    size_t idx = gtid(); const int nb = p.N / 4; if (idx >= (size_t)(p.M / 4) * nb) return;
    const int m0 = 4 * (int)(idx / nb), n0 = 4 * (int)(idx % nb);
    float acc[4][4];
#pragma unroll
    for (int i = 0; i < 4; ++i)
#pragma unroll
        for (int j = 0; j < 4; ++j) acc[i][j] = 0.f;
    for (int k = 0; k < p.K; k += 8) {
        bf16x8s a[4], b[4];
#pragma unroll
        for (int i = 0; i < 4; ++i) { a[i] = *(const bf16x8s*)(p.A + (size_t)(m0 + i) * p.K + k); b[i] = *(const bf16x8s*)(p.Bt + (size_t)(n0 + i) * p.K + k); }
#pragma unroll
        for (int kk = 0; kk < 8; ++kk) {
            float af[4], bfv[4];
#pragma unroll
            for (int i = 0; i < 4; ++i) { af[i] = bf2f(a[i].v[kk]); bfv[i] = bf2f(b[i].v[kk]); }
#pragma unroll
            for (int i = 0; i < 4; ++i)
#pragma unroll
                for (int j = 0; j < 4; ++j) acc[i][j] += af[i] * bfv[j];
        }
    }
#pragma unroll
    for (int i = 0; i < 4; ++i)
#pragma unroll
        for (int j = 0; j < 4; ++j) gemm_epi<MODE>(p, m0 + i, n0 + j, acc[i][j]);
}

__global__ void nk_qk_post(const float* tmpqk, const float* qg, const float* kg, const float* rope, bf16* DQ, bf16* DK) {
    size_t i = gtid(); if (i >= (size_t)T * 2 * DH * 2) return;
    const int c = (int)(i % 2), h = (int)((i / 2) % DH), which = (int)((i / (2 * DH)) % 2), t = (int)(i / (4 * DH));
    const float* src = tmpqk + (size_t)t * D + which * (D / 2) + h * 2 * DQK + c * DQK;
    const float* g = which ? kg : qg; bf16* dst = (which ? DK : DQ) + (size_t)t * (D / 2) + h * 2 * DQK + c * DQK;
    float ss = 0.f; for (int d = 0; d < DQK; ++d) ss += src[d] * src[d];
    const float rs = 1.0f / sqrtf(ss / DQK + EPS); constexpr int half = DQK / 2;
    const float sc = which ? 1.0f : (1.0f / sqrtf((float)DQK)) * LOG2E;
    for (int d = 0; d < half; ++d) {
        const float t1 = src[d] * rs * g[d], t2 = src[d + half] * rs * g[d + half];
        const float cs = rope[((size_t)t * half + d) * 2], sn = rope[((size_t)t * half + d) * 2 + 1];
        dst[d] = f2bf((t1 * cs - t2 * sn) * sc); dst[d + half] = f2bf((t2 * cs + t1 * sn) * sc);
    }
}
__global__ void nk_lam(const float* q1, const float* k1, const float* q2, const float* k2, float* out) {
    if (gtid() != 0) return; float a = 0.f, b = 0.f; for (int i = 0; i < DQK; ++i) { a += q1[i] * k1[i]; b += q2[i] * k2[i]; }
    out[0] = expf(a) - expf(b) + 0.2f;
}
__global__ void __launch_bounds__(256) nk_diff_stats(const bf16* DQ, const bf16* DK, float* stats) {
    size_t i = gtid(); if (i >= (size_t)T * DH * 2) return;
    const int c = (int)(i % 2), h = (int)((i / 2) % DH), t = (int)(i / (2 * DH)); const int b = t / SEQ, s = t % SEQ;
    const int nk = (s / CHUNK + 1) * CHUNK;
    float q[DQK]; const bf16* qp = DQ + (size_t)t * (D / 2) + h * 2 * DQK + c * DQK;
#pragma unroll
    for (int d = 0; d < DQK; ++d) q[d] = bf2f(qp[d]);
    float mx = -1e30f;
    for (int k = 0; k < nk; ++k) { const bf16* kp = DK + (size_t)(b * SEQ + k) * (D / 2) + h * 2 * DQK + c * DQK; float sdot = 0.f;
#pragma unroll
        for (int d = 0; d < DQK; ++d) sdot += q[d] * bf2f(kp[d]);
        mx = fmaxf(mx, sdot); }
    float sum = 0.f;
    for (int k = 0; k < nk; ++k) { const bf16* kp = DK + (size_t)(b * SEQ + k) * (D / 2) + h * 2 * DQK + c * DQK; float sdot = 0.f;
#pragma unroll
        for (int d = 0; d < DQK; ++d) sdot += q[d] * bf2f(kp[d]);
        sum += exp2f(sdot - mx); }
    stats[i * 2] = mx; stats[i * 2 + 1] = sum;
}
__global__ void __launch_bounds__(256) nk_diff_pv(const bf16* DQ, const bf16* DK, const bf16* DV, const float* stats, const float* lamp, float* otmp) {
    constexpr int DG = DVD / 4;
    size_t i = gtid(); if (i >= (size_t)T * DH * 4) return;
    const int dg = (int)(i % 4), h = (int)((i / 4) % DH), t = (int)(i / (4 * DH)); const int b = t / SEQ, s = t % SEQ;
    const int nk = (s / CHUNK + 1) * CHUNK; const float lam = lamp[0];
    float q[2 * DQK]; const bf16* qp = DQ + (size_t)t * (D / 2) + h * 2 * DQK;
#pragma unroll
    for (int d = 0; d < 2 * DQK; ++d) q[d] = bf2f(qp[d]);
    const float m0 = stats[((size_t)(t * DH + h) * 2 + 0) * 2], l0 = stats[((size_t)(t * DH + h) * 2 + 0) * 2 + 1];
    const float m1 = stats[((size_t)(t * DH + h) * 2 + 1) * 2], l1 = stats[((size_t)(t * DH + h) * 2 + 1) * 2 + 1];
    float acc[DG];
#pragma unroll
    for (int d = 0; d < DG; ++d) acc[d] = 0.f;
    for (int k = 0; k < nk; ++k) { const bf16* kp = DK + (size_t)(b * SEQ + k) * (D / 2) + h * 2 * DQK; float s0 = 0.f, s1 = 0.f;
#pragma unroll
        for (int d = 0; d < DQK; ++d) { s0 += q[d] * bf2f(kp[d]); s1 += q[DQK + d] * bf2f(kp[DQK + d]); }
        const float a = exp2f(s0 - m0) / l0 - lam * exp2f(s1 - m1) / l1;
        const bf16* vp = DV + (size_t)(b * SEQ + k) * (D / 2) + h * DVD + dg * DG;
#pragma unroll
        for (int d = 0; d < DG; ++d) acc[d] += a * bf2f(vp[d]); }
#pragma unroll
    for (int d = 0; d < DG; ++d) otmp[(size_t)t * (D / 2) + h * DVD + dg * DG + d] = acc[d];
}
__global__ void nk_diff_norm(const float* otmp, const float* g, bf16* MIX) {
    size_t i = gtid(); if (i >= (size_t)T * DH) return; const int h = (int)(i % DH), t = (int)(i / DH);
    const float* o = otmp + (size_t)t * (D / 2) + h * DVD; float ss = 0.f; for (int d = 0; d < DVD; ++d) ss += o[d] * o[d];
    const float rs = 1.0f / sqrtf(ss / DVD + EPS);
    for (int d = 0; d < DVD; ++d) MIX[(size_t)t * D + h * DVD + d] = f2bf(o[d] * rs * g[d] * 0.8f);
}
__global__ void nk_gla_cum(const float* GLR, const float* wa2, const float* ba, float* CUM) {
    size_t i = gtid(); constexpr int W = GH * GKD; if (i >= (size_t)B * NC * W) return;
    const int j = (int)(i % W), cb = (int)(i / W); float run = 0.f;
    for (int tt = 0; tt < CHUNK; ++tt) { const int t = cb * CHUNK + tt; float z = ba[j];
        for (int r = 0; r < GRK; ++r) z += GLR[(size_t)t * GRK + r] * wa2[(size_t)r * W + j];
        const float ls = fminf(z, 0.f) - log1pf(expf(-fabsf(z)));
        run += ls * (1.0f / 16.0f); CUM[(size_t)t * W + j] = run; }
}
__global__ void __launch_bounds__(256) nk_gla_run(const bf16* GQ, const bf16* GK, const bf16* GV, const float* CUM, float* otmp) {
    size_t i = gtid(); if (i >= (size_t)B * GH * GVD) return;
    const int v = (int)(i % GVD), h = (int)((i / GVD) % GH), b = (int)(i / (GVD * GH)); constexpr int W = GH * GKD;
    float S[GKD];
#pragma unroll
    for (int k = 0; k < GKD; ++k) S[k] = 0.f;
    for (int c = 0; c < NC; ++c) { const int t0 = b * SEQ + c * CHUNK; const float* ce = CUM + (size_t)(t0 + CHUNK - 1) * W + h * GKD;
#pragma unroll
        for (int k = 0; k < GKD; ++k) S[k] *= expf(ce[k]);
        for (int tt = 0; tt < CHUNK; ++tt) { const int t = t0 + tt; const float vv = bf2f(GV[(size_t)t * (D / 2) + h * GVD + v]);
            const bf16* kp = GK + (size_t)t * (D / 4) + h * GKD; const float* cp = CUM + (size_t)t * W + h * GKD;
#pragma unroll
            for (int k = 0; k < GKD; ++k) S[k] += bf2f(kp[k]) * expf(ce[k] - cp[k]) * vv; }
        for (int tt = 0; tt < CHUNK; ++tt) { const int t = t0 + tt; const bf16* qp = GQ + (size_t)t * (D / 4) + h * GKD; float o = 0.f;
#pragma unroll
            for (int k = 0; k < GKD; ++k) o += bf2f(qp[k]) * S[k];
            otmp[(size_t)t * (D / 2) + h * GVD + v] = o; } }
}
__global__ void nk_gla_norm(const float* otmp, const float* g, const bf16* GR, bf16* MIX) {
    size_t i = gtid(); if (i >= (size_t)T * GH) return; const int h = (int)(i % GH), t = (int)(i / GH);
    const float* o = otmp + (size_t)t * (D / 2) + h * GVD; float ss = 0.f; for (int d = 0; d < GVD; ++d) ss += o[d] * o[d];
    const float rs = 1.0f / sqrtf(ss / GVD + EPS);
    for (int d = 0; d < GVD; ++d) MIX[(size_t)t * D + D / 2 + h * GVD + d] = f2bf(o[d] * rs * g[d] * silu_f(bf2f(GR[(size_t)t * (D / 2) + h * GVD + d])));
}
__global__ void nk_cqss(const bf16* CQ, float* CQSS) {
    size_t i = gtid(); if (i >= (size_t)T * 8) return; const int j = (int)(i % 8), t = (int)(i / 8);
    float ss = 0.f; for (int d = 0; d < D / 8; ++d) { const float v = bf2f(CQ[(size_t)t * D + j * (D / 8) + d]); ss += v * v; } CQSS[i] = ss;
}
__global__ void nk_ckv_fix(const bf16* CKV, const float* qg, const float* kg, bf16* CK2, bf16* CVT) {
    size_t i = gtid(); if (i >= (size_t)B * NMEM * CH) return; const int h = (int)(i % CH), bm = (int)(i / CH); const int b = bm / NMEM, m = bm % NMEM;
    const bf16* kp = CKV + (size_t)bm * 2 * D + h * CHD; const bf16* vp = CKV + (size_t)bm * 2 * D + D + h * CHD;
    float ss = 0.f; for (int d = 0; d < CHD; ++d) { const float v = bf2f(kp[d]); ss += v * v; }
    const float rs = 1.0f / sqrtf(ss / CHD + EPS) * (1.0f / sqrtf((float)CHD)) * LOG2E;
    for (int d = 0; d < CHD; ++d) { CK2[(((size_t)b * CH + h) * NMEM + m) * CHD + d] = f2bf(bf2f(kp[d]) * rs * kg[d] * qg[d]);
        CVT[(((size_t)b * CH + h) * CHD + d) * NMEM + m] = vp[d]; }
}
__global__ void nk_cross_scores(const bf16* CQ, const float* CQSS, const bf16* CK2, float* P) {
    size_t i = gtid(); if (i >= (size_t)T * CH * NMEM) return; const int m = (int)(i % NMEM), h = (int)((i / NMEM) % CH), t = (int)(i / (NMEM * CH)); const int b = t / SEQ;
    const float rq = 1.0f / sqrtf((CQSS[(size_t)t * 8 + 2 * h] + CQSS[(size_t)t * 8 + 2 * h + 1]) / CHD + EPS);
    const bf16* qp = CQ + (size_t)t * D + h * CHD; const bf16* kp = CK2 + (((size_t)b * CH + h) * NMEM + m) * CHD; float s = 0.f;
    for (int d = 0; d < CHD; ++d) s += bf2f(qp[d]) * bf2f(kp[d]);
    P[i] = s * rq;
}
__global__ void nk_cross_softmax(float* P) {
    size_t i = gtid(); if (i >= (size_t)T * CH) return; float* p = P + i * NMEM; float mx = -1e30f;
    for (int m = 0; m < NMEM; ++m) mx = fmaxf(mx, p[m]); float sum = 0.f;
    for (int m = 0; m < NMEM; ++m) { p[m] = exp2f(p[m] - mx); sum += p[m]; }
    for (int m = 0; m < NMEM; ++m) p[m] /= sum;
}
__global__ void nk_cross_pv(const float* P, const bf16* CVT, bf16* CO) {
    size_t i = gtid(); if (i >= (size_t)T * D) return; const int d = (int)(i % CHD), h = (int)((i / CHD) % CH), t = (int)(i / D); const int b = t / SEQ;
    const float* p = P + ((size_t)t * CH + h) * NMEM; const bf16* vp = CVT + (((size_t)b * CH + h) * CHD + d) * NMEM; float o = 0.f;
    for (int m = 0; m < NMEM; ++m) o += p[m] * bf2f(vp[m]);
    CO[i] = f2bf(o);
}
__global__ void nk_router(const float* h2, const float* g, const float* wrg, const float* brg, const float* wre, const float* bre, bf16* XN, int* EXPERT, float* GATE, int* SLOTPOS, int* ctl) {
    size_t t = gtid(); if (t >= (size_t)T) return; const float* xr = h2 + t * D; float ss = 0.f;
    for (int i = 0; i < D; ++i) ss += xr[i] * xr[i]; const float rs = 1.0f / sqrtf(ss / D + EPS);
    float gl[NG], el[NE];
#pragma unroll
    for (int j = 0; j < NG; ++j) gl[j] = brg[j];
#pragma unroll
    for (int j = 0; j < NE; ++j) el[j] = bre[j];
    for (int i = 0; i < D; ++i) { const float xv = xr[i] * rs * g[i]; XN[t * D + i] = f2bf(xv);
#pragma unroll
        for (int j = 0; j < NG; ++j) gl[j] += xv * wrg[(size_t)i * NG + j];
#pragma unroll
        for (int j = 0; j < NE; ++j) el[j] += xv * wre[(size_t)i * NE + j]; }
    int grp = 0; float gm = gl[0];
#pragma unroll
    for (int j = 1; j < NG; ++j) if (gl[j] > gm) { gm = gl[j]; grp = j; }
    float gs = 0.f;
#pragma unroll
    for (int j = 0; j < NG; ++j) gs += expf(gl[j] - gm);
    const float grp_w = 1.0f / gs;
    float e8[EPG];
#pragma unroll
    for (int j = 0; j < EPG; ++j) { float v = 0.f;
#pragma unroll
        for (int gq = 0; gq < NG; ++gq) v = (grp == gq) ? el[gq * EPG + j] : v;
        e8[j] = v; }
    int i0 = 0; float v0 = e8[0];
#pragma unroll
    for (int j = 1; j < EPG; ++j) if (e8[j] > v0) { v0 = e8[j]; i0 = j; }
    int i1 = -1; float v1 = -1e30f;
#pragma unroll
    for (int j = 0; j < EPG; ++j) if (j != i0 && e8[j] > v1) { v1 = e8[j]; i1 = j; }
    const float r = expf(v1 - v0); const float g0 = grp_w / (1.f + r), g1 = grp_w * r / (1.f + r);
    const int e0 = grp * EPG + i0, e1 = grp * EPG + i1;
    EXPERT[t * 2] = e0; EXPERT[t * 2 + 1] = e1; GATE[t * 2] = g0; GATE[t * 2 + 1] = g1;
    SLOTPOS[t * 2] = atomicAdd(&ctl[CW_CNT + e0], 1); SLOTPOS[t * 2 + 1] = atomicAdd(&ctl[CW_CNT + e1], 1);
}
__global__ void nk_moe_offsets(int* ctl) {
    if (gtid() != 0) return; int base = 0, nt = 0;
    for (int e = 0; e < NE; ++e) { ctl[CW_BASE + e] = base; const int n = (ctl[CW_CNT + e] + ETILE - 1) / ETILE; for (int j = 0; j < n; ++j) ctl[CW_TILE_E + nt + j] = e; nt += n; base += n * ETILE; }
    ctl[CW_BASE + NE] = base; ctl[CW_NTILES] = nt; for (int j = nt; j < NTILE; ++j) ctl[CW_TILE_E + j] = -1;
}
__global__ void nk_moe_init_slots(int* SLOTTOK, float* SLOTGATE) { size_t i = gtid(); if (i < (size_t)PMAX) { SLOTTOK[i] = T; SLOTGATE[i] = 0.f; } }
__global__ void nk_moe_fill(const int* EXPERT, const float* GATE, const int* SLOTPOS, const int* ctl, int* SLOTTOK, float* SLOTGATE) {
    size_t i = gtid(); if (i >= (size_t)T * 2) return; const int e = EXPERT[i]; const int dst = ctl[CW_BASE + e] + SLOTPOS[i];
    SLOTTOK[dst] = (int)(i / 2); SLOTGATE[dst] = GATE[i];
}
__global__ void nk_moe_gu(const bf16* XN, const bf16* WGU, const int* SLOTTOK, const int* ctl, bf16* HE) {
    size_t i = gtid(); if (i >= (size_t)PMAX * DE) return; const int j = (int)(i % DE), p = (int)(i / DE); const int e = ctl[CW_TILE_E + p / ETILE];
    if (e < 0) return; const int tok = SLOTTOK[p];
    const int pn = j / GUH, jj = j % GUH; const bf16* wg = WGU + ((size_t)e * 2 * DE + pn * 2 * GUH + jj) * D; const bf16* wu = wg + (size_t)GUH * D;
    const bf16* xr = XN + (size_t)tok * D; float g = 0.f, u = 0.f;
    for (int k = 0; k < D; ++k) { const float xv = bf2f(xr[k]); g += xv * bf2f(wg[k]); u += xv * bf2f(wu[k]); }
    HE[i] = f2bf(silu_f(g) * u);
}
__global__ void nk_moe_down(const bf16* HE, const bf16* WD, const int* SLOTTOK, const float* SLOTGATE, const int* ctl, float* out) {
    size_t i = gtid(); if (i >= (size_t)PMAX * D) return; const int n = (int)(i % D), p = (int)(i / D); const int e = ctl[CW_TILE_E + p / ETILE];
    if (e < 0) return; const int tok = SLOTTOK[p]; if (tok >= T) return;
    const bf16* hr = HE + (size_t)p * DE; const bf16* wr = WD + ((size_t)e * D + n) * DE; float y = 0.f;
    for (int k = 0; k < DE; ++k) y += bf2f(hr[k]) * bf2f(wr[k]);
    atomicAdd(&out[(size_t)tok * D + n], y * SLOTGATE[p]);
}

#ifdef HOST_EMU
template <class F, class... A> static void emu_launch(F f, size_t n, A... a) { const unsigned blk = 256; const unsigned g = (unsigned)((n + blk - 1) / blk); gridDim = {g, 1, 1}; blockDim = {blk, 1, 1};
    for (unsigned b = 0; b < g; ++b) for (unsigned t = 0; t < blk; ++t) { blockIdx.x = b; threadIdx.x = t; f(a...); } }
#define LAUNCH(k, n, stream, ...) emu_launch(k, (size_t)(n), __VA_ARGS__)
#define MEMSET0(p, bytes, stream) memset(p, 0, bytes)
#else
#define LAUNCH(k, n, stream, ...) hipLaunchKernelGGL(k, dim3((unsigned)(((size_t)(n) + 255) / 256)), dim3(256), 0, stream, __VA_ARGS__)
#define MEMSET0(p, bytes, stream) (void)hipMemsetAsync(p, 0, bytes, stream)
#endif

extern "C" void kernel_launch(void* const* d_in, const int* in_sizes, int n_in, void* d_out, int out_size, void* d_ws, size_t ws_size, hipStream_t stream) {
    if (n_in != 31 || out_size != T * D || ws_size < WS_END) { fprintf(stderr, "kernel_launch: unexpected shapes (n_in %d out %d ws %zu need %zu)\n", n_in, out_size, ws_size, (size_t)WS_END); return; }
    (void)in_sizes;
    const float* x = (const float*)d_in[0]; const float* mem = (const float*)d_in[1]; const int* positions = (const int*)d_in[2];
    const float* g_attn = (const float*)d_in[3]; const float* w_in = (const float*)d_in[4]; const float* q_norm_g = (const float*)d_in[5]; const float* k_norm_g = (const float*)d_in[6];
    const float* lq1 = (const float*)d_in[7]; const float* lk1 = (const float*)d_in[8]; const float* lq2 = (const float*)d_in[9]; const float* lk2 = (const float*)d_in[10];
    const float* subln_g = (const float*)d_in[11]; const float* w_a2 = (const float*)d_in[12]; const float* b_a = (const float*)d_in[13]; const float* gla_out_g = (const float*)d_in[14];
    const float* w_out = (const float*)d_in[15]; const float* g_cross = (const float*)d_in[16]; const float* g_mem = (const float*)d_in[17]; const float* w_cq = (const float*)d_in[18];
    const float* w_ckv = (const float*)d_in[19]; const float* cq_g = (const float*)d_in[20]; const float* ck_g = (const float*)d_in[21]; const float* w_co = (const float*)d_in[22];
    const float* g_ffn = (const float*)d_in[23]; const float* w_rg = (const float*)d_in[24]; const float* b_rg = (const float*)d_in[25]; const float* w_re = (const float*)d_in[26];
    const float* b_re = (const float*)d_in[27]; const float* w_gate = (const float*)d_in[28]; const float* w_up = (const float*)d_in[29]; const float* w_down = (const float*)d_in[30];
    float* out = (float*)d_out; char* ws = (char*)d_ws;
    int* ctl = (int*)(ws + WS_CTL); float* lamp = (float*)(ctl + 16);
    bf16 *WIN = (bf16*)(ws + WS_WIN), *WLR = (bf16*)(ws + WS_WLR), *WOUT = (bf16*)(ws + WS_WOUT), *WCQ = (bf16*)(ws + WS_WCQ), *WCKV = (bf16*)(ws + WS_WCKV), *WCO = (bf16*)(ws + WS_WCO);
    bf16 *WGU = (bf16*)(ws + WS_WGU), *WD = (bf16*)(ws + WS_WD), *XN = (bf16*)(ws + WS_XN), *MEMN = (bf16*)(ws + WS_MEMN);
    char* sm = ws + WS_SMALL;
    float* GLR = (float*)(sm + SM_GLR); float* CQSS = (float*)(sm + SM_CQSS); int* EXPERT = (int*)(sm + SM_EXPERT); float* GATE = (float*)(sm + SM_GATE); int* SLOTPOS = (int*)(sm + SM_SLOTPOS);
    int* SLOTTOK = (int*)(sm + SM_SLOTTOK); float* SLOTGATE = (float*)(sm + SM_SLOTGATE); float* ROPE = (float*)(sm + SM_ROPE);
    bf16 *CKV = (bf16*)(sm + SM_CKV), *CK2 = (bf16*)(sm + SM_CK2), *CVT = (bf16*)(sm + SM_CVT);
    char* rb = ws + WS_B;
    bf16 *DQ = (bf16*)(rb + B_DQ), *DK = (bf16*)(rb + B_DK), *DV = (bf16*)(rb + B_DV), *GQ = (bf16*)(rb + B_GQ), *GK = (bf16*)(rb + B_GK), *GV = (bf16*)(rb + B_GV), *GRb = (bf16*)(rb + B_GR);
    bf16 *CQ = (bf16*)(rb + B_CQ), *CO = (bf16*)(rb + B_CO), *HE = (bf16*)(rb + B_HE);
    bf16* MIX = (bf16*)(ws + WS_C);
    float* TMPQK = (float*)(ws + WS_C);
    float* PTMP = (float*)(ws + WS_C);
    float* CUM = (float*)(ws + WS_D);
    float* OTMP = (float*)(ws + WS_D + al256((size_t)T * (D / 4) * 4));
    float* STATS = (float*)(ws + WS_D);

    MEMSET0(ws + WS_CTL, CTL_BYTES, stream);
    LAUNCH(nk_convT, (size_t)(5 * D / 2) * D, stream, w_in, IN_COLS, 0, WIN, 5 * D / 2, D);
    LAUNCH(nk_convT, (size_t)(D / 2) * D, stream, w_in, IN_COLS, O_GR, WIN + (size_t)(5 * D / 2) * D, D / 2, D);
    LAUNCH(nk_convT, (size_t)GRK * D, stream, w_in, IN_COLS, O_LR, WLR, GRK, D);
    LAUNCH(nk_convT, (size_t)D * D, stream, w_out, D, 0, WOUT, D, D);
    LAUNCH(nk_convT, (size_t)D * D, stream, w_cq, D, 0, WCQ, D, D);
    LAUNCH(nk_convT, (size_t)2 * D * D, stream, w_ckv, 2 * D, 0, WCKV, 2 * D, D);
    LAUNCH(nk_convT, (size_t)D * D, stream, w_co, D, 0, WCO, D, D);
    LAUNCH(nk_conv_gu, (size_t)NE * 2 * DE * D, stream, w_gate, w_up, WGU);
    LAUNCH(nk_conv_d, (size_t)NE * D * DE, stream, w_down, WD);
    LAUNCH(nk_rope_table, (size_t)T * (DQK / 2), stream, positions, ROPE);
    LAUNCH(nk_lam, 1, stream, lq1, lk1, lq2, lk2, lamp);
    LAUNCH(nk_zero_bf16, (size_t)D, stream, XN + (size_t)T * D, (size_t)D);
    LAUNCH(nk_rmsnorm_rows, T, stream, x, g_attn, XN, T, D);
    LAUNCH(nk_rmsnorm_rows, B * NMEM, stream, mem, g_mem, MEMN, B * NMEM, D);
    { GemmP p{XN, WIN, T, NIN, D, 0, TMPQK, nullptr, (bf16*)rb, nullptr}; LAUNCH(nk_gemm<0>, (size_t)(T / 4) * (NIN / 4), stream, p); }
    { GemmP p{XN, WLR, T, GRK, D, 0, GLR, nullptr, nullptr, nullptr}; LAUNCH(nk_gemm<5>, (size_t)(T / 4) * (GRK / 4), stream, p); }
    LAUNCH(nk_qk_post, (size_t)T * 4 * DH, stream, TMPQK, q_norm_g, k_norm_g, ROPE, DQ, DK);
    { GemmP p{MEMN, WCKV, B * NMEM, 2 * D, D, 0, nullptr, nullptr, CKV, nullptr}; LAUNCH(nk_gemm<2>, (size_t)(B * NMEM / 4) * (2 * D / 4), stream, p); }
    LAUNCH(nk_ckv_fix, (size_t)B * NMEM * CH, stream, CKV, cq_g, ck_g, CK2, CVT);
    LAUNCH(nk_diff_stats, (size_t)T * DH * 2, stream, DQ, DK, STATS);
    LAUNCH(nk_diff_pv, (size_t)T * DH * 4, stream, DQ, DK, DV, STATS, lamp, OTMP);
    LAUNCH(nk_diff_norm, (size_t)T * DH, stream, OTMP, subln_g, MIX);
    LAUNCH(nk_gla_cum, (size_t)B * NC * GH * GKD, stream, GLR, w_a2, b_a, CUM);
    LAUNCH(nk_gla_run, (size_t)B * GH * GVD, stream, GQ, GK, GV, CUM, OTMP);
    LAUNCH(nk_gla_norm, (size_t)T * GH, stream, OTMP, gla_out_g, GRb, MIX);
    { GemmP p{MIX, WOUT, T, D, D, 0, out, nullptr, nullptr, x}; LAUNCH(nk_gemm<1>, (size_t)(T / 4) * (D / 4), stream, p); }
    LAUNCH(nk_rmsnorm_rows, T, stream, out, g_cross, XN, T, D);
    { GemmP p{XN, WCQ, T, D, D, 0, nullptr, nullptr, CQ, nullptr}; LAUNCH(nk_gemm<2>, (size_t)(T / 4) * (D / 4), stream, p); }
    LAUNCH(nk_cqss, (size_t)T * 8, stream, CQ, CQSS);
    LAUNCH(nk_cross_scores, (size_t)T * CH * NMEM, stream, CQ, CQSS, CK2, PTMP);
    LAUNCH(nk_cross_softmax, (size_t)T * CH, stream, PTMP);
    LAUNCH(nk_cross_pv, (size_t)T * D, stream, PTMP, CVT, CO);
    { GemmP p{CO, WCO, T, D, D, 0, out, nullptr, nullptr, nullptr}; LAUNCH(nk_gemm<4>, (size_t)(T / 4) * (D / 4), stream, p); }
    LAUNCH(nk_router, T, stream, out, g_ffn, w_rg, b_rg, w_re, b_re, XN, EXPERT, GATE, SLOTPOS, ctl);
    LAUNCH(nk_moe_offsets, 1, stream, ctl);
    LAUNCH(nk_moe_init_slots, PMAX, stream, SLOTTOK, SLOTGATE);
    LAUNCH(nk_moe_fill, (size_t)T * 2, stream, EXPERT, GATE, SLOTPOS, ctl, SLOTTOK, SLOTGATE);
    LAUNCH(nk_moe_gu, (size_t)PMAX * DE, stream, XN, WGU, SLOTTOK, ctl, HE);
    LAUNCH(nk_moe_down, (size_t)PMAX * D, stream, HE, WD, SLOTTOK, SLOTGATE, ctl, out);
}
```

```cpp
#ifndef HOST_EMU
#include <hip/hip_runtime.h>
#else
#include <cstring>
struct EmuD3 { unsigned x, y, z; };
static EmuD3 blockIdx, threadIdx, blockDim, gridDim;
static size_t emu_tid, emu_nth;
#define __global__ static
#define __device__ static
#define __host__
#define __forceinline__ inline
#define __launch_bounds__(...)
typedef int hipStream_t;
static inline int atomicAdd(int* p, int v) { int o = *p; *p += v; return o; }
static inline float atomicAdd(float* p, float v) { float o = *p; *p += v; return o; }
#endif
#include <cstdint>
#include <cstdio>
#include <cmath>

#ifndef CFG_D
#define CFG_D 2048
#define CFG_SEQ 4096
#define CFG_NMEM 256
#define CFG_ETILE 256
#endif
namespace cfg {
constexpr int D = CFG_D, B = 2, SEQ = CFG_SEQ, T = B * SEQ, CHUNK = 64, NC = SEQ / CHUNK;
constexpr int DH = 8, DVD = D / 16, DQK = D / 32;
constexpr int GH = 4, GVD = D / 8, GKD = D / 16, GRK = 16;
constexpr int NMEM = CFG_NMEM, CH = 4, CHD = D / 4;
constexpr int NE = 32, EPG = 8, NG = 4, DE = D / 4;
constexpr int ETILE = CFG_ETILE, PMAX = 2 * T + NE * ETILE, NTILE = PMAX / ETILE;
constexpr int NIN = 3 * D;
constexpr int IN_COLS = 3 * D + GRK;
constexpr int O_DQ = 0, O_DK = D / 2, O_DV = D, O_GQ = 3 * D / 2, O_GK = 7 * D / 4, O_GV = 2 * D, O_LR = 5 * D / 2, O_GR = 5 * D / 2 + GRK;
constexpr float EPS = 1e-6f;
constexpr float LOG2E = 1.4426950408889634f;
}
using namespace cfg;
typedef unsigned short bf16;

constexpr size_t al256(size_t x) { return (x + 255) & ~(size_t)255; }
constexpr size_t WS_CTL = 0, CTL_BYTES = 1u << 20;
constexpr size_t WS_WIN = WS_CTL + CTL_BYTES;
constexpr size_t WS_WLR = WS_WIN + al256((size_t)NIN * D * 2);
constexpr size_t WS_WOUT = WS_WLR + al256((size_t)GRK * D * 2);
constexpr size_t WS_WCQ = WS_WOUT + al256((size_t)D * D * 2);
constexpr size_t WS_WCKV = WS_WCQ + al256((size_t)D * D * 2);
constexpr size_t WS_WCO = WS_WCKV + al256((size_t)2 * D * D * 2);
constexpr size_t WS_WGU = WS_WCO + al256((size_t)D * D * 2);
constexpr size_t WS_WD = WS_WGU + al256((size_t)NE * 2 * DE * D * 2);
constexpr size_t WS_XN = WS_WD + al256((size_t)NE * D * DE * 2);
constexpr size_t WS_MEMN = WS_XN + al256((size_t)(T + 1) * D * 2);
constexpr size_t WS_SMALL = WS_MEMN + al256((size_t)B * NMEM * D * 2);
constexpr size_t SM_GLR = 0;
constexpr size_t SM_CQSS = SM_GLR + al256((size_t)T * GRK * 4);
constexpr size_t SM_EXPERT = SM_CQSS + al256((size_t)T * 8 * 4);
constexpr size_t SM_GATE = SM_EXPERT + al256((size_t)T * 2 * 4);
constexpr size_t SM_SLOTPOS = SM_GATE + al256((size_t)T * 2 * 4);
constexpr size_t SM_SLOTTOK = SM_SLOTPOS + al256((size_t)T * 2 * 4);
constexpr size_t SM_SLOTGATE = SM_SLOTTOK + al256((size_t)PMAX * 4);
constexpr size_t SM_ROPE = SM_SLOTGATE + al256((size_t)PMAX * 4);
constexpr size_t SM_CKV = SM_ROPE + al256((size_t)T * DQK * 4);
constexpr size_t SM_CK2 = SM_CKV + al256((size_t)B * NMEM * 2 * D * 2);
constexpr size_t SM_CVT = SM_CK2 + al256((size_t)B * NMEM * D * 2);
constexpr size_t SM_STATS = SM_CVT + al256((size_t)B * NMEM * D * 2);
constexpr size_t SM_END = SM_STATS + al256((size_t)T * DH * 4 * 4);
constexpr size_t WS_B = WS_SMALL + al256(SM_END);
constexpr size_t B_DQ = 0, B_DK = B_DQ + (size_t)T * (D / 2) * 2, B_DV = B_DK + (size_t)T * (D / 2) * 2;
constexpr size_t B_GQ = B_DV + (size_t)T * (D / 2) * 2, B_GK = B_GQ + (size_t)T * (D / 4) * 2, B_GV = B_GK + (size_t)T * (D / 4) * 2, B_GR = B_GV + (size_t)T * (D / 2) * 2;
constexpr size_t B_END1 = B_GR + (size_t)T * (D / 2) * 2;
constexpr size_t B_CQ = 0, B_CO = B_CQ + (size_t)T * D * 2, B_HE = B_CO + (size_t)T * D * 2, B_END2 = B_HE + (size_t)PMAX * DE * 2;
constexpr size_t B_BYTES = al256(B_END1 > B_END2 ? B_END1 : B_END2);
constexpr size_t WS_C = WS_B + B_BYTES;
constexpr size_t WS_D = WS_C + al256((size_t)T * D * 2);
constexpr size_t WS_END = WS_D + al256((size_t)T * D * 5);

constexpr int CW_CNT = 64;
constexpr int CW_BASE = 128;
constexpr int CW_TILE_E = 256;
constexpr int CW_NTILES = 512;
constexpr int CW_BAR = 4096;

__device__ __forceinline__ bf16 f2bf(float f) { unsigned u; memcpy(&u, &f, 4); u = (u + 0x7fffu + ((u >> 16) & 1u)) >> 16; return (bf16)u; }
__device__ __forceinline__ float bf2f(bf16 b) { unsigned u = ((unsigned)b) << 16; float f; memcpy(&f, &u, 4); return f; }
__device__ __forceinline__ float silu_f(float x) { return x / (1.f + expf(-x)); }
#ifdef HOST_EMU
static inline size_t gtid() { return emu_tid; }
static inline size_t gnth() { return emu_nth; }
#else
__device__ __forceinline__ size_t gtid() { return (size_t)blockIdx.x * blockDim.x + threadIdx.x; }
__device__ __forceinline__ size_t gnth() { return (size_t)gridDim.x * blockDim.x; }
#endif
struct bf16x8s { bf16 v[8]; };

__device__ __forceinline__ void nk_rmsnorm_rows(const float* x, const float* g, bf16* out, int rows, int d) {
    for (size_t r = gtid(); r < (size_t)(rows); r += gnth()) {
    const float* xr = x + r * d; float ss = 0.f;
    for (int i = 0; i < d; ++i) ss += xr[i] * xr[i];
    const float rs = 1.0f / sqrtf(ss / d + EPS);
    for (int i = 0; i < d; ++i) out[r * d + i] = f2bf(xr[i] * rs * g[i]);
}}
__device__ __forceinline__ void nk_zero_bf16(bf16* p, size_t n) { for (size_t i = gtid(); i < n; i += gnth()) p[i] = 0; }
__device__ __forceinline__ void nk_convT(const float* W, int ldw, int col0, bf16* WT, int N, int K) {
    for (size_t i = gtid(); i < (size_t)(N * K); i += gnth()) {
    const int n = (int)(i / K), k = (int)(i % K);
    WT[i] = f2bf(W[(size_t)k * ldw + col0 + n]);
}}
constexpr int GUH = (DE >= 128) ? 128 : DE;
__device__ __forceinline__ void nk_conv_gu(const float* Wg, const float* Wu, bf16* WGU) {
    for (size_t i = gtid(); i < (size_t)(NE * 2 * DE * D); i += gnth()) {
    const int k = (int)(i % D); const int r = (int)((i / D) % (2 * DE)); const int e = (int)(i / ((size_t)D * 2 * DE));
    const int pn = r / (2 * GUH), ii = r % (2 * GUH); const int j = pn * GUH + (ii % GUH);
    const float* W = (ii < GUH) ? Wg : Wu;
    WGU[i] = f2bf(W[((size_t)e * D + k) * DE + j]);
}}
__device__ __forceinline__ void nk_conv_d(const float* Wd, bf16* WD) {
    for (size_t i = gtid(); i < (size_t)(NE * D * DE); i += gnth()) {
    const int j = (int)(i % DE); const int n = (int)((i / DE) % D); const int e = (int)(i / ((size_t)D * DE));
    WD[i] = f2bf(Wd[((size_t)e * DE + j) * D + n]);
}}
__device__ __forceinline__ void nk_rope_table(const int* positions, float* tab) {
    constexpr int half = DQK / 2; for (size_t i = gtid(); i < (size_t)(T * half); i += gnth()) {
    const int t = (int)(i / half), j = (int)(i % half);
    const float freq = powf(10000.0f, -(float)j / (float)half);
    const float ang = (float)positions[t] * freq;
    tab[i * 2] = cosf(ang); tab[i * 2 + 1] = sinf(ang);
}}

struct GemmP { const bf16* A; const bf16* Bt; int M, N, K, pad; float* f0; float* f1; bf16* b0; const float* x; };
template <int MODE> __device__ __forceinline__ void gemm_epi(const GemmP& p, int m, int n, float acc) {
    if constexpr (MODE == 0) {
        bf16* Bb = p.b0;
        if (n < D) { p.f0[(size_t)m * D + n] = acc; return; }
        if (n < O_GQ) { ((bf16*)((char*)Bb + B_DV))[(size_t)m * (D / 2) + (n - O_DV)] = f2bf(acc); return; }
        if (n < O_GK) { ((bf16*)((char*)Bb + B_GQ))[(size_t)m * (D / 4) + (n - O_GQ)] = f2bf(acc * (1.0f / sqrtf((float)GKD))); return; }
        if (n < O_GV) { ((bf16*)((char*)Bb + B_GK))[(size_t)m * (D / 4) + (n - O_GK)] = f2bf(acc); return; }
        if (n < O_LR) { ((bf16*)((char*)Bb + B_GV))[(size_t)m * (D / 2) + (n - O_GV)] = f2bf(acc); return; }
        ((bf16*)((char*)Bb + B_GR))[(size_t)m * (D / 2) + (n - O_LR)] = f2bf(acc);
    } else if constexpr (MODE == 1) { p.f0[(size_t)m * p.N + n] = p.x[(size_t)m * p.N + n] + acc;
    } else if constexpr (MODE == 2) { p.b0[(size_t)m * p.N + n] = f2bf(acc);
    } else if constexpr (MODE == 4) { p.f0[(size_t)m * p.N + n] += acc;
    } else { p.f0[(size_t)m * p.N + n] = acc; }
}
template <int MODE> __device__ __forceinline__ void nk_gemm(GemmP p) {
    const int nb = p.N / 4; for (size_t idx = gtid(); idx < (size_t)(p.M / 4) * nb; idx += gnth()) {
    const int m0 = 4 * (int)(idx / nb), n0 = 4 * (int)(idx % nb);
    float acc[4][4];
#pragma unroll
    for (int i = 0; i < 4; ++i)
#pragma unroll
        for (int j = 0; j < 4; ++j) acc[i][j] = 0.f;
    for (int k = 0; k < p.K; k += 8) {
        bf16x8s a[4], b[4];
#pragma unroll
        for (int i = 0; i < 4; ++i) { a[i] = *(const bf16x8s*)(p.A + (size_t)(m0 + i) * p.K + k); b[i] = *(const bf16x8s*)(p.Bt + (size_t)(n0 + i) * p.K + k); }
#pragma unroll
        for (int kk = 0; kk < 8; ++kk) {
            float af[4], bfv[4];
#pragma unroll
            for (int i = 0; i < 4; ++i) { af[i] = bf2f(a[i].v[kk]); bfv[i] = bf2f(b[i].v[kk]); }
#pragma unroll
            for (int i = 0; i < 4; ++i)
#pragma unroll
                for (int j = 0; j < 4; ++j) acc[i][j] += af[i] * bfv[j];
        }
    }
#pragma unroll
    for (int i = 0; i < 4; ++i)
#pragma unroll
        for (int j = 0; j < 4; ++j) gemm_epi<MODE>(p, m0 + i, n0 + j, acc[i][j]);
}}

__device__ __forceinline__ void nk_qk_post(const float* tmpqk, const float* qg, const float* kg, const float* rope, bf16* DQ, bf16* DK) {
    for (size_t i = gtid(); i < (size_t)(T * 2 * DH * 2); i += gnth()) {
    const int c = (int)(i % 2), h = (int)((i / 2) % DH), which = (int)((i / (2 * DH)) % 2), t = (int)(i / (4 * DH));
    const float* src = tmpqk + (size_t)t * D + which * (D / 2) + h * 2 * DQK + c * DQK;
    const float* g = which ? kg : qg; bf16* dst = (which ? DK : DQ) + (size_t)t * (D / 2) + h * 2 * DQK + c * DQK;
    float ss = 0.f; for (int d = 0; d < DQK; ++d) ss += src[d] * src[d];
    const float rs = 1.0f / sqrtf(ss / DQK + EPS); constexpr int half = DQK / 2;
    const float sc = which ? 1.0f : (1.0f / sqrtf((float)DQK)) * LOG2E;
    for (int d = 0; d < half; ++d) {
        const float t1 = src[d] * rs * g[d], t2 = src[d + half] * rs * g[d + half];
        const float cs = rope[((size_t)t * half + d) * 2], sn = rope[((size_t)t * half + d) * 2 + 1];
        dst[d] = f2bf((t1 * cs - t2 * sn) * sc); dst[d + half] = f2bf((t2 * cs + t1 * sn) * sc);
    }
}}
__device__ __forceinline__ void nk_lam(const float* q1, const float* k1, const float* q2, const float* k2, float* out) {
    if (gtid() != 0) return; float a = 0.f, b = 0.f; for (int i = 0; i < DQK; ++i) { a += q1[i] * k1[i]; b += q2[i] * k2[i]; }
    out[0] = expf(a) - expf(b) + 0.2f;
}
__device__ __forceinline__ void nk_diff_stats(const bf16* DQ, const bf16* DK, float* stats) {
    for (size_t i = gtid(); i < (size_t)(T * DH * 2); i += gnth()) {
    const int c = (int)(i % 2), h = (int)((i / 2) % DH), t = (int)(i / (2 * DH)); const int b = t / SEQ, s = t % SEQ;
    const int nk = (s / CHUNK + 1) * CHUNK;
    float q[DQK]; const bf16* qp = DQ + (size_t)t * (D / 2) + h * 2 * DQK + c * DQK;
#pragma unroll
    for (int d = 0; d < DQK; ++d) q[d] = bf2f(qp[d]);
    float mx = -1e30f;
    for (int k = 0; k < nk; ++k) { const bf16* kp = DK + (size_t)(b * SEQ + k) * (D / 2) + h * 2 * DQK + c * DQK; float sdot = 0.f;
#pragma unroll
        for (int d = 0; d < DQK; ++d) sdot += q[d] * bf2f(kp[d]);
        mx = fmaxf(mx, sdot); }
    float sum = 0.f;
    for (int k = 0; k < nk; ++k) { const bf16* kp = DK + (size_t)(b * SEQ + k) * (D / 2) + h * 2 * DQK + c * DQK; float sdot = 0.f;
#pragma unroll
        for (int d = 0; d < DQK; ++d) sdot += q[d] * bf2f(kp[d]);
        sum += exp2f(sdot - mx); }
    stats[i * 2] = mx; stats[i * 2 + 1] = sum;
}}
__device__ __forceinline__ void nk_diff_pv(const bf16* DQ, const bf16* DK, const bf16* DV, const float* stats, const float* lamp, float* otmp) {
    constexpr int NDG = 8, DG = DVD / NDG;
    for (size_t i = gtid(); i < (size_t)(T * DH * NDG); i += gnth()) {
    const int dg = (int)(i % NDG), h = (int)((i / NDG) % DH), t = (int)(i / (NDG * DH)); const int b = t / SEQ, s = t % SEQ;
    const int nk = (s / CHUNK + 1) * CHUNK; const float lam = lamp[0];
    float q[2 * DQK]; const bf16* qp = DQ + (size_t)t * (D / 2) + h * 2 * DQK;
#pragma unroll
    for (int d = 0; d < 2 * DQK; ++d) q[d] = bf2f(qp[d]);
    const float m0 = stats[((size_t)(t * DH + h) * 2 + 0) * 2], l0 = stats[((size_t)(t * DH + h) * 2 + 0) * 2 + 1];
    const float m1 = stats[((size_t)(t * DH + h) * 2 + 1) * 2], l1 = stats[((size_t)(t * DH + h) * 2 + 1) * 2 + 1];
    float acc[DG];
#pragma unroll
    for (int d = 0; d < DG; ++d) acc[d] = 0.f;
    for (int k = 0; k < nk; ++k) { const bf16* kp = DK + (size_t)(b * SEQ + k) * (D / 2) + h * 2 * DQK; float s0 = 0.f, s1 = 0.f;
#pragma unroll
        for (int d = 0; d < DQK; ++d) { s0 += q[d] * bf2f(kp[d]); s1 += q[DQK + d] * bf2f(kp[DQK + d]); }
        const float a = exp2f(s0 - m0) / l0 - lam * exp2f(s1 - m1) / l1;
        const bf16* vp = DV + (size_t)(b * SEQ + k) * (D / 2) + h * DVD + dg * DG;
#pragma unroll
        for (int d = 0; d < DG; ++d) acc[d] += a * bf2f(vp[d]); }
#pragma unroll
    for (int d = 0; d < DG; ++d) otmp[(size_t)t * (D / 2) + h * DVD + dg * DG + d] = acc[d];
}}
__device__ __forceinline__ void nk_diff_norm(const float* otmp, const float* g, bf16* MIX) {
    for (size_t i = gtid(); i < (size_t)(T * DH); i += gnth()) { const int h = (int)(i % DH), t = (int)(i / DH);
    const float* o = otmp + (size_t)t * (D / 2) + h * DVD; float ss = 0.f; for (int d = 0; d < DVD; ++d) ss += o[d] * o[d];
    const float rs = 1.0f / sqrtf(ss / DVD + EPS);
    for (int d = 0; d < DVD; ++d) MIX[(size_t)t * D + h * DVD + d] = f2bf(o[d] * rs * g[d] * 0.8f);
}}
__device__ __forceinline__ void nk_gla_cum(const float* GLR, const float* wa2, const float* ba, float* CUM) {
    constexpr int W = GH * GKD; for (size_t i = gtid(); i < (size_t)(B * NC * W); i += gnth()) {
    const int j = (int)(i % W), cb = (int)(i / W); float run = 0.f;
    for (int tt = 0; tt < CHUNK; ++tt) { const int t = cb * CHUNK + tt; float z = ba[j];
        for (int r = 0; r < GRK; ++r) z += GLR[(size_t)t * GRK + r] * wa2[(size_t)r * W + j];
        const float ls = fminf(z, 0.f) - log1pf(expf(-fabsf(z)));
        run += ls * (1.0f / 16.0f); CUM[(size_t)t * W + j] = run; }
}}
__device__ __forceinline__ void nk_gla_run(const bf16* GQ, const bf16* GK, const bf16* GV, const float* CUM, float* otmp) {
    constexpr int KH = GKD / 2;
    for (size_t i = gtid(); i < (size_t)(B * GH * GVD); i += gnth()) {
    const int v = (int)(i % GVD), h = (int)((i / GVD) % GH), b = (int)(i / (GVD * GH)); constexpr int W = GH * GKD;
    for (int kh = 0; kh < 2; ++kh) {
    float S[KH];
#pragma unroll
    for (int k = 0; k < KH; ++k) S[k] = 0.f;
    for (int c = 0; c < NC; ++c) { const int t0 = b * SEQ + c * CHUNK; const float* ce = CUM + (size_t)(t0 + CHUNK - 1) * W + h * GKD + kh * KH;
#pragma unroll
        for (int k = 0; k < KH; ++k) S[k] *= expf(ce[k]);
        for (int tt = 0; tt < CHUNK; ++tt) { const int t = t0 + tt; const float vv = bf2f(GV[(size_t)t * (D / 2) + h * GVD + v]);
            const bf16* kp = GK + (size_t)t * (D / 4) + h * GKD + kh * KH; const float* cp = CUM + (size_t)t * W + h * GKD + kh * KH;
#pragma unroll
            for (int k = 0; k < KH; ++k) S[k] += bf2f(kp[k]) * expf(ce[k] - cp[k]) * vv; }
        for (int tt = 0; tt < CHUNK; ++tt) { const int t = t0 + tt; const bf16* qp = GQ + (size_t)t * (D / 4) + h * GKD + kh * KH; float o = 0.f;
#pragma unroll
            for (int k = 0; k < KH; ++k) o += bf2f(qp[k]) * S[k];
            float* op = otmp + (size_t)t * (D / 2) + h * GVD + v; if (kh == 0) *op = o; else *op += o; } }
    } }
}
__device__ __forceinline__ void nk_gla_norm(const float* otmp, const float* g, const bf16* GR, bf16* MIX) {
    for (size_t i = gtid(); i < (size_t)(T * GH); i += gnth()) { const int h = (int)(i % GH), t = (int)(i / GH);
    const float* o = otmp + (size_t)t * (D / 2) + h * GVD; float ss = 0.f; for (int d = 0; d < GVD; ++d) ss += o[d] * o[d];
    const float rs = 1.0f / sqrtf(ss / GVD + EPS);
    for (int d = 0; d < GVD; ++d) MIX[(size_t)t * D + D / 2 + h * GVD + d] = f2bf(o[d] * rs * g[d] * silu_f(bf2f(GR[(size_t)t * (D / 2) + h * GVD + d])));
}}
__device__ __forceinline__ void nk_cqss(const bf16* CQ, float* CQSS) {
    for (size_t i = gtid(); i < (size_t)(T * 8); i += gnth()) { const int j = (int)(i % 8), t = (int)(i / 8);
    float ss = 0.f; for (int d = 0; d < D / 8; ++d) { const float v = bf2f(CQ[(size_t)t * D + j * (D / 8) + d]); ss += v * v; } CQSS[i] = ss;
}}
__device__ __forceinline__ void nk_ckv_fix(const bf16* CKV, const float* qg, const float* kg, bf16* CK2, bf16* CVT) {
    for (size_t i = gtid(); i < (size_t)(B * NMEM * CH); i += gnth()) { const int h = (int)(i % CH), bm = (int)(i / CH); const int b = bm / NMEM, m = bm % NMEM;
    const bf16* kp = CKV + (size_t)bm * 2 * D + h * CHD; const bf16* vp = CKV + (size_t)bm * 2 * D + D + h * CHD;
    float ss = 0.f; for (int d = 0; d < CHD; ++d) { const float v = bf2f(kp[d]); ss += v * v; }
    const float rs = 1.0f / sqrtf(ss / CHD + EPS) * (1.0f / sqrtf((float)CHD)) * LOG2E;
    for (int d = 0; d < CHD; ++d) { CK2[(((size_t)b * CH + h) * NMEM + m) * CHD + d] = f2bf(bf2f(kp[d]) * rs * kg[d] * qg[d]);
        CVT[(((size_t)b * CH + h) * CHD + d) * NMEM + m] = vp[d]; }
}}
__device__ __forceinline__ void nk_cross_scores(const bf16* CQ, const float* CQSS, const bf16* CK2, float* P) {
    for (size_t i = gtid(); i < (size_t)(T * CH * NMEM); i += gnth()) { const int m = (int)(i % NMEM), h = (int)((i / NMEM) % CH), t = (int)(i / (NMEM * CH)); const int b = t / SEQ;
    const float rq = 1.0f / sqrtf((CQSS[(size_t)t * 8 + 2 * h] + CQSS[(size_t)t * 8 + 2 * h + 1]) / CHD + EPS);
    const bf16* qp = CQ + (size_t)t * D + h * CHD; const bf16* kp = CK2 + (((size_t)b * CH + h) * NMEM + m) * CHD; float s = 0.f;
    for (int d = 0; d < CHD; ++d) s += bf2f(qp[d]) * bf2f(kp[d]);
    P[i] = s * rq;
}}
__device__ __forceinline__ void nk_cross_softmax(float* P) {
    for (size_t i = gtid(); i < (size_t)(T * CH); i += gnth()) { float* p = P + i * NMEM; float mx = -1e30f;
    for (int m = 0; m < NMEM; ++m) mx = fmaxf(mx, p[m]); float sum = 0.f;
    for (int m = 0; m < NMEM; ++m) { p[m] = exp2f(p[m] - mx); sum += p[m]; }
    for (int m = 0; m < NMEM; ++m) p[m] /= sum;
}}
__device__ __forceinline__ void nk_cross_pv(const float* P, const bf16* CVT, bf16* CO) {
    for (size_t i = gtid(); i < (size_t)(T * D); i += gnth()) { const int d = (int)(i % CHD), h = (int)((i / CHD) % CH), t = (int)(i / D); const int b = t / SEQ;
    const float* p = P + ((size_t)t * CH + h) * NMEM; const bf16* vp = CVT + (((size_t)b * CH + h) * CHD + d) * NMEM; float o = 0.f;
    for (int m = 0; m < NMEM; ++m) o += p[m] * bf2f(vp[m]);
    CO[i] = f2bf(o);
}}
__device__ __forceinline__ void nk_router(const float* h2, const float* g, const float* wrg, const float* brg, const float* wre, const float* bre, bf16* XN, int* EXPERT, float* GATE, int* SLOTPOS, int* ctl) {
    for (size_t t = gtid(); t < (size_t)(T); t += gnth()) { const float* xr = h2 + t * D; float ss = 0.f;
    for (int i = 0; i < D; ++i) ss += xr[i] * xr[i]; const float rs = 1.0f / sqrtf(ss / D + EPS);
    float gl[NG], el[NE];
#pragma unroll
    for (int j = 0; j < NG; ++j) gl[j] = brg[j];
#pragma unroll
    for (int j = 0; j < NE; ++j) el[j] = bre[j];
    for (int i = 0; i < D; ++i) { const float xv = xr[i] * rs * g[i]; XN[t * D + i] = f2bf(xv);
#pragma unroll
        for (int j = 0; j < NG; ++j) gl[j] += xv * wrg[(size_t)i * NG + j];
#pragma unroll
        for (int j = 0; j < NE; ++j) el[j] += xv * wre[(size_t)i * NE + j]; }
    int grp = 0; float gm = gl[0];
#pragma unroll
    for (int j = 1; j < NG; ++j) if (gl[j] > gm) { gm = gl[j]; grp = j; }
    float gs = 0.f;
#pragma unroll
    for (int j = 0; j < NG; ++j) gs += expf(gl[j] - gm);
    const float grp_w = 1.0f / gs;
    float e8[EPG];
#pragma unroll
    for (int j = 0; j < EPG; ++j) { float v = 0.f;
#pragma unroll
        for (int gq = 0; gq < NG; ++gq) v = (grp == gq) ? el[gq * EPG + j] : v;
        e8[j] = v; }
    int i0 = 0; float v0 = e8[0];
#pragma unroll
    for (int j = 1; j < EPG; ++j) if (e8[j] > v0) { v0 = e8[j]; i0 = j; }
    int i1 = -1; float v1 = -1e30f;
#pragma unroll
    for (int j = 0; j < EPG; ++j) if (j != i0 && e8[j] > v1) { v1 = e8[j]; i1 = j; }
    const float r = expf(v1 - v0); const float g0 = grp_w / (1.f + r), g1 = grp_w * r / (1.f + r);
    const int e0 = grp * EPG + i0, e1 = grp * EPG + i1;
    EXPERT[t * 2] = e0; EXPERT[t * 2 + 1] = e1; GATE[t * 2] = g0; GATE[t * 2 + 1] = g1;
    SLOTPOS[t * 2] = atomicAdd(&ctl[CW_CNT + e0], 1); SLOTPOS[t * 2 + 1] = atomicAdd(&ctl[CW_CNT + e1], 1);
}}
__device__ __forceinline__ void nk_moe_offsets(int* ctl) {
    if (gtid() != 0) return; int base = 0, nt = 0;
    for (int e = 0; e < NE; ++e) { ctl[CW_BASE + e] = base; const int n = (ctl[CW_CNT + e] + ETILE - 1) / ETILE; for (int j = 0; j < n; ++j) ctl[CW_TILE_E + nt + j] = e; nt += n; base += n * ETILE; }
    ctl[CW_BASE + NE] = base; ctl[CW_NTILES] = nt; for (int j = nt; j < NTILE; ++j) ctl[CW_TILE_E + j] = -1;
}
__device__ __forceinline__ void nk_moe_init_slots(int* SLOTTOK, float* SLOTGATE) { for (size_t i = gtid(); i < (size_t)PMAX; i += gnth()) { SLOTTOK[i] = T; SLOTGATE[i] = 0.f; } }
__device__ __forceinline__ void nk_moe_fill(const int* EXPERT, const float* GATE, const int* SLOTPOS, const int* ctl, int* SLOTTOK, float* SLOTGATE) {
    for (size_t i = gtid(); i < (size_t)(T * 2); i += gnth()) { const int e = EXPERT[i]; const int dst = ctl[CW_BASE + e] + SLOTPOS[i];
    SLOTTOK[dst] = (int)(i / 2); SLOTGATE[dst] = GATE[i];
}}
__device__ __forceinline__ void nk_moe_gu(const bf16* XN, const bf16* WGU, const int* SLOTTOK, const int* ctl, bf16* HE) {
    for (size_t i = gtid(); i < (size_t)(PMAX * DE); i += gnth()) { const int j = (int)(i % DE), p = (int)(i / DE); const int e = ctl[CW_TILE_E + p / ETILE];
    if (e < 0) continue; const int tok = SLOTTOK[p];
    const int pn = j / GUH, jj = j % GUH; const bf16* wg = WGU + ((size_t)e * 2 * DE + pn * 2 * GUH + jj) * D; const bf16* wu = wg + (size_t)GUH * D;
    const bf16* xr = XN + (size_t)tok * D; float g = 0.f, u = 0.f;
    for (int k = 0; k < D; ++k) { const float xv = bf2f(xr[k]); g += xv * bf2f(wg[k]); u += xv * bf2f(wu[k]); }
    HE[i] = f2bf(silu_f(g) * u);
}}
__device__ __forceinline__ void nk_moe_down(const bf16* HE, const bf16* WD, const int* SLOTTOK, const float* SLOTGATE, const int* ctl, float* out) {
    for (size_t i = gtid(); i < (size_t)(PMAX * D); i += gnth()) { const int n = (int)(i % D), p = (int)(i / D); const int e = ctl[CW_TILE_E + p / ETILE];
    if (e < 0) continue; const int tok = SLOTTOK[p]; if (tok >= T) continue;
    const bf16* hr = HE + (size_t)p * DE; const bf16* wr = WD + ((size_t)e * D + n) * DE; float y = 0.f;
    for (int k = 0; k < DE; ++k) y += bf2f(hr[k]) * bf2f(wr[k]);
    atomicAdd(&out[(size_t)tok * D + n], y * SLOTGATE[p]);
}}


struct Ctx {
    const float *x, *mem; const int* positions; const float *g_attn, *w_in, *q_norm_g, *k_norm_g, *lq1, *lk1, *lq2, *lk2, *subln_g, *w_a2, *b_a, *gla_out_g, *w_out, *g_cross, *g_mem, *w_cq, *w_ckv, *cq_g, *ck_g, *w_co,
        *g_ffn, *w_rg, *b_rg, *w_re, *b_re, *w_gate, *w_up, *w_down;
    float* out; char* ws;
};
#define WSP(T_, off) ((T_*)(c.ws + (off)))
constexpr int N_PHASES = 19;
template <int P> __device__ __forceinline__ void run_phase(const Ctx& c) {
    int* ctl = WSP(int, WS_CTL); float* lamp = (float*)(ctl + 16);
    bf16 *WIN = WSP(bf16, WS_WIN), *WLR = WSP(bf16, WS_WLR), *WOUT = WSP(bf16, WS_WOUT), *WCQ = WSP(bf16, WS_WCQ), *WCKV = WSP(bf16, WS_WCKV), *WCO = WSP(bf16, WS_WCO);
    bf16 *WGU = WSP(bf16, WS_WGU), *WD = WSP(bf16, WS_WD), *XN = WSP(bf16, WS_XN), *MEMN = WSP(bf16, WS_MEMN);
    float* GLR = WSP(float, WS_SMALL + SM_GLR); float* CQSS = WSP(float, WS_SMALL + SM_CQSS); int* EXPERT = WSP(int, WS_SMALL + SM_EXPERT); float* GATE = WSP(float, WS_SMALL + SM_GATE);
    int* SLOTPOS = WSP(int, WS_SMALL + SM_SLOTPOS); int* SLOTTOK = WSP(int, WS_SMALL + SM_SLOTTOK); float* SLOTGATE = WSP(float, WS_SMALL + SM_SLOTGATE); float* ROPE = WSP(float, WS_SMALL + SM_ROPE);
    bf16 *CKV = WSP(bf16, WS_SMALL + SM_CKV), *CK2 = WSP(bf16, WS_SMALL + SM_CK2), *CVT = WSP(bf16, WS_SMALL + SM_CVT); float* STATS = WSP(float, WS_SMALL + SM_STATS);
    char* rb = c.ws + WS_B;
    bf16 *DQ = (bf16*)(rb + B_DQ), *DK = (bf16*)(rb + B_DK), *DV = (bf16*)(rb + B_DV), *GQ = (bf16*)(rb + B_GQ), *GK = (bf16*)(rb + B_GK), *GV = (bf16*)(rb + B_GV), *GRb = (bf16*)(rb + B_GR);
    bf16 *CQ = (bf16*)(rb + B_CQ), *CO = (bf16*)(rb + B_CO), *HE = (bf16*)(rb + B_HE);
    bf16* MIX = WSP(bf16, WS_C);
    float* TMPQK = WSP(float, WS_C);
    float* PTMP = WSP(float, WS_C);
    float* CUM = WSP(float, WS_D);
    float* OTMPD = WSP(float, WS_D + al256((size_t)T * D));
    float* OTMPG = WSP(float, WS_D + al256((size_t)T * D) * 3);
    float* out = c.out;
    if constexpr (P == 0) {
        nk_convT(c.w_in, IN_COLS, 0, WIN, 5 * D / 2, D);
        nk_convT(c.w_in, IN_COLS, O_GR, WIN + (size_t)(5 * D / 2) * D, D / 2, D);
        nk_convT(c.w_in, IN_COLS, O_LR, WLR, GRK, D);
        nk_convT(c.w_out, D, 0, WOUT, D, D); nk_convT(c.w_cq, D, 0, WCQ, D, D); nk_convT(c.w_ckv, 2 * D, 0, WCKV, 2 * D, D); nk_convT(c.w_co, D, 0, WCO, D, D);
        nk_conv_gu(c.w_gate, c.w_up, WGU); nk_conv_d(c.w_down, WD);
        nk_rope_table(c.positions, ROPE); nk_lam(c.lq1, c.lk1, c.lq2, c.lk2, lamp);
        nk_zero_bf16(XN + (size_t)T * D, (size_t)D); nk_moe_init_slots(SLOTTOK, SLOTGATE);
        nk_rmsnorm_rows(c.x, c.g_attn, XN, T, D); nk_rmsnorm_rows(c.mem, c.g_mem, MEMN, B * NMEM, D);
    } else if constexpr (P == 1) {
        { GemmP p{XN, WIN, T, NIN, D, 0, TMPQK, nullptr, (bf16*)rb, nullptr}; nk_gemm<0>(p); }
        { GemmP p{XN, WLR, T, GRK, D, 0, GLR, nullptr, nullptr, nullptr}; nk_gemm<5>(p); }
        { GemmP p{MEMN, WCKV, B * NMEM, 2 * D, D, 0, nullptr, nullptr, CKV, nullptr}; nk_gemm<2>(p); }
    } else if constexpr (P == 2) {
        nk_qk_post(TMPQK, c.q_norm_g, c.k_norm_g, ROPE, DQ, DK); nk_ckv_fix(CKV, c.cq_g, c.ck_g, CK2, CVT);
    } else if constexpr (P == 3) {
        nk_diff_stats(DQ, DK, STATS); nk_gla_cum(GLR, c.w_a2, c.b_a, CUM);
    } else if constexpr (P == 4) {
        nk_diff_pv(DQ, DK, DV, STATS, lamp, OTMPD); nk_gla_run(GQ, GK, GV, CUM, OTMPG);
    } else if constexpr (P == 5) {
        nk_diff_norm(OTMPD, c.subln_g, MIX); nk_gla_norm(OTMPG, c.gla_out_g, GRb, MIX);
    } else if constexpr (P == 6) {
        GemmP p{MIX, WOUT, T, D, D, 0, out, nullptr, nullptr, c.x}; nk_gemm<1>(p);
    } else if constexpr (P == 7) {
        nk_rmsnorm_rows(out, c.g_cross, XN, T, D);
    } else if constexpr (P == 8) {
        GemmP p{XN, WCQ, T, D, D, 0, nullptr, nullptr, CQ, nullptr}; nk_gemm<2>(p);
    } else if constexpr (P == 9) {
        nk_cqss(CQ, CQSS);
    } else if constexpr (P == 10) {
        nk_cross_scores(CQ, CQSS, CK2, PTMP);
    } else if constexpr (P == 11) {
        nk_cross_softmax(PTMP);
    } else if constexpr (P == 12) {
        nk_cross_pv(PTMP, CVT, CO);
    } else if constexpr (P == 13) {
        GemmP p{CO, WCO, T, D, D, 0, out, nullptr, nullptr, nullptr}; nk_gemm<4>(p);
    } else if constexpr (P == 14) {
        nk_router(out, c.g_ffn, c.w_rg, c.b_rg, c.w_re, c.b_re, XN, EXPERT, GATE, SLOTPOS, ctl);
    } else if constexpr (P == 15) {
        nk_moe_offsets(ctl);
    } else if constexpr (P == 16) {
        nk_moe_fill(EXPERT, GATE, SLOTPOS, ctl, SLOTTOK, SLOTGATE);
    } else if constexpr (P == 17) {
        nk_moe_gu(XN, WGU, SLOTTOK, ctl, HE);
    } else if constexpr (P == 18) {
        nk_moe_down(HE, WD, SLOTTOK, SLOTGATE, ctl, out);
    }
}

#ifndef HOST_EMU
#define XB_TMO      128
#define XB_XCNT(j)  (256  + 64 * (j))
#define XB_XSUB(j)  (1280 + 64 * (j))
#define XB_XGEN(j)  (2304 + 64 * (j))
#define XB_TOP      3328
#define XB_TOPGEN   3392
#define XCD_BAR_WORDS 3456
#define XB_SPIN_CAP (1u << 20)
#define LAS __attribute__((address_space(3)))

__device__ __forceinline__ unsigned xb_ld(unsigned* p)              { return __hip_atomic_load(p, __ATOMIC_RELAXED, __HIP_MEMORY_SCOPE_AGENT); }
__device__ __forceinline__ unsigned xb_add(unsigned* p, unsigned v) { return __hip_atomic_fetch_add(p, v, __ATOMIC_RELAXED, __HIP_MEMORY_SCOPE_AGENT); }
__device__ __forceinline__ unsigned xb_xcc_id() { return (unsigned)__builtin_amdgcn_s_getreg((3 << 11) | 20) & 0xFu; }
#define XB_SPIN(cond, bar) do { unsigned _sp = 0; while (cond) { __builtin_amdgcn_s_sleep(1); \
    if ((++_sp & 255u) == 0u) { if (xb_ld(&(bar)[XB_TMO])) break; if (_sp > XB_SPIN_CAP) { atomicAdd(&(bar)[XB_TMO], 1u); break; } } } } while (0)

struct XcdBarrier {
    unsigned* bar; unsigned x;
    volatile LAS unsigned* st;
};
__device__ __forceinline__ XcdBarrier xcd_barrier_post(unsigned* bar, volatile LAS unsigned* st) {
    XcdBarrier b; b.bar = bar; b.x = xb_xcc_id(); b.st = st;
    if (threadIdx.x == 0) (void)xb_add(&bar[XB_XCNT(b.x)], 1u);
    return b;
}
__device__ __forceinline__ void xcd_barrier_complete(unsigned* bar, unsigned x, unsigned& nloc, unsigned& nx) {
    const unsigned G = gridDim.x * gridDim.y * gridDim.z;
    unsigned sum, cnt, mine, sp = 0u;
    for (;;) {
        sum = 0u; cnt = 0u; mine = 0u;
#pragma unroll
        for (unsigned j = 0; j < 16; ++j) { const unsigned c = xb_ld(&bar[XB_XCNT(j)]); sum += c; cnt += (c > 0u) ? 1u : 0u; mine = (j == x) ? c : mine; }
        if (sum == G) break;
        __builtin_amdgcn_s_sleep(1);
        if ((++sp & 255u) == 0u) { if (xb_ld(&bar[XB_TMO])) break; if (sp > XB_SPIN_CAP) { atomicAdd(&bar[XB_TMO], 1u); break; } }
    }
    nloc = mine > 0u ? mine : 1u; nx = cnt > 0u ? cnt : 1u;
}
__device__ __forceinline__ void xcd_barrier(const XcdBarrier& b) {
    asm volatile("s_waitcnt vmcnt(0)" ::: "memory");
    __syncthreads();
    if (threadIdx.x == 0) {
        unsigned* bar = b.bar;
        __builtin_amdgcn_s_waitcnt(0);
        unsigned nloc = b.st[0], nx = b.st[1];
        if (nloc == 0u) { xcd_barrier_complete(bar, b.x, nloc, nx); b.st[0] = nloc; b.st[1] = nx; }
        const unsigned old = xb_add(&bar[XB_XSUB(b.x)], 1u);
        const unsigned gen = old / nloc;
        if (old + 1u == (gen + 1u) * nloc) {
            __builtin_amdgcn_fence(__ATOMIC_RELEASE, "agent");
            asm volatile("s_waitcnt vmcnt(0)" ::: "memory");
            const unsigned og = xb_add(&bar[XB_TOP], 1u);
            const unsigned tg = og / nx;
            if (og + 1u == (tg + 1u) * nx) xb_add(&bar[XB_TOPGEN], 1u);
            else XB_SPIN(xb_ld(&bar[XB_TOPGEN]) == tg, bar);
            __builtin_amdgcn_fence(__ATOMIC_ACQUIRE, "agent");
            xb_add(&bar[XB_XGEN(b.x)], 1u);
            asm volatile("s_waitcnt vmcnt(0)" ::: "memory");
        } else {
            XB_SPIN(xb_ld(&bar[XB_XGEN(b.x)]) == gen, bar);
            __builtin_amdgcn_fence(__ATOMIC_ACQUIRE, "agent");
            asm volatile("s_waitcnt vmcnt(0)" ::: "memory");
        }
    }
    __syncthreads();
}

constexpr int NTHREADS = 512;
constexpr int LDS_BYTES = 147456;
constexpr int MISC_OFF = 131072 + 320;
__global__ void __launch_bounds__(NTHREADS, 2) fwd_kernel(Ctx c) {
    extern __shared__ __attribute__((aligned(16))) unsigned char lds[];
    LAS unsigned char* l3 = (LAS unsigned char*)lds;
    volatile LAS unsigned* MISC = (volatile LAS unsigned*)(l3 + MISC_OFF);
    for (int u = threadIdx.x; u < (LDS_BYTES - 131072) / 4; u += NTHREADS) ((LAS unsigned*)(l3 + 131072))[u] = 0u;
    __syncthreads();
    XcdBarrier bar = xcd_barrier_post((unsigned*)(c.ws + WS_CTL) + CW_BAR, MISC + 8);
#define PH(k) run_phase<k>(c); xcd_barrier(bar);
    PH(0) PH(1) PH(2) PH(3) PH(4) PH(5) PH(6) PH(7) PH(8) PH(9) PH(10) PH(11) PH(12) PH(13) PH(14) PH(15) PH(16) PH(17)
    run_phase<18>(c);
#undef PH
}
#endif

#ifdef HOST_EMU
template <int P> static void emu_phase(const Ctx& c) { const size_t nth = 4096; emu_nth = nth; for (size_t t = 0; t < nth; ++t) { emu_tid = t; run_phase<P>(c); } }
template <int... Ps> static void emu_all(const Ctx& c, std::integer_sequence<int, Ps...>) { (emu_phase<Ps>(c), ...); }
#endif

extern "C" void kernel_launch(void* const* d_in, const int* in_sizes, int n_in, void* d_out, int out_size, void* d_ws, size_t ws_size, hipStream_t stream) {
    if (n_in != 31 || out_size != T * D || ws_size < WS_END) { fprintf(stderr, "kernel_launch: unexpected shapes (n_in %d out %d ws %zu need %zu)\n", n_in, out_size, ws_size, (size_t)WS_END); return; }
    (void)in_sizes;
    Ctx c{};
    const float** fp = (const float**)&c.x;
    c.x = (const float*)d_in[0]; c.mem = (const float*)d_in[1]; c.positions = (const int*)d_in[2];
    c.g_attn = (const float*)d_in[3]; c.w_in = (const float*)d_in[4]; c.q_norm_g = (const float*)d_in[5]; c.k_norm_g = (const float*)d_in[6];
    c.lq1 = (const float*)d_in[7]; c.lk1 = (const float*)d_in[8]; c.lq2 = (const float*)d_in[9]; c.lk2 = (const float*)d_in[10];
    c.subln_g = (const float*)d_in[11]; c.w_a2 = (const float*)d_in[12]; c.b_a = (const float*)d_in[13]; c.gla_out_g = (const float*)d_in[14];
    c.w_out = (const float*)d_in[15]; c.g_cross = (const float*)d_in[16]; c.g_mem = (const float*)d_in[17]; c.w_cq = (const float*)d_in[18];
    c.w_ckv = (const float*)d_in[19]; c.cq_g = (const float*)d_in[20]; c.ck_g = (const float*)d_in[21]; c.w_co = (const float*)d_in[22];
    c.g_ffn = (const float*)d_in[23]; c.w_rg = (const float*)d_in[24]; c.b_rg = (const float*)d_in[25]; c.w_re = (const float*)d_in[26];
    c.b_re = (const float*)d_in[27]; c.w_gate = (const float*)d_in[28]; c.w_up = (const float*)d_in[29]; c.w_down = (const float*)d_in[30];
    c.out = (float*)d_out; c.ws = (char*)d_ws; (void)fp;
#ifdef HOST_EMU
    memset(c.ws + WS_CTL, 0, CTL_BYTES);
    emu_all(c, std::make_integer_sequence<int, N_PHASES>{});
#else
    static int grid = 0;
    if (grid == 0) {
        int dev = 0, cus = 0, per_cu = 0;
        if (hipGetDevice(&dev) != hipSuccess || hipDeviceGetAttribute(&cus, hipDeviceAttributeMultiprocessorCount, dev) != hipSuccess) { fprintf(stderr, "kernel_launch: device query failed\n"); grid = -1; return; }
        if (hipFuncSetAttribute((const void*)fwd_kernel, hipFuncAttributeMaxDynamicSharedMemorySize, LDS_BYTES) != hipSuccess) { fprintf(stderr, "kernel_launch: hipFuncSetAttribute failed\n"); grid = -1; return; }
        if (hipOccupancyMaxActiveBlocksPerMultiprocessor(&per_cu, (const void*)fwd_kernel, NTHREADS, LDS_BYTES) != hipSuccess || per_cu < 1) { fprintf(stderr, "kernel_launch: occupancy query says %d blocks per CU\n", per_cu); }
        (void)hipGetLastError();
        grid = cus;
    }
    if (grid < 0) return;
    (void)hipMemsetAsync(c.ws + WS_CTL, 0, CTL_BYTES, stream);
    hipLaunchKernelGGL(fwd_kernel, dim3(grid), dim3(NTHREADS), LDS_BYTES, stream, c);
#endif
}
```

```cpp
#ifndef HOST_EMU
#include <hip/hip_runtime.h>
#else
#include <cstring>
struct EmuD3 { unsigned x, y, z; };
static EmuD3 blockIdx, threadIdx, blockDim, gridDim;
static size_t emu_tid, emu_nth;
#define __global__ static
#define __device__ static
#define __host__
#define __forceinline__ inline
#define __launch_bounds__(...)
typedef int hipStream_t;
static inline int atomicAdd(int* p, int v) { int o = *p; *p += v; return o; }
static inline float atomicAdd(float* p, float v) { float o = *p; *p += v; return o; }
#endif
#include <cstdint>
#include <cstdio>
#include <cmath>

#ifndef CFG_D
#define CFG_D 2048
#define CFG_SEQ 4096
#define CFG_NMEM 256
#define CFG_ETILE 256
#endif
namespace cfg {
constexpr int D = CFG_D, B = 2, SEQ = CFG_SEQ, T = B * SEQ, CHUNK = 64, NC = SEQ / CHUNK;
constexpr int DH = 8, DVD = D / 16, DQK = D / 32;
constexpr int GH = 4, GVD = D / 8, GKD = D / 16, GRK = 16;
constexpr int NMEM = CFG_NMEM, CH = 4, CHD = D / 4;
constexpr int NE = 32, EPG = 8, NG = 4, DE = D / 4;
constexpr int ETILE = CFG_ETILE, PMAX = 2 * T + NE * ETILE, NTILE = PMAX / ETILE;
constexpr int NIN = 3 * D;
constexpr int IN_COLS = 3 * D + GRK;
constexpr int O_DQ = 0, O_DK = D / 2, O_DV = D, O_GQ = 3 * D / 2, O_GK = 7 * D / 4, O_GV = 2 * D, O_LR = 5 * D / 2, O_GR = 5 * D / 2 + GRK;
constexpr float EPS = 1e-6f;
constexpr float LOG2E = 1.4426950408889634f;
}
using namespace cfg;
typedef unsigned short bf16;

constexpr size_t al256(size_t x) { return (x + 255) & ~(size_t)255; }
constexpr size_t WS_CTL = 0, CTL_BYTES = 1u << 20;
constexpr size_t WS_WIN = WS_CTL + CTL_BYTES;
constexpr size_t WS_WLR = WS_WIN + al256((size_t)NIN * D * 2);
constexpr size_t WS_WOUT = WS_WLR + al256((size_t)GRK * D * 2);
constexpr size_t WS_WCQ = WS_WOUT + al256((size_t)D * D * 2);
constexpr size_t WS_WCKV = WS_WCQ + al256((size_t)D * D * 2);
constexpr size_t WS_WCO = WS_WCKV + al256((size_t)2 * D * D * 2);
constexpr size_t WS_WGU = WS_WCO + al256((size_t)D * D * 2);
constexpr size_t WS_WD = WS_WGU + al256((size_t)NE * 2 * DE * D * 2);
constexpr size_t WS_XN = WS_WD + al256((size_t)NE * D * DE * 2);
constexpr size_t WS_MEMN = WS_XN + al256((size_t)(T + 1) * D * 2);
constexpr size_t WS_SMALL = WS_MEMN + al256((size_t)B * NMEM * D * 2);
constexpr size_t SM_GLR = 0;
constexpr size_t SM_CQSS = SM_GLR + al256((size_t)T * GRK * 4);
constexpr size_t SM_SSP1 = SM_CQSS + al256((size_t)T * 32 * 4);
constexpr size_t SM_SSP2 = SM_SSP1 + al256((size_t)T * 32 * 4);
constexpr size_t SM_EXPERT = SM_SSP2 + al256((size_t)T * 32 * 4);
constexpr size_t SM_GATE = SM_EXPERT + al256((size_t)T * 2 * 4);
constexpr size_t SM_SLOTPOS = SM_GATE + al256((size_t)T * 2 * 4);
constexpr size_t SM_SLOTTOK = SM_SLOTPOS + al256((size_t)T * 2 * 4);
constexpr size_t SM_SLOTGATE = SM_SLOTTOK + al256((size_t)PMAX * 4);
constexpr size_t SM_ROPE = SM_SLOTGATE + al256((size_t)PMAX * 4);
constexpr size_t SM_CKV = SM_ROPE + al256((size_t)T * DQK * 4);
constexpr size_t SM_CK2 = SM_CKV + al256((size_t)B * NMEM * 2 * D * 2);
constexpr size_t SM_CVT = SM_CK2 + al256((size_t)B * NMEM * D * 2);
constexpr size_t SM_WRT = SM_CVT + al256((size_t)B * NMEM * D * 2);
constexpr size_t SM_STATS = SM_WRT + al256((size_t)48 * D * 2);
constexpr size_t SM_END = SM_STATS + al256((size_t)T * DH * 4 * 4);
constexpr size_t WS_B = WS_SMALL + al256(SM_END);
constexpr size_t B_DQ = 0, B_DK = B_DQ + (size_t)T * (D / 2) * 2, B_DV = B_DK + (size_t)T * (D / 2) * 2;
constexpr size_t B_GQ = B_DV + (size_t)T * (D / 2) * 2, B_GK = B_GQ + (size_t)T * (D / 4) * 2, B_GV = B_GK + (size_t)T * (D / 4) * 2, B_GR = B_GV + (size_t)T * (D / 2) * 2;
constexpr size_t B_END1 = B_GR + (size_t)T * (D / 2) * 2;
constexpr size_t B_CQ = 0, B_CO = B_CQ + (size_t)T * D * 2, B_HE = B_CO + (size_t)T * D * 2, B_END2 = B_HE + (size_t)PMAX * DE * 2;
constexpr size_t B_BYTES = al256(B_END1 > B_END2 ? B_END1 : B_END2);
constexpr size_t WS_C = WS_B + B_BYTES;
constexpr size_t WS_D = WS_C + al256((size_t)T * D * 2);
constexpr size_t WS_END = WS_D + al256((size_t)T * D * 5);

constexpr int CW_CNT = 64;
constexpr int CW_BASE = 128;
constexpr int CW_TILE_E = 256;
constexpr int CW_NTILES = 512;
constexpr int CW_BAR = 4096;

__device__ __forceinline__ bf16 f2bf(float f) { unsigned u; memcpy(&u, &f, 4); u = (u + 0x7fffu + ((u >> 16) & 1u)) >> 16; return (bf16)u; }
__device__ __forceinline__ float bf2f(bf16 b) { unsigned u = ((unsigned)b) << 16; float f; memcpy(&f, &u, 4); return f; }
__device__ __forceinline__ float silu_f(float x) { return x / (1.f + expf(-x)); }
#ifdef HOST_EMU
static inline size_t gtid() { return emu_tid; }
static inline size_t gnth() { return emu_nth; }
#else
__device__ __forceinline__ size_t gtid() { return (size_t)blockIdx.x * blockDim.x + threadIdx.x; }
__device__ __forceinline__ size_t gnth() { return (size_t)gridDim.x * blockDim.x; }
#endif
struct bf16x8s { bf16 v[8]; };
__host__ __device__ __forceinline__ int win_logical(int np) {
    if (np >= D) return np; const int t = np & ~255, p = np & 255; return t + 64 * ((p & 127) >> 5) + 32 * (p >> 7) + (p & 31);
}
__host__ __device__ __forceinline__ int win_src_col(int np) { const int l = win_logical(np); return l < O_LR ? l : l + GRK; }

__device__ __forceinline__ void nk_rmsnorm_rows(const float* x, const float* g, bf16* out, int rows, int d) {
    for (size_t r = gtid(); r < (size_t)(rows); r += gnth()) {
    const float* xr = x + r * d; float ss = 0.f;
    for (int i = 0; i < d; ++i) ss += xr[i] * xr[i];
    const float rs = 1.0f / sqrtf(ss / d + EPS);
    for (int i = 0; i < d; ++i) out[r * d + i] = f2bf(xr[i] * rs * g[i]);
}}
__device__ __forceinline__ void nk_glr(const float* x, const float* g, const float* w_in, float* GLR) {
    for (size_t i = gtid(); i < (size_t)T * GRK; i += gnth()) { const int cc = (int)(i % GRK), t = (int)(i / GRK); const float* xr = x + (size_t)t * D; float ss = 0.f;
        for (int k = 0; k < D; ++k) ss += xr[k] * xr[k]; const float rs = 1.0f / sqrtf(ss / D + EPS); float a = 0.f;
        for (int k = 0; k < D; ++k) a += xr[k] * rs * g[k] * w_in[(size_t)k * IN_COLS + O_LR + cc]; GLR[i] = a; }
}
__device__ __forceinline__ void nk_zero_bf16(bf16* p, size_t n) { for (size_t i = gtid(); i < n; i += gnth()) p[i] = 0; }
__device__ __forceinline__ void nk_convT(const float* W, int ldw, int col0, bf16* WT, int N, int K) {
    for (size_t i = gtid(); i < (size_t)(N * K); i += gnth()) {
    const int n = (int)(i / K), k = (int)(i % K);
    WT[i] = f2bf(W[(size_t)k * ldw + col0 + n]);
}}
__device__ __forceinline__ void nk_conv_win(const float* W, bf16* WT) {
    for (size_t i = gtid(); i < (size_t)NIN * D; i += gnth()) { const int n = (int)(i / D), k = (int)(i % D); WT[i] = f2bf(W[(size_t)k * IN_COLS + win_src_col(n)]); }
}
constexpr int GUH = (DE >= 128) ? 128 : DE;
__device__ __forceinline__ void nk_conv_gu(const float* Wg, const float* Wu, bf16* WGU) {
    for (size_t i = gtid(); i < (size_t)(NE * 2 * DE * D); i += gnth()) {
    const int k = (int)(i % D); const int r = (int)((i / D) % (2 * DE)); const int e = (int)(i / ((size_t)D * 2 * DE));
    const int pn = r / (2 * GUH), ii = r % (2 * GUH); const int j = pn * GUH + (ii % GUH);
    const float* W = (ii < GUH) ? Wg : Wu;
    WGU[i] = f2bf(W[((size_t)e * D + k) * DE + j]);
}}
__device__ __forceinline__ void nk_conv_d(const float* Wd, bf16* WD) {
    for (size_t i = gtid(); i < (size_t)(NE * D * DE); i += gnth()) {
    const int j = (int)(i % DE); const int n = (int)((i / DE) % D); const int e = (int)(i / ((size_t)D * DE));
    WD[i] = f2bf(Wd[((size_t)e * DE + j) * D + n]);
}}
__device__ __forceinline__ void nk_rope_table(const int* positions, float* tab) {
    constexpr int half = DQK / 2; for (size_t i = gtid(); i < (size_t)(T * half); i += gnth()) {
    const int t = (int)(i / half), j = (int)(i % half);
    const float freq = powf(10000.0f, -(float)j / (float)half);
    const float ang = (float)positions[t] * freq;
    tab[i * 2] = cosf(ang); tab[i * 2 + 1] = sinf(ang);
}}

struct GemmP { const bf16* A; const bf16* Bt; int M, N, K, pad; float* f0; float* f1; bf16* b0; const float* x; };
template <int MODE> __device__ __forceinline__ void gemm_epi(const GemmP& p, int m, int n, float acc) {
    if constexpr (MODE == 0) {
        bf16* Bb = p.b0; n = win_logical(n);
        if (n < D) { p.f0[(size_t)m * D + n] = acc; return; }
        if (n < O_GQ) { ((bf16*)((char*)Bb + B_DV))[(size_t)m * (D / 2) + (n - O_DV)] = f2bf(acc); return; }
        if (n < O_GK) { ((bf16*)((char*)Bb + B_GQ))[(size_t)m * (D / 4) + (n - O_GQ)] = f2bf(acc * (1.0f / sqrtf((float)GKD))); return; }
        if (n < O_GV) { ((bf16*)((char*)Bb + B_GK))[(size_t)m * (D / 4) + (n - O_GK)] = f2bf(acc); return; }
        if (n < O_LR) { ((bf16*)((char*)Bb + B_GV))[(size_t)m * (D / 2) + (n - O_GV)] = f2bf(acc); return; }
        ((bf16*)((char*)Bb + B_GR))[(size_t)m * (D / 2) + (n - O_LR)] = f2bf(acc);
    } else if constexpr (MODE == 1) { p.f0[(size_t)m * p.N + n] = p.x[(size_t)m * p.N + n] + acc;
    } else if constexpr (MODE == 2) { p.b0[(size_t)m * p.N + n] = f2bf(acc);
    } else if constexpr (MODE == 4) { p.f0[(size_t)m * p.N + n] += acc;
    } else { p.f0[(size_t)m * p.N + n] = acc; }
}
template <int MODE> __device__ __forceinline__ void nk_gemm(GemmP p) {
    const int nb = p.N / 4; for (size_t idx = gtid(); idx < (size_t)(p.M / 4) * nb; idx += gnth()) {
    const int m0 = 4 * (int)(idx / nb), n0 = 4 * (int)(idx % nb);
    float acc[4][4];
#pragma unroll
    for (int i = 0; i < 4; ++i)
#pragma unroll
        for (int j = 0; j < 4; ++j) acc[i][j] = 0.f;
    for (int k = 0; k < p.K; k += 8) {
        bf16x8s a[4], b[4];
#pragma unroll
        for (int i = 0; i < 4; ++i) { a[i] = *(const bf16x8s*)(p.A + (size_t)(m0 + i) * p.K + k); b[i] = *(const bf16x8s*)(p.Bt + (size_t)(n0 + i) * p.K + k); }
#pragma unroll
        for (int kk = 0; kk < 8; ++kk) {
            float af[4], bfv[4];
#pragma unroll
            for (int i = 0; i < 4; ++i) { af[i] = bf2f(a[i].v[kk]); bfv[i] = bf2f(b[i].v[kk]); }
#pragma unroll
            for (int i = 0; i < 4; ++i)
#pragma unroll
                for (int j = 0; j < 4; ++j) acc[i][j] += af[i] * bfv[j];
        }
    }
#pragma unroll
    for (int i = 0; i < 4; ++i)
#pragma unroll
        for (int j = 0; j < 4; ++j) gemm_epi<MODE>(p, m0 + i, n0 + j, acc[i][j]);
}}

__device__ __forceinline__ void nk_qk_post(const float* tmpqk, const float* qg, const float* kg, const float* rope, bf16* DQ, bf16* DK) {
    for (size_t i = gtid(); i < (size_t)(T * 2 * DH * 2); i += gnth()) {
    const int c = (int)(i % 2), h = (int)((i / 2) % DH), which = (int)((i / (2 * DH)) % 2), t = (int)(i / (4 * DH));
    const float* src = tmpqk + (size_t)t * D + which * (D / 2) + h * 2 * DQK + c * DQK;
    const float* g = which ? kg : qg; bf16* dst = (which ? DK : DQ) + (size_t)t * (D / 2) + h * 2 * DQK + c * DQK;
    float ss = 0.f; for (int d = 0; d < DQK; ++d) ss += src[d] * src[d];
    const float rs = 1.0f / sqrtf(ss / DQK + EPS); constexpr int half = DQK / 2;
    const float sc = which ? 1.0f : (1.0f / sqrtf((float)DQK)) * LOG2E;
    for (int d = 0; d < half; ++d) {
        const float t1 = src[d] * rs * g[d], t2 = src[d + half] * rs * g[d + half];
        const float cs = rope[((size_t)t * half + d) * 2], sn = rope[((size_t)t * half + d) * 2 + 1];
        dst[d] = f2bf((t1 * cs - t2 * sn) * sc); dst[d + half] = f2bf((t2 * cs + t1 * sn) * sc);
    }
}}
__device__ __forceinline__ void nk_lam(const float* q1, const float* k1, const float* q2, const float* k2, float* out) {
    if (gtid() != 0) return; float a = 0.f, b = 0.f; for (int i = 0; i < DQK; ++i) { a += q1[i] * k1[i]; b += q2[i] * k2[i]; }
    out[0] = expf(a) - expf(b) + 0.2f;
}
__device__ __forceinline__ void nk_diff_stats(const bf16* DQ, const bf16* DK, float* stats) {
    for (size_t i = gtid(); i < (size_t)(T * DH * 2); i += gnth()) {
    const int c = (int)(i % 2), h = (int)((i / 2) % DH), t = (int)(i / (2 * DH)); const int b = t / SEQ, s = t % SEQ;
    const int nk = (s / CHUNK + 1) * CHUNK;
    float q[DQK]; const bf16* qp = DQ + (size_t)t * (D / 2) + h * 2 * DQK + c * DQK;
#pragma unroll
    for (int d = 0; d < DQK; ++d) q[d] = bf2f(qp[d]);
    float mx = -1e30f;
    for (int k = 0; k < nk; ++k) { const bf16* kp = DK + (size_t)(b * SEQ + k) * (D / 2) + h * 2 * DQK + c * DQK; float sdot = 0.f;
#pragma unroll
        for (int d = 0; d < DQK; ++d) sdot += q[d] * bf2f(kp[d]);
        mx = fmaxf(mx, sdot); }
    float sum = 0.f;
    for (int k = 0; k < nk; ++k) { const bf16* kp = DK + (size_t)(b * SEQ + k) * (D / 2) + h * 2 * DQK + c * DQK; float sdot = 0.f;
#pragma unroll
        for (int d = 0; d < DQK; ++d) sdot += q[d] * bf2f(kp[d]);
        sum += exp2f(sdot - mx); }
    stats[i * 2] = mx; stats[i * 2 + 1] = sum;
}}
__device__ __forceinline__ void nk_diff_pv(const bf16* DQ, const bf16* DK, const bf16* DV, const float* stats, const float* lamp, float* otmp) {
    constexpr int NDG = 8, DG = DVD / NDG;
    for (size_t i = gtid(); i < (size_t)(T * DH * NDG); i += gnth()) {
    const int dg = (int)(i % NDG), h = (int)((i / NDG) % DH), t = (int)(i / (NDG * DH)); const int b = t / SEQ, s = t % SEQ;
    const int nk = (s / CHUNK + 1) * CHUNK; const float lam = lamp[0];
    float q[2 * DQK]; const bf16* qp = DQ + (size_t)t * (D / 2) + h * 2 * DQK;
#pragma unroll
    for (int d = 0; d < 2 * DQK; ++d) q[d] = bf2f(qp[d]);
    const float m0 = stats[((size_t)(t * DH + h) * 2 + 0) * 2], l0 = stats[((size_t)(t * DH + h) * 2 + 0) * 2 + 1];
    const float m1 = stats[((size_t)(t * DH + h) * 2 + 1) * 2], l1 = stats[((size_t)(t * DH + h) * 2 + 1) * 2 + 1];
    float acc[DG];
#pragma unroll
    for (int d = 0; d < DG; ++d) acc[d] = 0.f;
    for (int k = 0; k < nk; ++k) { const bf16* kp = DK + (size_t)(b * SEQ + k) * (D / 2) + h * 2 * DQK; float s0 = 0.f, s1 = 0.f;
#pragma unroll
        for (int d = 0; d < DQK; ++d) { s0 += q[d] * bf2f(kp[d]); s1 += q[DQK + d] * bf2f(kp[DQK + d]); }
        const float a = exp2f(s0 - m0) / l0 - lam * exp2f(s1 - m1) / l1;
        const bf16* vp = DV + (size_t)(b * SEQ + k) * (D / 2) + h * DVD + dg * DG;
#pragma unroll
        for (int d = 0; d < DG; ++d) acc[d] += a * bf2f(vp[d]); }
#pragma unroll
    for (int d = 0; d < DG; ++d) otmp[(size_t)t * (D / 2) + h * DVD + dg * DG + d] = acc[d];
}}
__device__ __forceinline__ void nk_diff_norm(const float* otmp, const float* g, bf16* MIX) {
    for (size_t i = gtid(); i < (size_t)(T * DH); i += gnth()) { const int h = (int)(i % DH), t = (int)(i / DH);
    const float* o = otmp + (size_t)t * (D / 2) + h * DVD; float ss = 0.f; for (int d = 0; d < DVD; ++d) ss += o[d] * o[d];
    const float rs = 1.0f / sqrtf(ss / DVD + EPS);
    for (int d = 0; d < DVD; ++d) MIX[(size_t)t * D + h * DVD + d] = f2bf(o[d] * rs * g[d] * 0.8f);
}}
__device__ __forceinline__ void nk_gla_cum(const float* GLR, const float* wa2, const float* ba, float* CUM) {
    constexpr int W = GH * GKD; for (size_t i = gtid(); i < (size_t)(B * NC * W); i += gnth()) {
    const int j = (int)(i % W), cb = (int)(i / W); float run = 0.f;
    for (int tt = 0; tt < CHUNK; ++tt) { const int t = cb * CHUNK + tt; float z = ba[j];
        for (int r = 0; r < GRK; ++r) z += GLR[(size_t)t * GRK + r] * wa2[(size_t)r * W + j];
        const float ls = fminf(z, 0.f) - log1pf(expf(-fabsf(z)));
        run += ls * (1.0f / 16.0f); CUM[(size_t)t * W + j] = run; }
}}
__device__ __forceinline__ void nk_gla_run(const bf16* GQ, const bf16* GK, const bf16* GV, const float* CUM, float* otmp) {
    constexpr int KH = GKD / 2;
    for (size_t i = gtid(); i < (size_t)(B * GH * GVD); i += gnth()) {
    const int v = (int)(i % GVD), h = (int)((i / GVD) % GH), b = (int)(i / (GVD * GH)); constexpr int W = GH * GKD;
    for (int kh = 0; kh < 2; ++kh) {
    float S[KH];
#pragma unroll
    for (int k = 0; k < KH; ++k) S[k] = 0.f;
    for (int c = 0; c < NC; ++c) { const int t0 = b * SEQ + c * CHUNK; const float* ce = CUM + (size_t)(t0 + CHUNK - 1) * W + h * GKD + kh * KH;
#pragma unroll
        for (int k = 0; k < KH; ++k) S[k] *= expf(ce[k]);
        for (int tt = 0; tt < CHUNK; ++tt) { const int t = t0 + tt; const float vv = bf2f(GV[(size_t)t * (D / 2) + h * GVD + v]);
            const bf16* kp = GK + (size_t)t * (D / 4) + h * GKD + kh * KH; const float* cp = CUM + (size_t)t * W + h * GKD + kh * KH;
#pragma unroll
            for (int k = 0; k < KH; ++k) S[k] += bf2f(kp[k]) * expf(ce[k] - cp[k]) * vv; }
        for (int tt = 0; tt < CHUNK; ++tt) { const int t = t0 + tt; const bf16* qp = GQ + (size_t)t * (D / 4) + h * GKD + kh * KH; float o = 0.f;
#pragma unroll
            for (int k = 0; k < KH; ++k) o += bf2f(qp[k]) * S[k];
            float* op = otmp + (size_t)t * (D / 2) + h * GVD + v; if (kh == 0) *op = o; else *op += o; } }
    } }
}
__device__ __forceinline__ void nk_gla_norm(const float* otmp, const float* g, const bf16* GR, bf16* MIX) {
    for (size_t i = gtid(); i < (size_t)(T * GH); i += gnth()) { const int h = (int)(i % GH), t = (int)(i / GH);
    const float* o = otmp + (size_t)t * (D / 2) + h * GVD; float ss = 0.f; for (int d = 0; d < GVD; ++d) ss += o[d] * o[d];
    const float rs = 1.0f / sqrtf(ss / GVD + EPS);
    for (int d = 0; d < GVD; ++d) MIX[(size_t)t * D + D / 2 + h * GVD + d] = f2bf(o[d] * rs * g[d] * silu_f(bf2f(GR[(size_t)t * (D / 2) + h * GVD + d])));
}}
__device__ __forceinline__ void nk_cqss(const bf16* CQ, float* CQSS) {
    for (size_t i = gtid(); i < (size_t)T * 32; i += gnth()) { const int j = (int)(i % 32), t = (int)(i / 32);
    float ss = 0.f; for (int d = 0; d < D / 32; ++d) { const float v = bf2f(CQ[(size_t)t * D + j * (D / 32) + d]); ss += v * v; } CQSS[i] = ss; }
}
__device__ __forceinline__ void nk_ckv_fix(const bf16* CKV, const float* qg, const float* kg, bf16* CK2, bf16* CVT) {
    for (size_t i = gtid(); i < (size_t)(B * NMEM * CH); i += gnth()) { const int h = (int)(i % CH), bm = (int)(i / CH); const int b = bm / NMEM, m = bm % NMEM;
    const bf16* kp = CKV + (size_t)bm * 2 * D + h * CHD; const bf16* vp = CKV + (size_t)bm * 2 * D + D + h * CHD;
    float ss = 0.f; for (int d = 0; d < CHD; ++d) { const float v = bf2f(kp[d]); ss += v * v; }
    const float rs = 1.0f / sqrtf(ss / CHD + EPS) * (1.0f / sqrtf((float)CHD)) * LOG2E;
    for (int d = 0; d < CHD; ++d) { CK2[(((size_t)b * CH + h) * NMEM + m) * CHD + d] = f2bf(bf2f(kp[d]) * rs * kg[d] * qg[d]);
        CVT[(((size_t)b * CH + h) * CHD + d) * NMEM + m] = vp[d]; }
}}
__device__ __forceinline__ void nk_cross_scores(const bf16* CQ, const float* CQSS, const bf16* CK2, float* P) {
    for (size_t i = gtid(); i < (size_t)(T * CH * NMEM); i += gnth()) { const int m = (int)(i % NMEM), h = (int)((i / NMEM) % CH), t = (int)(i / (NMEM * CH)); const int b = t / SEQ;
    float qs = 0.f; for (int j = 0; j < 8; ++j) qs += CQSS[(size_t)t * 32 + 8 * h + j];
    const float rq = 1.0f / sqrtf(qs / CHD + EPS);
    const bf16* qp = CQ + (size_t)t * D + h * CHD; const bf16* kp = CK2 + (((size_t)b * CH + h) * NMEM + m) * CHD; float s = 0.f;
    for (int d = 0; d < CHD; ++d) s += bf2f(qp[d]) * bf2f(kp[d]);
    P[i] = s * rq;
}}
__device__ __forceinline__ void nk_cross_softmax(float* P) {
    for (size_t i = gtid(); i < (size_t)(T * CH); i += gnth()) { float* p = P + i * NMEM; float mx = -1e30f;
    for (int m = 0; m < NMEM; ++m) mx = fmaxf(mx, p[m]); float sum = 0.f;
    for (int m = 0; m < NMEM; ++m) { p[m] = exp2f(p[m] - mx); sum += p[m]; }
    for (int m = 0; m < NMEM; ++m) p[m] /= sum;
}}
__device__ __forceinline__ void nk_cross_pv(const float* P, const bf16* CVT, bf16* CO) {
    for (size_t i = gtid(); i < (size_t)(T * D); i += gnth()) { const int d = (int)(i % CHD), h = (int)((i / CHD) % CH), t = (int)(i / D); const int b = t / SEQ;
    const float* p = P + ((size_t)t * CH + h) * NMEM; const bf16* vp = CVT + (((size_t)b * CH + h) * CHD + d) * NMEM; float o = 0.f;
    for (int m = 0; m < NMEM; ++m) o += p[m] * bf2f(vp[m]);
    CO[i] = f2bf(o);
}}
__device__ __forceinline__ void nk_router(const float* h2, const float* g, const float* wrg, const float* brg, const float* wre, const float* bre, bf16* XN, int* EXPERT, float* GATE, int* SLOTPOS, int* ctl) {
    for (size_t t = gtid(); t < (size_t)(T); t += gnth()) { const float* xr = h2 + t * D; float ss = 0.f;
    for (int i = 0; i < D; ++i) ss += xr[i] * xr[i]; const float rs = 1.0f / sqrtf(ss / D + EPS);
    float gl[NG], el[NE];
#pragma unroll
    for (int j = 0; j < NG; ++j) gl[j] = brg[j];
#pragma unroll
    for (int j = 0; j < NE; ++j) el[j] = bre[j];
    for (int i = 0; i < D; ++i) { const float xv = xr[i] * rs * g[i]; XN[t * D + i] = f2bf(xv);
#pragma unroll
        for (int j = 0; j < NG; ++j) gl[j] += xv * wrg[(size_t)i * NG + j];
#pragma unroll
        for (int j = 0; j < NE; ++j) el[j] += xv * wre[(size_t)i * NE + j]; }
    int grp = 0; float gm = gl[0];
#pragma unroll
    for (int j = 1; j < NG; ++j) if (gl[j] > gm) { gm = gl[j]; grp = j; }
    float gs = 0.f;
#pragma unroll
    for (int j = 0; j < NG; ++j) gs += expf(gl[j] - gm);
    const float grp_w = 1.0f / gs;
    float e8[EPG];
#pragma unroll
    for (int j = 0; j < EPG; ++j) { float v = 0.f;
#pragma unroll
        for (int gq = 0; gq < NG; ++gq) v = (grp == gq) ? el[gq * EPG + j] : v;
        e8[j] = v; }
    int i0 = 0; float v0 = e8[0];
#pragma unroll
    for (int j = 1; j < EPG; ++j) if (e8[j] > v0) { v0 = e8[j]; i0 = j; }
    int i1 = -1; float v1 = -1e30f;
#pragma unroll
    for (int j = 0; j < EPG; ++j) if (j != i0 && e8[j] > v1) { v1 = e8[j]; i1 = j; }
    const float r = expf(v1 - v0); const float g0 = grp_w / (1.f + r), g1 = grp_w * r / (1.f + r);
    const int e0 = grp * EPG + i0, e1 = grp * EPG + i1;
    EXPERT[t * 2] = e0; EXPERT[t * 2 + 1] = e1; GATE[t * 2] = g0; GATE[t * 2 + 1] = g1;
    SLOTPOS[t * 2] = atomicAdd(&ctl[CW_CNT + e0], 1); SLOTPOS[t * 2 + 1] = atomicAdd(&ctl[CW_CNT + e1], 1);
}}
__device__ __forceinline__ void nk_moe_offsets(int* ctl) {
    if (gtid() != 0) return; int base = 0, nt = 0;
    for (int e = 0; e < NE; ++e) { ctl[CW_BASE + e] = base; const int n = (ctl[CW_CNT + e] + ETILE - 1) / ETILE; for (int j = 0; j < n; ++j) ctl[CW_TILE_E + nt + j] = e; nt += n; base += n * ETILE; }
    ctl[CW_BASE + NE] = base; ctl[CW_NTILES] = nt; for (int j = nt; j < NTILE; ++j) ctl[CW_TILE_E + j] = -1;
}
__device__ __forceinline__ void nk_moe_init_slots(int* SLOTTOK, float* SLOTGATE) { for (size_t i = gtid(); i < (size_t)PMAX; i += gnth()) { SLOTTOK[i] = T; SLOTGATE[i] = 0.f; } }
__device__ __forceinline__ void nk_moe_fill(const int* EXPERT, const float* GATE, const int* SLOTPOS, const int* ctl, int* SLOTTOK, float* SLOTGATE) {
    for (size_t i = gtid(); i < (size_t)(T * 2); i += gnth()) { const int e = EXPERT[i]; const int dst = ctl[CW_BASE + e] + SLOTPOS[i];
    SLOTTOK[dst] = (int)(i / 2); SLOTGATE[dst] = GATE[i];
}}
__device__ __forceinline__ void nk_moe_gu(const bf16* XN, const bf16* WGU, const int* SLOTTOK, const int* ctl, bf16* HE) {
    for (size_t i = gtid(); i < (size_t)(PMAX * DE); i += gnth()) { const int j = (int)(i % DE), p = (int)(i / DE); const int e = ctl[CW_TILE_E + p / ETILE];
    if (e < 0) continue; const int tok = SLOTTOK[p];
    const int pn = j / GUH, jj = j % GUH; const bf16* wg = WGU + ((size_t)e * 2 * DE + pn * 2 * GUH + jj) * D; const bf16* wu = wg + (size_t)GUH * D;
    const bf16* xr = XN + (size_t)tok * D; float g = 0.f, u = 0.f;
    for (int k = 0; k < D; ++k) { const float xv = bf2f(xr[k]); g += xv * bf2f(wg[k]); u += xv * bf2f(wu[k]); }
    HE[i] = f2bf(silu_f(g) * u);
}}
__device__ __forceinline__ void nk_moe_down(const bf16* HE, const bf16* WD, const int* SLOTTOK, const float* SLOTGATE, const int* ctl, float* out) {
    for (size_t i = gtid(); i < (size_t)(PMAX * D); i += gnth()) { const int n = (int)(i % D), p = (int)(i / D); const int e = ctl[CW_TILE_E + p / ETILE];
    if (e < 0) continue; const int tok = SLOTTOK[p]; if (tok >= T) continue;
    const bf16* hr = HE + (size_t)p * DE; const bf16* wr = WD + ((size_t)e * D + n) * DE; float y = 0.f;
    for (int k = 0; k < DE; ++k) y += bf2f(hr[k]) * bf2f(wr[k]);
    atomicAdd(&out[(size_t)tok * D + n], y * SLOTGATE[p]);
}}


#ifndef HOST_EMU
static_assert(D == 2048 && SEQ == 4096 && NMEM == 256 && ETILE == 256, "the fast phases are written for the real shapes");
#define LAS __attribute__((address_space(3)))
#define GAS __attribute__((address_space(1)))
#define LDS_WAIT() asm volatile("s_waitcnt lgkmcnt(0)" ::: "memory")
#define VM_WAIT() asm volatile("s_waitcnt vmcnt(0)" ::: "memory")
namespace pg8 {
#define PG8_LAS __attribute__((address_space(3)))
typedef unsigned short bf16_t;
typedef short bf16x8 __attribute__((ext_vector_type(8)));
typedef float f32x4 __attribute__((ext_vector_type(4)));
typedef unsigned u32x4 __attribute__((ext_vector_type(4)));
constexpr int BM = 256, BK = 64, HALF = 128, HTB = HALF * BK * 2  , STAGE_BYTES = 8 * HTB, NXCD = 8, WGM = 8;

__host__ __device__ __forceinline__ int lds_byte(int r, int c) { const int st = (r >> 4) * 2 + (c >> 5), rr = r & 15, cc = c & 31, ob = rr * 64 + cc * 2; return st * 1024 + (ob ^ (((ob >> 9) & 1) << 5)); }
__host__ __device__ __forceinline__ void stage_rc(int b, int& R, int& C) { const int st = b / 1024, sb = b % 1024, swz = sb ^ (((sb >> 9) & 1) << 5); R = (st >> 1) * 16 + swz / 64; C = (st & 1) * 32 + (swz % 64) / 2; }
__host__ __device__ __forceinline__ int perm32(int rho) { const int n = rho >> 4, i = rho & 15; return 8 * (i >> 2) + 4 * n + (i & 3); }

struct Unit { int pm, pn; };
struct Gemm { const bf16_t* A; const bf16_t* Bt; int M, N, K; };

struct StaticOrder {
    int nM, nN, nwg, G, c;
    __host__ __device__ void init(int M, int N, int G_, int c_) { nM = M / BM; nN = N / BM; nwg = nM * nN; G = G_; c = c_; }
    __host__ __device__ bool next(int i, Unit& u) const {
        const long L = (long)i * G + c; if (L >= nwg) return false;
        int wgid = (int)L; { const int q = nwg / NXCD, r = nwg % NXCD, xcd = wgid % NXCD, off = wgid / NXCD; wgid = (xcd < r ? xcd * (q + 1) : r * (q + 1) + (xcd - r) * q) + off; }
        const int nig = WGM * nN, gid = wgid / nig, fm = gid * WGM, gsz = (nM - fm) < WGM ? (nM - fm) : WGM;
        u.pm = fm + ((wgid % nig) % gsz); u.pn = (wgid % nig) / gsz; return true;
    }
    __device__ __forceinline__ void a_ready(const Unit&) const {}
    __device__ __forceinline__ void done(const Unit&) const {}
};
__device__ __forceinline__ unsigned cvt_pk_bf16(float lo, float hi) { unsigned r; asm volatile("v_cvt_pk_bf16_f32 %0, %1, %2" : "=v"(r) : "v"(lo), "v"(hi)); return r; }
__device__ __forceinline__ float dot4(const f32x4 a) { return (a[0] * a[0] + a[1] * a[1]) + (a[2] * a[2] + a[3] * a[3]); }
struct EpiInProj {
    static constexpr bool PERM = true, AFTER_DRAIN = false;
    char* rb; const float* rope; const float* qg; const float* kg;
    __device__ __forceinline__ void operator()(const f32x4 (&acc)[2][2][4][2], const Unit& u, int wr, int wc, int fr, int fq) const {
        const int row0 = u.pm * BM + wr * 64 + fr;
        if (u.pn < 8) {
            const bool isk = u.pn >= 4; const float* g = isk ? kg : qg;
            bf16_t* dst = (bf16_t*)(rb + (isk ? B_DK : B_DQ)) + ((u.pn & 3) * 4 + wc) * 64 + 8 * fq;
            const float sc = isk ? 1.0f : 0.125f * LOG2E;
            const f32x4 ga0 = *(const f32x4*)(g + 8 * fq), ga1 = *(const f32x4*)(g + 8 * fq + 4), gb0 = *(const f32x4*)(g + 32 + 8 * fq), gb1 = *(const f32x4*)(g + 36 + 8 * fq);
#pragma unroll
            for (int ai = 0; ai < 2; ++ai)
#pragma unroll
                for (int m = 0; m < 4; ++m) {
                    const int row = row0 + ai * HALF + m * 16;
                    const f32x4 a0 = acc[ai][0][m][0], a1 = acc[ai][0][m][1], b0 = acc[ai][1][m][0], b1 = acc[ai][1][m][1];
                    float ss = (dot4(a0) + dot4(a1)) + (dot4(b0) + dot4(b1));
                    ss += __shfl_xor(ss, 16); ss += __shfl_xor(ss, 32);
                    const float rs = sc / sqrtf(ss * (1.0f / 64.0f) + EPS);
                    const f32x4* rp = (const f32x4*)(rope + ((size_t)row * 32 + 8 * fq) * 2);
                    const f32x4 r0 = rp[0], r1 = rp[1], r2 = rp[2], r3 = rp[3];
                    const f32x4 t1a = a0 * ga0 * rs, t1b = a1 * ga1 * rs, t2a = b0 * gb0 * rs, t2b = b1 * gb1 * rs;
                    u32x4 w1, w2;
                    w1.x = cvt_pk_bf16(t1a[0] * r0[0] - t2a[0] * r0[1], t1a[1] * r0[2] - t2a[1] * r0[3]); w1.y = cvt_pk_bf16(t1a[2] * r1[0] - t2a[2] * r1[1], t1a[3] * r1[2] - t2a[3] * r1[3]);
                    w1.z = cvt_pk_bf16(t1b[0] * r2[0] - t2b[0] * r2[1], t1b[1] * r2[2] - t2b[1] * r2[3]); w1.w = cvt_pk_bf16(t1b[2] * r3[0] - t2b[2] * r3[1], t1b[3] * r3[2] - t2b[3] * r3[3]);
                    w2.x = cvt_pk_bf16(t2a[0] * r0[0] + t1a[0] * r0[1], t2a[1] * r0[2] + t1a[1] * r0[3]); w2.y = cvt_pk_bf16(t2a[2] * r1[0] + t1a[2] * r1[1], t2a[3] * r1[2] + t1a[3] * r1[3]);
                    w2.z = cvt_pk_bf16(t2b[0] * r2[0] + t1b[0] * r2[1], t2b[1] * r2[2] + t1b[1] * r2[3]); w2.w = cvt_pk_bf16(t2b[2] * r3[0] + t1b[2] * r3[1], t2b[3] * r3[2] + t1b[3] * r3[3]);
                    bf16_t* rowp = dst + (size_t)row * (D / 2);
                    *(u32x4*)rowp = w1; *(u32x4*)(rowp + 32) = w2;
                }
        } else {
            const int pn = u.pn; bf16_t* base; int ldc, colt; float sc = 1.0f;
            if (pn < 12) { base = (bf16_t*)(rb + B_DV); ldc = D / 2; colt = (pn - 8) * BM; }
            else if (pn < 14) { base = (bf16_t*)(rb + B_GQ); ldc = D / 4; colt = (pn - 12) * BM; sc = 0.08838834764831845f; }
            else if (pn < 16) { base = (bf16_t*)(rb + B_GK); ldc = D / 4; colt = (pn - 14) * BM; }
            else if (pn < 20) { base = (bf16_t*)(rb + B_GV); ldc = D / 2; colt = (pn - 16) * BM; }
            else { base = (bf16_t*)(rb + B_GR); ldc = D / 2; colt = (pn - 20) * BM; }
            const int col0 = colt + wc * 32 + 8 * fq;
#pragma unroll
            for (int ai = 0; ai < 2; ++ai)
#pragma unroll
                for (int m = 0; m < 4; ++m) { bf16_t* rowp = base + (size_t)(row0 + ai * HALF + m * 16) * ldc + col0;
#pragma unroll
                    for (int bj = 0; bj < 2; ++bj) { const f32x4 v0 = acc[ai][bj][m][0] * sc, v1 = acc[ai][bj][m][1] * sc;
                        u32x4 w; w.x = cvt_pk_bf16(v0[0], v0[1]); w.y = cvt_pk_bf16(v0[2], v0[3]); w.z = cvt_pk_bf16(v1[0], v1[1]); w.w = cvt_pk_bf16(v1[2], v1[3]);
                        *(u32x4*)(rowp + bj * HALF) = w; } }
        }
    }
};
struct EpiResid {
    static constexpr bool PERM = true, AFTER_DRAIN = false;
    const float* base; float* out; bf16_t* xn; const float* g; float* ssp;
    __device__ __forceinline__ void operator()(const f32x4 (&acc)[2][2][4][2], const Unit& u, int wr, int wc, int fr, int fq) const {
        const int row0 = u.pm * BM + wr * 64 + fr, col0 = u.pn * BM + wc * 32 + 8 * fq;
        f32x4 gv[2][2];
#pragma unroll
        for (int bj = 0; bj < 2; ++bj)
#pragma unroll
            for (int n = 0; n < 2; ++n) gv[bj][n] = *(const f32x4*)(g + col0 + bj * HALF + 4 * n);
#pragma unroll
        for (int ai = 0; ai < 2; ++ai)
#pragma unroll
            for (int m = 0; m < 4; ++m) { const int row = row0 + ai * HALF + m * 16; const size_t off = (size_t)row * D + col0; float ss = 0.f;
#pragma unroll
                for (int bj = 0; bj < 2; ++bj) { const f32x4 b0 = *(const f32x4*)(base + off + bj * HALF), b1 = *(const f32x4*)(base + off + bj * HALF + 4);
                    const f32x4 v0 = acc[ai][bj][m][0] + b0, v1 = acc[ai][bj][m][1] + b1;
                    *(f32x4*)(out + off + bj * HALF) = v0; *(f32x4*)(out + off + bj * HALF + 4) = v1; ss += dot4(v0) + dot4(v1);
                    const f32x4 x0 = v0 * gv[bj][0], x1 = v1 * gv[bj][1];
                    u32x4 w; w.x = cvt_pk_bf16(x0[0], x0[1]); w.y = cvt_pk_bf16(x0[2], x0[3]); w.z = cvt_pk_bf16(x1[0], x1[1]); w.w = cvt_pk_bf16(x1[2], x1[3]);
                    *(u32x4*)(xn + off + bj * HALF) = w; }
                ss += __shfl_xor(ss, 16); ss += __shfl_xor(ss, 32);
                if (fq == 0) ssp[(size_t)row * 32 + u.pn * 4 + wc] = ss;
                if (m & 1) asm volatile("" ::: "memory"); }
    }
};
struct EpiCq {
    static constexpr bool PERM = true, AFTER_DRAIN = false;
    const float* ssp_in; bf16_t* cq; float* cqss;
    __device__ __forceinline__ void operator()(const f32x4 (&acc)[2][2][4][2], const Unit& u, int wr, int wc, int fr, int fq) const {
        const int lane = fr + 16 * fq, row0 = u.pm * BM + wr * 64 + fr, col0 = u.pn * BM + wc * 32 + 8 * fq;
        float rs2[2];
#pragma unroll
        for (int ai = 0; ai < 2; ++ai) { const f32x4* p = (const f32x4*)(ssp_in + (size_t)(u.pm * BM + ai * HALF + wr * 64 + lane) * 32); f32x4 s4 = p[0];
#pragma unroll
            for (int j = 1; j < 8; ++j) s4 += p[j];
            rs2[ai] = 1.0f / sqrtf(((s4[0] + s4[1]) + (s4[2] + s4[3])) * (1.0f / D) + EPS); }
#pragma unroll
        for (int ai = 0; ai < 2; ++ai)
#pragma unroll
            for (int m = 0; m < 4; ++m) { const int row = row0 + ai * HALF + m * 16; const size_t off = (size_t)row * D + col0; float ss = 0.f;
                const float rsr = __shfl(rs2[ai], 16 * m + fr);
#pragma unroll
                for (int bj = 0; bj < 2; ++bj) { const f32x4 v0 = acc[ai][bj][m][0] * rsr, v1 = acc[ai][bj][m][1] * rsr; ss += dot4(v0) + dot4(v1);
                    u32x4 w; w.x = cvt_pk_bf16(v0[0], v0[1]); w.y = cvt_pk_bf16(v0[2], v0[3]); w.z = cvt_pk_bf16(v1[0], v1[1]); w.w = cvt_pk_bf16(v1[2], v1[3]);
                    *(u32x4*)(cq + off + bj * HALF) = w; }
                ss += __shfl_xor(ss, 16); ss += __shfl_xor(ss, 32);
                if (fq == 0) cqss[(size_t)row * 32 + u.pn * 4 + wc] = ss; }
    }
};

struct MoeOrder {
    const int* ctl; int NP, G, c;
    __device__ __forceinline__ bool next(int i, Unit& u) const { const int nt = ctl[CW_NTILES]; const int L = i * G + c; if (L >= nt * NP) return false;
        const int rt = L / NP; u.pm = rt; u.pn = ctl[CW_TILE_E + rt] * NP + (L - rt * NP); return true; }
    __device__ __forceinline__ void a_ready(const Unit&) const {}
    __device__ __forceinline__ void done(const Unit&) const {}
};
__device__ __forceinline__ float silu_fast(float x) { return x * __builtin_amdgcn_rcpf(1.0f + __expf(-x)); }
struct EpiGU {
    static constexpr bool PERM = true, AFTER_DRAIN = false;
    const int* slottok; const float* ssp; bf16_t* he;
    __device__ __forceinline__ void operator()(const f32x4 (&acc)[2][2][4][2], const Unit& u, int wr, int wc, int fr, int fq) const {
        const int lane = fr + 16 * fq, p0 = u.pm * BM + wr * 64, ct = u.pn & 3;
        float rs2[2];
#pragma unroll
        for (int ai = 0; ai < 2; ++ai) { const int tok = slottok[p0 + ai * HALF + lane]; float rs = 0.f;
            if (tok < T) { const f32x4* p = (const f32x4*)(ssp + (size_t)tok * 32); f32x4 s4 = p[0];
#pragma unroll
                for (int j = 1; j < 8; ++j) s4 += p[j];
                rs = 1.0f / sqrtf(((s4[0] + s4[1]) + (s4[2] + s4[3])) * (1.0f / D) + EPS); }
            rs2[ai] = rs; }
#pragma unroll
        for (int ai = 0; ai < 2; ++ai)
#pragma unroll
            for (int m = 0; m < 4; ++m) { const float rsr = __shfl(rs2[ai], 16 * m + fr);
                bf16_t* rowp = he + (size_t)(p0 + ai * HALF + 16 * m + fr) * DE + ct * 128 + wc * 32 + 8 * fq;
                const f32x4 g0 = acc[ai][0][m][0] * rsr, g1 = acc[ai][0][m][1] * rsr, u0 = acc[ai][1][m][0] * rsr, u1 = acc[ai][1][m][1] * rsr;
                u32x4 w; w.x = cvt_pk_bf16(silu_fast(g0[0]) * u0[0], silu_fast(g0[1]) * u0[1]); w.y = cvt_pk_bf16(silu_fast(g0[2]) * u0[2], silu_fast(g0[3]) * u0[3]);
                w.z = cvt_pk_bf16(silu_fast(g1[0]) * u1[0], silu_fast(g1[1]) * u1[1]); w.w = cvt_pk_bf16(silu_fast(g1[2]) * u1[2], silu_fast(g1[3]) * u1[3]);
                *(u32x4*)rowp = w; }
    }
};
struct EpiDown {
    static constexpr bool PERM = true, AFTER_DRAIN = false;
    const int* slottok; const float* slotgate; float* out;
    __device__ __forceinline__ void operator()(const f32x4 (&acc)[2][2][4][2], const Unit& u, int wr, int wc, int fr, int fq) const {
        const int lane = fr + 16 * fq, p0 = u.pm * BM + wr * 64, ct = u.pn & 7;
        int tk2[2]; float gt2[2];
#pragma unroll
        for (int ai = 0; ai < 2; ++ai) { tk2[ai] = slottok[p0 + ai * HALF + lane]; gt2[ai] = slotgate[p0 + ai * HALF + lane]; }
#pragma unroll
        for (int ai = 0; ai < 2; ++ai)
#pragma unroll
            for (int m = 0; m < 4; ++m) { const int tok = __shfl(tk2[ai], 16 * m + fr); const float gt = __shfl(gt2[ai], 16 * m + fr);
                if (tok < T) { float* rowp = out + (size_t)tok * D + ct * BM + wc * 32 + 8 * fq;
#pragma unroll
                    for (int bj = 0; bj < 2; ++bj)
#pragma unroll
                        for (int n = 0; n < 2; ++n)
#pragma unroll
                            for (int i = 0; i < 4; ++i) (void)unsafeAtomicAdd(rowp + bj * HALF + 4 * n + i, acc[ai][bj][m][n][i] * gt); } }
    }
};
template <class Epi, class Sched, bool ALIGN_EPI = false, bool SP2 = false>
__device__ __forceinline__ void gemm_phase(PG8_LAS unsigned char* lds, const Gemm g, const Sched& S, const Epi& E) {
    const int tid = threadIdx.x, wid = __builtin_amdgcn_readfirstlane(tid >> 6), lane = tid & 63, wr = wid >> 2, wc = wid & 3, fr = lane & 15, fq = lane >> 4;
    const int K = g.K, nt = K / BK;
    unsigned voffA[2], voffB[2];
#pragma unroll
    for (int i = 0; i < 2; ++i) { int R, C; stage_rc(tid * 16 + i * 8192, R, C); const int Rb = Epi::PERM ? ((R & ~31) + perm32(R & 31)) : R;
        voffA[i] = (unsigned)(R * K + C) * 2u; voffB[i] = (unsigned)(Rb * K + C) * 2u; }
    const size_t kstep = (size_t)(BK * 2);
    const size_t hstep = (size_t)HALF * K * 2;
    const size_t tstep = 2 * hstep;
    const unsigned ldsw = (unsigned)wid * 1024u;
    const int aoff = lds_byte(wr * 64 + fr, fq * 8), boff = lds_byte(wc * 32 + fr, fq * 8);
#define PG8_SA(b, h) (((b) * 2 + (h)) * HTB)
#define PG8_SB(b, h) ((4 + (b) * 2 + (h)) * HTB)
#define PG8_STAGE(bufoff, gbase, voff) do { _Pragma("unroll") for (int _i = 0; _i < 2; ++_i) \
        __builtin_amdgcn_global_load_lds((const unsigned*)((const char*)(gbase) + (voff)[_i]), (PG8_LAS unsigned*)(lds + (bufoff) + ldsw + _i * 8192), 16, 0, 0); } while (0)
#define PG8_LDA(dst, b, h) do { _Pragma("unroll") for (int m = 0; m < 4; ++m) _Pragma("unroll") for (int k = 0; k < 2; ++k) dst[m][k] = *(const PG8_LAS bf16x8*)(lds + PG8_SA(b, h) + aoff + m * 2048 + k * 1024); } while (0)
#define PG8_LDB(dst, b, h) do { _Pragma("unroll") for (int n = 0; n < 2; ++n) _Pragma("unroll") for (int k = 0; k < 2; ++k) dst[n][k] = *(const PG8_LAS bf16x8*)(lds + PG8_SB(b, h) + boff + n * 2048 + k * 1024); } while (0)
#define PG8_MMA(ai, bj, At, Bt) do { __builtin_amdgcn_s_setprio(1); _Pragma("unroll") for (int m = 0; m < 4; ++m) _Pragma("unroll") for (int n = 0; n < 2; ++n) _Pragma("unroll") for (int k = 0; k < 2; ++k) \
        acc[ai][bj][m][n] = __builtin_amdgcn_mfma_f32_16x16x32_bf16(Bt[n][k], At[m][k], acc[ai][bj][m][n], 0, 0, 0); __builtin_amdgcn_s_setprio(0); } while (0)
#define PG8_WAIT_V(n) asm volatile("s_waitcnt vmcnt(" #n ")" ::: "memory")
#define PG8_WAIT_L(n) asm volatile("s_waitcnt lgkmcnt(" #n ")" ::: "memory")
#define PG8_BAR __builtin_amdgcn_s_barrier()
#define PG8_SCHED __builtin_amdgcn_sched_barrier(0)
    Unit cur, nxt; int ui = 0;
    if (!S.next(0, cur)) return;
    f32x4 acc[2][2][4][2];
#pragma unroll
    for (int a = 0; a < 2; ++a)
#pragma unroll
        for (int b = 0; b < 2; ++b)
#pragma unroll
            for (int m = 0; m < 4; ++m)
#pragma unroll
                for (int n = 0; n < 2; ++n) acc[a][b][m][n] = (f32x4){0.f, 0.f, 0.f, 0.f};
    bf16x8 At[4][2], B0[2][2], B1[2][2];
    const char* cA = (const char*)g.A + (size_t)cur.pm * tstep; const char* cB = (const char*)g.Bt + (size_t)cur.pn * tstep;
    S.a_ready(cur);
    if constexpr (SP2) {
        PG8_STAGE(PG8_SB(0, 0), cB, voffB); PG8_STAGE(PG8_SB(0, 1), cB + hstep, voffB); PG8_STAGE(PG8_SA(0, 0), cA, voffA); PG8_STAGE(PG8_SA(0, 1), cA + hstep, voffA);
        if (wr == 1) PG8_BAR;
        PG8_WAIT_V(2); PG8_BAR;
        PG8_STAGE(PG8_SB(1, 0), cB + kstep, voffB); PG8_STAGE(PG8_SA(1, 0), cA + kstep, voffA); PG8_STAGE(PG8_SB(1, 1), cB + hstep + kstep, voffB);
        PG8_WAIT_V(6); PG8_BAR;
    } else {
        PG8_STAGE(PG8_SB(0, 0), cB, voffB); PG8_STAGE(PG8_SA(0, 0), cA, voffA); PG8_STAGE(PG8_SB(0, 1), cB + hstep, voffB); PG8_STAGE(PG8_SA(0, 1), cA + hstep, voffA);
        if (wr == 1) PG8_BAR;
        PG8_WAIT_V(4); PG8_BAR;
        PG8_STAGE(PG8_SB(1, 0), cB + kstep, voffB); PG8_STAGE(PG8_SA(1, 0), cA + kstep, voffA); PG8_STAGE(PG8_SB(1, 1), cB + hstep + kstep, voffB);
        PG8_WAIT_V(6); PG8_BAR;
    }
    for (;;) {
        const bool has_next = S.next(ui + 1, nxt);
        const char* nA = has_next ? (const char*)g.A + (size_t)nxt.pm * tstep : cA; const char* nB = has_next ? (const char*)g.Bt + (size_t)nxt.pn * tstep : cB;
        for (int t = 0; t < nt; t += 2) {
            const bool last = (t == nt - 2);
            const char* a1 = cA + (size_t)(t + 1) * kstep;
            const char* a2 = last ? nA : cA + (size_t)(t + 2) * kstep; const char* b2 = last ? nB : cB + (size_t)(t + 2) * kstep;
            const char* a3 = a2 + kstep; const char* b3 = b2 + kstep;
            if (last && has_next) S.a_ready(nxt);
            if constexpr (SP2) {
            PG8_LDB(B0, 0, 0); PG8_LDB(B1, 0, 1); PG8_SCHED; PG8_LDA(At, 0, 0); PG8_STAGE(PG8_SA(1, 1), a1 + hstep, voffA);
            PG8_WAIT_V(8); PG8_WAIT_L(0); PG8_BAR; PG8_MMA(0, 0, At, B0); PG8_MMA(0, 1, At, B1); PG8_BAR; PG8_SCHED;
            PG8_LDA(At, 0, 1); PG8_STAGE(PG8_SB(0, 0), b2, voffB); PG8_STAGE(PG8_SB(0, 1), b2 + hstep, voffB); PG8_STAGE(PG8_SA(0, 0), a2, voffA);
            PG8_WAIT_V(8); PG8_WAIT_L(0); PG8_BAR; PG8_MMA(1, 0, At, B0); PG8_MMA(1, 1, At, B1); PG8_BAR; PG8_SCHED;
            PG8_LDB(B0, 1, 0); PG8_LDB(B1, 1, 1); PG8_SCHED; PG8_LDA(At, 1, 0); PG8_STAGE(PG8_SA(0, 1), a2 + hstep, voffA);
            PG8_WAIT_V(8); PG8_WAIT_L(0); PG8_BAR; PG8_MMA(0, 0, At, B0); PG8_MMA(0, 1, At, B1); PG8_BAR; PG8_SCHED;
            PG8_LDA(At, 1, 1); PG8_STAGE(PG8_SB(1, 0), b3, voffB); PG8_STAGE(PG8_SB(1, 1), b3 + hstep, voffB); PG8_STAGE(PG8_SA(1, 0), a3, voffA);
            PG8_WAIT_V(8); PG8_WAIT_L(0); PG8_BAR; PG8_MMA(1, 0, At, B0); PG8_MMA(1, 1, At, B1); PG8_BAR; PG8_SCHED;
            } else {
            PG8_LDB(B0, 0, 0); PG8_SCHED; PG8_LDA(At, 0, 0); PG8_STAGE(PG8_SA(1, 1), a1 + hstep, voffA);
            PG8_WAIT_L(8); PG8_BAR; PG8_WAIT_L(0); PG8_MMA(0, 0, At, B0); PG8_BAR; PG8_SCHED;
            PG8_LDB(B1, 0, 1); PG8_STAGE(PG8_SB(0, 0), b2, voffB);
            PG8_BAR; PG8_WAIT_L(0); PG8_MMA(0, 1, At, B1); PG8_BAR;
            PG8_LDA(At, 0, 1); PG8_STAGE(PG8_SA(0, 0), a2, voffA);
            PG8_BAR; PG8_WAIT_L(0); PG8_MMA(1, 0, At, B0); PG8_BAR; PG8_SCHED;
            PG8_STAGE(PG8_SB(0, 1), b2 + hstep, voffB);
            PG8_WAIT_V(6); PG8_BAR; PG8_MMA(1, 1, At, B1); PG8_BAR;
            PG8_LDB(B0, 1, 0); PG8_SCHED; PG8_LDA(At, 1, 0); PG8_STAGE(PG8_SA(0, 1), a2 + hstep, voffA);
            PG8_WAIT_L(8); PG8_BAR; PG8_WAIT_L(0); PG8_MMA(0, 0, At, B0); PG8_BAR; PG8_SCHED;
            PG8_LDB(B1, 1, 1); PG8_STAGE(PG8_SB(1, 0), b3, voffB);
            PG8_BAR; PG8_WAIT_L(0); PG8_MMA(0, 1, At, B1); PG8_BAR;
            PG8_LDA(At, 1, 1); PG8_STAGE(PG8_SA(1, 0), a3, voffA);
            PG8_BAR; PG8_WAIT_L(0); PG8_MMA(1, 0, At, B0); PG8_BAR; PG8_SCHED;
            PG8_STAGE(PG8_SB(1, 1), b3 + hstep, voffB);
            PG8_WAIT_V(6); PG8_BAR; PG8_MMA(1, 1, At, B1); PG8_BAR;
            }
        }
        if constexpr (ALIGN_EPI) { if (wr == 0) PG8_BAR; }
        if constexpr (!Epi::AFTER_DRAIN) { E(acc, cur, wr, wc, fr, fq); S.done(cur); }
        if (!has_next) break;
#pragma unroll
        for (int a = 0; a < 2; ++a)
#pragma unroll
            for (int b = 0; b < 2; ++b)
#pragma unroll
                for (int m = 0; m < 4; ++m)
#pragma unroll
                    for (int n = 0; n < 2; ++n) acc[a][b][m][n] = (f32x4){0.f, 0.f, 0.f, 0.f};
        cur = nxt; cA = nA; cB = nB; ++ui;
        if constexpr (ALIGN_EPI) { if (wr == 1) PG8_BAR; }
    }
    PG8_WAIT_V(0);
    if constexpr (!ALIGN_EPI) { if (wr == 0) PG8_BAR; }
    PG8_BAR;
    if constexpr (Epi::AFTER_DRAIN) { E.fused(acc, cur, wr, wc, fr, fq, lds, wid, lane); S.done(cur); }
#undef PG8_SA
#undef PG8_SB
#undef PG8_STAGE
#undef PG8_LDA
#undef PG8_LDB
#undef PG8_MMA
#undef PG8_WAIT_V
#undef PG8_WAIT_L
#undef PG8_BAR
#undef PG8_SCHED
}
template <class Epi, class Sched, bool ALIGN_EPI = true>
__device__ __forceinline__ void gemm_phase_gather(PG8_LAS unsigned char* lds, const Gemm g, const int* rowidx, const Sched& S, const Epi& E) {
    constexpr bool SP2 = true;
    const int tid = threadIdx.x, wid = __builtin_amdgcn_readfirstlane(tid >> 6), lane = tid & 63, wr = wid >> 2, wc = wid & 3, fr = lane & 15, fq = lane >> 4;
    const int K = g.K, nt = K / BK;
    unsigned voffB[2]; int RA[2], CA[2];
#pragma unroll
    for (int i = 0; i < 2; ++i) { int R, C; stage_rc(tid * 16 + i * 8192, R, C); const int Rb = Epi::PERM ? ((R & ~31) + perm32(R & 31)) : R;
        RA[i] = R; CA[i] = C; voffB[i] = (unsigned)(Rb * K + C) * 2u; }
    unsigned vc[2][2], vn[2][2];
#define PG8_GOFF(dst, pm_) do { _Pragma("unroll") for (int h_ = 0; h_ < 2; ++h_) _Pragma("unroll") for (int i_ = 0; i_ < 2; ++i_) \
        dst[h_][i_] = ((unsigned)rowidx[(pm_) * BM + h_ * HALF + RA[i_]] * (unsigned)K + (unsigned)CA[i_]) * 2u; } while (0)
#define PG8_STAGE_A(bufoff, gbase, v0, v1) do { \
        __builtin_amdgcn_global_load_lds((const unsigned*)((const char*)(gbase) + (v0)), (PG8_LAS unsigned*)(lds + (bufoff) + ldsw), 16, 0, 0); \
        __builtin_amdgcn_global_load_lds((const unsigned*)((const char*)(gbase) + (v1)), (PG8_LAS unsigned*)(lds + (bufoff) + ldsw + 8192), 16, 0, 0); } while (0)
    const size_t kstep = (size_t)(BK * 2);
    const size_t hstep = (size_t)HALF * K * 2;
    const size_t tstep = 2 * hstep;
    const unsigned ldsw = (unsigned)wid * 1024u;
    const int aoff = lds_byte(wr * 64 + fr, fq * 8), boff = lds_byte(wc * 32 + fr, fq * 8);
#define PG8_SA(b, h) (((b) * 2 + (h)) * HTB)
#define PG8_SB(b, h) ((4 + (b) * 2 + (h)) * HTB)
#define PG8_STAGE(bufoff, gbase, voff) do { _Pragma("unroll") for (int _i = 0; _i < 2; ++_i) \
        __builtin_amdgcn_global_load_lds((const unsigned*)((const char*)(gbase) + (voff)[_i]), (PG8_LAS unsigned*)(lds + (bufoff) + ldsw + _i * 8192), 16, 0, 0); } while (0)
#define PG8_LDA(dst, b, h) do { _Pragma("unroll") for (int m = 0; m < 4; ++m) _Pragma("unroll") for (int k = 0; k < 2; ++k) dst[m][k] = *(const PG8_LAS bf16x8*)(lds + PG8_SA(b, h) + aoff + m * 2048 + k * 1024); } while (0)
#define PG8_LDB(dst, b, h) do { _Pragma("unroll") for (int n = 0; n < 2; ++n) _Pragma("unroll") for (int k = 0; k < 2; ++k) dst[n][k] = *(const PG8_LAS bf16x8*)(lds + PG8_SB(b, h) + boff + n * 2048 + k * 1024); } while (0)
#define PG8_MMA(ai, bj, At, Bt) do { __builtin_amdgcn_s_setprio(1); _Pragma("unroll") for (int m = 0; m < 4; ++m) _Pragma("unroll") for (int n = 0; n < 2; ++n) _Pragma("unroll") for (int k = 0; k < 2; ++k) \
        acc[ai][bj][m][n] = __builtin_amdgcn_mfma_f32_16x16x32_bf16(Bt[n][k], At[m][k], acc[ai][bj][m][n], 0, 0, 0); __builtin_amdgcn_s_setprio(0); } while (0)
#define PG8_WAIT_V(n) asm volatile("s_waitcnt vmcnt(" #n ")" ::: "memory")
#define PG8_WAIT_L(n) asm volatile("s_waitcnt lgkmcnt(" #n ")" ::: "memory")
#define PG8_BAR __builtin_amdgcn_s_barrier()
#define PG8_SCHED __builtin_amdgcn_sched_barrier(0)
    Unit cur, nxt; int ui = 0;
    if (!S.next(0, cur)) return;
    f32x4 acc[2][2][4][2];
#pragma unroll
    for (int a = 0; a < 2; ++a)
#pragma unroll
        for (int b = 0; b < 2; ++b)
#pragma unroll
            for (int m = 0; m < 4; ++m)
#pragma unroll
                for (int n = 0; n < 2; ++n) acc[a][b][m][n] = (f32x4){0.f, 0.f, 0.f, 0.f};
    bf16x8 At[4][2], B0[2][2], B1[2][2];
    const char* cA = (const char*)g.A; PG8_GOFF(vc, cur.pm); const char* cB = (const char*)g.Bt + (size_t)cur.pn * tstep;
    S.a_ready(cur);
    if constexpr (SP2) {
        PG8_STAGE(PG8_SB(0, 0), cB, voffB); PG8_STAGE(PG8_SB(0, 1), cB + hstep, voffB); PG8_STAGE_A(PG8_SA(0, 0), cA, vc[0][0], vc[0][1]); PG8_STAGE_A(PG8_SA(0, 1), cA, vc[1][0], vc[1][1]);
        if (wr == 1) PG8_BAR;
        PG8_WAIT_V(2); PG8_BAR;
        PG8_STAGE(PG8_SB(1, 0), cB + kstep, voffB); PG8_STAGE_A(PG8_SA(1, 0), cA + kstep, vc[0][0], vc[0][1]); PG8_STAGE(PG8_SB(1, 1), cB + hstep + kstep, voffB);
        PG8_WAIT_V(6); PG8_BAR;
    }
    for (;;) {
        const bool has_next = S.next(ui + 1, nxt);
        const char* nA = cA; if (has_next) PG8_GOFF(vn, nxt.pm); else { vn[0][0] = vc[0][0]; vn[0][1] = vc[0][1]; vn[1][0] = vc[1][0]; vn[1][1] = vc[1][1]; } const char* nB = has_next ? (const char*)g.Bt + (size_t)nxt.pn * tstep : cB;
        for (int t = 0; t < nt; t += 2) {
            const bool last = (t == nt - 2);
            const char* a1 = cA + (size_t)(t + 1) * kstep;
            const char* a2 = last ? nA : cA + (size_t)(t + 2) * kstep; const char* b2 = last ? nB : cB + (size_t)(t + 2) * kstep;
            const char* a3 = a2 + kstep; const char* b3 = b2 + kstep;
            const unsigned o00 = last ? vn[0][0] : vc[0][0], o01 = last ? vn[0][1] : vc[0][1], o10 = last ? vn[1][0] : vc[1][0], o11 = last ? vn[1][1] : vc[1][1];
            if (last && has_next) S.a_ready(nxt);
            if constexpr (SP2) {
            PG8_LDB(B0, 0, 0); PG8_LDB(B1, 0, 1); PG8_SCHED; PG8_LDA(At, 0, 0); PG8_STAGE_A(PG8_SA(1, 1), a1, vc[1][0], vc[1][1]);
            PG8_WAIT_V(8); PG8_WAIT_L(0); PG8_BAR; PG8_MMA(0, 0, At, B0); PG8_MMA(0, 1, At, B1); PG8_BAR; PG8_SCHED;
            PG8_LDA(At, 0, 1); PG8_STAGE(PG8_SB(0, 0), b2, voffB); PG8_STAGE(PG8_SB(0, 1), b2 + hstep, voffB); PG8_STAGE_A(PG8_SA(0, 0), a2, o00, o01);
            PG8_WAIT_V(8); PG8_WAIT_L(0); PG8_BAR; PG8_MMA(1, 0, At, B0); PG8_MMA(1, 1, At, B1); PG8_BAR; PG8_SCHED;
            PG8_LDB(B0, 1, 0); PG8_LDB(B1, 1, 1); PG8_SCHED; PG8_LDA(At, 1, 0); PG8_STAGE_A(PG8_SA(0, 1), a2, o10, o11);
            PG8_WAIT_V(8); PG8_WAIT_L(0); PG8_BAR; PG8_MMA(0, 0, At, B0); PG8_MMA(0, 1, At, B1); PG8_BAR; PG8_SCHED;
            PG8_LDA(At, 1, 1); PG8_STAGE(PG8_SB(1, 0), b3, voffB); PG8_STAGE(PG8_SB(1, 1), b3 + hstep, voffB); PG8_STAGE_A(PG8_SA(1, 0), a3, o00, o01);
            PG8_WAIT_V(8); PG8_WAIT_L(0); PG8_BAR; PG8_MMA(1, 0, At, B0); PG8_MMA(1, 1, At, B1); PG8_BAR; PG8_SCHED;
            }
        }
        if constexpr (ALIGN_EPI) { if (wr == 0) PG8_BAR; }
        if constexpr (!Epi::AFTER_DRAIN) { E(acc, cur, wr, wc, fr, fq); S.done(cur); }
        if (!has_next) break;
#pragma unroll
        for (int a = 0; a < 2; ++a)
#pragma unroll
            for (int b = 0; b < 2; ++b)
#pragma unroll
                for (int m = 0; m < 4; ++m)
#pragma unroll
                    for (int n = 0; n < 2; ++n) acc[a][b][m][n] = (f32x4){0.f, 0.f, 0.f, 0.f};
        cur = nxt; cA = nA; cB = nB; ++ui; vc[0][0] = vn[0][0]; vc[0][1] = vn[0][1]; vc[1][0] = vn[1][0]; vc[1][1] = vn[1][1];
        if constexpr (ALIGN_EPI) { if (wr == 1) PG8_BAR; }
    }
    PG8_WAIT_V(0);
    if constexpr (!ALIGN_EPI) { if (wr == 0) PG8_BAR; }
    PG8_BAR;
    if constexpr (Epi::AFTER_DRAIN) { E.fused(acc, cur, wr, wc, fr, fq, lds, wid, lane); S.done(cur); }
#undef PG8_GOFF
#undef PG8_STAGE_A
#undef PG8_SA
#undef PG8_SB
#undef PG8_STAGE
#undef PG8_LDA
#undef PG8_LDB
#undef PG8_MMA
#undef PG8_WAIT_V
#undef PG8_WAIT_L
#undef PG8_BAR
#undef PG8_SCHED
}
}

typedef float f32x4 __attribute__((ext_vector_type(4)));
typedef unsigned u32x4 __attribute__((ext_vector_type(4)));
typedef unsigned u32x2 __attribute__((ext_vector_type(2)));
__device__ __forceinline__ unsigned pk2(float lo, float hi) { unsigned r; asm volatile("v_cvt_pk_bf16_f32 %0, %1, %2" : "=v"(r) : "v"(lo), "v"(hi)); return r; }
__device__ __forceinline__ float wave_sum(float v) {
#pragma unroll
    for (int o = 1; o < 64; o <<= 1) v += __shfl_xor(v, o);
    return v;
}
constexpr int F0_SCR = 64 * 65 * 4;
__device__ __forceinline__ void f0_transpose_item(const float* src, int ldw, int c0, int c1, bf16* dst, int K, LAS float* scr, int lane) {
    const float* sp = src + ((lane >> 5) ? c1 : c0) + (lane & 31);
    float v[64];
#pragma unroll
    for (int kk = 0; kk < 64; ++kk) v[kk] = sp[(size_t)kk * ldw];
#pragma unroll
    for (int kk = 0; kk < 64; ++kk) scr[kk * 65 + lane] = v[kk];
    LDS_WAIT(); asm volatile("" ::: "memory");
    const int c = lane & 7;
#pragma unroll
    for (int j = 0; j < 8; ++j) { const int n = (lane >> 3) + 8 * j; const LAS float* s = scr + (8 * c) * 65 + n;
        u32x4 o; o.x = pk2(s[0 * 65], s[1 * 65]); o.y = pk2(s[2 * 65], s[3 * 65]); o.z = pk2(s[4 * 65], s[5 * 65]); o.w = pk2(s[6 * 65], s[7 * 65]);
        *(u32x4*)(dst + (size_t)n * K + 8 * c) = o; }
    LDS_WAIT(); asm volatile("" ::: "memory");
}
template <bool WITH_LR> __device__ __forceinline__ void f0_rows2(const float* x0, const float* g, bf16* o0, const float* w_in, float* glr0, int lane) {
    f32x4 v[2][8]; float ss[2] = {0.f, 0.f};
#pragma unroll
    for (int r = 0; r < 2; ++r)
#pragma unroll
        for (int j = 0; j < 8; ++j) { v[r][j] = ((const f32x4*)(x0 + (size_t)r * D))[lane + 64 * j]; ss[r] += (v[r][j][0] * v[r][j][0] + v[r][j][1] * v[r][j][1]) + (v[r][j][2] * v[r][j][2] + v[r][j][3] * v[r][j][3]); }
    const float rs0 = 1.0f / sqrtf(wave_sum(ss[0]) * (1.0f / D) + EPS), rs1 = 1.0f / sqrtf(wave_sum(ss[1]) * (1.0f / D) + EPS);
    float acc[2][16];
    if (WITH_LR) {
#pragma unroll
        for (int r = 0; r < 2; ++r)
#pragma unroll
            for (int cc = 0; cc < 16; ++cc) acc[r][cc] = 0.f;
    }
#pragma unroll
    for (int j = 0; j < 8; ++j) { const f32x4 gv = ((const f32x4*)g)[lane + 64 * j];
        v[0][j] = v[0][j] * gv * rs0; v[1][j] = v[1][j] * gv * rs1;
        u32x2 w0, w1; w0.x = pk2(v[0][j][0], v[0][j][1]); w0.y = pk2(v[0][j][2], v[0][j][3]); w1.x = pk2(v[1][j][0], v[1][j][1]); w1.y = pk2(v[1][j][2], v[1][j][3]);
        ((u32x2*)o0)[lane + 64 * j] = w0; ((u32x2*)(o0 + D))[lane + 64 * j] = w1;
        if (WITH_LR) {
#pragma unroll
            for (int e = 0; e < 4; ++e) { const float* wp = w_in + (size_t)(4 * (lane + 64 * j) + e) * IN_COLS + O_LR;
                const f32x4 wa = *(const f32x4*)wp, wb = *(const f32x4*)(wp + 4), wc_ = *(const f32x4*)(wp + 8), wd = *(const f32x4*)(wp + 12);
#pragma unroll
                for (int r = 0; r < 2; ++r) { const float xv = v[r][j][e];
#pragma unroll
                    for (int q = 0; q < 4; ++q) { acc[r][q] += xv * wa[q]; acc[r][4 + q] += xv * wb[q]; acc[r][8 + q] += xv * wc_[q]; acc[r][12 + q] += xv * wd[q]; } } }
        }
    }
    if (WITH_LR) {
        float a16[16];
#pragma unroll
        for (int i = 0; i < 16; ++i) { const bool up = (lane & 32) != 0; const float keep = up ? acc[1][i] : acc[0][i], send = up ? acc[0][i] : acc[1][i]; a16[i] = keep + __shfl_xor(send, 32); }
        float a8[8];
#pragma unroll
        for (int i = 0; i < 8; ++i) { const bool up = (lane & 16) != 0; const float keep = up ? a16[8 + i] : a16[i], send = up ? a16[i] : a16[8 + i]; a8[i] = keep + __shfl_xor(send, 16); }
        float a4[4];
#pragma unroll
        for (int i = 0; i < 4; ++i) { const bool up = (lane & 8) != 0; const float keep = up ? a8[4 + i] : a8[i], send = up ? a8[i] : a8[4 + i]; a4[i] = keep + __shfl_xor(send, 8); }
        float a2[2];
#pragma unroll
        for (int i = 0; i < 2; ++i) { const bool up = (lane & 4) != 0; const float keep = up ? a4[2 + i] : a4[i], send = up ? a4[i] : a4[2 + i]; a2[i] = keep + __shfl_xor(send, 4); }
        float a1; { const bool up = (lane & 2) != 0; const float keep = up ? a2[1] : a2[0], send = up ? a2[0] : a2[1]; a1 = keep + __shfl_xor(send, 2); }
        a1 += __shfl_xor(a1, 1);
        if ((lane & 1) == 0) { const int idx = (lane >> 1) & 31; glr0[(size_t)(idx >> 4) * GRK + (idx & 15)] = a1; }
    }
}
struct Ctx;
__device__ __forceinline__ void fast_prologue(const Ctx& c, LAS unsigned char* lds);
#endif

struct Ctx {
    const float *x, *mem; const int* positions; const float *g_attn, *w_in, *q_norm_g, *k_norm_g, *lq1, *lk1, *lq2, *lk2, *subln_g, *w_a2, *b_a, *gla_out_g, *w_out, *g_cross, *g_mem, *w_cq, *w_ckv, *cq_g, *ck_g, *w_co,
        *g_ffn, *w_rg, *b_rg, *w_re, *b_re, *w_gate, *w_up, *w_down;
    float* out; char* ws;
};
#define WSP(T_, off) ((T_*)(c.ws + (off)))
#ifndef HOST_EMU
__device__ __forceinline__ void f0_wrt(const Ctx& c, bf16* WRT);
__device__ __forceinline__ void fast_prologue(const Ctx& c, LAS unsigned char* lds) {
    const int tid = threadIdx.x, lane = tid & 63, wave = __builtin_amdgcn_readfirstlane(tid >> 6);
    const int gw = blockIdx.x * 8 + wave, NGW = gridDim.x * 8;
    LAS float* scr = (LAS float*)(lds + wave * F0_SCR);
    int* ctl = WSP(int, WS_CTL); float* lamp = (float*)(ctl + 16);
    bf16 *WIN = WSP(bf16, WS_WIN), *WOUT = WSP(bf16, WS_WOUT), *WCQ = WSP(bf16, WS_WCQ), *WCKV = WSP(bf16, WS_WCKV), *WCO = WSP(bf16, WS_WCO);
    bf16 *WGU = WSP(bf16, WS_WGU), *WD = WSP(bf16, WS_WD), *XN = WSP(bf16, WS_XN), *MEMN = WSP(bf16, WS_MEMN);
    float* GLR = WSP(float, WS_SMALL + SM_GLR); int* SLOTTOK = WSP(int, WS_SMALL + SM_SLOTTOK); float* SLOTGATE = WSP(float, WS_SMALL + SM_SLOTGATE); float* ROPE = WSP(float, WS_SMALL + SM_ROPE);
    for (int it = gw; it < T / 2; it += NGW) f0_rows2<true>(c.x + (size_t)it * 2 * D, c.g_attn, XN + (size_t)it * 2 * D, c.w_in, GLR + (size_t)it * 2 * GRK, lane);
    for (int it = gw; it < B * NMEM / 2; it += NGW) f0_rows2<false>(c.mem + (size_t)it * 2 * D, c.g_mem, MEMN + (size_t)it * 2 * D, nullptr, nullptr, lane);
    constexpr int KB = D / 64, KBD = DE / 64;
    constexpr int I_WIN = (NIN / 64) * KB, I_SQ = (D / 64) * KB, I_CKV = (2 * D / 64) * KB, I_GU = NE * (2 * DE / 64) * KB, I_DN = NE * (D / 64) * KBD;
    constexpr int NITEMS = I_WIN + 3 * I_SQ + I_CKV + I_GU + I_DN;
    for (int it = gw; it < NITEMS; it += NGW) {
        int r = it;
        if (r < I_WIN) { const int kb = r % KB, n0 = (r / KB) * 64; f0_transpose_item(c.w_in + (size_t)kb * 64 * IN_COLS, IN_COLS, win_src_col(n0), win_src_col(n0 + 32), WIN + (size_t)n0 * D + kb * 64, D, scr, lane); continue; } r -= I_WIN;
        if (r < I_SQ) { const int kb = r % KB, n0 = (r / KB) * 64; f0_transpose_item(c.w_out + (size_t)kb * 64 * D, D, n0, n0 + 32, WOUT + (size_t)n0 * D + kb * 64, D, scr, lane); continue; } r -= I_SQ;
        if (r < I_SQ) { const int kb = r % KB, n0 = (r / KB) * 64; f0_transpose_item(c.w_cq + (size_t)kb * 64 * D, D, n0, n0 + 32, WCQ + (size_t)n0 * D + kb * 64, D, scr, lane); continue; } r -= I_SQ;
        if (r < I_SQ) { const int kb = r % KB, n0 = (r / KB) * 64; f0_transpose_item(c.w_co + (size_t)kb * 64 * D, D, n0, n0 + 32, WCO + (size_t)n0 * D + kb * 64, D, scr, lane); continue; } r -= I_SQ;
        if (r < I_CKV) { const int kb = r % KB, n0 = (r / KB) * 64; f0_transpose_item(c.w_ckv + (size_t)kb * 64 * 2 * D, 2 * D, n0, n0 + 32, WCKV + (size_t)n0 * D + kb * 64, D, scr, lane); continue; } r -= I_CKV;
        if (r < I_GU) { const int kb = r % KB, r0 = ((r / KB) % (2 * DE / 64)) * 64, e = r / (KB * (2 * DE / 64)); const int pn = r0 / 256, ii = r0 % 256; const float* W = (ii < 128) ? c.w_gate : c.w_up; const int col = pn * 128 + (ii & 127);
            f0_transpose_item(W + ((size_t)e * D + kb * 64) * DE, DE, col, col + 32, WGU + ((size_t)e * 2 * DE + r0) * D + kb * 64, D, scr, lane); continue; } r -= I_GU;
        { const int kb = r % KBD, n0 = ((r / KBD) % (D / 64)) * 64, e = r / (KBD * (D / 64));
          f0_transpose_item(c.w_down + ((size_t)e * DE + kb * 64) * D, D, n0, n0 + 32, WD + ((size_t)e * D + n0) * DE + kb * 64, DE, scr, lane); }
    }
    nk_rope_table(c.positions, ROPE); nk_lam(c.lq1, c.lk1, c.lq2, c.lk2, lamp);
    nk_zero_bf16(XN + (size_t)T * D, (size_t)D); nk_moe_init_slots(SLOTTOK, SLOTGATE); f0_wrt(c, WSP(bf16, WS_SMALL + SM_WRT));
}
#endif
#ifndef HOST_EMU
__device__ __forceinline__ void f0_wrt(const Ctx& c, bf16* WRT) {
    for (size_t i = gtid(); i < (size_t)48 * D; i += gnth()) { const int k = (int)(i % D), j = (int)(i / D);
        const float w = j < NG ? c.w_rg[(size_t)k * NG + j] : (j < NG + NE ? c.w_re[(size_t)k * NE + (j - NG)] : 0.f); WRT[i] = f2bf(w); }
}
__device__ __forceinline__ void fast_router(const Ctx& c, LAS unsigned char* lds) {
    typedef short bf16x8 __attribute__((ext_vector_type(8)));
    const int tid = threadIdx.x, lane = tid & 63, wave = __builtin_amdgcn_readfirstlane(tid >> 6), r = lane & 15, kq = lane >> 4;
    LAS float* red = (LAS float*)lds;
    LAS float* lg = (LAS float*)(lds + 8 * 32 * 48 * 4);
    const bf16* XN = WSP(bf16, WS_XN); const bf16* WRT = WSP(bf16, WS_SMALL + SM_WRT); const float* SSP2 = WSP(float, WS_SMALL + SM_SSP2);
    int* ctl = WSP(int, WS_CTL); int* EXPERT = WSP(int, WS_SMALL + SM_EXPERT); float* GATE = WSP(float, WS_SMALL + SM_GATE); int* SLOTPOS = WSP(int, WS_SMALL + SM_SLOTPOS);
    for (int ub = blockIdx.x; ub < T / 32; ub += gridDim.x) {
        const int row0 = ub * 32, k0 = wave * 256;
        f32x4 acc[2][3];
#pragma unroll
        for (int mb = 0; mb < 2; ++mb)
#pragma unroll
            for (int nb = 0; nb < 3; ++nb) acc[mb][nb] = (f32x4){0.f, 0.f, 0.f, 0.f};
#pragma unroll
        for (int st = 0; st < 8; ++st) { bf16x8 a[2], b[3];
#pragma unroll
            for (int mb = 0; mb < 2; ++mb) a[mb] = *(const bf16x8*)(XN + (size_t)(row0 + 16 * mb + r) * D + k0 + 32 * st + 8 * kq);
#pragma unroll
            for (int nb = 0; nb < 3; ++nb) b[nb] = *(const bf16x8*)(WRT + (size_t)(16 * nb + r) * D + k0 + 32 * st + 8 * kq);
#pragma unroll
            for (int mb = 0; mb < 2; ++mb)
#pragma unroll
                for (int nb = 0; nb < 3; ++nb) acc[mb][nb] = __builtin_amdgcn_mfma_f32_16x16x32_bf16(a[mb], b[nb], acc[mb][nb], 0, 0, 0); }
#pragma unroll
        for (int mb = 0; mb < 2; ++mb)
#pragma unroll
            for (int nb = 0; nb < 3; ++nb)
#pragma unroll
                for (int q = 0; q < 4; ++q) red[(wave * 32 + 16 * mb + 4 * kq + q) * 48 + 16 * nb + r] = acc[mb][nb][q];
        __syncthreads();
        { const int row = tid >> 4, q = tid & 15;
          float ps = SSP2[(size_t)(row0 + row) * 32 + 2 * q] + SSP2[(size_t)(row0 + row) * 32 + 2 * q + 1];
          ps += __shfl_xor(ps, 1); ps += __shfl_xor(ps, 2); ps += __shfl_xor(ps, 4); ps += __shfl_xor(ps, 8);
          const float rs = 1.0f / sqrtf(ps * (1.0f / D) + EPS);
#pragma unroll
          for (int j = 0; j < 3; ++j) { const int col = q + 16 * j; float sacc = 0.f;
#pragma unroll
              for (int w = 0; w < 8; ++w) sacc += red[(w * 32 + row) * 48 + col];
              const float bias = col < NG ? c.b_rg[col] : (col < NG + NE ? c.b_re[col - NG] : 0.f);
              lg[row * 48 + col] = sacc * rs + bias; } }
        __syncthreads();
        if (tid < 32) { const int t = row0 + tid; const LAS float* L = lg + tid * 48;
            float gl[NG], el[NE];
#pragma unroll
            for (int j = 0; j < NG; ++j) gl[j] = L[j];
#pragma unroll
            for (int j = 0; j < NE; ++j) el[j] = L[NG + j];
            int grp = 0; float gm = gl[0];
#pragma unroll
            for (int j = 1; j < NG; ++j) if (gl[j] > gm) { gm = gl[j]; grp = j; }
            float gs = 0.f;
#pragma unroll
            for (int j = 0; j < NG; ++j) gs += __expf(gl[j] - gm);
            const float grp_w = 1.0f / gs;
            float e8[EPG];
#pragma unroll
            for (int j = 0; j < EPG; ++j) { float v = 0.f;
#pragma unroll
                for (int gq = 0; gq < NG; ++gq) v = (grp == gq) ? el[gq * EPG + j] : v;
                e8[j] = v; }
            int i0 = 0; float v0 = e8[0];
#pragma unroll
            for (int j = 1; j < EPG; ++j) if (e8[j] > v0) { v0 = e8[j]; i0 = j; }
            int i1 = -1; float v1 = -1e30f;
#pragma unroll
            for (int j = 0; j < EPG; ++j) if (j != i0 && e8[j] > v1) { v1 = e8[j]; i1 = j; }
            const float rr = __expf(v1 - v0); const float g0 = grp_w / (1.f + rr), g1 = grp_w * rr / (1.f + rr);
            const int e0 = grp * EPG + i0, e1 = grp * EPG + i1;
            EXPERT[t * 2] = e0; EXPERT[t * 2 + 1] = e1; GATE[t * 2] = g0; GATE[t * 2 + 1] = g1;
            SLOTPOS[t * 2] = atomicAdd(&ctl[CW_CNT + e0], 1); SLOTPOS[t * 2 + 1] = atomicAdd(&ctl[CW_CNT + e1], 1); }
        __syncthreads();
    }
}
#endif
#ifdef HOST_EMU
#define FAST_P0 0
#define FAST_P1 0
#define FAST_P6 0
#define FAST_P13 0
#define FAST_MOE 0
typedef unsigned char* LdsPtr;
#else
#ifndef FAST_P0
#define FAST_P0 1
#endif
#ifndef FAST_P1
#define FAST_P1 1
#endif
#ifndef FAST_P6
#define FAST_P6 1
#endif
#ifndef FAST_P13
#define FAST_P13 1
#endif
#ifndef FAST_MOE
#define FAST_MOE 1
#endif
typedef LAS unsigned char* LdsPtr;
#endif
constexpr int N_PHASES = 18;
template <int P> __device__ __forceinline__ void run_phase(const Ctx& c, LdsPtr lds) {
    int* ctl = WSP(int, WS_CTL); float* lamp = (float*)(ctl + 16);
    bf16 *WIN = WSP(bf16, WS_WIN), *WOUT = WSP(bf16, WS_WOUT), *WCQ = WSP(bf16, WS_WCQ), *WCKV = WSP(bf16, WS_WCKV), *WCO = WSP(bf16, WS_WCO);
    bf16 *WGU = WSP(bf16, WS_WGU), *WD = WSP(bf16, WS_WD), *XN = WSP(bf16, WS_XN), *MEMN = WSP(bf16, WS_MEMN);
    float* SSP1 = WSP(float, WS_SMALL + SM_SSP1); float* SSP2 = WSP(float, WS_SMALL + SM_SSP2); (void)SSP1; (void)SSP2;
    float* GLR = WSP(float, WS_SMALL + SM_GLR); float* CQSS = WSP(float, WS_SMALL + SM_CQSS); int* EXPERT = WSP(int, WS_SMALL + SM_EXPERT); float* GATE = WSP(float, WS_SMALL + SM_GATE);
    int* SLOTPOS = WSP(int, WS_SMALL + SM_SLOTPOS); int* SLOTTOK = WSP(int, WS_SMALL + SM_SLOTTOK); float* SLOTGATE = WSP(float, WS_SMALL + SM_SLOTGATE); float* ROPE = WSP(float, WS_SMALL + SM_ROPE);
    bf16 *CKV = WSP(bf16, WS_SMALL + SM_CKV), *CK2 = WSP(bf16, WS_SMALL + SM_CK2), *CVT = WSP(bf16, WS_SMALL + SM_CVT); float* STATS = WSP(float, WS_SMALL + SM_STATS);
    char* rb = c.ws + WS_B;
    bf16 *DQ = (bf16*)(rb + B_DQ), *DK = (bf16*)(rb + B_DK), *DV = (bf16*)(rb + B_DV), *GQ = (bf16*)(rb + B_GQ), *GK = (bf16*)(rb + B_GK), *GV = (bf16*)(rb + B_GV), *GRb = (bf16*)(rb + B_GR);
    bf16 *CQ = (bf16*)(rb + B_CQ), *CO = (bf16*)(rb + B_CO), *HE = (bf16*)(rb + B_HE);
    bf16* MIX = WSP(bf16, WS_C);
    float* TMPQK = WSP(float, WS_C);
    float* PTMP = WSP(float, WS_C);
    float* CUM = WSP(float, WS_D);
    float* OTMPD = WSP(float, WS_D + al256((size_t)T * D));
    float* OTMPG = WSP(float, WS_D + al256((size_t)T * D) * 3);
    float* out = c.out; (void)lds; (void)TMPQK; (void)WIN;
    if constexpr (P == 0) {
#if FAST_P0
        fast_prologue(c, lds);
#else
        nk_conv_win(c.w_in, WIN);
        nk_convT(c.w_out, D, 0, WOUT, D, D); nk_convT(c.w_cq, D, 0, WCQ, D, D); nk_convT(c.w_ckv, 2 * D, 0, WCKV, 2 * D, D); nk_convT(c.w_co, D, 0, WCO, D, D);
        nk_conv_gu(c.w_gate, c.w_up, WGU); nk_conv_d(c.w_down, WD);
        nk_rope_table(c.positions, ROPE); nk_lam(c.lq1, c.lk1, c.lq2, c.lk2, lamp);
        nk_zero_bf16(XN + (size_t)T * D, (size_t)D); nk_moe_init_slots(SLOTTOK, SLOTGATE);
        nk_rmsnorm_rows(c.x, c.g_attn, XN, T, D); nk_rmsnorm_rows(c.mem, c.g_mem, MEMN, B * NMEM, D);
        nk_glr(c.x, c.g_attn, c.w_in, GLR);
#endif
    } else if constexpr (P == 1) {
#if FAST_P1
        pg8::Gemm g{XN, WIN, T, NIN, D}; pg8::StaticOrder S; S.init(T, NIN, (int)gridDim.x, (int)blockIdx.x);
        pg8::EpiInProj E{rb, ROPE, c.q_norm_g, c.k_norm_g};
        pg8::gemm_phase<pg8::EpiInProj, pg8::StaticOrder, true, true>(lds, g, S, E);
#else
        { GemmP p{XN, WIN, T, NIN, D, 0, TMPQK, nullptr, (bf16*)rb, nullptr}; nk_gemm<0>(p); }
#endif
    } else if constexpr (P == 2) {
#if !FAST_P1
        nk_qk_post(TMPQK, c.q_norm_g, c.k_norm_g, ROPE, DQ, DK);
#endif
        { GemmP p{MEMN, WCKV, B * NMEM, 2 * D, D, 0, nullptr, nullptr, CKV, nullptr}; nk_gemm<2>(p); }
    } else if constexpr (P == 3) {
        nk_ckv_fix(CKV, c.cq_g, c.ck_g, CK2, CVT); nk_diff_stats(DQ, DK, STATS); nk_gla_cum(GLR, c.w_a2, c.b_a, CUM);
    } else if constexpr (P == 4) {
        nk_diff_pv(DQ, DK, DV, STATS, lamp, OTMPD); nk_gla_run(GQ, GK, GV, CUM, OTMPG);
    } else if constexpr (P == 5) {
        nk_diff_norm(OTMPD, c.subln_g, MIX); nk_gla_norm(OTMPG, c.gla_out_g, GRb, MIX);
    } else if constexpr (P == 6) {
#if FAST_P6
        pg8::Gemm g{MIX, WOUT, T, D, D}; pg8::StaticOrder S; S.init(T, D, (int)gridDim.x, (int)blockIdx.x);
        pg8::EpiResid E{c.x, out, XN, c.g_cross, SSP1};
        pg8::gemm_phase<pg8::EpiResid, pg8::StaticOrder, true, true>(lds, g, S, E);
#else
        GemmP p{MIX, WOUT, T, D, D, 0, out, nullptr, nullptr, c.x}; nk_gemm<1>(p);
#endif
    } else if constexpr (P == 7) {
#if !FAST_P6
        nk_rmsnorm_rows(out, c.g_cross, XN, T, D);
#endif
    } else if constexpr (P == 8) {
#if FAST_P6
        pg8::Gemm g{XN, WCQ, T, D, D}; pg8::StaticOrder S; S.init(T, D, (int)gridDim.x, (int)blockIdx.x);
        pg8::EpiCq E{SSP1, CQ, CQSS};
        pg8::gemm_phase<pg8::EpiCq, pg8::StaticOrder, true, true>(lds, g, S, E);
#else
        GemmP p{XN, WCQ, T, D, D, 0, nullptr, nullptr, CQ, nullptr}; nk_gemm<2>(p);
#endif
    } else if constexpr (P == 9) {
#if !FAST_P6
        nk_cqss(CQ, CQSS);
#endif
    } else if constexpr (P == 10) {
        nk_cross_scores(CQ, CQSS, CK2, PTMP);
    } else if constexpr (P == 11) {
        nk_cross_softmax(PTMP);
    } else if constexpr (P == 12) {
        nk_cross_pv(PTMP, CVT, CO);
    } else if constexpr (P == 13) {
#if FAST_P13
        pg8::Gemm g{CO, WCO, T, D, D}; pg8::StaticOrder S; S.init(T, D, (int)gridDim.x, (int)blockIdx.x);
        pg8::EpiResid E{out, out, XN, c.g_ffn, SSP2};
        pg8::gemm_phase<pg8::EpiResid, pg8::StaticOrder, true, true>(lds, g, S, E);
#else
        GemmP p{CO, WCO, T, D, D, 0, out, nullptr, nullptr, nullptr}; nk_gemm<4>(p);
#endif
    } else if constexpr (P == 14) {
#if FAST_MOE
        fast_router(c, lds);
#else
        nk_router(out, c.g_ffn, c.w_rg, c.b_rg, c.w_re, c.b_re, XN, EXPERT, GATE, SLOTPOS, ctl);
#endif
    } else if constexpr (P == 15) {
        nk_moe_offsets(ctl);
    } else if constexpr (P == 16) {
        nk_moe_fill(EXPERT, GATE, SLOTPOS, ctl, SLOTTOK, SLOTGATE);
    } else if constexpr (P == 17) {
#if FAST_MOE
        pg8::Gemm g{XN, WGU, PMAX, NE * 2 * DE, D}; pg8::MoeOrder S{ctl, 4, (int)gridDim.x, (int)blockIdx.x};
        pg8::EpiGU E{SLOTTOK, SSP2, HE};
        pg8::gemm_phase_gather<pg8::EpiGU, pg8::MoeOrder, true>(lds, g, SLOTTOK, S, E);
#else
        nk_moe_gu(XN, WGU, SLOTTOK, ctl, HE);
#endif
    }
}
template <int P> __device__ __forceinline__ void run_phase_last(const Ctx& c, LdsPtr lds) {
    int* ctl = WSP(int, WS_CTL); bf16* WD = WSP(bf16, WS_WD); int* SLOTTOK = WSP(int, WS_SMALL + SM_SLOTTOK); float* SLOTGATE = WSP(float, WS_SMALL + SM_SLOTGATE); bf16* HE = (bf16*)(c.ws + WS_B + B_HE); (void)lds;
#if FAST_MOE
    pg8::Gemm g{HE, WD, PMAX, NE * D, DE}; pg8::MoeOrder S{ctl, 8, (int)gridDim.x, (int)blockIdx.x};
    pg8::EpiDown E{SLOTTOK, SLOTGATE, c.out};
    pg8::gemm_phase<pg8::EpiDown, pg8::MoeOrder, true, true>(lds, g, S, E);
#else
    nk_moe_down(HE, WD, SLOTTOK, SLOTGATE, ctl, c.out);
#endif
}

#ifndef HOST_EMU
#define XB_TMO      128
#define XB_XCNT(j)  (256  + 64 * (j))
#define XB_XSUB(j)  (1280 + 64 * (j))
#define XB_XGEN(j)  (2304 + 64 * (j))
#define XB_TOP      3328
#define XB_TOPGEN   3392
#define XCD_BAR_WORDS 3456
#define XB_SPIN_CAP (1u << 20)

__device__ __forceinline__ unsigned xb_ld(unsigned* p)              { return __hip_atomic_load(p, __ATOMIC_RELAXED, __HIP_MEMORY_SCOPE_AGENT); }
__device__ __forceinline__ unsigned xb_add(unsigned* p, unsigned v) { return __hip_atomic_fetch_add(p, v, __ATOMIC_RELAXED, __HIP_MEMORY_SCOPE_AGENT); }
__device__ __forceinline__ unsigned xb_xcc_id() { return (unsigned)__builtin_amdgcn_s_getreg((3 << 11) | 20) & 0xFu; }
#define XB_SPIN(cond, bar) do { unsigned _sp = 0; while (cond) { __builtin_amdgcn_s_sleep(1); \
    if ((++_sp & 255u) == 0u) { if (xb_ld(&(bar)[XB_TMO])) break; if (_sp > XB_SPIN_CAP) { atomicAdd(&(bar)[XB_TMO], 1u); break; } } } } while (0)

struct XcdBarrier {
    unsigned* bar; unsigned x;
    volatile LAS unsigned* st;
};
__device__ __forceinline__ XcdBarrier xcd_barrier_post(unsigned* bar, volatile LAS unsigned* st) {
    XcdBarrier b; b.bar = bar; b.x = xb_xcc_id(); b.st = st;
    if (threadIdx.x == 0) (void)xb_add(&bar[XB_XCNT(b.x)], 1u);
    return b;
}
__device__ __forceinline__ void xcd_barrier_complete(unsigned* bar, unsigned x, unsigned& nloc, unsigned& nx) {
    const unsigned G = gridDim.x * gridDim.y * gridDim.z;
    unsigned sum, cnt, mine, sp = 0u;
    for (;;) {
        sum = 0u; cnt = 0u; mine = 0u;
#pragma unroll
        for (unsigned j = 0; j < 16; ++j) { const unsigned c = xb_ld(&bar[XB_XCNT(j)]); sum += c; cnt += (c > 0u) ? 1u : 0u; mine = (j == x) ? c : mine; }
        if (sum == G) break;
        __builtin_amdgcn_s_sleep(1);
        if ((++sp & 255u) == 0u) { if (xb_ld(&bar[XB_TMO])) break; if (sp > XB_SPIN_CAP) { atomicAdd(&bar[XB_TMO], 1u); break; } }
    }
    nloc = mine > 0u ? mine : 1u; nx = cnt > 0u ? cnt : 1u;
}
__device__ __forceinline__ void xcd_barrier(const XcdBarrier& b) {
    asm volatile("s_waitcnt vmcnt(0)" ::: "memory");
    __syncthreads();
    if (threadIdx.x == 0) {
        unsigned* bar = b.bar;
        __builtin_amdgcn_s_waitcnt(0);
        unsigned nloc = b.st[0], nx = b.st[1];
        if (nloc == 0u) { xcd_barrier_complete(bar, b.x, nloc, nx); b.st[0] = nloc; b.st[1] = nx; }
        const unsigned old = xb_add(&bar[XB_XSUB(b.x)], 1u);
        const unsigned gen = old / nloc;
        if (old + 1u == (gen + 1u) * nloc) {
            __builtin_amdgcn_fence(__ATOMIC_RELEASE, "agent");
            asm volatile("s_waitcnt vmcnt(0)" ::: "memory");
            const unsigned og = xb_add(&bar[XB_TOP], 1u);
            const unsigned tg = og / nx;
            if (og + 1u == (tg + 1u) * nx) xb_add(&bar[XB_TOPGEN], 1u);
            else XB_SPIN(xb_ld(&bar[XB_TOPGEN]) == tg, bar);
            __builtin_amdgcn_fence(__ATOMIC_ACQUIRE, "agent");
            xb_add(&bar[XB_XGEN(b.x)], 1u);
            asm volatile("s_waitcnt vmcnt(0)" ::: "memory");
        } else {
            XB_SPIN(xb_ld(&bar[XB_XGEN(b.x)]) == gen, bar);
            __builtin_amdgcn_fence(__ATOMIC_ACQUIRE, "agent");
            asm volatile("s_waitcnt vmcnt(0)" ::: "memory");
        }
    }
    __syncthreads();
}

constexpr int NTHREADS = 512;
constexpr int LDS_BYTES = 147456;
constexpr int LDSCTL_OFF = 143360, MISC_OFF = LDSCTL_OFF + 64;
__global__ void __launch_bounds__(NTHREADS, 2) fwd_kernel(Ctx c) {
    extern __shared__ __attribute__((aligned(16))) unsigned char lds[];
    LAS unsigned char* l3 = (LAS unsigned char*)lds;
    volatile LAS unsigned* MISC = (volatile LAS unsigned*)(l3 + MISC_OFF);
    for (int u = threadIdx.x; u < (LDS_BYTES - LDSCTL_OFF) / 4; u += NTHREADS) ((LAS unsigned*)(l3 + LDSCTL_OFF))[u] = 0u;
    __syncthreads();
    XcdBarrier bar = xcd_barrier_post((unsigned*)(c.ws + WS_CTL) + CW_BAR, MISC + 8);
#define PH(k) run_phase<k>(c, l3); xcd_barrier(bar);
    PH(0) PH(1) PH(2) PH(3) PH(4) PH(5) PH(6) PH(7) PH(8) PH(9) PH(10) PH(11) PH(12) PH(13) PH(14) PH(15) PH(16) PH(17)
    run_phase_last<0>(c, l3);
#undef PH
}
#endif

#ifdef HOST_EMU
template <int P> static void emu_phase(const Ctx& c) { const size_t nth = 4096; emu_nth = nth; for (size_t t = 0; t < nth; ++t) { emu_tid = t; run_phase<P>(c, nullptr); } }
template <int... Ps> static void emu_all(const Ctx& c, std::integer_sequence<int, Ps...>) { (emu_phase<Ps>(c), ...); }
#endif

extern "C" void kernel_launch(void* const* d_in, const int* in_sizes, int n_in, void* d_out, int out_size, void* d_ws, size_t ws_size, hipStream_t stream) {
    if (n_in != 31 || out_size != T * D || ws_size < WS_END) { fprintf(stderr, "kernel_launch: unexpected shapes (n_in %d out %d ws %zu need %zu)\n", n_in, out_size, ws_size, (size_t)WS_END); return; }
    (void)in_sizes;
    Ctx c{};
    const float** fp = (const float**)&c.x;
    c.x = (const float*)d_in[0]; c.mem = (const float*)d_in[1]; c.positions = (const int*)d_in[2];
    c.g_attn = (const float*)d_in[3]; c.w_in = (const float*)d_in[4]; c.q_norm_g = (const float*)d_in[5]; c.k_norm_g = (const float*)d_in[6];
    c.lq1 = (const float*)d_in[7]; c.lk1 = (const float*)d_in[8]; c.lq2 = (const float*)d_in[9]; c.lk2 = (const float*)d_in[10];
    c.subln_g = (const float*)d_in[11]; c.w_a2 = (const float*)d_in[12]; c.b_a = (const float*)d_in[13]; c.gla_out_g = (const float*)d_in[14];
    c.w_out = (const float*)d_in[15]; c.g_cross = (const float*)d_in[16]; c.g_mem = (const float*)d_in[17]; c.w_cq = (const float*)d_in[18];
    c.w_ckv = (const float*)d_in[19]; c.cq_g = (const float*)d_in[20]; c.ck_g = (const float*)d_in[21]; c.w_co = (const float*)d_in[22];
    c.g_ffn = (const float*)d_in[23]; c.w_rg = (const float*)d_in[24]; c.b_rg = (const float*)d_in[25]; c.w_re = (const float*)d_in[26];
    c.b_re = (const float*)d_in[27]; c.w_gate = (const float*)d_in[28]; c.w_up = (const float*)d_in[29]; c.w_down = (const float*)d_in[30];
    c.out = (float*)d_out; c.ws = (char*)d_ws; (void)fp;
#ifdef HOST_EMU
    memset(c.ws + WS_CTL, 0, CTL_BYTES);
    emu_all(c, std::make_integer_sequence<int, N_PHASES>{});
    { const size_t nth = 4096; emu_nth = nth; for (size_t t = 0; t < nth; ++t) { emu_tid = t; run_phase_last<0>(c, nullptr); } }
#else
    static int grid = 0;
    if (grid == 0) {
        int dev = 0, cus = 0, per_cu = 0;
        if (hipGetDevice(&dev) != hipSuccess || hipDeviceGetAttribute(&cus, hipDeviceAttributeMultiprocessorCount, dev) != hipSuccess) { fprintf(stderr, "kernel_launch: device query failed\n"); grid = -1; return; }
        if (hipFuncSetAttribute((const void*)fwd_kernel, hipFuncAttributeMaxDynamicSharedMemorySize, LDS_BYTES) != hipSuccess) { fprintf(stderr, "kernel_launch: hipFuncSetAttribute failed\n"); grid = -1; return; }
        if (hipOccupancyMaxActiveBlocksPerMultiprocessor(&per_cu, (const void*)fwd_kernel, NTHREADS, LDS_BYTES) != hipSuccess || per_cu < 1) { fprintf(stderr, "kernel_launch: occupancy query says %d blocks per CU\n", per_cu); }
        (void)hipGetLastError();
        grid = cus;
    }
    if (grid < 0) return;
    (void)hipMemsetAsync(c.ws + WS_CTL, 0, CTL_BYTES, stream);
    hipLaunchKernelGGL(fwd_kernel, dim3(grid), dim3(NTHREADS), LDS_BYTES, stream, c);
#endif
}
```

```cpp
#ifndef HOST_EMU
#include <hip/hip_runtime.h>
#else
#include <cstring>
struct EmuD3 { unsigned x, y, z; };
static EmuD3 blockIdx, threadIdx, blockDim, gridDim;
static size_t emu_tid, emu_nth;
#define __global__ static
#define __device__ static
#define __host__
#define __forceinline__ inline
#define __launch_bounds__(...)
typedef int hipStream_t;
static inline int atomicAdd(int* p, int v) { int o = *p; *p += v; return o; }
static inline float atomicAdd(float* p, float v) { float o = *p; *p += v; return o; }
#endif
#include <cstdint>
#include <cstdio>
#include <cmath>

#ifndef CFG_D
#define CFG_D 2048
#define CFG_SEQ 4096
#define CFG_NMEM 256
#define CFG_ETILE 256
#endif
namespace cfg {
constexpr int D = CFG_D, B = 2, SEQ = CFG_SEQ, T = B * SEQ, CHUNK = 64, NC = SEQ / CHUNK;
constexpr int DH = 8, DVD = D / 16, DQK = D / 32;
constexpr int GH = 4, GVD = D / 8, GKD = D / 16, GRK = 16;
constexpr int NMEM = CFG_NMEM, CH = 4, CHD = D / 4;
constexpr int NE = 32, EPG = 8, NG = 4, DE = D / 4;
constexpr int ETILE = CFG_ETILE, PMAX = 2 * T + NE * ETILE, NTILE = PMAX / ETILE;
constexpr int NIN = 3 * D;
constexpr int IN_COLS = 3 * D + GRK;
constexpr int O_DQ = 0, O_DK = D / 2, O_DV = D, O_GQ = 3 * D / 2, O_GK = 7 * D / 4, O_GV = 2 * D, O_LR = 5 * D / 2, O_GR = 5 * D / 2 + GRK;
constexpr float EPS = 1e-6f;
constexpr float LOG2E = 1.4426950408889634f;
}
using namespace cfg;
typedef unsigned short bf16;

constexpr size_t al256(size_t x) { return (x + 255) & ~(size_t)255; }
constexpr size_t WS_CTL = 0, CTL_BYTES = 1u << 20;
constexpr size_t WS_WIN = WS_CTL + CTL_BYTES;
constexpr size_t WS_WLR = WS_WIN + al256((size_t)NIN * D * 2);
constexpr size_t WS_WOUT = WS_WLR + al256((size_t)GRK * D * 2);
constexpr size_t WS_WCQ = WS_WOUT + al256((size_t)D * D * 2);
constexpr size_t WS_WCKV = WS_WCQ + al256((size_t)D * D * 2);
constexpr size_t WS_WCO = WS_WCKV + al256((size_t)2 * D * D * 2);
constexpr size_t WS_WGU = WS_WCO + al256((size_t)D * D * 2);
constexpr size_t WS_WD = WS_WGU + al256((size_t)NE * 2 * DE * D * 2);
constexpr size_t WS_XN = WS_WD + al256((size_t)NE * D * DE * 2);
constexpr size_t WS_MEMN = WS_XN + al256((size_t)(T + 1) * D * 2);
constexpr size_t WS_SMALL = WS_MEMN + al256((size_t)B * NMEM * D * 2);
constexpr size_t SM_GLR = 0;
constexpr size_t SM_CQSS = SM_GLR + al256((size_t)T * GRK * 4);
constexpr size_t SM_SSP1 = SM_CQSS + al256((size_t)T * 32 * 4);
constexpr size_t SM_SSP2 = SM_SSP1 + al256((size_t)T * 32 * 4);
constexpr size_t SM_EXPERT = SM_SSP2 + al256((size_t)T * 32 * 4);
constexpr size_t SM_GATE = SM_EXPERT + al256((size_t)T * 2 * 4);
constexpr size_t SM_SLOTPOS = SM_GATE + al256((size_t)T * 2 * 4);
constexpr size_t SM_SLOTTOK = SM_SLOTPOS + al256((size_t)T * 2 * 4);
constexpr size_t SM_SLOTGATE = SM_SLOTTOK + al256((size_t)PMAX * 4);
constexpr size_t SM_ROPE = SM_SLOTGATE + al256((size_t)PMAX * 4);
constexpr size_t SM_CKV = SM_ROPE + al256((size_t)T * DQK * 4);
constexpr size_t SM_CK2 = SM_CKV + al256((size_t)B * NMEM * 2 * D * 2);
constexpr size_t SM_CVT = SM_CK2 + al256((size_t)B * NMEM * D * 2);
constexpr size_t SM_WRT = SM_CVT + al256((size_t)B * NMEM * D * 2);
constexpr size_t SM_DEC = SM_WRT + al256((size_t)48 * D * 2);
constexpr size_t SM_STATS = SM_DEC + al256((size_t)B * NC * GH * GKD * 4);
constexpr size_t SM_END = SM_STATS + al256((size_t)T * DH * 4 * 4);
constexpr size_t WS_B = WS_SMALL + al256(SM_END);
constexpr size_t B_DQ = 0, B_DK = B_DQ + (size_t)T * (D / 2) * 2, B_DV = B_DK + (size_t)T * (D / 2) * 2;
constexpr size_t B_GQ = B_DV + (size_t)T * (D / 2) * 2, B_GK = B_GQ + (size_t)T * (D / 4) * 2, B_GV = B_GK + (size_t)T * (D / 4) * 2, B_GR = B_GV + (size_t)T * (D / 2) * 2;
constexpr size_t B_END1 = B_GR + (size_t)T * (D / 2) * 2;
constexpr size_t B_CQ = 0, B_CO = B_CQ + (size_t)T * D * 2, B_HE = B_CO + (size_t)T * D * 2, B_END2 = B_HE + (size_t)PMAX * DE * 2;
constexpr size_t B_BYTES = al256(B_END1 > B_END2 ? B_END1 : B_END2);
constexpr size_t WS_C = WS_B + B_BYTES;
constexpr size_t WS_D = WS_C + al256((size_t)T * D * 2);
constexpr size_t WS_END = WS_D + al256((size_t)T * D * 5);

constexpr int CW_CNT = 64;
constexpr int CW_BASE = 128;
constexpr int CW_TILE_E = 256;
constexpr int CW_NTILES = 512;
constexpr int CW_BAR = 4096;
constexpr int CW_QUEUE = 1024;

__device__ __forceinline__ bf16 f2bf(float f) { unsigned u; memcpy(&u, &f, 4); u = (u + 0x7fffu + ((u >> 16) & 1u)) >> 16; return (bf16)u; }
__device__ __forceinline__ float bf2f(bf16 b) { unsigned u = ((unsigned)b) << 16; float f; memcpy(&f, &u, 4); return f; }
__device__ __forceinline__ float silu_f(float x) { return x / (1.f + expf(-x)); }
#ifdef HOST_EMU
static inline size_t gtid() { return emu_tid; }
static inline size_t gnth() { return emu_nth; }
#else
__device__ __forceinline__ size_t gtid() { return (size_t)blockIdx.x * blockDim.x + threadIdx.x; }
__device__ __forceinline__ size_t gnth() { return (size_t)gridDim.x * blockDim.x; }
#endif
struct bf16x8s { bf16 v[8]; };
__host__ __device__ __forceinline__ int win_logical(int np) {
    if (np >= D) return np; const int t = np & ~255, p = np & 255; return t + 64 * ((p & 127) >> 5) + 32 * (p >> 7) + (p & 31);
}
__host__ __device__ __forceinline__ int win_src_col(int np) { const int l = win_logical(np); return l < O_LR ? l : l + GRK; }

__device__ __forceinline__ void nk_rmsnorm_rows(const float* x, const float* g, bf16* out, int rows, int d) {
    for (size_t r = gtid(); r < (size_t)(rows); r += gnth()) {
    const float* xr = x + r * d; float ss = 0.f;
    for (int i = 0; i < d; ++i) ss += xr[i] * xr[i];
    const float rs = 1.0f / sqrtf(ss / d + EPS);
    for (int i = 0; i < d; ++i) out[r * d + i] = f2bf(xr[i] * rs * g[i]);
}}
__device__ __forceinline__ void nk_glr(const float* x, const float* g, const float* w_in, float* GLR) {
    for (size_t i = gtid(); i < (size_t)T * GRK; i += gnth()) { const int cc = (int)(i % GRK), t = (int)(i / GRK); const float* xr = x + (size_t)t * D; float ss = 0.f;
        for (int k = 0; k < D; ++k) ss += xr[k] * xr[k]; const float rs = 1.0f / sqrtf(ss / D + EPS); float a = 0.f;
        for (int k = 0; k < D; ++k) a += xr[k] * rs * g[k] * w_in[(size_t)k * IN_COLS + O_LR + cc]; GLR[i] = a; }
}
__device__ __forceinline__ void nk_zero_bf16(bf16* p, size_t n) { for (size_t i = gtid(); i < n; i += gnth()) p[i] = 0; }
__device__ __forceinline__ void nk_convT(const float* W, int ldw, int col0, bf16* WT, int N, int K) {
    for (size_t i = gtid(); i < (size_t)(N * K); i += gnth()) {
    const int n = (int)(i / K), k = (int)(i % K);
    WT[i] = f2bf(W[(size_t)k * ldw + col0 + n]);
}}
__device__ __forceinline__ void nk_conv_win(const float* W, bf16* WT) {
    for (size_t i = gtid(); i < (size_t)NIN * D; i += gnth()) { const int n = (int)(i / D), k = (int)(i % D); WT[i] = f2bf(W[(size_t)k * IN_COLS + win_src_col(n)]); }
}
constexpr int GUH = (DE >= 128) ? 128 : DE;
__device__ __forceinline__ void nk_conv_gu(const float* Wg, const float* Wu, bf16* WGU) {
    for (size_t i = gtid(); i < (size_t)(NE * 2 * DE * D); i += gnth()) {
    const int k = (int)(i % D); const int r = (int)((i / D) % (2 * DE)); const int e = (int)(i / ((size_t)D * 2 * DE));
    const int pn = r / (2 * GUH), ii = r % (2 * GUH); const int j = pn * GUH + (ii % GUH);
    const float* W = (ii < GUH) ? Wg : Wu;
    WGU[i] = f2bf(W[((size_t)e * D + k) * DE + j]);
}}
__device__ __forceinline__ void nk_conv_d(const float* Wd, bf16* WD) {
    for (size_t i = gtid(); i < (size_t)(NE * D * DE); i += gnth()) {
    const int j = (int)(i % DE); const int n = (int)((i / DE) % D); const int e = (int)(i / ((size_t)D * DE));
    WD[i] = f2bf(Wd[((size_t)e * DE + j) * D + n]);
}}
__device__ __forceinline__ void nk_rope_table(const int* positions, float* tab) {
    constexpr int half = DQK / 2; for (size_t i = gtid(); i < (size_t)(T * half); i += gnth()) {
    const int t = (int)(i / half), j = (int)(i % half);
    const float freq = powf(10000.0f, -(float)j / (float)half);
    const float ang = (float)positions[t] * freq;
    tab[i * 2] = cosf(ang); tab[i * 2 + 1] = sinf(ang);
}}

struct GemmP { const bf16* A; const bf16* Bt; int M, N, K, pad; float* f0; float* f1; bf16* b0; const float* x; };
template <int MODE> __device__ __forceinline__ void gemm_epi(const GemmP& p, int m, int n, float acc) {
    if constexpr (MODE == 0) {
        bf16* Bb = p.b0; n = win_logical(n);
        if (n < D) { p.f0[(size_t)m * D + n] = acc; return; }
        if (n < O_GQ) { ((bf16*)((char*)Bb + B_DV))[(size_t)m * (D / 2) + (n - O_DV)] = f2bf(acc); return; }
        if (n < O_GK) { ((bf16*)((char*)Bb + B_GQ))[(size_t)m * (D / 4) + (n - O_GQ)] = f2bf(acc * (1.0f / sqrtf((float)GKD))); return; }
        if (n < O_GV) { ((bf16*)((char*)Bb + B_GK))[(size_t)m * (D / 4) + (n - O_GK)] = f2bf(acc); return; }
        if (n < O_LR) { ((bf16*)((char*)Bb + B_GV))[(size_t)m * (D / 2) + (n - O_GV)] = f2bf(acc); return; }
        ((bf16*)((char*)Bb + B_GR))[(size_t)m * (D / 2) + (n - O_LR)] = f2bf(acc);
    } else if constexpr (MODE == 1) { p.f0[(size_t)m * p.N + n] = p.x[(size_t)m * p.N + n] + acc;
    } else if constexpr (MODE == 2) { p.b0[(size_t)m * p.N + n] = f2bf(acc);
    } else if constexpr (MODE == 4) { p.f0[(size_t)m * p.N + n] += acc;
    } else { p.f0[(size_t)m * p.N + n] = acc; }
}
template <int MODE> __device__ __forceinline__ void nk_gemm(GemmP p) {
    const int nb = p.N / 4; for (size_t idx = gtid(); idx < (size_t)(p.M / 4) * nb; idx += gnth()) {
    const int m0 = 4 * (int)(idx / nb), n0 = 4 * (int)(idx % nb);
    float acc[4][4];
#pragma unroll
    for (int i = 0; i < 4; ++i)
#pragma unroll
        for (int j = 0; j < 4; ++j) acc[i][j] = 0.f;
    for (int k = 0; k < p.K; k += 8) {
        bf16x8s a[4], b[4];
#pragma unroll
        for (int i = 0; i < 4; ++i) { a[i] = *(const bf16x8s*)(p.A + (size_t)(m0 + i) * p.K + k); b[i] = *(const bf16x8s*)(p.Bt + (size_t)(n0 + i) * p.K + k); }
#pragma unroll
        for (int kk = 0; kk < 8; ++kk) {
            float af[4], bfv[4];
#pragma unroll
            for (int i = 0; i < 4; ++i) { af[i] = bf2f(a[i].v[kk]); bfv[i] = bf2f(b[i].v[kk]); }
#pragma unroll
            for (int i = 0; i < 4; ++i)
#pragma unroll
                for (int j = 0; j < 4; ++j) acc[i][j] += af[i] * bfv[j];
        }
    }
#pragma unroll
    for (int i = 0; i < 4; ++i)
#pragma unroll
        for (int j = 0; j < 4; ++j) gemm_epi<MODE>(p, m0 + i, n0 + j, acc[i][j]);
}}

__device__ __forceinline__ void nk_qk_post(const float* tmpqk, const float* qg, const float* kg, const float* rope, bf16* DQ, bf16* DK) {
    for (size_t i = gtid(); i < (size_t)(T * 2 * DH * 2); i += gnth()) {
    const int c = (int)(i % 2), h = (int)((i / 2) % DH), which = (int)((i / (2 * DH)) % 2), t = (int)(i / (4 * DH));
    const float* src = tmpqk + (size_t)t * D + which * (D / 2) + h * 2 * DQK + c * DQK;
    const float* g = which ? kg : qg; bf16* dst = (which ? DK : DQ) + (size_t)t * (D / 2) + h * 2 * DQK + c * DQK;
    float ss = 0.f; for (int d = 0; d < DQK; ++d) ss += src[d] * src[d];
    const float rs = 1.0f / sqrtf(ss / DQK + EPS); constexpr int half = DQK / 2;
    const float sc = which ? 1.0f : (1.0f / sqrtf((float)DQK)) * LOG2E;
    for (int d = 0; d < half; ++d) {
        const float t1 = src[d] * rs * g[d], t2 = src[d + half] * rs * g[d + half];
        const float cs = rope[((size_t)t * half + d) * 2], sn = rope[((size_t)t * half + d) * 2 + 1];
        dst[d] = f2bf((t1 * cs - t2 * sn) * sc); dst[d + half] = f2bf((t2 * cs + t1 * sn) * sc);
    }
}}
__device__ __forceinline__ void nk_lam(const float* q1, const float* k1, const float* q2, const float* k2, float* out) {
    if (gtid() != 0) return; float a = 0.f, b = 0.f; for (int i = 0; i < DQK; ++i) { a += q1[i] * k1[i]; b += q2[i] * k2[i]; }
    out[0] = expf(a) - expf(b) + 0.2f;
}
__device__ __forceinline__ void nk_mref(const float* qg, const float* kg, float* out) {
    if (gtid() != 0) return; float mq = 0.f, mk = 0.f; for (int i = 0; i < DQK; ++i) { mq = fmaxf(mq, fabsf(qg[i])); mk = fmaxf(mk, fabsf(kg[i])); }
    out[0] = (float)DQK * mq * mk * (1.0f / sqrtf((float)DQK)) * LOG2E * 1.02f;
}
__device__ __forceinline__ void nk_diff_stats(const bf16* DQ, const bf16* DK, float* stats) {
    for (size_t i = gtid(); i < (size_t)(T * DH * 2); i += gnth()) {
    const int c = (int)(i % 2), h = (int)((i / 2) % DH), t = (int)(i / (2 * DH)); const int b = t / SEQ, s = t % SEQ;
    const int nk = (s / CHUNK + 1) * CHUNK;
    float q[DQK]; const bf16* qp = DQ + (size_t)t * (D / 2) + h * 2 * DQK + c * DQK;
#pragma unroll
    for (int d = 0; d < DQK; ++d) q[d] = bf2f(qp[d]);
    float mx = -1e30f;
    for (int k = 0; k < nk; ++k) { const bf16* kp = DK + (size_t)(b * SEQ + k) * (D / 2) + h * 2 * DQK + c * DQK; float sdot = 0.f;
#pragma unroll
        for (int d = 0; d < DQK; ++d) sdot += q[d] * bf2f(kp[d]);
        mx = fmaxf(mx, sdot); }
    float sum = 0.f;
    for (int k = 0; k < nk; ++k) { const bf16* kp = DK + (size_t)(b * SEQ + k) * (D / 2) + h * 2 * DQK + c * DQK; float sdot = 0.f;
#pragma unroll
        for (int d = 0; d < DQK; ++d) sdot += q[d] * bf2f(kp[d]);
        sum += exp2f(sdot - mx); }
    stats[i * 2] = mx; stats[i * 2 + 1] = sum;
}}
__device__ __forceinline__ void nk_diff_pv(const bf16* DQ, const bf16* DK, const bf16* DV, const float* stats, const float* lamp, float* otmp) {
    constexpr int NDG = 8, DG = DVD / NDG;
    for (size_t i = gtid(); i < (size_t)(T * DH * NDG); i += gnth()) {
    const int dg = (int)(i % NDG), h = (int)((i / NDG) % DH), t = (int)(i / (NDG * DH)); const int b = t / SEQ, s = t % SEQ;
    const int nk = (s / CHUNK + 1) * CHUNK; const float lam = lamp[0];
    float q[2 * DQK]; const bf16* qp = DQ + (size_t)t * (D / 2) + h * 2 * DQK;
#pragma unroll
    for (int d = 0; d < 2 * DQK; ++d) q[d] = bf2f(qp[d]);
    const float m0 = stats[((size_t)(t * DH + h) * 2 + 0) * 2], l0 = stats[((size_t)(t * DH + h) * 2 + 0) * 2 + 1];
    const float m1 = stats[((size_t)(t * DH + h) * 2 + 1) * 2], l1 = stats[((size_t)(t * DH + h) * 2 + 1) * 2 + 1];
    float acc[DG];
#pragma unroll
    for (int d = 0; d < DG; ++d) acc[d] = 0.f;
    for (int k = 0; k < nk; ++k) { const bf16* kp = DK + (size_t)(b * SEQ + k) * (D / 2) + h * 2 * DQK; float s0 = 0.f, s1 = 0.f;
#pragma unroll
        for (int d = 0; d < DQK; ++d) { s0 += q[d] * bf2f(kp[d]); s1 += q[DQK + d] * bf2f(kp[DQK + d]); }
        const float a = exp2f(s0 - m0) / l0 - lam * exp2f(s1 - m1) / l1;
        const bf16* vp = DV + (size_t)(b * SEQ + k) * (D / 2) + h * DVD + dg * DG;
#pragma unroll
        for (int d = 0; d < DG; ++d) acc[d] += a * bf2f(vp[d]); }
#pragma unroll
    for (int d = 0; d < DG; ++d) otmp[(size_t)t * (D / 2) + h * DVD + dg * DG + d] = acc[d];
}}
__device__ __forceinline__ void nk_diff_norm(const float* otmp, const float* g, bf16* MIX) {
    for (size_t i = gtid(); i < (size_t)(T * DH); i += gnth()) { const int h = (int)(i % DH), t = (int)(i / DH);
    const float* o = otmp + (size_t)t * (D / 2) + h * DVD; float ss = 0.f; for (int d = 0; d < DVD; ++d) ss += o[d] * o[d];
    const float rs = 1.0f / sqrtf(ss / DVD + EPS);
    for (int d = 0; d < DVD; ++d) MIX[(size_t)t * D + h * DVD + d] = f2bf(o[d] * rs * g[d] * 0.8f);
}}
__device__ __forceinline__ void nk_gla_cum(const float* GLR, const float* wa2, const float* ba, float* CUM) {
    constexpr int W = GH * GKD; for (size_t i = gtid(); i < (size_t)(B * NC * W); i += gnth()) {
    const int j = (int)(i % W), cb = (int)(i / W); float run = 0.f;
    for (int tt = 0; tt < CHUNK; ++tt) { const int t = cb * CHUNK + tt; float z = ba[j];
        for (int r = 0; r < GRK; ++r) z += GLR[(size_t)t * GRK + r] * wa2[(size_t)r * W + j];
        const float ls = fminf(z, 0.f) - log1pf(expf(-fabsf(z)));
        run += ls * (1.0f / 16.0f); CUM[(size_t)t * W + j] = run; }
}}
__device__ __forceinline__ void nk_gla_prep(const float* GLR, const float* wa2, const float* ba, const bf16* GK, bf16* KD, float* DEC) {
    constexpr int W = GH * GKD;
    for (size_t i = gtid(); i < (size_t)B * NC * W; i += gnth()) { const int j = (int)(i % W), cb = (int)(i / W);
        float w[GRK];
#pragma unroll
        for (int r = 0; r < GRK; ++r) w[r] = wa2[(size_t)r * W + j];
        const float bj = ba[j]; float run = 0.f;
        for (int tt = 0; tt < CHUNK; ++tt) { const float* gl = GLR + (size_t)(cb * CHUNK + tt) * GRK; float z = bj;
#pragma unroll
            for (int r = 0; r < GRK; ++r) z += gl[r] * w[r];
            run += (fminf(z, 0.f) - log1pf(expf(-fabsf(z)))) * (1.0f / 16.0f); }
        const float end = run; DEC[i] = expf(end); run = 0.f;
        for (int tt = 0; tt < CHUNK; ++tt) { const int t = cb * CHUNK + tt; const float* gl = GLR + (size_t)t * GRK; float z = bj;
#pragma unroll
            for (int r = 0; r < GRK; ++r) z += gl[r] * w[r];
            run += (fminf(z, 0.f) - log1pf(expf(-fabsf(z)))) * (1.0f / 16.0f);
            KD[(size_t)t * W + j] = f2bf(bf2f(GK[(size_t)t * W + j]) * expf(end - run)); } }
}
__device__ __forceinline__ void nk_gla_run(const bf16* GQ, const bf16* GK, const bf16* GV, const float* CUM, float* otmp) {
    constexpr int KH = GKD / 2;
    for (size_t i = gtid(); i < (size_t)(B * GH * GVD); i += gnth()) {
    const int v = (int)(i % GVD), h = (int)((i / GVD) % GH), b = (int)(i / (GVD * GH)); constexpr int W = GH * GKD;
    for (int kh = 0; kh < 2; ++kh) {
    float S[KH];
#pragma unroll
    for (int k = 0; k < KH; ++k) S[k] = 0.f;
    for (int c = 0; c < NC; ++c) { const int t0 = b * SEQ + c * CHUNK; const float* ce = CUM + (size_t)(t0 + CHUNK - 1) * W + h * GKD + kh * KH;
#pragma unroll
        for (int k = 0; k < KH; ++k) S[k] *= expf(ce[k]);
        for (int tt = 0; tt < CHUNK; ++tt) { const int t = t0 + tt; const float vv = bf2f(GV[(size_t)t * (D / 2) + h * GVD + v]);
            const bf16* kp = GK + (size_t)t * (D / 4) + h * GKD + kh * KH; const float* cp = CUM + (size_t)t * W + h * GKD + kh * KH;
#pragma unroll
            for (int k = 0; k < KH; ++k) S[k] += bf2f(kp[k]) * expf(ce[k] - cp[k]) * vv; }
        for (int tt = 0; tt < CHUNK; ++tt) { const int t = t0 + tt; const bf16* qp = GQ + (size_t)t * (D / 4) + h * GKD + kh * KH; float o = 0.f;
#pragma unroll
            for (int k = 0; k < KH; ++k) o += bf2f(qp[k]) * S[k];
            float* op = otmp + (size_t)t * (D / 2) + h * GVD + v; if (kh == 0) *op = o; else *op += o; } }
    } }
}
__device__ __forceinline__ void nk_gla_norm(const float* otmp, const float* g, const bf16* GR, bf16* MIX) {
    for (size_t i = gtid(); i < (size_t)(T * GH); i += gnth()) { const int h = (int)(i % GH), t = (int)(i / GH);
    const float* o = otmp + (size_t)t * (D / 2) + h * GVD; float ss = 0.f; for (int d = 0; d < GVD; ++d) ss += o[d] * o[d];
    const float rs = 1.0f / sqrtf(ss / GVD + EPS);
    for (int d = 0; d < GVD; ++d) MIX[(size_t)t * D + D / 2 + h * GVD + d] = f2bf(o[d] * rs * g[d] * silu_f(bf2f(GR[(size_t)t * (D / 2) + h * GVD + d])));
}}
__device__ __forceinline__ void nk_cqss(const bf16* CQ, float* CQSS) {
    for (size_t i = gtid(); i < (size_t)T * 32; i += gnth()) { const int j = (int)(i % 32), t = (int)(i / 32);
    float ss = 0.f; for (int d = 0; d < D / 32; ++d) { const float v = bf2f(CQ[(size_t)t * D + j * (D / 32) + d]); ss += v * v; } CQSS[i] = ss; }
}
__device__ __forceinline__ void nk_ckv_fix(const bf16* CKV, const float* qg, const float* kg, bf16* CK2, bf16* CVT) {
    for (size_t i = gtid(); i < (size_t)(B * NMEM * CH); i += gnth()) { const int h = (int)(i % CH), bm = (int)(i / CH); const int b = bm / NMEM, m = bm % NMEM;
    const bf16* kp = CKV + (size_t)bm * 2 * D + h * CHD; const bf16* vp = CKV + (size_t)bm * 2 * D + D + h * CHD;
    float ss = 0.f; for (int d = 0; d < CHD; ++d) { const float v = bf2f(kp[d]); ss += v * v; }
    const float rs = 1.0f / sqrtf(ss / CHD + EPS) * (1.0f / sqrtf((float)CHD)) * LOG2E;
    for (int d = 0; d < CHD; ++d) { CK2[(((size_t)b * CH + h) * NMEM + m) * CHD + d] = f2bf(bf2f(kp[d]) * rs * kg[d] * qg[d]);
        CVT[(((size_t)b * CH + h) * CHD + d) * NMEM + m] = vp[d]; }
}}
__device__ __forceinline__ void nk_cross_scores(const bf16* CQ, const float* CQSS, const bf16* CK2, float* P) {
    for (size_t i = gtid(); i < (size_t)(T * CH * NMEM); i += gnth()) { const int m = (int)(i % NMEM), h = (int)((i / NMEM) % CH), t = (int)(i / (NMEM * CH)); const int b = t / SEQ;
    float qs = 0.f; for (int j = 0; j < 8; ++j) qs += CQSS[(size_t)t * 32 + 8 * h + j];
    const float rq = 1.0f / sqrtf(qs / CHD + EPS);
    const bf16* qp = CQ + (size_t)t * D + h * CHD; const bf16* kp = CK2 + (((size_t)b * CH + h) * NMEM + m) * CHD; float s = 0.f;
    for (int d = 0; d < CHD; ++d) s += bf2f(qp[d]) * bf2f(kp[d]);
    P[i] = s * rq;
}}
__device__ __forceinline__ void nk_cross_softmax(float* P) {
    for (size_t i = gtid(); i < (size_t)(T * CH); i += gnth()) { float* p = P + i * NMEM; float mx = -1e30f;
    for (int m = 0; m < NMEM; ++m) mx = fmaxf(mx, p[m]); float sum = 0.f;
    for (int m = 0; m < NMEM; ++m) { p[m] = exp2f(p[m] - mx); sum += p[m]; }
    for (int m = 0; m < NMEM; ++m) p[m] /= sum;
}}
__device__ __forceinline__ void nk_cross_pv(const float* P, const bf16* CVT, bf16* CO) {
    for (size_t i = gtid(); i < (size_t)(T * D); i += gnth()) { const int d = (int)(i % CHD), h = (int)((i / CHD) % CH), t = (int)(i / D); const int b = t / SEQ;
    const float* p = P + ((size_t)t * CH + h) * NMEM; const bf16* vp = CVT + (((size_t)b * CH + h) * CHD + d) * NMEM; float o = 0.f;
    for (int m = 0; m < NMEM; ++m) o += p[m] * bf2f(vp[m]);
    CO[i] = f2bf(o);
}}
__device__ __forceinline__ void nk_router(const float* h2, const float* g, const float* wrg, const float* brg, const float* wre, const float* bre, bf16* XN, int* EXPERT, float* GATE, int* SLOTPOS, int* ctl) {
    for (size_t t = gtid(); t < (size_t)(T); t += gnth()) { const float* xr = h2 + t * D; float ss = 0.f;
    for (int i = 0; i < D; ++i) ss += xr[i] * xr[i]; const float rs = 1.0f / sqrtf(ss / D + EPS);
    float gl[NG], el[NE];
#pragma unroll
    for (int j = 0; j < NG; ++j) gl[j] = brg[j];
#pragma unroll
    for (int j = 0; j < NE; ++j) el[j] = bre[j];
    for (int i = 0; i < D; ++i) { const float xv = xr[i] * rs * g[i]; XN[t * D + i] = f2bf(xv);
#pragma unroll
        for (int j = 0; j < NG; ++j) gl[j] += xv * wrg[(size_t)i * NG + j];
#pragma unroll
        for (int j = 0; j < NE; ++j) el[j] += xv * wre[(size_t)i * NE + j]; }
    int grp = 0; float gm = gl[0];
#pragma unroll
    for (int j = 1; j < NG; ++j) if (gl[j] > gm) { gm = gl[j]; grp = j; }
    float gs = 0.f;
#pragma unroll
    for (int j = 0; j < NG; ++j) gs += expf(gl[j] - gm);
    const float grp_w = 1.0f / gs;
    float e8[EPG];
#pragma unroll
    for (int j = 0; j < EPG; ++j) { float v = 0.f;
#pragma unroll
        for (int gq = 0; gq < NG; ++gq) v = (grp == gq) ? el[gq * EPG + j] : v;
        e8[j] = v; }
    int i0 = 0; float v0 = e8[0];
#pragma unroll
    for (int j = 1; j < EPG; ++j) if (e8[j] > v0) { v0 = e8[j]; i0 = j; }
    int i1 = -1; float v1 = -1e30f;
#pragma unroll
    for (int j = 0; j < EPG; ++j) if (j != i0 && e8[j] > v1) { v1 = e8[j]; i1 = j; }
    const float r = expf(v1 - v0); const float g0 = grp_w / (1.f + r), g1 = grp_w * r / (1.f + r);
    const int e0 = grp * EPG + i0, e1 = grp * EPG + i1;
    EXPERT[t * 2] = e0; EXPERT[t * 2 + 1] = e1; GATE[t * 2] = g0; GATE[t * 2 + 1] = g1;
    SLOTPOS[t * 2] = atomicAdd(&ctl[CW_CNT + e0], 1); SLOTPOS[t * 2 + 1] = atomicAdd(&ctl[CW_CNT + e1], 1);
}}
__device__ __forceinline__ void nk_moe_offsets(int* ctl) {
    if (gtid() != 0) return; int base = 0, nt = 0;
    for (int e = 0; e < NE; ++e) { ctl[CW_BASE + e] = base; const int n = (ctl[CW_CNT + e] + ETILE - 1) / ETILE; for (int j = 0; j < n; ++j) ctl[CW_TILE_E + nt + j] = e; nt += n; base += n * ETILE; }
    ctl[CW_BASE + NE] = base; ctl[CW_NTILES] = nt; for (int j = nt; j < NTILE; ++j) ctl[CW_TILE_E + j] = -1;
}
__device__ __forceinline__ void nk_moe_init_slots(int* SLOTTOK, float* SLOTGATE) { for (size_t i = gtid(); i < (size_t)PMAX; i += gnth()) { SLOTTOK[i] = T; SLOTGATE[i] = 0.f; } }
__device__ __forceinline__ void nk_moe_fill(const int* EXPERT, const float* GATE, const int* SLOTPOS, const int* ctl, int* SLOTTOK, float* SLOTGATE) {
    for (size_t i = gtid(); i < (size_t)(T * 2); i += gnth()) { const int e = EXPERT[i]; const int dst = ctl[CW_BASE + e] + SLOTPOS[i];
    SLOTTOK[dst] = (int)(i / 2); SLOTGATE[dst] = GATE[i];
}}
__device__ __forceinline__ void nk_moe_gu(const bf16* XN, const bf16* WGU, const int* SLOTTOK, const int* ctl, bf16* HE) {
    for (size_t i = gtid(); i < (size_t)(PMAX * DE); i += gnth()) { const int j = (int)(i % DE), p = (int)(i / DE); const int e = ctl[CW_TILE_E + p / ETILE];
    if (e < 0) continue; const int tok = SLOTTOK[p];
    const int pn = j / GUH, jj = j % GUH; const bf16* wg = WGU + ((size_t)e * 2 * DE + pn * 2 * GUH + jj) * D; const bf16* wu = wg + (size_t)GUH * D;
    const bf16* xr = XN + (size_t)tok * D; float g = 0.f, u = 0.f;
    for (int k = 0; k < D; ++k) { const float xv = bf2f(xr[k]); g += xv * bf2f(wg[k]); u += xv * bf2f(wu[k]); }
    HE[i] = f2bf(silu_f(g) * u);
}}
__device__ __forceinline__ void nk_moe_down(const bf16* HE, const bf16* WD, const int* SLOTTOK, const float* SLOTGATE, const int* ctl, float* out) {
    for (size_t i = gtid(); i < (size_t)(PMAX * D); i += gnth()) { const int n = (int)(i % D), p = (int)(i / D); const int e = ctl[CW_TILE_E + p / ETILE];
    if (e < 0) continue; const int tok = SLOTTOK[p]; if (tok >= T) continue;
    const bf16* hr = HE + (size_t)p * DE; const bf16* wr = WD + ((size_t)e * D + n) * DE; float y = 0.f;
    for (int k = 0; k < DE; ++k) y += bf2f(hr[k]) * bf2f(wr[k]);
    atomicAdd(&out[(size_t)tok * D + n], y * SLOTGATE[p]);
}}


#ifndef HOST_EMU
static_assert(D == 2048 && SEQ == 4096 && NMEM == 256 && ETILE == 256, "the fast phases are written for the real shapes");
#define LAS __attribute__((address_space(3)))
#define GAS __attribute__((address_space(1)))
#define LDS_WAIT() asm volatile("s_waitcnt lgkmcnt(0)" ::: "memory")
#define VM_WAIT() asm volatile("s_waitcnt vmcnt(0)" ::: "memory")
namespace pg8 {
#define PG8_LAS __attribute__((address_space(3)))
typedef unsigned short bf16_t;
typedef short bf16x8 __attribute__((ext_vector_type(8)));
typedef float f32x4 __attribute__((ext_vector_type(4)));
typedef unsigned u32x4 __attribute__((ext_vector_type(4)));
constexpr int BM = 256, BK = 64, HALF = 128, HTB = HALF * BK * 2  , STAGE_BYTES = 8 * HTB, NXCD = 8, WGM = 8;

__host__ __device__ __forceinline__ int lds_byte(int r, int c) { const int st = (r >> 4) * 2 + (c >> 5), rr = r & 15, cc = c & 31, ob = rr * 64 + cc * 2; return st * 1024 + (ob ^ (((ob >> 9) & 1) << 5)); }
__host__ __device__ __forceinline__ void stage_rc(int b, int& R, int& C) { const int st = b / 1024, sb = b % 1024, swz = sb ^ (((sb >> 9) & 1) << 5); R = (st >> 1) * 16 + swz / 64; C = (st & 1) * 32 + (swz % 64) / 2; }
__host__ __device__ __forceinline__ int perm32(int rho) { const int n = rho >> 4, i = rho & 15; return 8 * (i >> 2) + 4 * n + (i & 3); }

struct Unit { int pm, pn; };
struct Gemm { const bf16_t* A; const bf16_t* Bt; int M, N, K; };

struct StaticOrder {
    int nM, nN, nwg, G, c;
    __host__ __device__ void init(int M, int N, int G_, int c_) { nM = M / BM; nN = N / BM; nwg = nM * nN; G = G_; c = c_; }
    __host__ __device__ bool next(int i, Unit& u) const {
        const long L = (long)i * G + c; if (L >= nwg) return false;
        int wgid = (int)L; { const int q = nwg / NXCD, r = nwg % NXCD, xcd = wgid % NXCD, off = wgid / NXCD; wgid = (xcd < r ? xcd * (q + 1) : r * (q + 1) + (xcd - r) * q) + off; }
        const int nig = WGM * nN, gid = wgid / nig, fm = gid * WGM, gsz = (nM - fm) < WGM ? (nM - fm) : WGM;
        u.pm = fm + ((wgid % nig) % gsz); u.pn = (wgid % nig) / gsz; return true;
    }
    __device__ __forceinline__ void a_ready(const Unit&) const {}
    __device__ __forceinline__ void done(const Unit&) const {}
};
__device__ __forceinline__ unsigned cvt_pk_bf16(float lo, float hi) { unsigned r; asm volatile("v_cvt_pk_bf16_f32 %0, %1, %2" : "=v"(r) : "v"(lo), "v"(hi)); return r; }
__device__ __forceinline__ float dot4(const f32x4 a) { return (a[0] * a[0] + a[1] * a[1]) + (a[2] * a[2] + a[3] * a[3]); }
struct EpiInProj {
    static constexpr bool PERM = true, AFTER_DRAIN = false;
    char* rb; const float* rope; const float* qg; const float* kg;
    __device__ __forceinline__ void operator()(const f32x4 (&acc)[2][2][4][2], const Unit& u, int wr, int wc, int fr, int fq) const {
        const int row0 = u.pm * BM + wr * 64 + fr;
        if (u.pn < 8) {
            const bool isk = u.pn >= 4; const float* g = isk ? kg : qg;
            bf16_t* dst = (bf16_t*)(rb + (isk ? B_DK : B_DQ)) + ((u.pn & 3) * 4 + wc) * 64 + 8 * fq;
            const float sc = isk ? 1.0f : 0.125f * LOG2E;
            const f32x4 ga0 = *(const f32x4*)(g + 8 * fq), ga1 = *(const f32x4*)(g + 8 * fq + 4), gb0 = *(const f32x4*)(g + 32 + 8 * fq), gb1 = *(const f32x4*)(g + 36 + 8 * fq);
#pragma unroll
            for (int ai = 0; ai < 2; ++ai)
#pragma unroll
                for (int m = 0; m < 4; ++m) {
                    const int row = row0 + ai * HALF + m * 16;
                    const f32x4 a0 = acc[ai][0][m][0], a1 = acc[ai][0][m][1], b0 = acc[ai][1][m][0], b1 = acc[ai][1][m][1];
                    float ss = (dot4(a0) + dot4(a1)) + (dot4(b0) + dot4(b1));
                    ss += __shfl_xor(ss, 16); ss += __shfl_xor(ss, 32);
                    const float rs = sc / sqrtf(ss * (1.0f / 64.0f) + EPS);
                    const f32x4* rp = (const f32x4*)(rope + ((size_t)row * 32 + 8 * fq) * 2);
                    const f32x4 r0 = rp[0], r1 = rp[1], r2 = rp[2], r3 = rp[3];
                    const f32x4 t1a = a0 * ga0 * rs, t1b = a1 * ga1 * rs, t2a = b0 * gb0 * rs, t2b = b1 * gb1 * rs;
                    u32x4 w1, w2;
                    w1.x = cvt_pk_bf16(t1a[0] * r0[0] - t2a[0] * r0[1], t1a[1] * r0[2] - t2a[1] * r0[3]); w1.y = cvt_pk_bf16(t1a[2] * r1[0] - t2a[2] * r1[1], t1a[3] * r1[2] - t2a[3] * r1[3]);
                    w1.z = cvt_pk_bf16(t1b[0] * r2[0] - t2b[0] * r2[1], t1b[1] * r2[2] - t2b[1] * r2[3]); w1.w = cvt_pk_bf16(t1b[2] * r3[0] - t2b[2] * r3[1], t1b[3] * r3[2] - t2b[3] * r3[3]);
                    w2.x = cvt_pk_bf16(t2a[0] * r0[0] + t1a[0] * r0[1], t2a[1] * r0[2] + t1a[1] * r0[3]); w2.y = cvt_pk_bf16(t2a[2] * r1[0] + t1a[2] * r1[1], t2a[3] * r1[2] + t1a[3] * r1[3]);
                    w2.z = cvt_pk_bf16(t2b[0] * r2[0] + t1b[0] * r2[1], t2b[1] * r2[2] + t1b[1] * r2[3]); w2.w = cvt_pk_bf16(t2b[2] * r3[0] + t1b[2] * r3[1], t2b[3] * r3[2] + t1b[3] * r3[3]);
                    bf16_t* rowp = dst + (size_t)row * (D / 2);
                    *(u32x4*)rowp = w1; *(u32x4*)(rowp + 32) = w2;
                }
        } else {
            const int pn = u.pn; bf16_t* base; int ldc, colt; float sc = 1.0f;
            if (pn < 12) { base = (bf16_t*)(rb + B_DV); ldc = D / 2; colt = (pn - 8) * BM; }
            else if (pn < 14) { base = (bf16_t*)(rb + B_GQ); ldc = D / 4; colt = (pn - 12) * BM; sc = 0.08838834764831845f; }
            else if (pn < 16) { base = (bf16_t*)(rb + B_GK); ldc = D / 4; colt = (pn - 14) * BM; }
            else if (pn < 20) { base = (bf16_t*)(rb + B_GV); ldc = D / 2; colt = (pn - 16) * BM; }
            else { base = (bf16_t*)(rb + B_GR); ldc = D / 2; colt = (pn - 20) * BM; }
            const int col0 = colt + wc * 32 + 8 * fq;
#pragma unroll
            for (int ai = 0; ai < 2; ++ai)
#pragma unroll
                for (int m = 0; m < 4; ++m) { bf16_t* rowp = base + (size_t)(row0 + ai * HALF + m * 16) * ldc + col0;
#pragma unroll
                    for (int bj = 0; bj < 2; ++bj) { const f32x4 v0 = acc[ai][bj][m][0] * sc, v1 = acc[ai][bj][m][1] * sc;
                        u32x4 w; w.x = cvt_pk_bf16(v0[0], v0[1]); w.y = cvt_pk_bf16(v0[2], v0[3]); w.z = cvt_pk_bf16(v1[0], v1[1]); w.w = cvt_pk_bf16(v1[2], v1[3]);
                        *(u32x4*)(rowp + bj * HALF) = w; } }
        }
    }
};
struct EpiResid {
    static constexpr bool PERM = true, AFTER_DRAIN = false;
    const float* base; float* out; bf16_t* xn; const float* g; float* ssp;
    __device__ __forceinline__ void operator()(const f32x4 (&acc)[2][2][4][2], const Unit& u, int wr, int wc, int fr, int fq) const {
        const int row0 = u.pm * BM + wr * 64 + fr, col0 = u.pn * BM + wc * 32 + 8 * fq;
        f32x4 gv[2][2];
#pragma unroll
        for (int bj = 0; bj < 2; ++bj)
#pragma unroll
            for (int n = 0; n < 2; ++n) gv[bj][n] = *(const f32x4*)(g + col0 + bj * HALF + 4 * n);
#pragma unroll
        for (int ai = 0; ai < 2; ++ai)
#pragma unroll
            for (int m = 0; m < 4; ++m) { const int row = row0 + ai * HALF + m * 16; const size_t off = (size_t)row * D + col0; float ss = 0.f;
#pragma unroll
                for (int bj = 0; bj < 2; ++bj) { const f32x4 b0 = *(const f32x4*)(base + off + bj * HALF), b1 = *(const f32x4*)(base + off + bj * HALF + 4);
                    const f32x4 v0 = acc[ai][bj][m][0] + b0, v1 = acc[ai][bj][m][1] + b1;
                    *(f32x4*)(out + off + bj * HALF) = v0; *(f32x4*)(out + off + bj * HALF + 4) = v1; ss += dot4(v0) + dot4(v1);
                    const f32x4 x0 = v0 * gv[bj][0], x1 = v1 * gv[bj][1];
                    u32x4 w; w.x = cvt_pk_bf16(x0[0], x0[1]); w.y = cvt_pk_bf16(x0[2], x0[3]); w.z = cvt_pk_bf16(x1[0], x1[1]); w.w = cvt_pk_bf16(x1[2], x1[3]);
                    *(u32x4*)(xn + off + bj * HALF) = w; }
                ss += __shfl_xor(ss, 16); ss += __shfl_xor(ss, 32);
                if (fq == 0) ssp[(size_t)row * 32 + u.pn * 4 + wc] = ss;
                if (m & 1) asm volatile("" ::: "memory"); }
    }
};
struct EpiCq {
    static constexpr bool PERM = true, AFTER_DRAIN = false;
    const float* ssp_in; bf16_t* cq; float* cqss;
    __device__ __forceinline__ void operator()(const f32x4 (&acc)[2][2][4][2], const Unit& u, int wr, int wc, int fr, int fq) const {
        const int lane = fr + 16 * fq, row0 = u.pm * BM + wr * 64 + fr, col0 = u.pn * BM + wc * 32 + 8 * fq;
        float rs2[2];
#pragma unroll
        for (int ai = 0; ai < 2; ++ai) { const f32x4* p = (const f32x4*)(ssp_in + (size_t)(u.pm * BM + ai * HALF + wr * 64 + lane) * 32); f32x4 s4 = p[0];
#pragma unroll
            for (int j = 1; j < 8; ++j) s4 += p[j];
            rs2[ai] = 1.0f / sqrtf(((s4[0] + s4[1]) + (s4[2] + s4[3])) * (1.0f / D) + EPS); }
#pragma unroll
        for (int ai = 0; ai < 2; ++ai)
#pragma unroll
            for (int m = 0; m < 4; ++m) { const int row = row0 + ai * HALF + m * 16; const size_t off = (size_t)row * D + col0; float ss = 0.f;
                const float rsr = __shfl(rs2[ai], 16 * m + fr);
#pragma unroll
                for (int bj = 0; bj < 2; ++bj) { const f32x4 v0 = acc[ai][bj][m][0] * rsr, v1 = acc[ai][bj][m][1] * rsr; ss += dot4(v0) + dot4(v1);
                    u32x4 w; w.x = cvt_pk_bf16(v0[0], v0[1]); w.y = cvt_pk_bf16(v0[2], v0[3]); w.z = cvt_pk_bf16(v1[0], v1[1]); w.w = cvt_pk_bf16(v1[2], v1[3]);
                    *(u32x4*)(cq + off + bj * HALF) = w; }
                ss += __shfl_xor(ss, 16); ss += __shfl_xor(ss, 32);
                if (fq == 0) cqss[(size_t)row * 32 + u.pn * 4 + wc] = ss; }
    }
};

struct MoeOrder {
    const int* ctl; int NP, G, c;
    __device__ __forceinline__ bool next(int i, Unit& u) const { const int nt = ctl[CW_NTILES]; const int L = i * G + c; if (L >= nt * NP) return false;
        const int rt = L / NP; u.pm = rt; u.pn = ctl[CW_TILE_E + rt] * NP + (L - rt * NP); return true; }
    __device__ __forceinline__ void a_ready(const Unit&) const {}
    __device__ __forceinline__ void done(const Unit&) const {}
};
__device__ __forceinline__ float silu_fast(float x) { return x * __builtin_amdgcn_rcpf(1.0f + __expf(-x)); }
struct EpiGU {
    static constexpr bool PERM = true, AFTER_DRAIN = false;
    const int* slottok; const float* ssp; bf16_t* he;
    __device__ __forceinline__ void operator()(const f32x4 (&acc)[2][2][4][2], const Unit& u, int wr, int wc, int fr, int fq) const {
        const int lane = fr + 16 * fq, p0 = u.pm * BM + wr * 64, ct = u.pn & 3;
        float rs2[2];
#pragma unroll
        for (int ai = 0; ai < 2; ++ai) { const int tok = slottok[p0 + ai * HALF + lane]; float rs = 0.f;
            if (tok < T) { const f32x4* p = (const f32x4*)(ssp + (size_t)tok * 32); f32x4 s4 = p[0];
#pragma unroll
                for (int j = 1; j < 8; ++j) s4 += p[j];
                rs = 1.0f / sqrtf(((s4[0] + s4[1]) + (s4[2] + s4[3])) * (1.0f / D) + EPS); }
            rs2[ai] = rs; }
#pragma unroll
        for (int ai = 0; ai < 2; ++ai)
#pragma unroll
            for (int m = 0; m < 4; ++m) { const float rsr = __shfl(rs2[ai], 16 * m + fr);
                bf16_t* rowp = he + (size_t)(p0 + ai * HALF + 16 * m + fr) * DE + ct * 128 + wc * 32 + 8 * fq;
                const f32x4 g0 = acc[ai][0][m][0] * rsr, g1 = acc[ai][0][m][1] * rsr, u0 = acc[ai][1][m][0] * rsr, u1 = acc[ai][1][m][1] * rsr;
                u32x4 w; w.x = cvt_pk_bf16(silu_fast(g0[0]) * u0[0], silu_fast(g0[1]) * u0[1]); w.y = cvt_pk_bf16(silu_fast(g0[2]) * u0[2], silu_fast(g0[3]) * u0[3]);
                w.z = cvt_pk_bf16(silu_fast(g1[0]) * u1[0], silu_fast(g1[1]) * u1[1]); w.w = cvt_pk_bf16(silu_fast(g1[2]) * u1[2], silu_fast(g1[3]) * u1[3]);
                *(u32x4*)rowp = w; }
    }
};
struct EpiDown {
    static constexpr bool PERM = true, AFTER_DRAIN = false;
    const int* slottok; const float* slotgate; float* out;
    __device__ __forceinline__ void operator()(const f32x4 (&acc)[2][2][4][2], const Unit& u, int wr, int wc, int fr, int fq) const {
        const int lane = fr + 16 * fq, p0 = u.pm * BM + wr * 64, ct = u.pn & 7;
        int tk2[2]; float gt2[2];
#pragma unroll
        for (int ai = 0; ai < 2; ++ai) { tk2[ai] = slottok[p0 + ai * HALF + lane]; gt2[ai] = slotgate[p0 + ai * HALF + lane]; }
#pragma unroll
        for (int ai = 0; ai < 2; ++ai)
#pragma unroll
            for (int m = 0; m < 4; ++m) { const int tok = __shfl(tk2[ai], 16 * m + fr); const float gt = __shfl(gt2[ai], 16 * m + fr);
                if (tok < T) { float* rowp = out + (size_t)tok * D + ct * BM + wc * 32 + 8 * fq;
#pragma unroll
                    for (int bj = 0; bj < 2; ++bj)
#pragma unroll
                        for (int n = 0; n < 2; ++n)
#pragma unroll
                            for (int i = 0; i < 4; ++i) (void)unsafeAtomicAdd(rowp + bj * HALF + 4 * n + i, acc[ai][bj][m][n][i] * gt); } }
    }
};
template <class Epi, class Sched, bool ALIGN_EPI = false, bool SP2 = false>
__device__ __forceinline__ void gemm_phase(PG8_LAS unsigned char* lds, const Gemm g, const Sched& S, const Epi& E) {
    const int tid = threadIdx.x, wid = __builtin_amdgcn_readfirstlane(tid >> 6), lane = tid & 63, wr = wid >> 2, wc = wid & 3, fr = lane & 15, fq = lane >> 4;
    const int K = g.K, nt = K / BK;
    unsigned voffA[2], voffB[2];
#pragma unroll
    for (int i = 0; i < 2; ++i) { int R, C; stage_rc(tid * 16 + i * 8192, R, C); const int Rb = Epi::PERM ? ((R & ~31) + perm32(R & 31)) : R;
        voffA[i] = (unsigned)(R * K + C) * 2u; voffB[i] = (unsigned)(Rb * K + C) * 2u; }
    const size_t kstep = (size_t)(BK * 2);
    const size_t hstep = (size_t)HALF * K * 2;
    const size_t tstep = 2 * hstep;
    const unsigned ldsw = (unsigned)wid * 1024u;
    const int aoff = lds_byte(wr * 64 + fr, fq * 8), boff = lds_byte(wc * 32 + fr, fq * 8);
#define PG8_SA(b, h) (((b) * 2 + (h)) * HTB)
#define PG8_SB(b, h) ((4 + (b) * 2 + (h)) * HTB)
#define PG8_STAGE(bufoff, gbase, voff) do { _Pragma("unroll") for (int _i = 0; _i < 2; ++_i) \
        __builtin_amdgcn_global_load_lds((const unsigned*)((const char*)(gbase) + (voff)[_i]), (PG8_LAS unsigned*)(lds + (bufoff) + ldsw + _i * 8192), 16, 0, 0); } while (0)
#define PG8_LDA(dst, b, h) do { _Pragma("unroll") for (int m = 0; m < 4; ++m) _Pragma("unroll") for (int k = 0; k < 2; ++k) dst[m][k] = *(const PG8_LAS bf16x8*)(lds + PG8_SA(b, h) + aoff + m * 2048 + k * 1024); } while (0)
#define PG8_LDB(dst, b, h) do { _Pragma("unroll") for (int n = 0; n < 2; ++n) _Pragma("unroll") for (int k = 0; k < 2; ++k) dst[n][k] = *(const PG8_LAS bf16x8*)(lds + PG8_SB(b, h) + boff + n * 2048 + k * 1024); } while (0)
#define PG8_MMA(ai, bj, At, Bt) do { __builtin_amdgcn_s_setprio(1); _Pragma("unroll") for (int m = 0; m < 4; ++m) _Pragma("unroll") for (int n = 0; n < 2; ++n) _Pragma("unroll") for (int k = 0; k < 2; ++k) \
        acc[ai][bj][m][n] = __builtin_amdgcn_mfma_f32_16x16x32_bf16(Bt[n][k], At[m][k], acc[ai][bj][m][n], 0, 0, 0); __builtin_amdgcn_s_setprio(0); } while (0)
#define PG8_WAIT_V(n) asm volatile("s_waitcnt vmcnt(" #n ")" ::: "memory")
#define PG8_WAIT_L(n) asm volatile("s_waitcnt lgkmcnt(" #n ")" ::: "memory")
#define PG8_BAR __builtin_amdgcn_s_barrier()
#define PG8_SCHED __builtin_amdgcn_sched_barrier(0)
    Unit cur, nxt; int ui = 0;
    if (!S.next(0, cur)) return;
    f32x4 acc[2][2][4][2];
#pragma unroll
    for (int a = 0; a < 2; ++a)
#pragma unroll
        for (int b = 0; b < 2; ++b)
#pragma unroll
            for (int m = 0; m < 4; ++m)
#pragma unroll
                for (int n = 0; n < 2; ++n) acc[a][b][m][n] = (f32x4){0.f, 0.f, 0.f, 0.f};
    bf16x8 At[4][2], B0[2][2], B1[2][2];
    const char* cA = (const char*)g.A + (size_t)cur.pm * tstep; const char* cB = (const char*)g.Bt + (size_t)cur.pn * tstep;
    S.a_ready(cur);
    if constexpr (SP2) {
        PG8_STAGE(PG8_SB(0, 0), cB, voffB); PG8_STAGE(PG8_SB(0, 1), cB + hstep, voffB); PG8_STAGE(PG8_SA(0, 0), cA, voffA); PG8_STAGE(PG8_SA(0, 1), cA + hstep, voffA);
        if (wr == 1) PG8_BAR;
        PG8_WAIT_V(2); PG8_BAR;
        PG8_STAGE(PG8_SB(1, 0), cB + kstep, voffB); PG8_STAGE(PG8_SA(1, 0), cA + kstep, voffA); PG8_STAGE(PG8_SB(1, 1), cB + hstep + kstep, voffB);
        PG8_WAIT_V(6); PG8_BAR;
    } else {
        PG8_STAGE(PG8_SB(0, 0), cB, voffB); PG8_STAGE(PG8_SA(0, 0), cA, voffA); PG8_STAGE(PG8_SB(0, 1), cB + hstep, voffB); PG8_STAGE(PG8_SA(0, 1), cA + hstep, voffA);
        if (wr == 1) PG8_BAR;
        PG8_WAIT_V(4); PG8_BAR;
        PG8_STAGE(PG8_SB(1, 0), cB + kstep, voffB); PG8_STAGE(PG8_SA(1, 0), cA + kstep, voffA); PG8_STAGE(PG8_SB(1, 1), cB + hstep + kstep, voffB);
        PG8_WAIT_V(6); PG8_BAR;
    }
    for (;;) {
        const bool has_next = S.next(ui + 1, nxt);
        const char* nA = has_next ? (const char*)g.A + (size_t)nxt.pm * tstep : cA; const char* nB = has_next ? (const char*)g.Bt + (size_t)nxt.pn * tstep : cB;
        for (int t = 0; t < nt; t += 2) {
            const bool last = (t == nt - 2);
            const char* a1 = cA + (size_t)(t + 1) * kstep;
            const char* a2 = last ? nA : cA + (size_t)(t + 2) * kstep; const char* b2 = last ? nB : cB + (size_t)(t + 2) * kstep;
            const char* a3 = a2 + kstep; const char* b3 = b2 + kstep;
            if (last && has_next) S.a_ready(nxt);
            if constexpr (SP2) {
            PG8_LDB(B0, 0, 0); PG8_LDB(B1, 0, 1); PG8_SCHED; PG8_LDA(At, 0, 0); PG8_STAGE(PG8_SA(1, 1), a1 + hstep, voffA);
            PG8_WAIT_V(8); PG8_WAIT_L(0); PG8_BAR; PG8_MMA(0, 0, At, B0); PG8_MMA(0, 1, At, B1); PG8_BAR; PG8_SCHED;
            PG8_LDA(At, 0, 1); PG8_STAGE(PG8_SB(0, 0), b2, voffB); PG8_STAGE(PG8_SB(0, 1), b2 + hstep, voffB); PG8_STAGE(PG8_SA(0, 0), a2, voffA);
            PG8_WAIT_V(8); PG8_WAIT_L(0); PG8_BAR; PG8_MMA(1, 0, At, B0); PG8_MMA(1, 1, At, B1); PG8_BAR; PG8_SCHED;
            PG8_LDB(B0, 1, 0); PG8_LDB(B1, 1, 1); PG8_SCHED; PG8_LDA(At, 1, 0); PG8_STAGE(PG8_SA(0, 1), a2 + hstep, voffA);
            PG8_WAIT_V(8); PG8_WAIT_L(0); PG8_BAR; PG8_MMA(0, 0, At, B0); PG8_MMA(0, 1, At, B1); PG8_BAR; PG8_SCHED;
            PG8_LDA(At, 1, 1); PG8_STAGE(PG8_SB(1, 0), b3, voffB); PG8_STAGE(PG8_SB(1, 1), b3 + hstep, voffB); PG8_STAGE(PG8_SA(1, 0), a3, voffA);
            PG8_WAIT_V(8); PG8_WAIT_L(0); PG8_BAR; PG8_MMA(1, 0, At, B0); PG8_MMA(1, 1, At, B1); PG8_BAR; PG8_SCHED;
            } else {
            PG8_LDB(B0, 0, 0); PG8_SCHED; PG8_LDA(At, 0, 0); PG8_STAGE(PG8_SA(1, 1), a1 + hstep, voffA);
            PG8_WAIT_L(8); PG8_BAR; PG8_WAIT_L(0); PG8_MMA(0, 0, At, B0); PG8_BAR; PG8_SCHED;
            PG8_LDB(B1, 0, 1); PG8_STAGE(PG8_SB(0, 0), b2, voffB);
            PG8_BAR; PG8_WAIT_L(0); PG8_MMA(0, 1, At, B1); PG8_BAR;
            PG8_LDA(At, 0, 1); PG8_STAGE(PG8_SA(0, 0), a2, voffA);
            PG8_BAR; PG8_WAIT_L(0); PG8_MMA(1, 0, At, B0); PG8_BAR; PG8_SCHED;
            PG8_STAGE(PG8_SB(0, 1), b2 + hstep, voffB);
            PG8_WAIT_V(6); PG8_BAR; PG8_MMA(1, 1, At, B1); PG8_BAR;
            PG8_LDB(B0, 1, 0); PG8_SCHED; PG8_LDA(At, 1, 0); PG8_STAGE(PG8_SA(0, 1), a2 + hstep, voffA);
            PG8_WAIT_L(8); PG8_BAR; PG8_WAIT_L(0); PG8_MMA(0, 0, At, B0); PG8_BAR; PG8_SCHED;
            PG8_LDB(B1, 1, 1); PG8_STAGE(PG8_SB(1, 0), b3, voffB);
            PG8_BAR; PG8_WAIT_L(0); PG8_MMA(0, 1, At, B1); PG8_BAR;
            PG8_LDA(At, 1, 1); PG8_STAGE(PG8_SA(1, 0), a3, voffA);
            PG8_BAR; PG8_WAIT_L(0); PG8_MMA(1, 0, At, B0); PG8_BAR; PG8_SCHED;
            PG8_STAGE(PG8_SB(1, 1), b3 + hstep, voffB);
            PG8_WAIT_V(6); PG8_BAR; PG8_MMA(1, 1, At, B1); PG8_BAR;
            }
        }
        if constexpr (ALIGN_EPI) { if (wr == 0) PG8_BAR; }
        if constexpr (!Epi::AFTER_DRAIN) { E(acc, cur, wr, wc, fr, fq); S.done(cur); }
        if (!has_next) break;
#pragma unroll
        for (int a = 0; a < 2; ++a)
#pragma unroll
            for (int b = 0; b < 2; ++b)
#pragma unroll
                for (int m = 0; m < 4; ++m)
#pragma unroll
                    for (int n = 0; n < 2; ++n) acc[a][b][m][n] = (f32x4){0.f, 0.f, 0.f, 0.f};
        cur = nxt; cA = nA; cB = nB; ++ui;
        if constexpr (ALIGN_EPI) { if (wr == 1) PG8_BAR; }
    }
    PG8_WAIT_V(0);
    if constexpr (!ALIGN_EPI) { if (wr == 0) PG8_BAR; }
    PG8_BAR;
    if constexpr (Epi::AFTER_DRAIN) { E.fused(acc, cur, wr, wc, fr, fq, lds, wid, lane); S.done(cur); }
#undef PG8_SA
#undef PG8_SB
#undef PG8_STAGE
#undef PG8_LDA
#undef PG8_LDB
#undef PG8_MMA
#undef PG8_WAIT_V
#undef PG8_WAIT_L
#undef PG8_BAR
#undef PG8_SCHED
}
template <class Epi, class Sched, bool ALIGN_EPI = true>
__device__ __forceinline__ void gemm_phase_gather(PG8_LAS unsigned char* lds, const Gemm g, const int* rowidx, const Sched& S, const Epi& E) {
    constexpr bool SP2 = true;
    const int tid = threadIdx.x, wid = __builtin_amdgcn_readfirstlane(tid >> 6), lane = tid & 63, wr = wid >> 2, wc = wid & 3, fr = lane & 15, fq = lane >> 4;
    const int K = g.K, nt = K / BK;
    unsigned voffB[2]; int RA[2], CA[2];
#pragma unroll
    for (int i = 0; i < 2; ++i) { int R, C; stage_rc(tid * 16 + i * 8192, R, C); const int Rb = Epi::PERM ? ((R & ~31) + perm32(R & 31)) : R;
        RA[i] = R; CA[i] = C; voffB[i] = (unsigned)(Rb * K + C) * 2u; }
    unsigned vc[2][2], vn[2][2];
#define PG8_GOFF(dst, pm_) do { _Pragma("unroll") for (int h_ = 0; h_ < 2; ++h_) _Pragma("unroll") for (int i_ = 0; i_ < 2; ++i_) \
        dst[h_][i_] = ((unsigned)rowidx[(pm_) * BM + h_ * HALF + RA[i_]] * (unsigned)K + (unsigned)CA[i_]) * 2u; } while (0)
#define PG8_STAGE_A(bufoff, gbase, v0, v1) do { \
        __builtin_amdgcn_global_load_lds((const unsigned*)((const char*)(gbase) + (v0)), (PG8_LAS unsigned*)(lds + (bufoff) + ldsw), 16, 0, 0); \
        __builtin_amdgcn_global_load_lds((const unsigned*)((const char*)(gbase) + (v1)), (PG8_LAS unsigned*)(lds + (bufoff) + ldsw + 8192), 16, 0, 0); } while (0)
    const size_t kstep = (size_t)(BK * 2);
    const size_t hstep = (size_t)HALF * K * 2;
    const size_t tstep = 2 * hstep;
    const unsigned ldsw = (unsigned)wid * 1024u;
    const int aoff = lds_byte(wr * 64 + fr, fq * 8), boff = lds_byte(wc * 32 + fr, fq * 8);
#define PG8_SA(b, h) (((b) * 2 + (h)) * HTB)
#define PG8_SB(b, h) ((4 + (b) * 2 + (h)) * HTB)
#define PG8_STAGE(bufoff, gbase, voff) do { _Pragma("unroll") for (int _i = 0; _i < 2; ++_i) \
        __builtin_amdgcn_global_load_lds((const unsigned*)((const char*)(gbase) + (voff)[_i]), (PG8_LAS unsigned*)(lds + (bufoff) + ldsw + _i * 8192), 16, 0, 0); } while (0)
#define PG8_LDA(dst, b, h) do { _Pragma("unroll") for (int m = 0; m < 4; ++m) _Pragma("unroll") for (int k = 0; k < 2; ++k) dst[m][k] = *(const PG8_LAS bf16x8*)(lds + PG8_SA(b, h) + aoff + m * 2048 + k * 1024); } while (0)
#define PG8_LDB(dst, b, h) do { _Pragma("unroll") for (int n = 0; n < 2; ++n) _Pragma("unroll") for (int k = 0; k < 2; ++k) dst[n][k] = *(const PG8_LAS bf16x8*)(lds + PG8_SB(b, h) + boff + n * 2048 + k * 1024); } while (0)
#define PG8_MMA(ai, bj, At, Bt) do { __builtin_amdgcn_s_setprio(1); _Pragma("unroll") for (int m = 0; m < 4; ++m) _Pragma("unroll") for (int n = 0; n < 2; ++n) _Pragma("unroll") for (int k = 0; k < 2; ++k) \
        acc[ai][bj][m][n] = __builtin_amdgcn_mfma_f32_16x16x32_bf16(Bt[n][k], At[m][k], acc[ai][bj][m][n], 0, 0, 0); __builtin_amdgcn_s_setprio(0); } while (0)
#define PG8_WAIT_V(n) asm volatile("s_waitcnt vmcnt(" #n ")" ::: "memory")
#define PG8_WAIT_L(n) asm volatile("s_waitcnt lgkmcnt(" #n ")" ::: "memory")
#define PG8_BAR __builtin_amdgcn_s_barrier()
#define PG8_SCHED __builtin_amdgcn_sched_barrier(0)
    Unit cur, nxt; int ui = 0;
    if (!S.next(0, cur)) return;
    f32x4 acc[2][2][4][2];
#pragma unroll
    for (int a = 0; a < 2; ++a)
#pragma unroll
        for (int b = 0; b < 2; ++b)
#pragma unroll
            for (int m = 0; m < 4; ++m)
#pragma unroll
                for (int n = 0; n < 2; ++n) acc[a][b][m][n] = (f32x4){0.f, 0.f, 0.f, 0.f};
    bf16x8 At[4][2], B0[2][2], B1[2][2];
    const char* cA = (const char*)g.A; PG8_GOFF(vc, cur.pm); const char* cB = (const char*)g.Bt + (size_t)cur.pn * tstep;
    S.a_ready(cur);
    if constexpr (SP2) {
        PG8_STAGE(PG8_SB(0, 0), cB, voffB); PG8_STAGE(PG8_SB(0, 1), cB + hstep, voffB); PG8_STAGE_A(PG8_SA(0, 0), cA, vc[0][0], vc[0][1]); PG8_STAGE_A(PG8_SA(0, 1), cA, vc[1][0], vc[1][1]);
        if (wr == 1) PG8_BAR;
        PG8_WAIT_V(2); PG8_BAR;
        PG8_STAGE(PG8_SB(1, 0), cB + kstep, voffB); PG8_STAGE_A(PG8_SA(1, 0), cA + kstep, vc[0][0], vc[0][1]); PG8_STAGE(PG8_SB(1, 1), cB + hstep + kstep, voffB);
        PG8_WAIT_V(6); PG8_BAR;
    }
    for (;;) {
        const bool has_next = S.next(ui + 1, nxt);
        const char* nA = cA; if (has_next) PG8_GOFF(vn, nxt.pm); else { vn[0][0] = vc[0][0]; vn[0][1] = vc[0][1]; vn[1][0] = vc[1][0]; vn[1][1] = vc[1][1]; } const char* nB = has_next ? (const char*)g.Bt + (size_t)nxt.pn * tstep : cB;
        for (int t = 0; t < nt; t += 2) {
            const bool last = (t == nt - 2);
            const char* a1 = cA + (size_t)(t + 1) * kstep;
            const char* a2 = last ? nA : cA + (size_t)(t + 2) * kstep; const char* b2 = last ? nB : cB + (size_t)(t + 2) * kstep;
            const char* a3 = a2 + kstep; const char* b3 = b2 + kstep;
            const unsigned o00 = last ? vn[0][0] : vc[0][0], o01 = last ? vn[0][1] : vc[0][1], o10 = last ? vn[1][0] : vc[1][0], o11 = last ? vn[1][1] : vc[1][1];
            if (last && has_next) S.a_ready(nxt);
            if constexpr (SP2) {
            PG8_LDB(B0, 0, 0); PG8_LDB(B1, 0, 1); PG8_SCHED; PG8_LDA(At, 0, 0); PG8_STAGE_A(PG8_SA(1, 1), a1, vc[1][0], vc[1][1]);
            PG8_WAIT_V(8); PG8_WAIT_L(0); PG8_BAR; PG8_MMA(0, 0, At, B0); PG8_MMA(0, 1, At, B1); PG8_BAR; PG8_SCHED;
            PG8_LDA(At, 0, 1); PG8_STAGE(PG8_SB(0, 0), b2, voffB); PG8_STAGE(PG8_SB(0, 1), b2 + hstep, voffB); PG8_STAGE_A(PG8_SA(0, 0), a2, o00, o01);
            PG8_WAIT_V(8); PG8_WAIT_L(0); PG8_BAR; PG8_MMA(1, 0, At, B0); PG8_MMA(1, 1, At, B1); PG8_BAR; PG8_SCHED;
            PG8_LDB(B0, 1, 0); PG8_LDB(B1, 1, 1); PG8_SCHED; PG8_LDA(At, 1, 0); PG8_STAGE_A(PG8_SA(0, 1), a2, o10, o11);
            PG8_WAIT_V(8); PG8_WAIT_L(0); PG8_BAR; PG8_MMA(0, 0, At, B0); PG8_MMA(0, 1, At, B1); PG8_BAR; PG8_SCHED;
            PG8_LDA(At, 1, 1); PG8_STAGE(PG8_SB(1, 0), b3, voffB); PG8_STAGE(PG8_SB(1, 1), b3 + hstep, voffB); PG8_STAGE_A(PG8_SA(1, 0), a3, o00, o01);
            PG8_WAIT_V(8); PG8_WAIT_L(0); PG8_BAR; PG8_MMA(1, 0, At, B0); PG8_MMA(1, 1, At, B1); PG8_BAR; PG8_SCHED;
            }
        }
        if constexpr (ALIGN_EPI) { if (wr == 0) PG8_BAR; }
        if constexpr (!Epi::AFTER_DRAIN) { E(acc, cur, wr, wc, fr, fq); S.done(cur); }
        if (!has_next) break;
#pragma unroll
        for (int a = 0; a < 2; ++a)
#pragma unroll
            for (int b = 0; b < 2; ++b)
#pragma unroll
                for (int m = 0; m < 4; ++m)
#pragma unroll
                    for (int n = 0; n < 2; ++n) acc[a][b][m][n] = (f32x4){0.f, 0.f, 0.f, 0.f};
        cur = nxt; cA = nA; cB = nB; ++ui; vc[0][0] = vn[0][0]; vc[0][1] = vn[0][1]; vc[1][0] = vn[1][0]; vc[1][1] = vn[1][1];
        if constexpr (ALIGN_EPI) { if (wr == 1) PG8_BAR; }
    }
    PG8_WAIT_V(0);
    if constexpr (!ALIGN_EPI) { if (wr == 0) PG8_BAR; }
    PG8_BAR;
    if constexpr (Epi::AFTER_DRAIN) { E.fused(acc, cur, wr, wc, fr, fq, lds, wid, lane); S.done(cur); }
#undef PG8_GOFF
#undef PG8_STAGE_A
#undef PG8_SA
#undef PG8_SB
#undef PG8_STAGE
#undef PG8_LDA
#undef PG8_LDB
#undef PG8_MMA
#undef PG8_WAIT_V
#undef PG8_WAIT_L
#undef PG8_BAR
#undef PG8_SCHED
}
}

typedef float f32x4 __attribute__((ext_vector_type(4)));
typedef unsigned u32x4 __attribute__((ext_vector_type(4)));
typedef unsigned u32x2 __attribute__((ext_vector_type(2)));
__device__ __forceinline__ unsigned pk2(float lo, float hi) { unsigned r; asm volatile("v_cvt_pk_bf16_f32 %0, %1, %2" : "=v"(r) : "v"(lo), "v"(hi)); return r; }
__device__ __forceinline__ float wave_sum(float v) {
#pragma unroll
    for (int o = 1; o < 64; o <<= 1) v += __shfl_xor(v, o);
    return v;
}
constexpr int F0_SCR = 64 * 65 * 4;
__device__ __forceinline__ void f0_transpose_item(const float* src, int ldw, int c0, int c1, bf16* dst, int K, LAS float* scr, int lane) {
    const float* sp = src + ((lane >> 5) ? c1 : c0) + (lane & 31);
    float v[64];
#pragma unroll
    for (int kk = 0; kk < 64; ++kk) v[kk] = sp[(size_t)kk * ldw];
#pragma unroll
    for (int kk = 0; kk < 64; ++kk) scr[kk * 65 + lane] = v[kk];
    LDS_WAIT(); asm volatile("" ::: "memory");
    const int c = lane & 7;
#pragma unroll
    for (int j = 0; j < 8; ++j) { const int n = (lane >> 3) + 8 * j; const LAS float* s = scr + (8 * c) * 65 + n;
        u32x4 o; o.x = pk2(s[0 * 65], s[1 * 65]); o.y = pk2(s[2 * 65], s[3 * 65]); o.z = pk2(s[4 * 65], s[5 * 65]); o.w = pk2(s[6 * 65], s[7 * 65]);
        *(u32x4*)(dst + (size_t)n * K + 8 * c) = o; }
    LDS_WAIT(); asm volatile("" ::: "memory");
}
template <bool WITH_LR> __device__ __forceinline__ void f0_rows2(const float* x0, const float* g, bf16* o0, const float* w_in, float* glr0, int lane) {
    f32x4 v[2][8]; float ss[2] = {0.f, 0.f};
#pragma unroll
    for (int r = 0; r < 2; ++r)
#pragma unroll
        for (int j = 0; j < 8; ++j) { v[r][j] = ((const f32x4*)(x0 + (size_t)r * D))[lane + 64 * j]; ss[r] += (v[r][j][0] * v[r][j][0] + v[r][j][1] * v[r][j][1]) + (v[r][j][2] * v[r][j][2] + v[r][j][3] * v[r][j][3]); }
    const float rs0 = 1.0f / sqrtf(wave_sum(ss[0]) * (1.0f / D) + EPS), rs1 = 1.0f / sqrtf(wave_sum(ss[1]) * (1.0f / D) + EPS);
    float acc[2][16];
    if (WITH_LR) {
#pragma unroll
        for (int r = 0; r < 2; ++r)
#pragma unroll
            for (int cc = 0; cc < 16; ++cc) acc[r][cc] = 0.f;
    }
#pragma unroll
    for (int j = 0; j < 8; ++j) { const f32x4 gv = ((const f32x4*)g)[lane + 64 * j];
        v[0][j] = v[0][j] * gv * rs0; v[1][j] = v[1][j] * gv * rs1;
        u32x2 w0, w1; w0.x = pk2(v[0][j][0], v[0][j][1]); w0.y = pk2(v[0][j][2], v[0][j][3]); w1.x = pk2(v[1][j][0], v[1][j][1]); w1.y = pk2(v[1][j][2], v[1][j][3]);
        ((u32x2*)o0)[lane + 64 * j] = w0; ((u32x2*)(o0 + D))[lane + 64 * j] = w1;
        if (WITH_LR) {
#pragma unroll
            for (int e = 0; e < 4; ++e) { const float* wp = w_in + (size_t)(4 * (lane + 64 * j) + e) * IN_COLS + O_LR;
                const f32x4 wa = *(const f32x4*)wp, wb = *(const f32x4*)(wp + 4), wc_ = *(const f32x4*)(wp + 8), wd = *(const f32x4*)(wp + 12);
#pragma unroll
                for (int r = 0; r < 2; ++r) { const float xv = v[r][j][e];
#pragma unroll
                    for (int q = 0; q < 4; ++q) { acc[r][q] += xv * wa[q]; acc[r][4 + q] += xv * wb[q]; acc[r][8 + q] += xv * wc_[q]; acc[r][12 + q] += xv * wd[q]; } } }
        }
    }
    if (WITH_LR) {
        float a16[16];
#pragma unroll
        for (int i = 0; i < 16; ++i) { const bool up = (lane & 32) != 0; const float keep = up ? acc[1][i] : acc[0][i], send = up ? acc[0][i] : acc[1][i]; a16[i] = keep + __shfl_xor(send, 32); }
        float a8[8];
#pragma unroll
        for (int i = 0; i < 8; ++i) { const bool up = (lane & 16) != 0; const float keep = up ? a16[8 + i] : a16[i], send = up ? a16[i] : a16[8 + i]; a8[i] = keep + __shfl_xor(send, 16); }
        float a4[4];
#pragma unroll
        for (int i = 0; i < 4; ++i) { const bool up = (lane & 8) != 0; const float keep = up ? a8[4 + i] : a8[i], send = up ? a8[i] : a8[4 + i]; a4[i] = keep + __shfl_xor(send, 8); }
        float a2[2];
#pragma unroll
        for (int i = 0; i < 2; ++i) { const bool up = (lane & 4) != 0; const float keep = up ? a4[2 + i] : a4[i], send = up ? a4[i] : a4[2 + i]; a2[i] = keep + __shfl_xor(send, 4); }
        float a1; { const bool up = (lane & 2) != 0; const float keep = up ? a2[1] : a2[0], send = up ? a2[0] : a2[1]; a1 = keep + __shfl_xor(send, 2); }
        a1 += __shfl_xor(a1, 1);
        if ((lane & 1) == 0) { const int idx = (lane >> 1) & 31; glr0[(size_t)(idx >> 4) * GRK + (idx & 15)] = a1; }
    }
}
struct Ctx;
__device__ __forceinline__ void fast_prologue(const Ctx& c, LAS unsigned char* lds);
#endif

#ifndef HOST_EMU
namespace fa {
typedef short bf16x8 __attribute__((ext_vector_type(8)));
typedef short s16x4 __attribute__((ext_vector_type(4)));
typedef float f32x16 __attribute__((ext_vector_type(16)));
typedef float f32x4 __attribute__((ext_vector_type(4)));
typedef unsigned u32x4 __attribute__((ext_vector_type(4)));
constexpr int TILE_B = 16384;
constexpr int STAGE_B = 4 * TILE_B;
constexpr int XL_OFF = 2 * STAGE_B;
#define FA_SBAR() __builtin_amdgcn_sched_barrier(0)
__device__ __forceinline__ int crow(int r, int hi) { return (r & 3) + 8 * (r >> 2) + 4 * hi; }
__device__ __forceinline__ unsigned cvtpk(float lo, float hi) { unsigned r; asm volatile("v_cvt_pk_bf16_f32 %0, %1, %2" : "=v"(r) : "v"(lo), "v"(hi)); return r; }
__device__ __forceinline__ int v_rd_base(int lane) { return ((lane & 3) << 3) | (((lane >> 2) & 3) << 6) | (((lane >> 4) & 1) << 5) | (((lane >> 5) & 1) << 8); }
constexpr int v_rd_off(int d0, int ks, int half) { return d0 * 512 + ks * 4096 + half * 2048; }
template <int OFF> __device__ __forceinline__ s16x4 tr_read(int vb) { s16x4 r; asm volatile("ds_read_b64_tr_b16 %0, %1 offset:%2" : "=&v"(r) : "v"(vb), "i"(OFF) : "memory"); return r; }

struct DmaOff { unsigned koff0, koff1, voff; };
__device__ __forceinline__ DmaOff dma_offsets(int lane) {
    const int l4 = lane >> 4, c16 = lane & 15, w2 = (lane & 31) >> 2, l5 = lane >> 5; DmaOff o;
    o.koff0 = (unsigned)(l4 * (D / 2) + 8 * (c16 ^ l4)) * 2u; o.koff1 = (unsigned)(l4 * (D / 2) + 8 * (c16 ^ (4 + l4))) * 2u;
    o.voff = (unsigned)(((w2 & 3) + 8 * (w2 >> 2)) * (D / 2) + l5 * 32 + (lane & 3) * 8) * 2u;
    return o;
}
__device__ __forceinline__ void issue_stage(LAS unsigned char* stage, const bf16* DKb, const bf16* DVb, int key_e, int wave, const DmaOff& o) {
    const int tsel = wave >> 2, kv = (wave >> 1) & 1, pb = 8 * (wave & 1), key0 = key_e + 64 * tsel;
    LAS unsigned char* dst = stage + tsel * 2 * TILE_B + kv * TILE_B + 1024 * pb;
    if (kv == 0) {
        const char* base = (const char*)(DKb + (size_t)(key0 + 4 * pb) * (D / 2));
#pragma unroll
        for (int i = 0; i < 8; ++i)
            __builtin_amdgcn_global_load_lds((const unsigned*)(base + (size_t)(4 * i) * (D / 2) * 2 + ((i & 1) ? o.koff1 : o.koff0)), (LAS unsigned*)(dst + 1024 * i), 16, 0, 0);
    } else {
#pragma unroll
        for (int i = 0; i < 8; ++i) { const int p = pb + i, ku = 4 * ((p >> 1) & 1) + 16 * (p >> 2);
            const char* base = (const char*)(DVb + (size_t)(key0 + ku) * (D / 2) + 64 * (p & 1));
            __builtin_amdgcn_global_load_lds((const unsigned*)(base + o.voff), (LAS unsigned*)(dst + 1024 * i), 16, 0, 0); }
    }
}
__device__ __forceinline__ void attn_finish(f32x16 (&o)[4], float l, int wave, float lam, const float* subln_g, bf16* mixw, LAS unsigned char* lds);
template <int KH, bool SHIFT> __device__ __forceinline__ float qk_exp_pack(bf16x8& pa_lo, bf16x8& pa_hi, LAS const unsigned char* Kc  , const bf16x8 (&qr)[4], float negm, int r32, int hi, int sw) {
    f32x16 p;
#pragma unroll
    for (int r = 0; r < 16; ++r) p[r] = 0.f;
#pragma unroll
    for (int d0 = 0; d0 < 4; ++d0) { const int cb = (d0 * 16 + hi * 8) * 2;
        const bf16x8 kf = *(LAS const bf16x8*)(Kc + (32 * KH + r32) * 256 + (cb ^ sw));
        p = __builtin_amdgcn_mfma_f32_32x32x16_bf16(kf, qr[d0], p, 0, 0, 0); }
    float s = 0.f;
#pragma unroll
    for (int r = 0; r < 16; ++r) { p[r] = __builtin_amdgcn_exp2f(SHIFT ? p[r] + negm : p[r]); s += p[r]; }
#define FA_PK4(P, BASE, OUT) do { unsigned a0 = cvtpk(P[BASE + 0], P[BASE + 1]), a1 = cvtpk(P[BASE + 2], P[BASE + 3]); \
    unsigned b0 = cvtpk(P[BASE + 4], P[BASE + 5]), b1 = cvtpk(P[BASE + 6], P[BASE + 7]); \
    auto r0 = __builtin_amdgcn_permlane32_swap(a0, b0, false, false); auto r1 = __builtin_amdgcn_permlane32_swap(a1, b1, false, false); \
    u32x4 w = {r0[0], r1[0], r0[1], r1[1]}; OUT = *reinterpret_cast<bf16x8*>(&w); } while (0)
    FA_PK4(p, 0, pa_lo); FA_PK4(p, 8, pa_hi);
#undef FA_PK4
    return s;
}
template <int D0> __device__ __forceinline__ void pv1(f32x16& oa, int vb, const bf16x8 (&pa)[4]) {
    const s16x4 l0 = tr_read<v_rd_off(D0, 0, 0)>(vb), h0 = tr_read<v_rd_off(D0, 0, 1)>(vb), l1 = tr_read<v_rd_off(D0, 1, 0)>(vb), h1 = tr_read<v_rd_off(D0, 1, 1)>(vb);
    const s16x4 l2 = tr_read<v_rd_off(D0, 2, 0)>(vb), h2 = tr_read<v_rd_off(D0, 2, 1)>(vb), l3 = tr_read<v_rd_off(D0, 3, 0)>(vb), h3 = tr_read<v_rd_off(D0, 3, 1)>(vb);
    asm volatile("s_waitcnt lgkmcnt(0)" ::: "memory"); FA_SBAR();
#define FA_PK(L, H) (bf16x8){L[0], L[1], L[2], L[3], H[0], H[1], H[2], H[3]}
    oa = __builtin_amdgcn_mfma_f32_32x32x16_bf16(pa[0], FA_PK(l0, h0), oa, 0, 0, 0);
    oa = __builtin_amdgcn_mfma_f32_32x32x16_bf16(pa[1], FA_PK(l1, h1), oa, 0, 0, 0);
    oa = __builtin_amdgcn_mfma_f32_32x32x16_bf16(pa[2], FA_PK(l2, h2), oa, 0, 0, 0);
    oa = __builtin_amdgcn_mfma_f32_32x32x16_bf16(pa[3], FA_PK(l3, h3), oa, 0, 0, 0);
#undef FA_PK
}

template <bool SHIFT> __device__ __forceinline__ void attn_unit(int b, int h, int j, const bf16* DQ, const bf16* DK, const bf16* DV, bf16* MIX, const float* subln_g, float lam, float mref, LAS unsigned char* lds) {
    const int tid = threadIdx.x; int lane = tid & 63; asm volatile("" : "+v"(lane));
    const int r32 = lane & 31, hi = lane >> 5; const int wave = __builtin_amdgcn_readfirstlane(tid >> 6);
    const int wq = wave & 3, comp = wave >> 2;
    const size_t rowbase = (size_t)b * SEQ;
    const bf16* DKb = DK + rowbase * (D / 2) + h * 128; const bf16* DVb = DV + rowbase * (D / 2) + h * 128;
    const DmaOff dof = dma_offsets(lane);
    issue_stage(lds, DKb, DVb, 0, wave, dof);
    bf16x8 qr[4];
    { const bf16* Qw = DQ + (rowbase + 128 * j + 32 * wq + r32) * (D / 2) + h * 128 + comp * 64 + hi * 8;
#pragma unroll
      for (int d0 = 0; d0 < 4; ++d0) qr[d0] = *(const bf16x8*)(Qw + d0 * 16); }
    f32x16 o[4];
#pragma unroll
    for (int d = 0; d < 4; ++d)
#pragma unroll
        for (int r = 0; r < 16; ++r) o[d][r] = 0.f;
    float l = 0.f; const float negm = -mref;
    const int last_tile = 2 * j + (wq >> 1);
    const unsigned lds0 = (unsigned)(uintptr_t)lds; const int sw = (r32 & 7) << 4;
    for (int s = 0; s <= j; ++s) {
        asm volatile("s_waitcnt vmcnt(0)" ::: "memory"); __builtin_amdgcn_s_barrier(); asm volatile("" ::: "memory");
        if (s < j) issue_stage(lds + ((s + 1) & 1) * STAGE_B, DKb, DVb, 128 * (s + 1), wave, dof);
#pragma unroll
        for (int ts = 0; ts < 2; ++ts) {
            if (2 * s + ts <= last_tile) {
                LAS const unsigned char* Kc = lds + (s & 1) * STAGE_B + ts * 2 * TILE_B + comp * 128;
                const int vb = (int)(lds0 + (s & 1) * STAGE_B + ts * 2 * TILE_B + TILE_B) + v_rd_base(lane);
                bf16x8 pa[4];
                l += qk_exp_pack<0, SHIFT>(pa[0], pa[1], Kc, qr, negm, r32, hi, sw); FA_SBAR(); l += qk_exp_pack<1, SHIFT>(pa[2], pa[3], Kc, qr, negm, r32, hi, sw); FA_SBAR();
                pv1<0>(o[0], vb, pa); pv1<1>(o[1], vb, pa); pv1<2>(o[2], vb, pa); pv1<3>(o[3], vb, pa);
            }
        }
    }
    asm volatile("s_waitcnt lgkmcnt(0)" ::: "memory"); __builtin_amdgcn_s_barrier(); asm volatile("" ::: "memory");
    attn_finish(o, l, wave, lam, subln_g, MIX + (rowbase + 128 * j + 32 * wq) * D + h * 128, lds);
}
__device__ __forceinline__ void attn_finish(f32x16 (&o)[4], float l, int wave, float lam, const float* subln_g, bf16* mixw, LAS unsigned char* lds) {
    int lane = threadIdx.x & 63; asm volatile("" : "+v"(lane));
    const int r32 = lane & 31, hi = lane >> 5, wq = wave & 3, comp = wave >> 2;
    LAS float* X1 = (LAS float*)lds;
    LAS float* LI = (LAS float*)(lds + XL_OFF) + wave * 32;
    l += __shfl_xor(l, 32);
    if (hi == 0) LI[r32] = (comp ? lam : 1.0f) * __builtin_amdgcn_rcpf(l);
    asm volatile("s_waitcnt lgkmcnt(0)" ::: "memory");
#pragma unroll
    for (int r = 0; r < 16; ++r) { const float inv = LI[crow(r, hi)];
#pragma unroll
        for (int d = 0; d < 4; ++d) o[d][r] *= inv; }
    if (comp == 1) {
#pragma unroll
        for (int d = 0; d < 4; ++d)
#pragma unroll
            for (int r = 0; r < 16; ++r) X1[((wq * 4 + d) * 16 + r) * 64 + lane] = o[d][r];
    }
    asm volatile("s_waitcnt lgkmcnt(0)" ::: "memory"); __builtin_amdgcn_s_barrier(); asm volatile("" ::: "memory");
    if (comp == 0) {
#pragma unroll
        for (int d = 0; d < 4; ++d)
#pragma unroll
            for (int r = 0; r < 16; ++r) { o[d][r] -= X1[((wq * 4 + d) * 16 + r) * 64 + lane]; if ((r & 3) == 3) { asm volatile("s_waitcnt lgkmcnt(0)" ::: "memory"); FA_SBAR(); } }
    }
    asm volatile("s_waitcnt lgkmcnt(0)" ::: "memory"); __builtin_amdgcn_s_barrier(); asm volatile("" ::: "memory");
    if (comp == 0) {
        LAS float* W = (LAS float*)(lds + wq * (32 * 132 * 4));
#pragma unroll
        for (int r = 0; r < 16; ++r) { const int q = crow(r, hi);
#pragma unroll
            for (int d = 0; d < 4; ++d) W[q * 132 + 32 * d + r32] = o[d][r]; }
        asm volatile("s_waitcnt lgkmcnt(0)" ::: "memory");
        const int q = lane >> 1, hf = lane & 1;
        f32x4 v[16]; float ss = 0.f;
#pragma unroll
        for (int i = 0; i < 16; ++i) { v[i] = *(LAS const f32x4*)(W + q * 132 + hf * 64 + 4 * i); ss += (v[i][0] * v[i][0] + v[i][1] * v[i][1]) + (v[i][2] * v[i][2] + v[i][3] * v[i][3]); }
        ss += __shfl_xor(ss, 1);
        const float rs = 0.8f / sqrtf(ss * (1.0f / 128.0f) + EPS);
        bf16* op = mixw + (size_t)q * D + hf * 64;
#pragma unroll
        for (int i = 0; i < 8; ++i) { const f32x4 ga = *(const f32x4*)(subln_g + hf * 64 + 8 * i), gb = *(const f32x4*)(subln_g + hf * 64 + 8 * i + 4);
            const f32x4 a = v[2 * i] * ga * rs, c = v[2 * i + 1] * gb * rs;
            u32x4 w; w.x = cvtpk(a[0], a[1]); w.y = cvtpk(a[2], a[3]); w.z = cvtpk(c[0], c[1]); w.w = cvtpk(c[2], c[3]);
            *(u32x4*)(op + 8 * i) = w; }
    }
    asm volatile("s_waitcnt lgkmcnt(0)" ::: "memory"); __builtin_amdgcn_s_barrier(); asm volatile("" ::: "memory");
}
#undef FA_SBAR
}
#endif

#ifndef HOST_EMU
namespace fg {
typedef short bf16x8 __attribute__((ext_vector_type(8)));
typedef short s16x4 __attribute__((ext_vector_type(4)));
typedef float f32x16 __attribute__((ext_vector_type(16)));
typedef float f32x4 __attribute__((ext_vector_type(4)));
typedef unsigned u32x2 __attribute__((ext_vector_type(2)));
constexpr int IMG = 16384, STAGE_B = 4 * IMG;
constexpr int DEC_OFF = 2 * STAGE_B;
constexpr int SS_OFF = DEC_OFF + 1024;
#define FG_SBAR() __builtin_amdgcn_sched_barrier(0)
__device__ __forceinline__ unsigned cvtpk(float lo, float hi) { unsigned r; asm volatile("v_cvt_pk_bf16_f32 %0, %1, %2" : "=v"(r) : "v"(lo), "v"(hi)); return r; }
__device__ __forceinline__ int v_rd_base(int lane) { return ((lane & 3) << 3) | (((lane >> 2) & 3) << 6) | (((lane >> 4) & 1) << 5) | (((lane >> 5) & 1) << 8); }
constexpr int v_rd_off(int d0, int ks, int half) { return d0 * 512 + ks * 4096 + half * 2048; }
template <int OFF> __device__ __forceinline__ s16x4 tr_read(int vb) { s16x4 r; asm volatile("ds_read_b64_tr_b16 %0, %1 offset:%2" : "=&v"(r) : "v"(vb), "i"(OFF) : "memory"); return r; }
#define FG_PK(L, H) (bf16x8){L[0], L[1], L[2], L[3], H[0], H[1], H[2], H[3]}

__device__ __forceinline__ void issue_chunk(LAS unsigned char* stage, LAS unsigned char* decl, const bf16* GQb, const bf16* KDb, const bf16* GVb, const float* DECc, int wave, int lane) {
    const int img = wave >> 1, pb = 8 * (wave & 1);
    LAS unsigned char* dst = stage + img * IMG + 1024 * pb;
    if (img == 0) {
#pragma unroll
        for (int i = 0; i < 8; ++i) { const int row = 4 * (pb + i) + (lane >> 4), ch = (lane & 15) ^ (row & 15);
            __builtin_amdgcn_global_load_lds((const unsigned*)(GQb + (size_t)row * (D / 4) + 8 * ch), (LAS unsigned*)(dst + 1024 * i), 16, 0, 0); }
    } else {
        const int w2 = (lane & 31) >> 2, kl = (w2 & 3) + 8 * (w2 >> 2), cl = (lane >> 5) * 32 + (lane & 3) * 8;
        const bf16* base = img == 1 ? KDb : GVb + (img - 2) * 128; const int pitch = img == 1 ? D / 4 : D / 2;
#pragma unroll
        for (int i = 0; i < 8; ++i) { const int p = pb + i, k = kl + 4 * ((p >> 1) & 1) + 16 * (p >> 2), cidx = cl + 64 * (p & 1);
            __builtin_amdgcn_global_load_lds((const unsigned*)(base + (size_t)k * pitch + cidx), (LAS unsigned*)(dst + 1024 * i), 16, 0, 0); }
    }
    if (wave == 0 && lane < 32) __builtin_amdgcn_global_load_lds((const unsigned*)(DECc + 4 * lane), (LAS unsigned*)decl, 16, 0, 0);
}

__device__ __forceinline__ void gla_seq(int b, int h, const bf16* GQ, const bf16* KD, const bf16* GV, const bf16* GRb, const float* DEC, const float* gout, bf16* MIX, LAS unsigned char* lds) {
    const int tid = threadIdx.x; int lane = tid & 63; asm volatile("" : "+v"(lane));
    const int r32 = lane & 31, hi = lane >> 5; const int wave = __builtin_amdgcn_readfirstlane(tid >> 6);
    const size_t t00 = (size_t)b * SEQ;
    const bf16* GQb = GQ + t00 * (D / 4) + h * 128; const bf16* KDb = KD + t00 * (D / 4) + h * 128; const bf16* GVb = GV + t00 * (D / 2) + h * 256;
    const float* DECb = DEC + (size_t)(b * NC) * (D / 4) + h * 128;
    const bf16* GRw = GRb + t00 * (D / 2) + h * 256 + 32 * wave + 4 * hi; bf16* MIXw = MIX + t00 * D + D / 2 + h * 256 + 32 * wave + 4 * hi;
    f32x4 gq[4];
#pragma unroll
    for (int g = 0; g < 4; ++g) gq[g] = *(const f32x4*)(gout + 32 * wave + 8 * g + 4 * hi);
    f32x16 S[4];
#pragma unroll
    for (int mb = 0; mb < 4; ++mb)
#pragma unroll
        for (int r = 0; r < 16; ++r) S[mb][r] = 0.f;
    const unsigned lds0 = (unsigned)(uintptr_t)lds;
    LAS float* SS = (LAS float*)(lds + SS_OFF);
    issue_chunk(lds, lds + DEC_OFF, GQb, KDb, GVb, DECb, wave, lane);
    for (int c = 0; c < NC; ++c) {
        asm volatile("s_waitcnt vmcnt(0)" ::: "memory"); __builtin_amdgcn_s_barrier(); asm volatile("" ::: "memory");
        u32x2 grv[2][4];
#pragma unroll
        for (int tb = 0; tb < 2; ++tb)
#pragma unroll
            for (int g = 0; g < 4; ++g) grv[tb][g] = *(const u32x2*)(GRw + (size_t)(64 * c + 32 * tb + r32) * (D / 2) + 8 * g);
        if (c + 1 < NC) issue_chunk(lds + ((c + 1) & 1) * STAGE_B, lds + DEC_OFF + ((c + 1) & 1) * 512, GQb + (size_t)(64 * (c + 1)) * (D / 4), KDb + (size_t)(64 * (c + 1)) * (D / 4),
                                    GVb + (size_t)(64 * (c + 1)) * (D / 2), DECb + (size_t)(c + 1) * (D / 4), wave, lane);
        LAS const unsigned char* st = lds + (c & 1) * STAGE_B;
        { LAS const float* dl = (LAS const float*)(lds + DEC_OFF + (c & 1) * 512) + 4 * hi;
#pragma unroll
          for (int mb = 0; mb < 4; ++mb)
#pragma unroll
              for (int g = 0; g < 4; ++g) { const f32x4 d4 = *(LAS const f32x4*)(dl + 32 * mb + 8 * g);
#pragma unroll
                  for (int e = 0; e < 4; ++e) S[mb][4 * g + e] *= d4[e]; } }
        { const int kb = (int)(lds0 + (c & 1) * STAGE_B + IMG) + v_rd_base(lane), vbse = (int)(lds0 + (c & 1) * STAGE_B + 2 * IMG + (wave >> 2) * IMG + (wave & 3) * 512) + v_rd_base(lane);
#define FG_KS(KS) do { const s16x4 vl = tr_read<v_rd_off(0, KS, 0)>(vbse), vh = tr_read<v_rd_off(0, KS, 1)>(vbse); \
            const s16x4 a0l = tr_read<v_rd_off(0, KS, 0)>(kb), a0h = tr_read<v_rd_off(0, KS, 1)>(kb), a1l = tr_read<v_rd_off(1, KS, 0)>(kb), a1h = tr_read<v_rd_off(1, KS, 1)>(kb); \
            const s16x4 a2l = tr_read<v_rd_off(2, KS, 0)>(kb), a2h = tr_read<v_rd_off(2, KS, 1)>(kb), a3l = tr_read<v_rd_off(3, KS, 0)>(kb), a3h = tr_read<v_rd_off(3, KS, 1)>(kb); \
            asm volatile("s_waitcnt lgkmcnt(0)" ::: "memory"); FG_SBAR(); const bf16x8 vf = FG_PK(vl, vh); \
            S[0] = __builtin_amdgcn_mfma_f32_32x32x16_bf16(FG_PK(a0l, a0h), vf, S[0], 0, 0, 0); S[1] = __builtin_amdgcn_mfma_f32_32x32x16_bf16(FG_PK(a1l, a1h), vf, S[1], 0, 0, 0); \
            S[2] = __builtin_amdgcn_mfma_f32_32x32x16_bf16(FG_PK(a2l, a2h), vf, S[2], 0, 0, 0); S[3] = __builtin_amdgcn_mfma_f32_32x32x16_bf16(FG_PK(a3l, a3h), vf, S[3], 0, 0, 0); } while (0)
          FG_KS(0); FG_KS(1); FG_KS(2); FG_KS(3);
#undef FG_KS
        }
        f32x16 ot[2];
#pragma unroll
        for (int tb = 0; tb < 2; ++tb)
#pragma unroll
            for (int r = 0; r < 16; ++r) ot[tb][r] = 0.f;
#pragma unroll
        for (int mb = 0; mb < 4; ++mb)
#pragma unroll
            for (int s = 0; s < 2; ++s) {
                typedef unsigned u32x4v __attribute__((ext_vector_type(4)));
                u32x4v w; w.x = cvtpk(S[mb][8 * s + 0], S[mb][8 * s + 1]); w.y = cvtpk(S[mb][8 * s + 2], S[mb][8 * s + 3]); w.z = cvtpk(S[mb][8 * s + 4], S[mb][8 * s + 5]); w.w = cvtpk(S[mb][8 * s + 6], S[mb][8 * s + 7]);
                const bf16x8 sa = *reinterpret_cast<bf16x8*>(&w);
                const int ch = 4 * mb + 2 * s;
#pragma unroll
                for (int tb = 0; tb < 2; ++tb) { const int row = 32 * tb + r32;
                    const u32x2 q0 = *(LAS const u32x2*)(st + row * 256 + ((ch ^ (row & 15)) << 4) + 8 * hi), q1 = *(LAS const u32x2*)(st + row * 256 + (((ch + 1) ^ (row & 15)) << 4) + 8 * hi);
                    u32x4v qw; qw.x = q0.x; qw.y = q0.y; qw.z = q1.x; qw.w = q1.y;
                    ot[tb] = __builtin_amdgcn_mfma_f32_32x32x16_bf16(sa, *reinterpret_cast<bf16x8*>(&qw), ot[tb], 0, 0, 0); } }
        float ssq[2];
#pragma unroll
        for (int tb = 0; tb < 2; ++tb) { float a = 0.f;
#pragma unroll
            for (int r = 0; r < 16; ++r) a += ot[tb][r] * ot[tb][r];
            a += __shfl_xor(a, 32); ssq[tb] = a; }
        if (hi == 0) { SS[wave * 64 + r32] = ssq[0]; SS[wave * 64 + 32 + r32] = ssq[1]; }
        asm volatile("s_waitcnt lgkmcnt(0)" ::: "memory"); __builtin_amdgcn_s_barrier(); asm volatile("" ::: "memory");
#pragma unroll
        for (int tb = 0; tb < 2; ++tb) { float a = 0.f;
#pragma unroll
            for (int w8 = 0; w8 < 8; ++w8) a += SS[w8 * 64 + 32 * tb + r32];
            const float rs = 1.0f / sqrtf(a * (1.0f / 256.0f) + EPS);
            bf16* op = MIXw + (size_t)(64 * c + 32 * tb + r32) * D;
#pragma unroll
            for (int g = 0; g < 4; ++g) { float v[4];
#pragma unroll
                for (int e = 0; e < 4; ++e) { const unsigned gw = e < 2 ? grv[tb][g].x : grv[tb][g].y; const float gr = __uint_as_float((e & 1) ? (gw & 0xffff0000u) : (gw << 16));
                    v[e] = ot[tb][4 * g + e] * rs * gq[g][e] * (gr * __builtin_amdgcn_rcpf(1.0f + __expf(-gr))); }
                u32x2 o2; o2.x = cvtpk(v[0], v[1]); o2.y = cvtpk(v[2], v[3]); *(u32x2*)(op + 8 * g) = o2; } }
    }
    asm volatile("s_waitcnt vmcnt(0) lgkmcnt(0)" ::: "memory"); __builtin_amdgcn_s_barrier(); asm volatile("" ::: "memory");
}
#undef FG_PK
#undef FG_SBAR
}
#endif

struct Ctx {
    const float *x, *mem; const int* positions; const float *g_attn, *w_in, *q_norm_g, *k_norm_g, *lq1, *lk1, *lq2, *lk2, *subln_g, *w_a2, *b_a, *gla_out_g, *w_out, *g_cross, *g_mem, *w_cq, *w_ckv, *cq_g, *ck_g, *w_co,
        *g_ffn, *w_rg, *b_rg, *w_re, *b_re, *w_gate, *w_up, *w_down;
    float* out; char* ws;
};
#define WSP(T_, off) ((T_*)(c.ws + (off)))
#ifndef HOST_EMU
__device__ __forceinline__ void f0_wrt(const Ctx& c, bf16* WRT);
__device__ __forceinline__ void fast_prologue(const Ctx& c, LAS unsigned char* lds) {
    const int tid = threadIdx.x, lane = tid & 63, wave = __builtin_amdgcn_readfirstlane(tid >> 6);
    const int gw = blockIdx.x * 8 + wave, NGW = gridDim.x * 8;
    LAS float* scr = (LAS float*)(lds + wave * F0_SCR);
    int* ctl = WSP(int, WS_CTL); float* lamp = (float*)(ctl + 16);
    bf16 *WIN = WSP(bf16, WS_WIN), *WOUT = WSP(bf16, WS_WOUT), *WCQ = WSP(bf16, WS_WCQ), *WCKV = WSP(bf16, WS_WCKV), *WCO = WSP(bf16, WS_WCO);
    bf16 *WGU = WSP(bf16, WS_WGU), *WD = WSP(bf16, WS_WD), *XN = WSP(bf16, WS_XN), *MEMN = WSP(bf16, WS_MEMN);
    float* GLR = WSP(float, WS_SMALL + SM_GLR); int* SLOTTOK = WSP(int, WS_SMALL + SM_SLOTTOK); float* SLOTGATE = WSP(float, WS_SMALL + SM_SLOTGATE); float* ROPE = WSP(float, WS_SMALL + SM_ROPE);
    for (int it = gw; it < T / 2; it += NGW) f0_rows2<true>(c.x + (size_t)it * 2 * D, c.g_attn, XN + (size_t)it * 2 * D, c.w_in, GLR + (size_t)it * 2 * GRK, lane);
    for (int it = gw; it < B * NMEM / 2; it += NGW) f0_rows2<false>(c.mem + (size_t)it * 2 * D, c.g_mem, MEMN + (size_t)it * 2 * D, nullptr, nullptr, lane);
    constexpr int KB = D / 64, KBD = DE / 64;
    constexpr int I_WIN = (NIN / 64) * KB, I_SQ = (D / 64) * KB, I_CKV = (2 * D / 64) * KB, I_GU = NE * (2 * DE / 64) * KB, I_DN = NE * (D / 64) * KBD;
    constexpr int NITEMS = I_WIN + 3 * I_SQ + I_CKV + I_GU + I_DN;
    for (int it = gw; it < NITEMS; it += NGW) {
        int r = it;
        if (r < I_WIN) { const int kb = r % KB, n0 = (r / KB) * 64; f0_transpose_item(c.w_in + (size_t)kb * 64 * IN_COLS, IN_COLS, win_src_col(n0), win_src_col(n0 + 32), WIN + (size_t)n0 * D + kb * 64, D, scr, lane); continue; } r -= I_WIN;
        if (r < I_SQ) { const int kb = r % KB, n0 = (r / KB) * 64; f0_transpose_item(c.w_out + (size_t)kb * 64 * D, D, n0, n0 + 32, WOUT + (size_t)n0 * D + kb * 64, D, scr, lane); continue; } r -= I_SQ;
        if (r < I_SQ) { const int kb = r % KB, n0 = (r / KB) * 64; f0_transpose_item(c.w_cq + (size_t)kb * 64 * D, D, n0, n0 + 32, WCQ + (size_t)n0 * D + kb * 64, D, scr, lane); continue; } r -= I_SQ;
        if (r < I_SQ) { const int kb = r % KB, n0 = (r / KB) * 64; f0_transpose_item(c.w_co + (size_t)kb * 64 * D, D, n0, n0 + 32, WCO + (size_t)n0 * D + kb * 64, D, scr, lane); continue; } r -= I_SQ;
        if (r < I_CKV) { const int kb = r % KB, n0 = (r / KB) * 64; f0_transpose_item(c.w_ckv + (size_t)kb * 64 * 2 * D, 2 * D, n0, n0 + 32, WCKV + (size_t)n0 * D + kb * 64, D, scr, lane); continue; } r -= I_CKV;
        if (r < I_GU) { const int kb = r % KB, r0 = ((r / KB) % (2 * DE / 64)) * 64, e = r / (KB * (2 * DE / 64)); const int pn = r0 / 256, ii = r0 % 256; const float* W = (ii < 128) ? c.w_gate : c.w_up; const int col = pn * 128 + (ii & 127);
            f0_transpose_item(W + ((size_t)e * D + kb * 64) * DE, DE, col, col + 32, WGU + ((size_t)e * 2 * DE + r0) * D + kb * 64, D, scr, lane); continue; } r -= I_GU;
        { const int kb = r % KBD, n0 = ((r / KBD) % (D / 64)) * 64, e = r / (KBD * (D / 64));
          f0_transpose_item(c.w_down + ((size_t)e * DE + kb * 64) * D, D, n0, n0 + 32, WD + ((size_t)e * D + n0) * DE + kb * 64, DE, scr, lane); }
    }
    nk_rope_table(c.positions, ROPE); nk_lam(c.lq1, c.lk1, c.lq2, c.lk2, lamp); nk_mref(c.q_norm_g, c.k_norm_g, lamp + 1);
    nk_zero_bf16(XN + (size_t)T * D, (size_t)D); nk_moe_init_slots(SLOTTOK, SLOTGATE); f0_wrt(c, WSP(bf16, WS_SMALL + SM_WRT));
}
#endif
#ifndef HOST_EMU
__device__ __forceinline__ void f0_wrt(const Ctx& c, bf16* WRT) {
    for (size_t i = gtid(); i < (size_t)48 * D; i += gnth()) { const int k = (int)(i % D), j = (int)(i / D);
        const float w = j < NG ? c.w_rg[(size_t)k * NG + j] : (j < NG + NE ? c.w_re[(size_t)k * NE + (j - NG)] : 0.f); WRT[i] = f2bf(w); }
}
__device__ __forceinline__ void fast_router(const Ctx& c, LAS unsigned char* lds) {
    typedef short bf16x8 __attribute__((ext_vector_type(8)));
    const int tid = threadIdx.x, lane = tid & 63, wave = __builtin_amdgcn_readfirstlane(tid >> 6), r = lane & 15, kq = lane >> 4;
    LAS float* red = (LAS float*)lds;
    LAS float* lg = (LAS float*)(lds + 8 * 32 * 48 * 4);
    const bf16* XN = WSP(bf16, WS_XN); const bf16* WRT = WSP(bf16, WS_SMALL + SM_WRT); const float* SSP2 = WSP(float, WS_SMALL + SM_SSP2);
    int* ctl = WSP(int, WS_CTL); int* EXPERT = WSP(int, WS_SMALL + SM_EXPERT); float* GATE = WSP(float, WS_SMALL + SM_GATE); int* SLOTPOS = WSP(int, WS_SMALL + SM_SLOTPOS);
    for (int ub = blockIdx.x; ub < T / 32; ub += gridDim.x) {
        const int row0 = ub * 32, k0 = wave * 256;
        f32x4 acc[2][3];
#pragma unroll
        for (int mb = 0; mb < 2; ++mb)
#pragma unroll
            for (int nb = 0; nb < 3; ++nb) acc[mb][nb] = (f32x4){0.f, 0.f, 0.f, 0.f};
#pragma unroll
        for (int st = 0; st < 8; ++st) { bf16x8 a[2], b[3];
#pragma unroll
            for (int mb = 0; mb < 2; ++mb) a[mb] = *(const bf16x8*)(XN + (size_t)(row0 + 16 * mb + r) * D + k0 + 32 * st + 8 * kq);
#pragma unroll
            for (int nb = 0; nb < 3; ++nb) b[nb] = *(const bf16x8*)(WRT + (size_t)(16 * nb + r) * D + k0 + 32 * st + 8 * kq);
#pragma unroll
            for (int mb = 0; mb < 2; ++mb)
#pragma unroll
                for (int nb = 0; nb < 3; ++nb) acc[mb][nb] = __builtin_amdgcn_mfma_f32_16x16x32_bf16(a[mb], b[nb], acc[mb][nb], 0, 0, 0); }
#pragma unroll
        for (int mb = 0; mb < 2; ++mb)
#pragma unroll
            for (int nb = 0; nb < 3; ++nb)
#pragma unroll
                for (int q = 0; q < 4; ++q) red[(wave * 32 + 16 * mb + 4 * kq + q) * 48 + 16 * nb + r] = acc[mb][nb][q];
        __syncthreads();
        { const int row = tid >> 4, q = tid & 15;
          float ps = SSP2[(size_t)(row0 + row) * 32 + 2 * q] + SSP2[(size_t)(row0 + row) * 32 + 2 * q + 1];
          ps += __shfl_xor(ps, 1); ps += __shfl_xor(ps, 2); ps += __shfl_xor(ps, 4); ps += __shfl_xor(ps, 8);
          const float rs = 1.0f / sqrtf(ps * (1.0f / D) + EPS);
#pragma unroll
          for (int j = 0; j < 3; ++j) { const int col = q + 16 * j; float sacc = 0.f;
#pragma unroll
              for (int w = 0; w < 8; ++w) sacc += red[(w * 32 + row) * 48 + col];
              const float bias = col < NG ? c.b_rg[col] : (col < NG + NE ? c.b_re[col - NG] : 0.f);
              lg[row * 48 + col] = sacc * rs + bias; } }
        __syncthreads();
        if (tid < 32) { const int t = row0 + tid; const LAS float* L = lg + tid * 48;
            float gl[NG], el[NE];
#pragma unroll
            for (int j = 0; j < NG; ++j) gl[j] = L[j];
#pragma unroll
            for (int j = 0; j < NE; ++j) el[j] = L[NG + j];
            int grp = 0; float gm = gl[0];
#pragma unroll
            for (int j = 1; j < NG; ++j) if (gl[j] > gm) { gm = gl[j]; grp = j; }
            float gs = 0.f;
#pragma unroll
            for (int j = 0; j < NG; ++j) gs += __expf(gl[j] - gm);
            const float grp_w = 1.0f / gs;
            float e8[EPG];
#pragma unroll
            for (int j = 0; j < EPG; ++j) { float v = 0.f;
#pragma unroll
                for (int gq = 0; gq < NG; ++gq) v = (grp == gq) ? el[gq * EPG + j] : v;
                e8[j] = v; }
            int i0 = 0; float v0 = e8[0];
#pragma unroll
            for (int j = 1; j < EPG; ++j) if (e8[j] > v0) { v0 = e8[j]; i0 = j; }
            int i1 = -1; float v1 = -1e30f;
#pragma unroll
            for (int j = 0; j < EPG; ++j) if (j != i0 && e8[j] > v1) { v1 = e8[j]; i1 = j; }
            const float rr = __expf(v1 - v0); const float g0 = grp_w / (1.f + rr), g1 = grp_w * rr / (1.f + rr);
            const int e0 = grp * EPG + i0, e1 = grp * EPG + i1;
            EXPERT[t * 2] = e0; EXPERT[t * 2 + 1] = e1; GATE[t * 2] = g0; GATE[t * 2 + 1] = g1;
            SLOTPOS[t * 2] = atomicAdd(&ctl[CW_CNT + e0], 1); SLOTPOS[t * 2 + 1] = atomicAdd(&ctl[CW_CNT + e1], 1); }
        __syncthreads();
    }
}
#endif
#ifdef HOST_EMU
#define FAST_P0 0
#define FAST_P1 0
#define FAST_P6 0
#define FAST_P13 0
#define FAST_MOE 0
#define FAST_ATT 0
#define FAST_GLA 0
typedef unsigned char* LdsPtr;
#else
#ifndef FAST_P0
#define FAST_P0 1
#endif
#ifndef FAST_P1
#define FAST_P1 1
#endif
#ifndef FAST_P6
#define FAST_P6 1
#endif
#ifndef FAST_P13
#define FAST_P13 1
#endif
#ifndef FAST_ATT
#define FAST_ATT 1
#endif
#ifndef FAST_GLA
#define FAST_GLA 1
#endif
#ifndef FAST_MOE
#define FAST_MOE 1
#endif
typedef LAS unsigned char* LdsPtr;
#endif
constexpr int N_PHASES = 18;
template <int P> __device__ __forceinline__ void run_phase(const Ctx& c, LdsPtr lds) {
    int* ctl = WSP(int, WS_CTL); float* lamp = (float*)(ctl + 16);
    bf16 *WIN = WSP(bf16, WS_WIN), *WOUT = WSP(bf16, WS_WOUT), *WCQ = WSP(bf16, WS_WCQ), *WCKV = WSP(bf16, WS_WCKV), *WCO = WSP(bf16, WS_WCO);
    bf16 *WGU = WSP(bf16, WS_WGU), *WD = WSP(bf16, WS_WD), *XN = WSP(bf16, WS_XN), *MEMN = WSP(bf16, WS_MEMN);
    float* SSP1 = WSP(float, WS_SMALL + SM_SSP1); float* SSP2 = WSP(float, WS_SMALL + SM_SSP2); (void)SSP1; (void)SSP2;
    float* GLR = WSP(float, WS_SMALL + SM_GLR); float* CQSS = WSP(float, WS_SMALL + SM_CQSS); int* EXPERT = WSP(int, WS_SMALL + SM_EXPERT); float* GATE = WSP(float, WS_SMALL + SM_GATE);
    int* SLOTPOS = WSP(int, WS_SMALL + SM_SLOTPOS); int* SLOTTOK = WSP(int, WS_SMALL + SM_SLOTTOK); float* SLOTGATE = WSP(float, WS_SMALL + SM_SLOTGATE); float* ROPE = WSP(float, WS_SMALL + SM_ROPE);
    bf16 *CKV = WSP(bf16, WS_SMALL + SM_CKV), *CK2 = WSP(bf16, WS_SMALL + SM_CK2), *CVT = WSP(bf16, WS_SMALL + SM_CVT); float* STATS = WSP(float, WS_SMALL + SM_STATS);
    char* rb = c.ws + WS_B;
    bf16 *DQ = (bf16*)(rb + B_DQ), *DK = (bf16*)(rb + B_DK), *DV = (bf16*)(rb + B_DV), *GQ = (bf16*)(rb + B_GQ), *GK = (bf16*)(rb + B_GK), *GV = (bf16*)(rb + B_GV), *GRb = (bf16*)(rb + B_GR);
    bf16 *CQ = (bf16*)(rb + B_CQ), *CO = (bf16*)(rb + B_CO), *HE = (bf16*)(rb + B_HE);
    bf16* MIX = WSP(bf16, WS_C);
    float* TMPQK = WSP(float, WS_C);
    float* PTMP = WSP(float, WS_C);
    float* CUM = WSP(float, WS_D);
    float* OTMPD = WSP(float, WS_D + al256((size_t)T * D));
    float* OTMPG = WSP(float, WS_D + al256((size_t)T * D) * 3);
    float* out = c.out; (void)lds; (void)TMPQK; (void)WIN;
    if constexpr (P == 0) {
#if FAST_P0
        fast_prologue(c, lds);
#else
        nk_conv_win(c.w_in, WIN);
        nk_convT(c.w_out, D, 0, WOUT, D, D); nk_convT(c.w_cq, D, 0, WCQ, D, D); nk_convT(c.w_ckv, 2 * D, 0, WCKV, 2 * D, D); nk_convT(c.w_co, D, 0, WCO, D, D);
        nk_conv_gu(c.w_gate, c.w_up, WGU); nk_conv_d(c.w_down, WD);
        nk_rope_table(c.positions, ROPE); nk_lam(c.lq1, c.lk1, c.lq2, c.lk2, lamp);
        nk_zero_bf16(XN + (size_t)T * D, (size_t)D); nk_moe_init_slots(SLOTTOK, SLOTGATE);
        nk_rmsnorm_rows(c.x, c.g_attn, XN, T, D); nk_rmsnorm_rows(c.mem, c.g_mem, MEMN, B * NMEM, D);
        nk_glr(c.x, c.g_attn, c.w_in, GLR);
#endif
    } else if constexpr (P == 1) {
#if FAST_P1
        pg8::Gemm g{XN, WIN, T, NIN, D}; pg8::StaticOrder S; S.init(T, NIN, (int)gridDim.x, (int)blockIdx.x);
        pg8::EpiInProj E{rb, ROPE, c.q_norm_g, c.k_norm_g};
        pg8::gemm_phase<pg8::EpiInProj, pg8::StaticOrder, true, true>(lds, g, S, E);
#else
        { GemmP p{XN, WIN, T, NIN, D, 0, TMPQK, nullptr, (bf16*)rb, nullptr}; nk_gemm<0>(p); }
#endif
    } else if constexpr (P == 2) {
#if !FAST_P1
        nk_qk_post(TMPQK, c.q_norm_g, c.k_norm_g, ROPE, DQ, DK);
#endif
        { GemmP p{MEMN, WCKV, B * NMEM, 2 * D, D, 0, nullptr, nullptr, CKV, nullptr}; nk_gemm<2>(p); }
    } else if constexpr (P == 3) {
        nk_ckv_fix(CKV, c.cq_g, c.ck_g, CK2, CVT);
#if FAST_GLA
        nk_gla_prep(GLR, c.w_a2, c.b_a, GK, (bf16*)CUM, WSP(float, WS_SMALL + SM_DEC));
#else
        nk_gla_cum(GLR, c.w_a2, c.b_a, CUM);
#endif
#if !FAST_ATT
        nk_diff_stats(DQ, DK, STATS);
#endif
    } else if constexpr (P == 4) {
#if FAST_ATT
        { const float lam = lamp[0], mref = lamp[1];
#if FAST_GLA
          LAS int* qslot = (LAS int*)(lds + 143360);
          for (;;) {
              if (threadIdx.x == 0) *qslot = atomicAdd(&ctl[CW_QUEUE], 1);
              __syncthreads(); const int item = *qslot; __syncthreads();
              if (item >= 8 + 512) break;
              if (item < 8) fg::gla_seq(item >> 2, item & 3, GQ, (const bf16*)CUM, GV, GRb, WSP(float, WS_SMALL + SM_DEC), c.gla_out_g, MIX, lds);
              else { const int u = item - 8, jq = 31 - (u >> 4), bh = u & 15;
                  if (mref <= 24.0f) fa::attn_unit<false>(bh >> 3, bh & 7, jq, DQ, DK, DV, MIX, c.subln_g, lam, mref, lds);
                  else fa::attn_unit<true>(bh >> 3, bh & 7, jq, DQ, DK, DV, MIX, c.subln_g, lam, mref, lds); } }
#else
          const int G = (int)gridDim.x;
          for (int pi = (int)blockIdx.x; pi < 256; pi += G) { const int vcu = (pi & 7) * 32 + (pi >> 3), bh = vcu >> 4, pr = vcu & 15;
              for (int k2 = 0; k2 < 2; ++k2) { const int jq = k2 ? pr : 31 - pr;
                  if (mref <= 24.0f) fa::attn_unit<false>(bh >> 3, bh & 7, jq, DQ, DK, DV, MIX, c.subln_g, lam, mref, lds);
                  else fa::attn_unit<true>(bh >> 3, bh & 7, jq, DQ, DK, DV, MIX, c.subln_g, lam, mref, lds); } }
#endif
        }
#else
        nk_diff_pv(DQ, DK, DV, STATS, lamp, OTMPD);
#endif
#if !FAST_GLA
        nk_gla_run(GQ, GK, GV, CUM, OTMPG);
#endif
    } else if constexpr (P == 5) {
#if !FAST_ATT
        nk_diff_norm(OTMPD, c.subln_g, MIX);
#endif
#if !FAST_GLA
        nk_gla_norm(OTMPG, c.gla_out_g, GRb, MIX);
#endif
    } else if constexpr (P == 6) {
#if FAST_P6
        pg8::Gemm g{MIX, WOUT, T, D, D}; pg8::StaticOrder S; S.init(T, D, (int)gridDim.x, (int)blockIdx.x);
        pg8::EpiResid E{c.x, out, XN, c.g_cross, SSP1};
        pg8::gemm_phase<pg8::EpiResid, pg8::StaticOrder, true, true>(lds, g, S, E);
#else
        GemmP p{MIX, WOUT, T, D, D, 0, out, nullptr, nullptr, c.x}; nk_gemm<1>(p);
#endif
    } else if constexpr (P == 7) {
#if !FAST_P6
        nk_rmsnorm_rows(out, c.g_cross, XN, T, D);
#endif
    } else if constexpr (P == 8) {
#if FAST_P6
        pg8::Gemm g{XN, WCQ, T, D, D}; pg8::StaticOrder S; S.init(T, D, (int)gridDim.x, (int)blockIdx.x);
        pg8::EpiCq E{SSP1, CQ, CQSS};
        pg8::gemm_phase<pg8::EpiCq, pg8::StaticOrder, true, true>(lds, g, S, E);
#else
        GemmP p{XN, WCQ, T, D, D, 0, nullptr, nullptr, CQ, nullptr}; nk_gemm<2>(p);
#endif
    } else if constexpr (P == 9) {
#if !FAST_P6
        nk_cqss(CQ, CQSS);
#endif
    } else if constexpr (P == 10) {
        nk_cross_scores(CQ, CQSS, CK2, PTMP);
    } else if constexpr (P == 11) {
        nk_cross_softmax(PTMP);
    } else if constexpr (P == 12) {
        nk_cross_pv(PTMP, CVT, CO);
    } else if constexpr (P == 13) {
#if FAST_P13
        pg8::Gemm g{CO, WCO, T, D, D}; pg8::StaticOrder S; S.init(T, D, (int)gridDim.x, (int)blockIdx.x);
        pg8::EpiResid E{out, out, XN, c.g_ffn, SSP2};
        pg8::gemm_phase<pg8::EpiResid, pg8::StaticOrder, true, true>(lds, g, S, E);
#else
        GemmP p{CO, WCO, T, D, D, 0, out, nullptr, nullptr, nullptr}; nk_gemm<4>(p);
#endif
    } else if constexpr (P == 14) {
#if FAST_MOE
        fast_router(c, lds);
#else
        nk_router(out, c.g_ffn, c.w_rg, c.b_rg, c.w_re, c.b_re, XN, EXPERT, GATE, SLOTPOS, ctl);
#endif
    } else if constexpr (P == 15) {
        nk_moe_offsets(ctl);
    } else if constexpr (P == 16) {
        nk_moe_fill(EXPERT, GATE, SLOTPOS, ctl, SLOTTOK, SLOTGATE);
    } else if constexpr (P == 17) {
#if FAST_MOE
        pg8::Gemm g{XN, WGU, PMAX, NE * 2 * DE, D}; pg8::MoeOrder S{ctl, 4, (int)gridDim.x, (int)blockIdx.x};
        pg8::EpiGU E{SLOTTOK, SSP2, HE};
        pg8::gemm_phase_gather<pg8::EpiGU, pg8::MoeOrder, true>(lds, g, SLOTTOK, S, E);
#else
        nk_moe_gu(XN, WGU, SLOTTOK, ctl, HE);
#endif
    }
}
template <int P> __device__ __forceinline__ void run_phase_last(const Ctx& c, LdsPtr lds) {
    int* ctl = WSP(int, WS_CTL); bf16* WD = WSP(bf16, WS_WD); int* SLOTTOK = WSP(int, WS_SMALL + SM_SLOTTOK); float* SLOTGATE = WSP(float, WS_SMALL + SM_SLOTGATE); bf16* HE = (bf16*)(c.ws + WS_B + B_HE); (void)lds;
#if FAST_MOE
    pg8::Gemm g{HE, WD, PMAX, NE * D, DE}; pg8::MoeOrder S{ctl, 8, (int)gridDim.x, (int)blockIdx.x};
    pg8::EpiDown E{SLOTTOK, SLOTGATE, c.out};
    pg8::gemm_phase<pg8::EpiDown, pg8::MoeOrder, true, true>(lds, g, S, E);
#else
    nk_moe_down(HE, WD, SLOTTOK, SLOTGATE, ctl, c.out);
#endif
}

#ifndef HOST_EMU
#define XB_TMO      128
#define XB_XCNT(j)  (256  + 64 * (j))
#define XB_XSUB(j)  (1280 + 64 * (j))
#define XB_XGEN(j)  (2304 + 64 * (j))
#define XB_TOP      3328
#define XB_TOPGEN   3392
#define XCD_BAR_WORDS 3456
#define XB_SPIN_CAP (1u << 20)

__device__ __forceinline__ unsigned xb_ld(unsigned* p)              { return __hip_atomic_load(p, __ATOMIC_RELAXED, __HIP_MEMORY_SCOPE_AGENT); }
__device__ __forceinline__ unsigned xb_add(unsigned* p, unsigned v) { return __hip_atomic_fetch_add(p, v, __ATOMIC_RELAXED, __HIP_MEMORY_SCOPE_AGENT); }
__device__ __forceinline__ unsigned xb_xcc_id() { return (unsigned)__builtin_amdgcn_s_getreg((3 << 11) | 20) & 0xFu; }
#define XB_SPIN(cond, bar) do { unsigned _sp = 0; while (cond) { __builtin_amdgcn_s_sleep(1); \
    if ((++_sp & 255u) == 0u) { if (xb_ld(&(bar)[XB_TMO])) break; if (_sp > XB_SPIN_CAP) { atomicAdd(&(bar)[XB_TMO], 1u); break; } } } } while (0)

struct XcdBarrier {
    unsigned* bar; unsigned x;
    volatile LAS unsigned* st;
};
__device__ __forceinline__ XcdBarrier xcd_barrier_post(unsigned* bar, volatile LAS unsigned* st) {
    XcdBarrier b; b.bar = bar; b.x = xb_xcc_id(); b.st = st;
    if (threadIdx.x == 0) (void)xb_add(&bar[XB_XCNT(b.x)], 1u);
    return b;
}
__device__ __forceinline__ void xcd_barrier_complete(unsigned* bar, unsigned x, unsigned& nloc, unsigned& nx) {
    const unsigned G = gridDim.x * gridDim.y * gridDim.z;
    unsigned sum, cnt, mine, sp = 0u;
    for (;;) {
        sum = 0u; cnt = 0u; mine = 0u;
#pragma unroll
        for (unsigned j = 0; j < 16; ++j) { const unsigned c = xb_ld(&bar[XB_XCNT(j)]); sum += c; cnt += (c > 0u) ? 1u : 0u; mine = (j == x) ? c : mine; }
        if (sum == G) break;
        __builtin_amdgcn_s_sleep(1);
        if ((++sp & 255u) == 0u) { if (xb_ld(&bar[XB_TMO])) break; if (sp > XB_SPIN_CAP) { atomicAdd(&bar[XB_TMO], 1u); break; } }
    }
    nloc = mine > 0u ? mine : 1u; nx = cnt > 0u ? cnt : 1u;
}
__device__ __forceinline__ void xcd_barrier(const XcdBarrier& b) {
    asm volatile("s_waitcnt vmcnt(0)" ::: "memory");
    __syncthreads();
    if (threadIdx.x == 0) {
        unsigned* bar = b.bar;
        __builtin_amdgcn_s_waitcnt(0);
        unsigned nloc = b.st[0], nx = b.st[1];
        if (nloc == 0u) { xcd_barrier_complete(bar, b.x, nloc, nx); b.st[0] = nloc; b.st[1] = nx; }
        const unsigned old = xb_add(&bar[XB_XSUB(b.x)], 1u);
        const unsigned gen = old / nloc;
        if (old + 1u == (gen + 1u) * nloc) {
            __builtin_amdgcn_fence(__ATOMIC_RELEASE, "agent");
            asm volatile("s_waitcnt vmcnt(0)" ::: "memory");
            const unsigned og = xb_add(&bar[XB_TOP], 1u);
            const unsigned tg = og / nx;
            if (og + 1u == (tg + 1u) * nx) xb_add(&bar[XB_TOPGEN], 1u);
            else XB_SPIN(xb_ld(&bar[XB_TOPGEN]) == tg, bar);
            __builtin_amdgcn_fence(__ATOMIC_ACQUIRE, "agent");
            xb_add(&bar[XB_XGEN(b.x)], 1u);
            asm volatile("s_waitcnt vmcnt(0)" ::: "memory");
        } else {
            XB_SPIN(xb_ld(&bar[XB_XGEN(b.x)]) == gen, bar);
            __builtin_amdgcn_fence(__ATOMIC_ACQUIRE, "agent");
            asm volatile("s_waitcnt vmcnt(0)" ::: "memory");
        }
    }
    __syncthreads();
}

constexpr int NTHREADS = 512;
constexpr int LDS_BYTES = 147456;
constexpr int LDSCTL_OFF = 143360, MISC_OFF = LDSCTL_OFF + 64;
__global__ void __launch_bounds__(NTHREADS, 2) fwd_kernel(Ctx c) {
    extern __shared__ __attribute__((aligned(16))) unsigned char lds[];
    LAS unsigned char* l3 = (LAS unsigned char*)lds;
    volatile LAS unsigned* MISC = (volatile LAS unsigned*)(l3 + MISC_OFF);
    for (int u = threadIdx.x; u < (LDS_BYTES - LDSCTL_OFF) / 4; u += NTHREADS) ((LAS unsigned*)(l3 + LDSCTL_OFF))[u] = 0u;
    __syncthreads();
    XcdBarrier bar = xcd_barrier_post((unsigned*)(c.ws + WS_CTL) + CW_BAR, MISC + 8);
#define PH(k) run_phase<k>(c, l3); xcd_barrier(bar);
    PH(0) PH(1) PH(2) PH(3) PH(4) PH(5) PH(6) PH(7) PH(8) PH(9) PH(10) PH(11) PH(12) PH(13) PH(14) PH(15) PH(16) PH(17)
    run_phase_last<0>(c, l3);
#undef PH
}
#endif

#ifdef HOST_EMU
template <int P> static void emu_phase(const Ctx& c) { const size_t nth = 4096; emu_nth = nth; for (size_t t = 0; t < nth; ++t) { emu_tid = t; run_phase<P>(c, nullptr); } }
template <int... Ps> static void emu_all(const Ctx& c, std::integer_sequence<int, Ps...>) { (emu_phase<Ps>(c), ...); }
#endif

extern "C" void kernel_launch(void* const* d_in, const int* in_sizes, int n_in, void* d_out, int out_size, void* d_ws, size_t ws_size, hipStream_t stream) {
    if (n_in != 31 || out_size != T * D || ws_size < WS_END) { fprintf(stderr, "kernel_launch: unexpected shapes (n_in %d out %d ws %zu need %zu)\n", n_in, out_size, ws_size, (size_t)WS_END); return; }
    (void)in_sizes;
    Ctx c{};
    const float** fp = (const float**)&c.x;
    c.x = (const float*)d_in[0]; c.mem = (const float*)d_in[1]; c.positions = (const int*)d_in[2];
    c.g_attn = (const float*)d_in[3]; c.w_in = (const float*)d_in[4]; c.q_norm_g = (const float*)d_in[5]; c.k_norm_g = (const float*)d_in[6];
    c.lq1 = (const float*)d_in[7]; c.lk1 = (const float*)d_in[8]; c.lq2 = (const float*)d_in[9]; c.lk2 = (const float*)d_in[10];
    c.subln_g = (const float*)d_in[11]; c.w_a2 = (const float*)d_in[12]; c.b_a = (const float*)d_in[13]; c.gla_out_g = (const float*)d_in[14];
    c.w_out = (const float*)d_in[15]; c.g_cross = (const float*)d_in[16]; c.g_mem = (const float*)d_in[17]; c.w_cq = (const float*)d_in[18];
    c.w_ckv = (const float*)d_in[19]; c.cq_g = (const float*)d_in[20]; c.ck_g = (const float*)d_in[21]; c.w_co = (const float*)d_in[22];
    c.g_ffn = (const float*)d_in[23]; c.w_rg = (const float*)d_in[24]; c.b_rg = (const float*)d_in[25]; c.w_re = (const float*)d_in[26];
    c.b_re = (const float*)d_in[27]; c.w_gate = (const float*)d_in[28]; c.w_up = (const float*)d_in[29]; c.w_down = (const float*)d_in[30];
    c.out = (float*)d_out; c.ws = (char*)d_ws; (void)fp;
#ifdef HOST_EMU
    memset(c.ws + WS_CTL, 0, CTL_BYTES);
    emu_all(c, std::make_integer_sequence<int, N_PHASES>{});
    { const size_t nth = 4096; emu_nth = nth; for (size_t t = 0; t < nth; ++t) { emu_tid = t; run_phase_last<0>(c, nullptr); } }
#else
    static int grid = 0;
    if (grid == 0) {
        int dev = 0, cus = 0, per_cu = 0;
        if (hipGetDevice(&dev) != hipSuccess || hipDeviceGetAttribute(&cus, hipDeviceAttributeMultiprocessorCount, dev) != hipSuccess) { fprintf(stderr, "kernel_launch: device query failed\n"); grid = -1; return; }
        if (hipFuncSetAttribute((const void*)fwd_kernel, hipFuncAttributeMaxDynamicSharedMemorySize, LDS_BYTES) != hipSuccess) { fprintf(stderr, "kernel_launch: hipFuncSetAttribute failed\n"); grid = -1; return; }
        if (hipOccupancyMaxActiveBlocksPerMultiprocessor(&per_cu, (const void*)fwd_kernel, NTHREADS, LDS_BYTES) != hipSuccess || per_cu < 1) { fprintf(stderr, "kernel_launch: occupancy query says %d blocks per CU\n", per_cu); }
        (void)hipGetLastError();
        grid = cus;
    }
    if (grid < 0) return;
    (void)hipMemsetAsync(c.ws + WS_CTL, 0, CTL_BYTES, stream);
    hipLaunchKernelGGL(fwd_kernel, dim3(grid), dim3(NTHREADS), LDS_BYTES, stream, c);
#endif
}
```

```cpp
#ifndef HOST_EMU
#include <hip/hip_runtime.h>
#else
#include <cstring>
struct EmuD3 { unsigned x, y, z; };
static EmuD3 blockIdx, threadIdx, blockDim, gridDim;
static size_t emu_tid, emu_nth;
#define __global__ static
#define __device__ static
#define __host__
#define __forceinline__ inline
#define __launch_bounds__(...)
typedef int hipStream_t;
static inline int atomicAdd(int* p, int v) { int o = *p; *p += v; return o; }
static inline float atomicAdd(float* p, float v) { float o = *p; *p += v; return o; }
#endif
#include <cstdint>
#include <cstdio>
#include <cmath>

#ifndef CFG_D
#define CFG_D 2048
#define CFG_SEQ 4096
#define CFG_NMEM 256
#define CFG_ETILE 256
#endif
namespace cfg {
constexpr int D = CFG_D, B = 2, SEQ = CFG_SEQ, T = B * SEQ, CHUNK = 64, NC = SEQ / CHUNK;
constexpr int DH = 8, DVD = D / 16, DQK = D / 32;
constexpr int GH = 4, GVD = D / 8, GKD = D / 16, GRK = 16;
constexpr int NMEM = CFG_NMEM, CH = 4, CHD = D / 4;
constexpr int NE = 32, EPG = 8, NG = 4, DE = D / 4;
constexpr int ETILE = CFG_ETILE, PMAX = 2 * T + NE * ETILE, NTILE = PMAX / ETILE;
constexpr int NIN = 3 * D;
constexpr int IN_COLS = 3 * D + GRK;
constexpr int O_DQ = 0, O_DK = D / 2, O_DV = D, O_GQ = 3 * D / 2, O_GK = 7 * D / 4, O_GV = 2 * D, O_LR = 5 * D / 2, O_GR = 5 * D / 2 + GRK;
constexpr float EPS = 1e-6f;
constexpr float LOG2E = 1.4426950408889634f;
}
using namespace cfg;
typedef unsigned short bf16;

constexpr size_t al256(size_t x) { return (x + 255) & ~(size_t)255; }
constexpr size_t WS_CTL = 0, CTL_BYTES = 1u << 20;
constexpr size_t WS_WIN = WS_CTL + CTL_BYTES;
constexpr size_t WS_WLR = WS_WIN + al256((size_t)NIN * D * 2);
constexpr size_t WS_WOUT = WS_WLR + al256((size_t)GRK * D * 2);
constexpr size_t WS_WCQ = WS_WOUT + al256((size_t)D * D * 2);
constexpr size_t WS_WCKV = WS_WCQ + al256((size_t)D * D * 2);
constexpr size_t WS_WCO = WS_WCKV + al256((size_t)2 * D * D * 2);
constexpr size_t WS_WGU = WS_WCO + al256((size_t)D * D * 2);
constexpr size_t WS_WD = WS_WGU + al256((size_t)NE * 2 * DE * D * 2);
constexpr size_t WS_XN = WS_WD + al256((size_t)NE * D * DE * 2);
constexpr size_t WS_MEMN = WS_XN + al256((size_t)(T + 1) * D * 2);
constexpr size_t WS_SMALL = WS_MEMN + al256((size_t)B * NMEM * D * 2);
constexpr size_t SM_GLR = 0;
constexpr size_t SM_CQSS = SM_GLR + al256((size_t)T * GRK * 4);
constexpr size_t SM_SSP1 = SM_CQSS + al256((size_t)T * 32 * 4);
constexpr size_t SM_SSP2 = SM_SSP1 + al256((size_t)T * 32 * 4);
constexpr size_t SM_EXPERT = SM_SSP2 + al256((size_t)T * 32 * 4);
constexpr size_t SM_GATE = SM_EXPERT + al256((size_t)T * 2 * 4);
constexpr size_t SM_SLOTPOS = SM_GATE + al256((size_t)T * 2 * 4);
constexpr size_t SM_SLOTTOK = SM_SLOTPOS + al256((size_t)T * 2 * 4);
constexpr size_t SM_SLOTGATE = SM_SLOTTOK + al256((size_t)PMAX * 4);
constexpr size_t SM_ROPE = SM_SLOTGATE + al256((size_t)PMAX * 4);
constexpr size_t SM_CKV = SM_ROPE + al256((size_t)T * DQK * 4);
constexpr size_t SM_CK2 = SM_CKV + al256((size_t)B * NMEM * 2 * D * 2);
constexpr size_t SM_CVT = SM_CK2 + al256((size_t)B * NMEM * D * 2);
constexpr size_t SM_WRT = SM_CVT + al256((size_t)B * NMEM * D * 2);
constexpr size_t SM_DEC = SM_WRT + al256((size_t)48 * D * 2);
constexpr size_t SM_STATS = SM_DEC + al256((size_t)B * NC * GH * GKD * 4);
constexpr size_t SM_END = SM_STATS + al256((size_t)T * DH * 4 * 4);
constexpr size_t WS_B = WS_SMALL + al256(SM_END);
constexpr size_t B_DQ = 0, B_DK = B_DQ + (size_t)T * (D / 2) * 2, B_DV = B_DK + (size_t)T * (D / 2) * 2;
constexpr size_t B_GQ = B_DV + (size_t)T * (D / 2) * 2, B_GK = B_GQ + (size_t)T * (D / 4) * 2, B_GV = B_GK + (size_t)T * (D / 4) * 2, B_GR = B_GV + (size_t)T * (D / 2) * 2;
constexpr size_t B_END1 = B_GR + (size_t)T * (D / 2) * 2;
constexpr size_t B_CQ = 0, B_CO = B_CQ + (size_t)T * D * 2, B_HE = B_CO + (size_t)T * D * 2, B_END2 = B_HE + (size_t)PMAX * DE * 2;
constexpr size_t B_BYTES = al256(B_END1 > B_END2 ? B_END1 : B_END2);
constexpr size_t WS_C = WS_B + B_BYTES;
constexpr size_t WS_D = WS_C + al256((size_t)T * D * 2);
constexpr size_t WS_END = WS_D + al256((size_t)T * D * 5);

constexpr int CW_CNT = 64;
constexpr int CW_BASE = 128;
constexpr int CW_TILE_E = 256;
constexpr int CW_NTILES = 512;
constexpr int CW_BAR = 4096;
constexpr int CW_QUEUE = 1024;

__device__ __forceinline__ bf16 f2bf(float f) { unsigned u; memcpy(&u, &f, 4); u = (u + 0x7fffu + ((u >> 16) & 1u)) >> 16; return (bf16)u; }
__device__ __forceinline__ float bf2f(bf16 b) { unsigned u = ((unsigned)b) << 16; float f; memcpy(&f, &u, 4); return f; }
__device__ __forceinline__ float silu_f(float x) { return x / (1.f + expf(-x)); }
#ifdef HOST_EMU
static inline size_t gtid() { return emu_tid; }
static inline size_t gnth() { return emu_nth; }
#else
__device__ __forceinline__ size_t gtid() { return (size_t)blockIdx.x * blockDim.x + threadIdx.x; }
__device__ __forceinline__ size_t gnth() { return (size_t)gridDim.x * blockDim.x; }
#endif
struct bf16x8s { bf16 v[8]; };
__host__ __device__ __forceinline__ int win_logical(int np) {
    if (np >= D) return np; const int t = np & ~255, p = np & 255; return t + 64 * ((p & 127) >> 5) + 32 * (p >> 7) + (p & 31);
}
__host__ __device__ __forceinline__ int win_src_col(int np) { const int l = win_logical(np); return l < O_LR ? l : l + GRK; }

__device__ __forceinline__ void nk_rmsnorm_rows(const float* x, const float* g, bf16* out, int rows, int d) {
    for (size_t r = gtid(); r < (size_t)(rows); r += gnth()) {
    const float* xr = x + r * d; float ss = 0.f;
    for (int i = 0; i < d; ++i) ss += xr[i] * xr[i];
    const float rs = 1.0f / sqrtf(ss / d + EPS);
    for (int i = 0; i < d; ++i) out[r * d + i] = f2bf(xr[i] * rs * g[i]);
}}
__device__ __forceinline__ void nk_glr(const float* x, const float* g, const float* w_in, float* GLR) {
    for (size_t i = gtid(); i < (size_t)T * GRK; i += gnth()) { const int cc = (int)(i % GRK), t = (int)(i / GRK); const float* xr = x + (size_t)t * D; float ss = 0.f;
        for (int k = 0; k < D; ++k) ss += xr[k] * xr[k]; const float rs = 1.0f / sqrtf(ss / D + EPS); float a = 0.f;
        for (int k = 0; k < D; ++k) a += xr[k] * rs * g[k] * w_in[(size_t)k * IN_COLS + O_LR + cc]; GLR[i] = a; }
}
__device__ __forceinline__ void nk_zero_bf16(bf16* p, size_t n) { for (size_t i = gtid(); i < n; i += gnth()) p[i] = 0; }
__device__ __forceinline__ void nk_convT(const float* W, int ldw, int col0, bf16* WT, int N, int K) {
    for (size_t i = gtid(); i < (size_t)(N * K); i += gnth()) {
    const int n = (int)(i / K), k = (int)(i % K);
    WT[i] = f2bf(W[(size_t)k * ldw + col0 + n]);
}}
__device__ __forceinline__ void nk_conv_win(const float* W, bf16* WT) {
    for (size_t i = gtid(); i < (size_t)NIN * D; i += gnth()) { const int n = (int)(i / D), k = (int)(i % D); WT[i] = f2bf(W[(size_t)k * IN_COLS + win_src_col(n)]); }
}
constexpr int GUH = (DE >= 128) ? 128 : DE;
__device__ __forceinline__ void nk_conv_gu(const float* Wg, const float* Wu, bf16* WGU) {
    for (size_t i = gtid(); i < (size_t)(NE * 2 * DE * D); i += gnth()) {
    const int k = (int)(i % D); const int r = (int)((i / D) % (2 * DE)); const int e = (int)(i / ((size_t)D * 2 * DE));
    const int pn = r / (2 * GUH), ii = r % (2 * GUH); const int j = pn * GUH + (ii % GUH);
    const float* W = (ii < GUH) ? Wg : Wu;
    WGU[i] = f2bf(W[((size_t)e * D + k) * DE + j]);
}}
__device__ __forceinline__ void nk_conv_d(const float* Wd, bf16* WD) {
    for (size_t i = gtid(); i < (size_t)(NE * D * DE); i += gnth()) {
    const int j = (int)(i % DE); const int n = (int)((i / DE) % D); const int e = (int)(i / ((size_t)D * DE));
    WD[i] = f2bf(Wd[((size_t)e * DE + j) * D + n]);
}}
__device__ __forceinline__ void nk_rope_table(const int* positions, float* tab) {
    constexpr int half = DQK / 2; for (size_t i = gtid(); i < (size_t)(T * half); i += gnth()) {
    const int t = (int)(i / half), j = (int)(i % half);
    const float freq = powf(10000.0f, -(float)j / (float)half);
    const float ang = (float)positions[t] * freq;
    tab[i * 2] = cosf(ang); tab[i * 2 + 1] = sinf(ang);
}}

struct GemmP { const bf16* A; const bf16* Bt; int M, N, K, pad; float* f0; float* f1; bf16* b0; const float* x; };
template <int MODE> __device__ __forceinline__ void gemm_epi(const GemmP& p, int m, int n, float acc) {
    if constexpr (MODE == 0) {
        bf16* Bb = p.b0; n = win_logical(n);
        if (n < D) { p.f0[(size_t)m * D + n] = acc; return; }
        if (n < O_GQ) { ((bf16*)((char*)Bb + B_DV))[(size_t)m * (D / 2) + (n - O_DV)] = f2bf(acc); return; }
        if (n < O_GK) { ((bf16*)((char*)Bb + B_GQ))[(size_t)m * (D / 4) + (n - O_GQ)] = f2bf(acc * (1.0f / sqrtf((float)GKD))); return; }
        if (n < O_GV) { ((bf16*)((char*)Bb + B_GK))[(size_t)m * (D / 4) + (n - O_GK)] = f2bf(acc); return; }
        if (n < O_LR) { ((bf16*)((char*)Bb + B_GV))[(size_t)m * (D / 2) + (n - O_GV)] = f2bf(acc); return; }
        ((bf16*)((char*)Bb + B_GR))[(size_t)m * (D / 2) + (n - O_LR)] = f2bf(acc);
    } else if constexpr (MODE == 1) { p.f0[(size_t)m * p.N + n] = p.x[(size_t)m * p.N + n] + acc;
    } else if constexpr (MODE == 2) { p.b0[(size_t)m * p.N + n] = f2bf(acc);
    } else if constexpr (MODE == 4) { p.f0[(size_t)m * p.N + n] += acc;
    } else { p.f0[(size_t)m * p.N + n] = acc; }
}
template <int MODE> __device__ __forceinline__ void nk_gemm(GemmP p) {
    const int nb = p.N / 4; for (size_t idx = gtid(); idx < (size_t)(p.M / 4) * nb; idx += gnth()) {
    const int m0 = 4 * (int)(idx / nb), n0 = 4 * (int)(idx % nb);
    float acc[4][4];
#pragma unroll
    for (int i = 0; i < 4; ++i)
#pragma unroll
        for (int j = 0; j < 4; ++j) acc[i][j] = 0.f;
    for (int k = 0; k < p.K; k += 8) {
        bf16x8s a[4], b[4];
#pragma unroll
        for (int i = 0; i < 4; ++i) { a[i] = *(const bf16x8s*)(p.A + (size_t)(m0 + i) * p.K + k); b[i] = *(const bf16x8s*)(p.Bt + (size_t)(n0 + i) * p.K + k); }
#pragma unroll
        for (int kk = 0; kk < 8; ++kk) {
            float af[4], bfv[4];
#pragma unroll
            for (int i = 0; i < 4; ++i) { af[i] = bf2f(a[i].v[kk]); bfv[i] = bf2f(b[i].v[kk]); }
#pragma unroll
            for (int i = 0; i < 4; ++i)
#pragma unroll
                for (int j = 0; j < 4; ++j) acc[i][j] += af[i] * bfv[j];
        }
    }
#pragma unroll
    for (int i = 0; i < 4; ++i)
#pragma unroll
        for (int j = 0; j < 4; ++j) gemm_epi<MODE>(p, m0 + i, n0 + j, acc[i][j]);
}}

__device__ __forceinline__ void nk_qk_post(const float* tmpqk, const float* qg, const float* kg, const float* rope, bf16* DQ, bf16* DK) {
    for (size_t i = gtid(); i < (size_t)(T * 2 * DH * 2); i += gnth()) {
    const int c = (int)(i % 2), h = (int)((i / 2) % DH), which = (int)((i / (2 * DH)) % 2), t = (int)(i / (4 * DH));
    const float* src = tmpqk + (size_t)t * D + which * (D / 2) + h * 2 * DQK + c * DQK;
    const float* g = which ? kg : qg; bf16* dst = (which ? DK : DQ) + (size_t)t * (D / 2) + h * 2 * DQK + c * DQK;
    float ss = 0.f; for (int d = 0; d < DQK; ++d) ss += src[d] * src[d];
    const float rs = 1.0f / sqrtf(ss / DQK + EPS); constexpr int half = DQK / 2;
    const float sc = which ? 1.0f : (1.0f / sqrtf((float)DQK)) * LOG2E;
    for (int d = 0; d < half; ++d) {
        const float t1 = src[d] * rs * g[d], t2 = src[d + half] * rs * g[d + half];
        const float cs = rope[((size_t)t * half + d) * 2], sn = rope[((size_t)t * half + d) * 2 + 1];
        dst[d] = f2bf((t1 * cs - t2 * sn) * sc); dst[d + half] = f2bf((t2 * cs + t1 * sn) * sc);
    }
}}
__device__ __forceinline__ void nk_lam(const float* q1, const float* k1, const float* q2, const float* k2, float* out) {
    if (gtid() != 0) return; float a = 0.f, b = 0.f; for (int i = 0; i < DQK; ++i) { a += q1[i] * k1[i]; b += q2[i] * k2[i]; }
    out[0] = expf(a) - expf(b) + 0.2f;
}
__device__ __forceinline__ void nk_mref(const float* qg, const float* kg, float* out) {
    if (gtid() != 0) return; float mq = 0.f, mk = 0.f; for (int i = 0; i < DQK; ++i) { mq = fmaxf(mq, fabsf(qg[i])); mk = fmaxf(mk, fabsf(kg[i])); }
    out[0] = (float)DQK * mq * mk * (1.0f / sqrtf((float)DQK)) * LOG2E * 1.02f;
}
__device__ __forceinline__ void nk_diff_stats(const bf16* DQ, const bf16* DK, float* stats) {
    for (size_t i = gtid(); i < (size_t)(T * DH * 2); i += gnth()) {
    const int c = (int)(i % 2), h = (int)((i / 2) % DH), t = (int)(i / (2 * DH)); const int b = t / SEQ, s = t % SEQ;
    const int nk = (s / CHUNK + 1) * CHUNK;
    float q[DQK]; const bf16* qp = DQ + (size_t)t * (D / 2) + h * 2 * DQK + c * DQK;
#pragma unroll
    for (int d = 0; d < DQK; ++d) q[d] = bf2f(qp[d]);
    float mx = -1e30f;
    for (int k = 0; k < nk; ++k) { const bf16* kp = DK + (size_t)(b * SEQ + k) * (D / 2) + h * 2 * DQK + c * DQK; float sdot = 0.f;
#pragma unroll
        for (int d = 0; d < DQK; ++d) sdot += q[d] * bf2f(kp[d]);
        mx = fmaxf(mx, sdot); }
    float sum = 0.f;
    for (int k = 0; k < nk; ++k) { const bf16* kp = DK + (size_t)(b * SEQ + k) * (D / 2) + h * 2 * DQK + c * DQK; float sdot = 0.f;
#pragma unroll
        for (int d = 0; d < DQK; ++d) sdot += q[d] * bf2f(kp[d]);
        sum += exp2f(sdot - mx); }
    stats[i * 2] = mx; stats[i * 2 + 1] = sum;
}}
__device__ __forceinline__ void nk_diff_pv(const bf16* DQ, const bf16* DK, const bf16* DV, const float* stats, const float* lamp, float* otmp) {
    constexpr int NDG = 8, DG = DVD / NDG;
    for (size_t i = gtid(); i < (size_t)(T * DH * NDG); i += gnth()) {
    const int dg = (int)(i % NDG), h = (int)((i / NDG) % DH), t = (int)(i / (NDG * DH)); const int b = t / SEQ, s = t % SEQ;
    const int nk = (s / CHUNK + 1) * CHUNK; const float lam = lamp[0];
    float q[2 * DQK]; const bf16* qp = DQ + (size_t)t * (D / 2) + h * 2 * DQK;
#pragma unroll
    for (int d = 0; d < 2 * DQK; ++d) q[d] = bf2f(qp[d]);
    const float m0 = stats[((size_t)(t * DH + h) * 2 + 0) * 2], l0 = stats[((size_t)(t * DH + h) * 2 + 0) * 2 + 1];
    const float m1 = stats[((size_t)(t * DH + h) * 2 + 1) * 2], l1 = stats[((size_t)(t * DH + h) * 2 + 1) * 2 + 1];
    float acc[DG];
#pragma unroll
    for (int d = 0; d < DG; ++d) acc[d] = 0.f;
    for (int k = 0; k < nk; ++k) { const bf16* kp = DK + (size_t)(b * SEQ + k) * (D / 2) + h * 2 * DQK; float s0 = 0.f, s1 = 0.f;
#pragma unroll
        for (int d = 0; d < DQK; ++d) { s0 += q[d] * bf2f(kp[d]); s1 += q[DQK + d] * bf2f(kp[DQK + d]); }
        const float a = exp2f(s0 - m0) / l0 - lam * exp2f(s1 - m1) / l1;
        const bf16* vp = DV + (size_t)(b * SEQ + k) * (D / 2) + h * DVD + dg * DG;
#pragma unroll
        for (int d = 0; d < DG; ++d) acc[d] += a * bf2f(vp[d]); }
#pragma unroll
    for (int d = 0; d < DG; ++d) otmp[(size_t)t * (D / 2) + h * DVD + dg * DG + d] = acc[d];
}}
__device__ __forceinline__ void nk_diff_norm(const float* otmp, const float* g, bf16* MIX) {
    for (size_t i = gtid(); i < (size_t)(T * DH); i += gnth()) { const int h = (int)(i % DH), t = (int)(i / DH);
    const float* o = otmp + (size_t)t * (D / 2) + h * DVD; float ss = 0.f; for (int d = 0; d < DVD; ++d) ss += o[d] * o[d];
    const float rs = 1.0f / sqrtf(ss / DVD + EPS);
    for (int d = 0; d < DVD; ++d) MIX[(size_t)t * D + h * DVD + d] = f2bf(o[d] * rs * g[d] * 0.8f);
}}
__device__ __forceinline__ void nk_gla_cum(const float* GLR, const float* wa2, const float* ba, float* CUM) {
    constexpr int W = GH * GKD; for (size_t i = gtid(); i < (size_t)(B * NC * W); i += gnth()) {
    const int j = (int)(i % W), cb = (int)(i / W); float run = 0.f;
    for (int tt = 0; tt < CHUNK; ++tt) { const int t = cb * CHUNK + tt; float z = ba[j];
        for (int r = 0; r < GRK; ++r) z += GLR[(size_t)t * GRK + r] * wa2[(size_t)r * W + j];
        const float ls = fminf(z, 0.f) - log1pf(expf(-fabsf(z)));
        run += ls * (1.0f / 16.0f); CUM[(size_t)t * W + j] = run; }
}}
__device__ __forceinline__ void nk_gla_prep(const float* GLR, const float* wa2, const float* ba, const bf16* GK, bf16* KD, float* DEC) {
    constexpr int W = GH * GKD;
    for (size_t i = gtid(); i < (size_t)B * NC * W; i += gnth()) { const int j = (int)(i % W), cb = (int)(i / W);
        float w[GRK];
#pragma unroll
        for (int r = 0; r < GRK; ++r) w[r] = wa2[(size_t)r * W + j];
        const float bj = ba[j]; float run = 0.f;
        for (int tt = 0; tt < CHUNK; ++tt) { const float* gl = GLR + (size_t)(cb * CHUNK + tt) * GRK; float z = bj;
#pragma unroll
            for (int r = 0; r < GRK; ++r) z += gl[r] * w[r];
            run += (fminf(z, 0.f) - log1pf(expf(-fabsf(z)))) * (1.0f / 16.0f); }
        const float end = run; DEC[i] = expf(end); run = 0.f;
        for (int tt = 0; tt < CHUNK; ++tt) { const int t = cb * CHUNK + tt; const float* gl = GLR + (size_t)t * GRK; float z = bj;
#pragma unroll
            for (int r = 0; r < GRK; ++r) z += gl[r] * w[r];
            run += (fminf(z, 0.f) - log1pf(expf(-fabsf(z)))) * (1.0f / 16.0f);
            KD[(size_t)t * W + j] = f2bf(bf2f(GK[(size_t)t * W + j]) * expf(end - run)); } }
}
__device__ __forceinline__ void nk_gla_run(const bf16* GQ, const bf16* GK, const bf16* GV, const float* CUM, float* otmp) {
    constexpr int KH = GKD / 2;
    for (size_t i = gtid(); i < (size_t)(B * GH * GVD); i += gnth()) {
    const int v = (int)(i % GVD), h = (int)((i / GVD) % GH), b = (int)(i / (GVD * GH)); constexpr int W = GH * GKD;
    for (int kh = 0; kh < 2; ++kh) {
    float S[KH];
#pragma unroll
    for (int k = 0; k < KH; ++k) S[k] = 0.f;
    for (int c = 0; c < NC; ++c) { const int t0 = b * SEQ + c * CHUNK; const float* ce = CUM + (size_t)(t0 + CHUNK - 1) * W + h * GKD + kh * KH;
#pragma unroll
        for (int k = 0; k < KH; ++k) S[k] *= expf(ce[k]);
        for (int tt = 0; tt < CHUNK; ++tt) { const int t = t0 + tt; const float vv = bf2f(GV[(size_t)t * (D / 2) + h * GVD + v]);
            const bf16* kp = GK + (size_t)t * (D / 4) + h * GKD + kh * KH; const float* cp = CUM + (size_t)t * W + h * GKD + kh * KH;
#pragma unroll
            for (int k = 0; k < KH; ++k) S[k] += bf2f(kp[k]) * expf(ce[k] - cp[k]) * vv; }
        for (int tt = 0; tt < CHUNK; ++tt) { const int t = t0 + tt; const bf16* qp = GQ + (size_t)t * (D / 4) + h * GKD + kh * KH; float o = 0.f;
#pragma unroll
            for (int k = 0; k < KH; ++k) o += bf2f(qp[k]) * S[k];
            float* op = otmp + (size_t)t * (D / 2) + h * GVD + v; if (kh == 0) *op = o; else *op += o; } }
    } }
}
__device__ __forceinline__ void nk_gla_norm(const float* otmp, const float* g, const bf16* GR, bf16* MIX) {
    for (size_t i = gtid(); i < (size_t)(T * GH); i += gnth()) { const int h = (int)(i % GH), t = (int)(i / GH);
    const float* o = otmp + (size_t)t * (D / 2) + h * GVD; float ss = 0.f; for (int d = 0; d < GVD; ++d) ss += o[d] * o[d];
    const float rs = 1.0f / sqrtf(ss / GVD + EPS);
    for (int d = 0; d < GVD; ++d) MIX[(size_t)t * D + D / 2 + h * GVD + d] = f2bf(o[d] * rs * g[d] * silu_f(bf2f(GR[(size_t)t * (D / 2) + h * GVD + d])));
}}
__device__ __forceinline__ void nk_cqss(const bf16* CQ, float* CQSS) {
    for (size_t i = gtid(); i < (size_t)T * 32; i += gnth()) { const int j = (int)(i % 32), t = (int)(i / 32);
    float ss = 0.f; for (int d = 0; d < D / 32; ++d) { const float v = bf2f(CQ[(size_t)t * D + j * (D / 32) + d]); ss += v * v; } CQSS[i] = ss; }
}
__device__ __forceinline__ void nk_ckv_fix(const bf16* CKV, const float* qg, const float* kg, bf16* CK2, bf16* CVT) {
    for (size_t i = gtid(); i < (size_t)(B * NMEM * CH); i += gnth()) { const int h = (int)(i % CH), bm = (int)(i / CH); const int b = bm / NMEM, m = bm % NMEM;
    const bf16* kp = CKV + (size_t)bm * 2 * D + h * CHD; const bf16* vp = CKV + (size_t)bm * 2 * D + D + h * CHD;
    float ss = 0.f; for (int d = 0; d < CHD; ++d) { const float v = bf2f(kp[d]); ss += v * v; }
    const float rs = 1.0f / sqrtf(ss / CHD + EPS) * (1.0f / sqrtf((float)CHD)) * LOG2E;
    for (int d = 0; d < CHD; ++d) { CK2[(((size_t)b * CH + h) * NMEM + m) * CHD + d] = f2bf(bf2f(kp[d]) * rs * kg[d] * qg[d]);
        CVT[(((size_t)b * CH + h) * CHD + d) * NMEM + m] = vp[d]; }
}}
__device__ __forceinline__ void nk_cross_scores(const bf16* CQ, const float* CQSS, const bf16* CK2, float* P) {
    for (size_t i = gtid(); i < (size_t)(T * CH * NMEM); i += gnth()) { const int m = (int)(i % NMEM), h = (int)((i / NMEM) % CH), t = (int)(i / (NMEM * CH)); const int b = t / SEQ;
    float qs = 0.f; for (int j = 0; j < 8; ++j) qs += CQSS[(size_t)t * 32 + 8 * h + j];
    const float rq = 1.0f / sqrtf(qs / CHD + EPS);
    const bf16* qp = CQ + (size_t)t * D + h * CHD; const bf16* kp = CK2 + (((size_t)b * CH + h) * NMEM + m) * CHD; float s = 0.f;
    for (int d = 0; d < CHD; ++d) s += bf2f(qp[d]) * bf2f(kp[d]);
    P[i] = s * rq;
}}
__device__ __forceinline__ void nk_cross_softmax(float* P) {
    for (size_t i = gtid(); i < (size_t)(T * CH); i += gnth()) { float* p = P + i * NMEM; float mx = -1e30f;
    for (int m = 0; m < NMEM; ++m) mx = fmaxf(mx, p[m]); float sum = 0.f;
    for (int m = 0; m < NMEM; ++m) { p[m] = exp2f(p[m] - mx); sum += p[m]; }
    for (int m = 0; m < NMEM; ++m) p[m] /= sum;
}}
__device__ __forceinline__ void nk_cross_pv(const float* P, const bf16* CVT, bf16* CO) {
    for (size_t i = gtid(); i < (size_t)(T * D); i += gnth()) { const int d = (int)(i % CHD), h = (int)((i / CHD) % CH), t = (int)(i / D); const int b = t / SEQ;
    const float* p = P + ((size_t)t * CH + h) * NMEM; const bf16* vp = CVT + (((size_t)b * CH + h) * CHD + d) * NMEM; float o = 0.f;
    for (int m = 0; m < NMEM; ++m) o += p[m] * bf2f(vp[m]);
    CO[i] = f2bf(o);
}}
__device__ __forceinline__ void nk_router(const float* h2, const float* g, const float* wrg, const float* brg, const float* wre, const float* bre, bf16* XN, int* EXPERT, float* GATE, int* SLOTPOS, int* ctl) {
    for (size_t t = gtid(); t < (size_t)(T); t += gnth()) { const float* xr = h2 + t * D; float ss = 0.f;
    for (int i = 0; i < D; ++i) ss += xr[i] * xr[i]; const float rs = 1.0f / sqrtf(ss / D + EPS);
    float gl[NG], el[NE];
#pragma unroll
    for (int j = 0; j < NG; ++j) gl[j] = brg[j];
#pragma unroll
    for (int j = 0; j < NE; ++j) el[j] = bre[j];
    for (int i = 0; i < D; ++i) { const float xv = xr[i] * rs * g[i]; XN[t * D + i] = f2bf(xv);
#pragma unroll
        for (int j = 0; j < NG; ++j) gl[j] += xv * wrg[(size_t)i * NG + j];
#pragma unroll
        for (int j = 0; j < NE; ++j) el[j] += xv * wre[(size_t)i * NE + j]; }
    int grp = 0; float gm = gl[0];
#pragma unroll
    for (int j = 1; j < NG; ++j) if (gl[j] > gm) { gm = gl[j]; grp = j; }
    float gs = 0.f;
#pragma unroll
    for (int j = 0; j < NG; ++j) gs += expf(gl[j] - gm);
    const float grp_w = 1.0f / gs;
    float e8[EPG];
#pragma unroll
    for (int j = 0; j < EPG; ++j) { float v = 0.f;
#pragma unroll
        for (int gq = 0; gq < NG; ++gq) v = (grp == gq) ? el[gq * EPG + j] : v;
        e8[j] = v; }
    int i0 = 0; float v0 = e8[0];
#pragma unroll
    for (int j = 1; j < EPG; ++j) if (e8[j] > v0) { v0 = e8[j]; i0 = j; }
    int i1 = -1; float v1 = -1e30f;
#pragma unroll
    for (int j = 0; j < EPG; ++j) if (j != i0 && e8[j] > v1) { v1 = e8[j]; i1 = j; }
    const float r = expf(v1 - v0); const float g0 = grp_w / (1.f + r), g1 = grp_w * r / (1.f + r);
    const int e0 = grp * EPG + i0, e1 = grp * EPG + i1;
    EXPERT[t * 2] = e0; EXPERT[t * 2 + 1] = e1; GATE[t * 2] = g0; GATE[t * 2 + 1] = g1;
    SLOTPOS[t * 2] = atomicAdd(&ctl[CW_CNT + e0], 1); SLOTPOS[t * 2 + 1] = atomicAdd(&ctl[CW_CNT + e1], 1);
}}
__device__ __forceinline__ void nk_moe_offsets(int* ctl) {
    if (gtid() != 0) return; int base = 0, nt = 0;
    for (int e = 0; e < NE; ++e) { ctl[CW_BASE + e] = base; const int n = (ctl[CW_CNT + e] + ETILE - 1) / ETILE; for (int j = 0; j < n; ++j) ctl[CW_TILE_E + nt + j] = e; nt += n; base += n * ETILE; }
    ctl[CW_BASE + NE] = base; ctl[CW_NTILES] = nt; for (int j = nt; j < NTILE; ++j) ctl[CW_TILE_E + j] = -1;
}
__device__ __forceinline__ void nk_moe_init_slots(int* SLOTTOK, float* SLOTGATE) { for (size_t i = gtid(); i < (size_t)PMAX; i += gnth()) { SLOTTOK[i] = T; SLOTGATE[i] = 0.f; } }
__device__ __forceinline__ void nk_moe_fill(const int* EXPERT, const float* GATE, const int* SLOTPOS, const int* ctl, int* SLOTTOK, float* SLOTGATE) {
    for (size_t i = gtid(); i < (size_t)(T * 2); i += gnth()) { const int e = EXPERT[i]; const int dst = ctl[CW_BASE + e] + SLOTPOS[i];
    SLOTTOK[dst] = (int)(i / 2); SLOTGATE[dst] = GATE[i];
}}
__device__ __forceinline__ void nk_moe_gu(const bf16* XN, const bf16* WGU, const int* SLOTTOK, const int* ctl, bf16* HE) {
    for (size_t i = gtid(); i < (size_t)(PMAX * DE); i += gnth()) { const int j = (int)(i % DE), p = (int)(i / DE); const int e = ctl[CW_TILE_E + p / ETILE];
    if (e < 0) continue; const int tok = SLOTTOK[p];
    const int pn = j / GUH, jj = j % GUH; const bf16* wg = WGU + ((size_t)e * 2 * DE + pn * 2 * GUH + jj) * D; const bf16* wu = wg + (size_t)GUH * D;
    const bf16* xr = XN + (size_t)tok * D; float g = 0.f, u = 0.f;
    for (int k = 0; k < D; ++k) { const float xv = bf2f(xr[k]); g += xv * bf2f(wg[k]); u += xv * bf2f(wu[k]); }
    HE[i] = f2bf(silu_f(g) * u);
}}
__device__ __forceinline__ void nk_moe_down(const bf16* HE, const bf16* WD, const int* SLOTTOK, const float* SLOTGATE, const int* ctl, float* out) {
    for (size_t i = gtid(); i < (size_t)(PMAX * D); i += gnth()) { const int n = (int)(i % D), p = (int)(i / D); const int e = ctl[CW_TILE_E + p / ETILE];
    if (e < 0) continue; const int tok = SLOTTOK[p]; if (tok >= T) continue;
    const bf16* hr = HE + (size_t)p * DE; const bf16* wr = WD + ((size_t)e * D + n) * DE; float y = 0.f;
    for (int k = 0; k < DE; ++k) y += bf2f(hr[k]) * bf2f(wr[k]);
    atomicAdd(&out[(size_t)tok * D + n], y * SLOTGATE[p]);
}}


#ifndef HOST_EMU
static_assert(D == 2048 && SEQ == 4096 && NMEM == 256 && ETILE == 256, "the fast phases are written for the real shapes");
#define LAS __attribute__((address_space(3)))
#define GAS __attribute__((address_space(1)))
#define LDS_WAIT() asm volatile("s_waitcnt lgkmcnt(0)" ::: "memory")
#define VM_WAIT() asm volatile("s_waitcnt vmcnt(0)" ::: "memory")
namespace pg8 {
#define PG8_LAS __attribute__((address_space(3)))
typedef unsigned short bf16_t;
typedef short bf16x8 __attribute__((ext_vector_type(8)));
typedef float f32x4 __attribute__((ext_vector_type(4)));
typedef unsigned u32x4 __attribute__((ext_vector_type(4)));
constexpr int BM = 256, BK = 64, HALF = 128, HTB = HALF * BK * 2  , STAGE_BYTES = 8 * HTB, NXCD = 8, WGM = 8;

__host__ __device__ __forceinline__ int lds_byte(int r, int c) { const int st = (r >> 4) * 2 + (c >> 5), rr = r & 15, cc = c & 31, ob = rr * 64 + cc * 2; return st * 1024 + (ob ^ (((ob >> 9) & 1) << 5)); }
__host__ __device__ __forceinline__ void stage_rc(int b, int& R, int& C) { const int st = b / 1024, sb = b % 1024, swz = sb ^ (((sb >> 9) & 1) << 5); R = (st >> 1) * 16 + swz / 64; C = (st & 1) * 32 + (swz % 64) / 2; }
__host__ __device__ __forceinline__ int perm32(int rho) { const int n = rho >> 4, i = rho & 15; return 8 * (i >> 2) + 4 * n + (i & 3); }

struct Unit { int pm, pn; };
struct Gemm { const bf16_t* A; const bf16_t* Bt; int M, N, K; };

struct StaticOrder {
    int nM, nN, nwg, G, c;
    __host__ __device__ void init(int M, int N, int G_, int c_) { nM = M / BM; nN = N / BM; nwg = nM * nN; G = G_; c = c_; }
    __host__ __device__ bool next(int i, Unit& u) const {
        const long L = (long)i * G + c; if (L >= nwg) return false;
        int wgid = (int)L; { const int q = nwg / NXCD, r = nwg % NXCD, xcd = wgid % NXCD, off = wgid / NXCD; wgid = (xcd < r ? xcd * (q + 1) : r * (q + 1) + (xcd - r) * q) + off; }
        const int nig = WGM * nN, gid = wgid / nig, fm = gid * WGM, gsz = (nM - fm) < WGM ? (nM - fm) : WGM;
        u.pm = fm + ((wgid % nig) % gsz); u.pn = (wgid % nig) / gsz; return true;
    }
    __device__ __forceinline__ void a_ready(const Unit&) const {}
    __device__ __forceinline__ void done(const Unit&) const {}
};
__device__ __forceinline__ unsigned cvt_pk_bf16(float lo, float hi) { unsigned r; asm volatile("v_cvt_pk_bf16_f32 %0, %1, %2" : "=v"(r) : "v"(lo), "v"(hi)); return r; }
__device__ __forceinline__ float dot4(const f32x4 a) { return (a[0] * a[0] + a[1] * a[1]) + (a[2] * a[2] + a[3] * a[3]); }
struct EpiInProj {
    static constexpr bool PERM = true, AFTER_DRAIN = false;
    char* rb; const float* rope; const float* qg; const float* kg;
    __device__ __forceinline__ void operator()(const f32x4 (&acc)[2][2][4][2], const Unit& u, int wr, int wc, int fr, int fq) const {
        const int row0 = u.pm * BM + wr * 64 + fr;
        if (u.pn < 8) {
            const bool isk = u.pn >= 4; const float* g = isk ? kg : qg;
            bf16_t* dst = (bf16_t*)(rb + (isk ? B_DK : B_DQ)) + ((u.pn & 3) * 4 + wc) * 64 + 8 * fq;
            const float sc = isk ? 1.0f : 0.125f * LOG2E;
            const f32x4 ga0 = *(const f32x4*)(g + 8 * fq), ga1 = *(const f32x4*)(g + 8 * fq + 4), gb0 = *(const f32x4*)(g + 32 + 8 * fq), gb1 = *(const f32x4*)(g + 36 + 8 * fq);
#pragma unroll
            for (int ai = 0; ai < 2; ++ai)
#pragma unroll
                for (int m = 0; m < 4; ++m) {
                    const int row = row0 + ai * HALF + m * 16;
                    const f32x4 a0 = acc[ai][0][m][0], a1 = acc[ai][0][m][1], b0 = acc[ai][1][m][0], b1 = acc[ai][1][m][1];
                    float ss = (dot4(a0) + dot4(a1)) + (dot4(b0) + dot4(b1));
                    ss += __shfl_xor(ss, 16); ss += __shfl_xor(ss, 32);
                    const float rs = sc / sqrtf(ss * (1.0f / 64.0f) + EPS);
                    const f32x4* rp = (const f32x4*)(rope + ((size_t)row * 32 + 8 * fq) * 2);
                    const f32x4 r0 = rp[0], r1 = rp[1], r2 = rp[2], r3 = rp[3];
                    const f32x4 t1a = a0 * ga0 * rs, t1b = a1 * ga1 * rs, t2a = b0 * gb0 * rs, t2b = b1 * gb1 * rs;
                    u32x4 w1, w2;
                    w1.x = cvt_pk_bf16(t1a[0] * r0[0] - t2a[0] * r0[1], t1a[1] * r0[2] - t2a[1] * r0[3]); w1.y = cvt_pk_bf16(t1a[2] * r1[0] - t2a[2] * r1[1], t1a[3] * r1[2] - t2a[3] * r1[3]);
                    w1.z = cvt_pk_bf16(t1b[0] * r2[0] - t2b[0] * r2[1], t1b[1] * r2[2] - t2b[1] * r2[3]); w1.w = cvt_pk_bf16(t1b[2] * r3[0] - t2b[2] * r3[1], t1b[3] * r3[2] - t2b[3] * r3[3]);
                    w2.x = cvt_pk_bf16(t2a[0] * r0[0] + t1a[0] * r0[1], t2a[1] * r0[2] + t1a[1] * r0[3]); w2.y = cvt_pk_bf16(t2a[2] * r1[0] + t1a[2] * r1[1], t2a[3] * r1[2] + t1a[3] * r1[3]);
                    w2.z = cvt_pk_bf16(t2b[0] * r2[0] + t1b[0] * r2[1], t2b[1] * r2[2] + t1b[1] * r2[3]); w2.w = cvt_pk_bf16(t2b[2] * r3[0] + t1b[2] * r3[1], t2b[3] * r3[2] + t1b[3] * r3[3]);
                    bf16_t* rowp = dst + (size_t)row * (D / 2);
                    *(u32x4*)rowp = w1; *(u32x4*)(rowp + 32) = w2;
                }
        } else {
            const int pn = u.pn; bf16_t* base; int ldc, colt; float sc = 1.0f;
            if (pn < 12) { base = (bf16_t*)(rb + B_DV); ldc = D / 2; colt = (pn - 8) * BM; }
            else if (pn < 14) { base = (bf16_t*)(rb + B_GQ); ldc = D / 4; colt = (pn - 12) * BM; sc = 0.08838834764831845f; }
            else if (pn < 16) { base = (bf16_t*)(rb + B_GK); ldc = D / 4; colt = (pn - 14) * BM; }
            else if (pn < 20) { base = (bf16_t*)(rb + B_GV); ldc = D / 2; colt = (pn - 16) * BM; }
            else { base = (bf16_t*)(rb + B_GR); ldc = D / 2; colt = (pn - 20) * BM; }
            const int col0 = colt + wc * 32 + 8 * fq;
#pragma unroll
            for (int ai = 0; ai < 2; ++ai)
#pragma unroll
                for (int m = 0; m < 4; ++m) { bf16_t* rowp = base + (size_t)(row0 + ai * HALF + m * 16) * ldc + col0;
#pragma unroll
                    for (int bj = 0; bj < 2; ++bj) { const f32x4 v0 = acc[ai][bj][m][0] * sc, v1 = acc[ai][bj][m][1] * sc;
                        u32x4 w; w.x = cvt_pk_bf16(v0[0], v0[1]); w.y = cvt_pk_bf16(v0[2], v0[3]); w.z = cvt_pk_bf16(v1[0], v1[1]); w.w = cvt_pk_bf16(v1[2], v1[3]);
                        *(u32x4*)(rowp + bj * HALF) = w; } }
        }
    }
};
struct EpiResid {
    static constexpr bool PERM = true, AFTER_DRAIN = false;
    const float* base; float* out; bf16_t* xn; const float* g; float* ssp;
    __device__ __forceinline__ void operator()(const f32x4 (&acc)[2][2][4][2], const Unit& u, int wr, int wc, int fr, int fq) const {
        const int row0 = u.pm * BM + wr * 64 + fr, col0 = u.pn * BM + wc * 32 + 8 * fq;
        f32x4 gv[2][2];
#pragma unroll
        for (int bj = 0; bj < 2; ++bj)
#pragma unroll
            for (int n = 0; n < 2; ++n) gv[bj][n] = *(const f32x4*)(g + col0 + bj * HALF + 4 * n);
#pragma unroll
        for (int ai = 0; ai < 2; ++ai)
#pragma unroll
            for (int m = 0; m < 4; ++m) { const int row = row0 + ai * HALF + m * 16; const size_t off = (size_t)row * D + col0; float ss = 0.f;
#pragma unroll
                for (int bj = 0; bj < 2; ++bj) { const f32x4 b0 = *(const f32x4*)(base + off + bj * HALF), b1 = *(const f32x4*)(base + off + bj * HALF + 4);
                    const f32x4 v0 = acc[ai][bj][m][0] + b0, v1 = acc[ai][bj][m][1] + b1;
                    *(f32x4*)(out + off + bj * HALF) = v0; *(f32x4*)(out + off + bj * HALF + 4) = v1; ss += dot4(v0) + dot4(v1);
                    const f32x4 x0 = v0 * gv[bj][0], x1 = v1 * gv[bj][1];
                    u32x4 w; w.x = cvt_pk_bf16(x0[0], x0[1]); w.y = cvt_pk_bf16(x0[2], x0[3]); w.z = cvt_pk_bf16(x1[0], x1[1]); w.w = cvt_pk_bf16(x1[2], x1[3]);
                    *(u32x4*)(xn + off + bj * HALF) = w; }
                ss += __shfl_xor(ss, 16); ss += __shfl_xor(ss, 32);
                if (fq == 0) ssp[(size_t)row * 32 + u.pn * 4 + wc] = ss;
                if (m & 1) asm volatile("" ::: "memory"); }
    }
};
struct EpiCq {
    static constexpr bool PERM = true, AFTER_DRAIN = false;
    const float* ssp_in; bf16_t* cq; float* cqss;
    __device__ __forceinline__ void operator()(const f32x4 (&acc)[2][2][4][2], const Unit& u, int wr, int wc, int fr, int fq) const {
        const int lane = fr + 16 * fq, row0 = u.pm * BM + wr * 64 + fr, col0 = u.pn * BM + wc * 32 + 8 * fq;
        float rs2[2];
#pragma unroll
        for (int ai = 0; ai < 2; ++ai) { const f32x4* p = (const f32x4*)(ssp_in + (size_t)(u.pm * BM + ai * HALF + wr * 64 + lane) * 32); f32x4 s4 = p[0];
#pragma unroll
            for (int j = 1; j < 8; ++j) s4 += p[j];
            rs2[ai] = 1.0f / sqrtf(((s4[0] + s4[1]) + (s4[2] + s4[3])) * (1.0f / D) + EPS); }
#pragma unroll
        for (int ai = 0; ai < 2; ++ai)
#pragma unroll
            for (int m = 0; m < 4; ++m) { const int row = row0 + ai * HALF + m * 16; const size_t off = (size_t)row * D + col0; float ss = 0.f;
                const float rsr = __shfl(rs2[ai], 16 * m + fr);
#pragma unroll
                for (int bj = 0; bj < 2; ++bj) { const f32x4 v0 = acc[ai][bj][m][0] * rsr, v1 = acc[ai][bj][m][1] * rsr; ss += dot4(v0) + dot4(v1);
                    u32x4 w; w.x = cvt_pk_bf16(v0[0], v0[1]); w.y = cvt_pk_bf16(v0[2], v0[3]); w.z = cvt_pk_bf16(v1[0], v1[1]); w.w = cvt_pk_bf16(v1[2], v1[3]);
                    *(u32x4*)(cq + off + bj * HALF) = w; }
                ss += __shfl_xor(ss, 16); ss += __shfl_xor(ss, 32);
                if (fq == 0) cqss[(size_t)row * 32 + u.pn * 4 + wc] = ss; }
    }
};

struct EpiPlain {
    static constexpr bool PERM = true, AFTER_DRAIN = false;
    bf16_t* out; int ldc;
    __device__ __forceinline__ void operator()(const f32x4 (&acc)[2][2][4][2], const Unit& u, int wr, int wc, int fr, int fq) const {
        const int row0 = u.pm * BM + wr * 64 + fr, col0 = u.pn * BM + wc * 32 + 8 * fq;
#pragma unroll
        for (int ai = 0; ai < 2; ++ai)
#pragma unroll
            for (int m = 0; m < 4; ++m) { bf16_t* rowp = out + (size_t)(row0 + ai * HALF + m * 16) * ldc + col0;
#pragma unroll
                for (int bj = 0; bj < 2; ++bj) { const f32x4 v0 = acc[ai][bj][m][0], v1 = acc[ai][bj][m][1];
                    u32x4 w; w.x = cvt_pk_bf16(v0[0], v0[1]); w.y = cvt_pk_bf16(v0[2], v0[3]); w.z = cvt_pk_bf16(v1[0], v1[1]); w.w = cvt_pk_bf16(v1[2], v1[3]);
                    *(u32x4*)(rowp + bj * HALF) = w; } }
    }
};
struct MoeOrder {
    const int* ctl; int NP, G, c;
    __device__ __forceinline__ bool next(int i, Unit& u) const { const int nt = ctl[CW_NTILES]; const int L = i * G + c; if (L >= nt * NP) return false;
        const int rt = L / NP; u.pm = rt; u.pn = ctl[CW_TILE_E + rt] * NP + (L - rt * NP); return true; }
    __device__ __forceinline__ void a_ready(const Unit&) const {}
    __device__ __forceinline__ void done(const Unit&) const {}
};
__device__ __forceinline__ float silu_fast(float x) { return x * __builtin_amdgcn_rcpf(1.0f + __expf(-x)); }
struct EpiGU {
    static constexpr bool PERM = true, AFTER_DRAIN = false;
    const int* slottok; const float* ssp; bf16_t* he;
    __device__ __forceinline__ void operator()(const f32x4 (&acc)[2][2][4][2], const Unit& u, int wr, int wc, int fr, int fq) const {
        const int lane = fr + 16 * fq, p0 = u.pm * BM + wr * 64, ct = u.pn & 3;
        float rs2[2];
#pragma unroll
        for (int ai = 0; ai < 2; ++ai) { const int tok = slottok[p0 + ai * HALF + lane]; float rs = 0.f;
            if (tok < T) { const f32x4* p = (const f32x4*)(ssp + (size_t)tok * 32); f32x4 s4 = p[0];
#pragma unroll
                for (int j = 1; j < 8; ++j) s4 += p[j];
                rs = 1.0f / sqrtf(((s4[0] + s4[1]) + (s4[2] + s4[3])) * (1.0f / D) + EPS); }
            rs2[ai] = rs; }
#pragma unroll
        for (int ai = 0; ai < 2; ++ai)
#pragma unroll
            for (int m = 0; m < 4; ++m) { const float rsr = __shfl(rs2[ai], 16 * m + fr);
                bf16_t* rowp = he + (size_t)(p0 + ai * HALF + 16 * m + fr) * DE + ct * 128 + wc * 32 + 8 * fq;
                const f32x4 g0 = acc[ai][0][m][0] * rsr, g1 = acc[ai][0][m][1] * rsr, u0 = acc[ai][1][m][0] * rsr, u1 = acc[ai][1][m][1] * rsr;
                u32x4 w; w.x = cvt_pk_bf16(silu_fast(g0[0]) * u0[0], silu_fast(g0[1]) * u0[1]); w.y = cvt_pk_bf16(silu_fast(g0[2]) * u0[2], silu_fast(g0[3]) * u0[3]);
                w.z = cvt_pk_bf16(silu_fast(g1[0]) * u1[0], silu_fast(g1[1]) * u1[1]); w.w = cvt_pk_bf16(silu_fast(g1[2]) * u1[2], silu_fast(g1[3]) * u1[3]);
                *(u32x4*)rowp = w; }
    }
};
struct EpiDown {
    static constexpr bool PERM = true, AFTER_DRAIN = false;
    const float* slotgate; bf16_t* y;
    __device__ __forceinline__ void operator()(const f32x4 (&acc)[2][2][4][2], const Unit& u, int wr, int wc, int fr, int fq) const {
        const int lane = fr + 16 * fq, p0 = u.pm * BM + wr * 64, ct = u.pn & 7;
        float gt2[2];
#pragma unroll
        for (int ai = 0; ai < 2; ++ai) gt2[ai] = slotgate[p0 + ai * HALF + lane];
#pragma unroll
        for (int ai = 0; ai < 2; ++ai)
#pragma unroll
            for (int m = 0; m < 4; ++m) { const float gt = __shfl(gt2[ai], 16 * m + fr);
                bf16_t* rowp = y + (size_t)(p0 + ai * HALF + 16 * m + fr) * D + ct * BM + wc * 32 + 8 * fq;
#pragma unroll
                for (int bj = 0; bj < 2; ++bj) { const f32x4 v0 = acc[ai][bj][m][0] * gt, v1 = acc[ai][bj][m][1] * gt;
                    u32x4 w; w.x = cvt_pk_bf16(v0[0], v0[1]); w.y = cvt_pk_bf16(v0[2], v0[3]); w.z = cvt_pk_bf16(v1[0], v1[1]); w.w = cvt_pk_bf16(v1[2], v1[3]);
                    *(u32x4*)(rowp + bj * HALF) = w; } }
    }
};
template <class Epi, class Sched, bool ALIGN_EPI = false, bool SP2 = false>
__device__ __forceinline__ void gemm_phase(PG8_LAS unsigned char* lds, const Gemm g, const Sched& S, const Epi& E) {
    const int tid = threadIdx.x, wid = __builtin_amdgcn_readfirstlane(tid >> 6), lane = tid & 63, wr = wid >> 2, wc = wid & 3, fr = lane & 15, fq = lane >> 4;
    const int K = g.K, nt = K / BK;
    unsigned voffA[2], voffB[2];
#pragma unroll
    for (int i = 0; i < 2; ++i) { int R, C; stage_rc(tid * 16 + i * 8192, R, C); const int Rb = Epi::PERM ? ((R & ~31) + perm32(R & 31)) : R;
        voffA[i] = (unsigned)(R * K + C) * 2u; voffB[i] = (unsigned)(Rb * K + C) * 2u; }
    const size_t kstep = (size_t)(BK * 2);
    const size_t hstep = (size_t)HALF * K * 2;
    const size_t tstep = 2 * hstep;
    const unsigned ldsw = (unsigned)wid * 1024u;
    const int aoff = lds_byte(wr * 64 + fr, fq * 8), boff = lds_byte(wc * 32 + fr, fq * 8);
#define PG8_SA(b, h) (((b) * 2 + (h)) * HTB)
#define PG8_SB(b, h) ((4 + (b) * 2 + (h)) * HTB)
#define PG8_STAGE(bufoff, gbase, voff) do { _Pragma("unroll") for (int _i = 0; _i < 2; ++_i) \
        __builtin_amdgcn_global_load_lds((const unsigned*)((const char*)(gbase) + (voff)[_i]), (PG8_LAS unsigned*)(lds + (bufoff) + ldsw + _i * 8192), 16, 0, 0); } while (0)
#define PG8_LDA(dst, b, h) do { _Pragma("unroll") for (int m = 0; m < 4; ++m) _Pragma("unroll") for (int k = 0; k < 2; ++k) dst[m][k] = *(const PG8_LAS bf16x8*)(lds + PG8_SA(b, h) + aoff + m * 2048 + k * 1024); } while (0)
#define PG8_LDB(dst, b, h) do { _Pragma("unroll") for (int n = 0; n < 2; ++n) _Pragma("unroll") for (int k = 0; k < 2; ++k) dst[n][k] = *(const PG8_LAS bf16x8*)(lds + PG8_SB(b, h) + boff + n * 2048 + k * 1024); } while (0)
#define PG8_MMA(ai, bj, At, Bt) do { __builtin_amdgcn_s_setprio(1); _Pragma("unroll") for (int m = 0; m < 4; ++m) _Pragma("unroll") for (int n = 0; n < 2; ++n) _Pragma("unroll") for (int k = 0; k < 2; ++k) \
        acc[ai][bj][m][n] = __builtin_amdgcn_mfma_f32_16x16x32_bf16(Bt[n][k], At[m][k], acc[ai][bj][m][n], 0, 0, 0); __builtin_amdgcn_s_setprio(0); } while (0)
#define PG8_WAIT_V(n) asm volatile("s_waitcnt vmcnt(" #n ")" ::: "memory")
#define PG8_WAIT_L(n) asm volatile("s_waitcnt lgkmcnt(" #n ")" ::: "memory")
#define PG8_BAR __builtin_amdgcn_s_barrier()
#define PG8_SCHED __builtin_amdgcn_sched_barrier(0)
    Unit cur, nxt; int ui = 0;
    if (!S.next(0, cur)) return;
    f32x4 acc[2][2][4][2];
#pragma unroll
    for (int a = 0; a < 2; ++a)
#pragma unroll
        for (int b = 0; b < 2; ++b)
#pragma unroll
            for (int m = 0; m < 4; ++m)
#pragma unroll
                for (int n = 0; n < 2; ++n) acc[a][b][m][n] = (f32x4){0.f, 0.f, 0.f, 0.f};
    bf16x8 At[4][2], B0[2][2], B1[2][2];
    const char* cA = (const char*)g.A + (size_t)cur.pm * tstep; const char* cB = (const char*)g.Bt + (size_t)cur.pn * tstep;
    S.a_ready(cur);
    if constexpr (SP2) {
        PG8_STAGE(PG8_SB(0, 0), cB, voffB); PG8_STAGE(PG8_SB(0, 1), cB + hstep, voffB); PG8_STAGE(PG8_SA(0, 0), cA, voffA); PG8_STAGE(PG8_SA(0, 1), cA + hstep, voffA);
        if (wr == 1) PG8_BAR;
        PG8_WAIT_V(2); PG8_BAR;
        PG8_STAGE(PG8_SB(1, 0), cB + kstep, voffB); PG8_STAGE(PG8_SA(1, 0), cA + kstep, voffA); PG8_STAGE(PG8_SB(1, 1), cB + hstep + kstep, voffB);
        PG8_WAIT_V(6); PG8_BAR;
    } else {
        PG8_STAGE(PG8_SB(0, 0), cB, voffB); PG8_STAGE(PG8_SA(0, 0), cA, voffA); PG8_STAGE(PG8_SB(0, 1), cB + hstep, voffB); PG8_STAGE(PG8_SA(0, 1), cA + hstep, voffA);
        if (wr == 1) PG8_BAR;
        PG8_WAIT_V(4); PG8_BAR;
        PG8_STAGE(PG8_SB(1, 0), cB + kstep, voffB); PG8_STAGE(PG8_SA(1, 0), cA + kstep, voffA); PG8_STAGE(PG8_SB(1, 1), cB + hstep + kstep, voffB);
        PG8_WAIT_V(6); PG8_BAR;
    }
    for (;;) {
        const bool has_next = S.next(ui + 1, nxt);
        const char* nA = has_next ? (const char*)g.A + (size_t)nxt.pm * tstep : cA; const char* nB = has_next ? (const char*)g.Bt + (size_t)nxt.pn * tstep : cB;
        for (int t = 0; t < nt; t += 2) {
            const bool last = (t == nt - 2);
            const char* a1 = cA + (size_t)(t + 1) * kstep;
            const char* a2 = last ? nA : cA + (size_t)(t + 2) * kstep; const char* b2 = last ? nB : cB + (size_t)(t + 2) * kstep;
            const char* a3 = a2 + kstep; const char* b3 = b2 + kstep;
            if (last && has_next) S.a_ready(nxt);
            if constexpr (SP2) {
            PG8_LDB(B0, 0, 0); PG8_LDB(B1, 0, 1); PG8_SCHED; PG8_LDA(At, 0, 0); PG8_STAGE(PG8_SA(1, 1), a1 + hstep, voffA);
            PG8_WAIT_V(8); PG8_WAIT_L(0); PG8_BAR; PG8_MMA(0, 0, At, B0); PG8_MMA(0, 1, At, B1); PG8_BAR; PG8_SCHED;
            PG8_LDA(At, 0, 1); PG8_STAGE(PG8_SB(0, 0), b2, voffB); PG8_STAGE(PG8_SB(0, 1), b2 + hstep, voffB); PG8_STAGE(PG8_SA(0, 0), a2, voffA);
            PG8_WAIT_V(8); PG8_WAIT_L(0); PG8_BAR; PG8_MMA(1, 0, At, B0); PG8_MMA(1, 1, At, B1); PG8_BAR; PG8_SCHED;
            PG8_LDB(B0, 1, 0); PG8_LDB(B1, 1, 1); PG8_SCHED; PG8_LDA(At, 1, 0); PG8_STAGE(PG8_SA(0, 1), a2 + hstep, voffA);
            PG8_WAIT_V(8); PG8_WAIT_L(0); PG8_BAR; PG8_MMA(0, 0, At, B0); PG8_MMA(0, 1, At, B1); PG8_BAR; PG8_SCHED;
            PG8_LDA(At, 1, 1); PG8_STAGE(PG8_SB(1, 0), b3, voffB); PG8_STAGE(PG8_SB(1, 1), b3 + hstep, voffB); PG8_STAGE(PG8_SA(1, 0), a3, voffA);
            PG8_WAIT_V(8); PG8_WAIT_L(0); PG8_BAR; PG8_MMA(1, 0, At, B0); PG8_MMA(1, 1, At, B1); PG8_BAR; PG8_SCHED;
            } else {
            PG8_LDB(B0, 0, 0); PG8_SCHED; PG8_LDA(At, 0, 0); PG8_STAGE(PG8_SA(1, 1), a1 + hstep, voffA);
            PG8_WAIT_L(8); PG8_BAR; PG8_WAIT_L(0); PG8_MMA(0, 0, At, B0); PG8_BAR; PG8_SCHED;
            PG8_LDB(B1, 0, 1); PG8_STAGE(PG8_SB(0, 0), b2, voffB);
            PG8_BAR; PG8_WAIT_L(0); PG8_MMA(0, 1, At, B1); PG8_BAR;
            PG8_LDA(At, 0, 1); PG8_STAGE(PG8_SA(0, 0), a2, voffA);
            PG8_BAR; PG8_WAIT_L(0); PG8_MMA(1, 0, At, B0); PG8_BAR; PG8_SCHED;
            PG8_STAGE(PG8_SB(0, 1), b2 + hstep, voffB);
            PG8_WAIT_V(6); PG8_BAR; PG8_MMA(1, 1, At, B1); PG8_BAR;
            PG8_LDB(B0, 1, 0); PG8_SCHED; PG8_LDA(At, 1, 0); PG8_STAGE(PG8_SA(0, 1), a2 + hstep, voffA);
            PG8_WAIT_L(8); PG8_BAR; PG8_WAIT_L(0); PG8_MMA(0, 0, At, B0); PG8_BAR; PG8_SCHED;
            PG8_LDB(B1, 1, 1); PG8_STAGE(PG8_SB(1, 0), b3, voffB);
            PG8_BAR; PG8_WAIT_L(0); PG8_MMA(0, 1, At, B1); PG8_BAR;
            PG8_LDA(At, 1, 1); PG8_STAGE(PG8_SA(1, 0), a3, voffA);
            PG8_BAR; PG8_WAIT_L(0); PG8_MMA(1, 0, At, B0); PG8_BAR; PG8_SCHED;
            PG8_STAGE(PG8_SB(1, 1), b3 + hstep, voffB);
            PG8_WAIT_V(6); PG8_BAR; PG8_MMA(1, 1, At, B1); PG8_BAR;
            }
        }
        if constexpr (ALIGN_EPI) { if (wr == 0) PG8_BAR; }
        if constexpr (!Epi::AFTER_DRAIN) { E(acc, cur, wr, wc, fr, fq); S.done(cur); }
        if (!has_next) break;
#pragma unroll
        for (int a = 0; a < 2; ++a)
#pragma unroll
            for (int b = 0; b < 2; ++b)
#pragma unroll
                for (int m = 0; m < 4; ++m)
#pragma unroll
                    for (int n = 0; n < 2; ++n) acc[a][b][m][n] = (f32x4){0.f, 0.f, 0.f, 0.f};
        cur = nxt; cA = nA; cB = nB; ++ui;
        if constexpr (ALIGN_EPI) { if (wr == 1) PG8_BAR; }
    }
    PG8_WAIT_V(0);
    if constexpr (!ALIGN_EPI) { if (wr == 0) PG8_BAR; }
    PG8_BAR;
    if constexpr (Epi::AFTER_DRAIN) { E.fused(acc, cur, wr, wc, fr, fq, lds, wid, lane); S.done(cur); }
#undef PG8_SA
#undef PG8_SB
#undef PG8_STAGE
#undef PG8_LDA
#undef PG8_LDB
#undef PG8_MMA
#undef PG8_WAIT_V
#undef PG8_WAIT_L
#undef PG8_BAR
#undef PG8_SCHED
}
template <class Epi, class Sched, bool ALIGN_EPI = true>
__device__ __forceinline__ void gemm_phase_gather(PG8_LAS unsigned char* lds, const Gemm g, const int* rowidx, const Sched& S, const Epi& E) {
    constexpr bool SP2 = true;
    const int tid = threadIdx.x, wid = __builtin_amdgcn_readfirstlane(tid >> 6), lane = tid & 63, wr = wid >> 2, wc = wid & 3, fr = lane & 15, fq = lane >> 4;
    const int K = g.K, nt = K / BK;
    unsigned voffB[2]; int RA[2], CA[2];
#pragma unroll
    for (int i = 0; i < 2; ++i) { int R, C; stage_rc(tid * 16 + i * 8192, R, C); const int Rb = Epi::PERM ? ((R & ~31) + perm32(R & 31)) : R;
        RA[i] = R; CA[i] = C; voffB[i] = (unsigned)(Rb * K + C) * 2u; }
    unsigned vc[2][2], vn[2][2];
#define PG8_GOFF(dst, pm_) do { _Pragma("unroll") for (int h_ = 0; h_ < 2; ++h_) _Pragma("unroll") for (int i_ = 0; i_ < 2; ++i_) \
        dst[h_][i_] = ((unsigned)rowidx[(pm_) * BM + h_ * HALF + RA[i_]] * (unsigned)K + (unsigned)CA[i_]) * 2u; } while (0)
#define PG8_STAGE_A(bufoff, gbase, v0, v1) do { \
        __builtin_amdgcn_global_load_lds((const unsigned*)((const char*)(gbase) + (v0)), (PG8_LAS unsigned*)(lds + (bufoff) + ldsw), 16, 0, 0); \
        __builtin_amdgcn_global_load_lds((const unsigned*)((const char*)(gbase) + (v1)), (PG8_LAS unsigned*)(lds + (bufoff) + ldsw + 8192), 16, 0, 0); } while (0)
    const size_t kstep = (size_t)(BK * 2);
    const size_t hstep = (size_t)HALF * K * 2;
    const size_t tstep = 2 * hstep;
    const unsigned ldsw = (unsigned)wid * 1024u;
    const int aoff = lds_byte(wr * 64 + fr, fq * 8), boff = lds_byte(wc * 32 + fr, fq * 8);
#define PG8_SA(b, h) (((b) * 2 + (h)) * HTB)
#define PG8_SB(b, h) ((4 + (b) * 2 + (h)) * HTB)
#define PG8_STAGE(bufoff, gbase, voff) do { _Pragma("unroll") for (int _i = 0; _i < 2; ++_i) \
        __builtin_amdgcn_global_load_lds((const unsigned*)((const char*)(gbase) + (voff)[_i]), (PG8_LAS unsigned*)(lds + (bufoff) + ldsw + _i * 8192), 16, 0, 0); } while (0)
#define PG8_LDA(dst, b, h) do { _Pragma("unroll") for (int m = 0; m < 4; ++m) _Pragma("unroll") for (int k = 0; k < 2; ++k) dst[m][k] = *(const PG8_LAS bf16x8*)(lds + PG8_SA(b, h) + aoff + m * 2048 + k * 1024); } while (0)
#define PG8_LDB(dst, b, h) do { _Pragma("unroll") for (int n = 0; n < 2; ++n) _Pragma("unroll") for (int k = 0; k < 2; ++k) dst[n][k] = *(const PG8_LAS bf16x8*)(lds + PG8_SB(b, h) + boff + n * 2048 + k * 1024); } while (0)
#define PG8_MMA(ai, bj, At, Bt) do { __builtin_amdgcn_s_setprio(1); _Pragma("unroll") for (int m = 0; m < 4; ++m) _Pragma("unroll") for (int n = 0; n < 2; ++n) _Pragma("unroll") for (int k = 0; k < 2; ++k) \
        acc[ai][bj][m][n] = __builtin_amdgcn_mfma_f32_16x16x32_bf16(Bt[n][k], At[m][k], acc[ai][bj][m][n], 0, 0, 0); __builtin_amdgcn_s_setprio(0); } while (0)
#define PG8_WAIT_V(n) asm volatile("s_waitcnt vmcnt(" #n ")" ::: "memory")
#define PG8_WAIT_L(n) asm volatile("s_waitcnt lgkmcnt(" #n ")" ::: "memory")
#define PG8_BAR __builtin_amdgcn_s_barrier()
#define PG8_SCHED __builtin_amdgcn_sched_barrier(0)
    Unit cur, nxt; int ui = 0;
    if (!S.next(0, cur)) return;
    f32x4 acc[2][2][4][2];
#pragma unroll
    for (int a = 0; a < 2; ++a)
#pragma unroll
        for (int b = 0; b < 2; ++b)
#pragma unroll
            for (int m = 0; m < 4; ++m)
#pragma unroll
                for (int n = 0; n < 2; ++n) acc[a][b][m][n] = (f32x4){0.f, 0.f, 0.f, 0.f};
    bf16x8 At[4][2], B0[2][2], B1[2][2];
    const char* cA = (const char*)g.A; PG8_GOFF(vc, cur.pm); const char* cB = (const char*)g.Bt + (size_t)cur.pn * tstep;
    S.a_ready(cur);
    if constexpr (SP2) {
        PG8_STAGE(PG8_SB(0, 0), cB, voffB); PG8_STAGE(PG8_SB(0, 1), cB + hstep, voffB); PG8_STAGE_A(PG8_SA(0, 0), cA, vc[0][0], vc[0][1]); PG8_STAGE_A(PG8_SA(0, 1), cA, vc[1][0], vc[1][1]);
        if (wr == 1) PG8_BAR;
        PG8_WAIT_V(2); PG8_BAR;
        PG8_STAGE(PG8_SB(1, 0), cB + kstep, voffB); PG8_STAGE_A(PG8_SA(1, 0), cA + kstep, vc[0][0], vc[0][1]); PG8_STAGE(PG8_SB(1, 1), cB + hstep + kstep, voffB);
        PG8_WAIT_V(6); PG8_BAR;
    }
    for (;;) {
        const bool has_next = S.next(ui + 1, nxt);
        const char* nA = cA; if (has_next) PG8_GOFF(vn, nxt.pm); else { vn[0][0] = vc[0][0]; vn[0][1] = vc[0][1]; vn[1][0] = vc[1][0]; vn[1][1] = vc[1][1]; } const char* nB = has_next ? (const char*)g.Bt + (size_t)nxt.pn * tstep : cB;
        for (int t = 0; t < nt; t += 2) {
            const bool last = (t == nt - 2);
            const char* a1 = cA + (size_t)(t + 1) * kstep;
            const char* a2 = last ? nA : cA + (size_t)(t + 2) * kstep; const char* b2 = last ? nB : cB + (size_t)(t + 2) * kstep;
            const char* a3 = a2 + kstep; const char* b3 = b2 + kstep;
            const unsigned o00 = last ? vn[0][0] : vc[0][0], o01 = last ? vn[0][1] : vc[0][1], o10 = last ? vn[1][0] : vc[1][0], o11 = last ? vn[1][1] : vc[1][1];
            if (last && has_next) S.a_ready(nxt);
            if constexpr (SP2) {
            PG8_LDB(B0, 0, 0); PG8_LDB(B1, 0, 1); PG8_SCHED; PG8_LDA(At, 0, 0); PG8_STAGE_A(PG8_SA(1, 1), a1, vc[1][0], vc[1][1]);
            PG8_WAIT_V(8); PG8_WAIT_L(0); PG8_BAR; PG8_MMA(0, 0, At, B0); PG8_MMA(0, 1, At, B1); PG8_BAR; PG8_SCHED;
            PG8_LDA(At, 0, 1); PG8_STAGE(PG8_SB(0, 0), b2, voffB); PG8_STAGE(PG8_SB(0, 1), b2 + hstep, voffB); PG8_STAGE_A(PG8_SA(0, 0), a2, o00, o01);
            PG8_WAIT_V(8); PG8_WAIT_L(0); PG8_BAR; PG8_MMA(1, 0, At, B0); PG8_MMA(1, 1, At, B1); PG8_BAR; PG8_SCHED;
            PG8_LDB(B0, 1, 0); PG8_LDB(B1, 1, 1); PG8_SCHED; PG8_LDA(At, 1, 0); PG8_STAGE_A(PG8_SA(0, 1), a2, o10, o11);
            PG8_WAIT_V(8); PG8_WAIT_L(0); PG8_BAR; PG8_MMA(0, 0, At, B0); PG8_MMA(0, 1, At, B1); PG8_BAR; PG8_SCHED;
            PG8_LDA(At, 1, 1); PG8_STAGE(PG8_SB(1, 0), b3, voffB); PG8_STAGE(PG8_SB(1, 1), b3 + hstep, voffB); PG8_STAGE_A(PG8_SA(1, 0), a3, o00, o01);
            PG8_WAIT_V(8); PG8_WAIT_L(0); PG8_BAR; PG8_MMA(1, 0, At, B0); PG8_MMA(1, 1, At, B1); PG8_BAR; PG8_SCHED;
            }
        }
        if constexpr (ALIGN_EPI) { if (wr == 0) PG8_BAR; }
        if constexpr (!Epi::AFTER_DRAIN) { E(acc, cur, wr, wc, fr, fq); S.done(cur); }
        if (!has_next) break;
#pragma unroll
        for (int a = 0; a < 2; ++a)
#pragma unroll
            for (int b = 0; b < 2; ++b)
#pragma unroll
                for (int m = 0; m < 4; ++m)
#pragma unroll
                    for (int n = 0; n < 2; ++n) acc[a][b][m][n] = (f32x4){0.f, 0.f, 0.f, 0.f};
        cur = nxt; cA = nA; cB = nB; ++ui; vc[0][0] = vn[0][0]; vc[0][1] = vn[0][1]; vc[1][0] = vn[1][0]; vc[1][1] = vn[1][1];
        if constexpr (ALIGN_EPI) { if (wr == 1) PG8_BAR; }
    }
    PG8_WAIT_V(0);
    if constexpr (!ALIGN_EPI) { if (wr == 0) PG8_BAR; }
    PG8_BAR;
    if constexpr (Epi::AFTER_DRAIN) { E.fused(acc, cur, wr, wc, fr, fq, lds, wid, lane); S.done(cur); }
#undef PG8_GOFF
#undef PG8_STAGE_A
#undef PG8_SA
#undef PG8_SB
#undef PG8_STAGE
#undef PG8_LDA
#undef PG8_LDB
#undef PG8_MMA
#undef PG8_WAIT_V
#undef PG8_WAIT_L
#undef PG8_BAR
#undef PG8_SCHED
}
}

typedef float f32x4 __attribute__((ext_vector_type(4)));
typedef unsigned u32x4 __attribute__((ext_vector_type(4)));
typedef unsigned u32x2 __attribute__((ext_vector_type(2)));
__device__ __forceinline__ unsigned pk2(float lo, float hi) { unsigned r; asm volatile("v_cvt_pk_bf16_f32 %0, %1, %2" : "=v"(r) : "v"(lo), "v"(hi)); return r; }
__device__ __forceinline__ float wave_sum(float v) {
#pragma unroll
    for (int o = 1; o < 64; o <<= 1) v += __shfl_xor(v, o);
    return v;
}
constexpr int F0_SCR = 64 * 65 * 4;
__device__ __forceinline__ void f0_transpose_item(const float* src, int ldw, int c0, int c1, bf16* dst, int K, LAS float* scr, int lane) {
    const float* sp = src + ((lane >> 5) ? c1 : c0) + (lane & 31);
    float v[64];
#pragma unroll
    for (int kk = 0; kk < 64; ++kk) v[kk] = sp[(size_t)kk * ldw];
#pragma unroll
    for (int kk = 0; kk < 64; ++kk) scr[kk * 65 + lane] = v[kk];
    LDS_WAIT(); asm volatile("" ::: "memory");
    const int c = lane & 7;
#pragma unroll
    for (int j = 0; j < 8; ++j) { const int n = (lane >> 3) + 8 * j; const LAS float* s = scr + (8 * c) * 65 + n;
        u32x4 o; o.x = pk2(s[0 * 65], s[1 * 65]); o.y = pk2(s[2 * 65], s[3 * 65]); o.z = pk2(s[4 * 65], s[5 * 65]); o.w = pk2(s[6 * 65], s[7 * 65]);
        *(u32x4*)(dst + (size_t)n * K + 8 * c) = o; }
    LDS_WAIT(); asm volatile("" ::: "memory");
}
template <bool WITH_LR> __device__ __forceinline__ void f0_rows2(const float* x0, const float* g, bf16* o0, const float* w_in, float* glr0, int lane) {
    f32x4 v[2][8]; float ss[2] = {0.f, 0.f};
#pragma unroll
    for (int r = 0; r < 2; ++r)
#pragma unroll
        for (int j = 0; j < 8; ++j) { v[r][j] = ((const f32x4*)(x0 + (size_t)r * D))[lane + 64 * j]; ss[r] += (v[r][j][0] * v[r][j][0] + v[r][j][1] * v[r][j][1]) + (v[r][j][2] * v[r][j][2] + v[r][j][3] * v[r][j][3]); }
    const float rs0 = 1.0f / sqrtf(wave_sum(ss[0]) * (1.0f / D) + EPS), rs1 = 1.0f / sqrtf(wave_sum(ss[1]) * (1.0f / D) + EPS);
    float acc[2][16];
    if (WITH_LR) {
#pragma unroll
        for (int r = 0; r < 2; ++r)
#pragma unroll
            for (int cc = 0; cc < 16; ++cc) acc[r][cc] = 0.f;
    }
#pragma unroll
    for (int j = 0; j < 8; ++j) { const f32x4 gv = ((const f32x4*)g)[lane + 64 * j];
        v[0][j] = v[0][j] * gv * rs0; v[1][j] = v[1][j] * gv * rs1;
        u32x2 w0, w1; w0.x = pk2(v[0][j][0], v[0][j][1]); w0.y = pk2(v[0][j][2], v[0][j][3]); w1.x = pk2(v[1][j][0], v[1][j][1]); w1.y = pk2(v[1][j][2], v[1][j][3]);
        ((u32x2*)o0)[lane + 64 * j] = w0; ((u32x2*)(o0 + D))[lane + 64 * j] = w1;
        if (WITH_LR) {
#pragma unroll
            for (int e = 0; e < 4; ++e) { const float* wp = w_in + (size_t)(4 * (lane + 64 * j) + e) * IN_COLS + O_LR;
                const f32x4 wa = *(const f32x4*)wp, wb = *(const f32x4*)(wp + 4), wc_ = *(const f32x4*)(wp + 8), wd = *(const f32x4*)(wp + 12);
#pragma unroll
                for (int r = 0; r < 2; ++r) { const float xv = v[r][j][e];
#pragma unroll
                    for (int q = 0; q < 4; ++q) { acc[r][q] += xv * wa[q]; acc[r][4 + q] += xv * wb[q]; acc[r][8 + q] += xv * wc_[q]; acc[r][12 + q] += xv * wd[q]; } } }
        }
    }
    if (WITH_LR) {
        float a16[16];
#pragma unroll
        for (int i = 0; i < 16; ++i) { const bool up = (lane & 32) != 0; const float keep = up ? acc[1][i] : acc[0][i], send = up ? acc[0][i] : acc[1][i]; a16[i] = keep + __shfl_xor(send, 32); }
        float a8[8];
#pragma unroll
        for (int i = 0; i < 8; ++i) { const bool up = (lane & 16) != 0; const float keep = up ? a16[8 + i] : a16[i], send = up ? a16[i] : a16[8 + i]; a8[i] = keep + __shfl_xor(send, 16); }
        float a4[4];
#pragma unroll
        for (int i = 0; i < 4; ++i) { const bool up = (lane & 8) != 0; const float keep = up ? a8[4 + i] : a8[i], send = up ? a8[i] : a8[4 + i]; a4[i] = keep + __shfl_xor(send, 8); }
        float a2[2];
#pragma unroll
        for (int i = 0; i < 2; ++i) { const bool up = (lane & 4) != 0; const float keep = up ? a4[2 + i] : a4[i], send = up ? a4[i] : a4[2 + i]; a2[i] = keep + __shfl_xor(send, 4); }
        float a1; { const bool up = (lane & 2) != 0; const float keep = up ? a2[1] : a2[0], send = up ? a2[0] : a2[1]; a1 = keep + __shfl_xor(send, 2); }
        a1 += __shfl_xor(a1, 1);
        if ((lane & 1) == 0) { const int idx = (lane >> 1) & 31; glr0[(size_t)(idx >> 4) * GRK + (idx & 15)] = a1; }
    }
}
struct Ctx;
__device__ __forceinline__ void fast_prologue(const Ctx& c, LAS unsigned char* lds);
#endif

#ifndef HOST_EMU
namespace fa {
typedef short bf16x8 __attribute__((ext_vector_type(8)));
typedef short s16x4 __attribute__((ext_vector_type(4)));
typedef float f32x16 __attribute__((ext_vector_type(16)));
typedef float f32x4 __attribute__((ext_vector_type(4)));
typedef unsigned u32x4 __attribute__((ext_vector_type(4)));
constexpr int TILE_B = 16384;
constexpr int STAGE_B = 4 * TILE_B;
constexpr int XL_OFF = 2 * STAGE_B;
#define FA_SBAR() __builtin_amdgcn_sched_barrier(0)
__device__ __forceinline__ int crow(int r, int hi) { return (r & 3) + 8 * (r >> 2) + 4 * hi; }
__device__ __forceinline__ unsigned cvtpk(float lo, float hi) { unsigned r; asm volatile("v_cvt_pk_bf16_f32 %0, %1, %2" : "=v"(r) : "v"(lo), "v"(hi)); return r; }
__device__ __forceinline__ int v_rd_base(int lane) { return ((lane & 3) << 3) | (((lane >> 2) & 3) << 6) | (((lane >> 4) & 1) << 5) | (((lane >> 5) & 1) << 8); }
constexpr int v_rd_off(int d0, int ks, int half) { return d0 * 512 + ks * 4096 + half * 2048; }
template <int OFF> __device__ __forceinline__ s16x4 tr_read(int vb) { s16x4 r; asm volatile("ds_read_b64_tr_b16 %0, %1 offset:%2" : "=&v"(r) : "v"(vb), "i"(OFF) : "memory"); return r; }

struct DmaOff { unsigned koff0, koff1, voff; };
__device__ __forceinline__ DmaOff dma_offsets(int lane) {
    const int l4 = lane >> 4, c16 = lane & 15, w2 = (lane & 31) >> 2, l5 = lane >> 5; DmaOff o;
    o.koff0 = (unsigned)(l4 * (D / 2) + 8 * (c16 ^ l4)) * 2u; o.koff1 = (unsigned)(l4 * (D / 2) + 8 * (c16 ^ (4 + l4))) * 2u;
    o.voff = (unsigned)(((w2 & 3) + 8 * (w2 >> 2)) * (D / 2) + l5 * 32 + (lane & 3) * 8) * 2u;
    return o;
}
__device__ __forceinline__ void issue_stage(LAS unsigned char* stage, const bf16* DKb, const bf16* DVb, int key_e, int wave, const DmaOff& o) {
    const int tsel = wave >> 2, kv = (wave >> 1) & 1, pb = 8 * (wave & 1), key0 = key_e + 64 * tsel;
    LAS unsigned char* dst = stage + tsel * 2 * TILE_B + kv * TILE_B + 1024 * pb;
    if (kv == 0) {
        const char* base = (const char*)(DKb + (size_t)(key0 + 4 * pb) * (D / 2));
#pragma unroll
        for (int i = 0; i < 8; ++i)
            __builtin_amdgcn_global_load_lds((const unsigned*)(base + (size_t)(4 * i) * (D / 2) * 2 + ((i & 1) ? o.koff1 : o.koff0)), (LAS unsigned*)(dst + 1024 * i), 16, 0, 0);
    } else {
#pragma unroll
        for (int i = 0; i < 8; ++i) { const int p = pb + i, ku = 4 * ((p >> 1) & 1) + 16 * (p >> 2);
            const char* base = (const char*)(DVb + (size_t)(key0 + ku) * (D / 2) + 64 * (p & 1));
            __builtin_amdgcn_global_load_lds((const unsigned*)(base + o.voff), (LAS unsigned*)(dst + 1024 * i), 16, 0, 0); }
    }
}
__device__ __forceinline__ void attn_finish(f32x16 (&o)[4], float l, int wave, float lam, const float* subln_g, bf16* mixw, LAS unsigned char* lds);
template <int KH, bool SHIFT> __device__ __forceinline__ float qk_exp_pack(bf16x8& pa_lo, bf16x8& pa_hi, LAS const unsigned char* Kc  , const bf16x8 (&qr)[4], float negm, int r32, int hi, int sw) {
    f32x16 p;
#pragma unroll
    for (int r = 0; r < 16; ++r) p[r] = 0.f;
#pragma unroll
    for (int d0 = 0; d0 < 4; ++d0) { const int cb = (d0 * 16 + hi * 8) * 2;
        const bf16x8 kf = *(LAS const bf16x8*)(Kc + (32 * KH + r32) * 256 + (cb ^ sw));
        p = __builtin_amdgcn_mfma_f32_32x32x16_bf16(kf, qr[d0], p, 0, 0, 0); }
    float s = 0.f;
#pragma unroll
    for (int r = 0; r < 16; ++r) { p[r] = __builtin_amdgcn_exp2f(SHIFT ? p[r] + negm : p[r]); s += p[r]; }
#define FA_PK4(P, BASE, OUT) do { unsigned a0 = cvtpk(P[BASE + 0], P[BASE + 1]), a1 = cvtpk(P[BASE + 2], P[BASE + 3]); \
    unsigned b0 = cvtpk(P[BASE + 4], P[BASE + 5]), b1 = cvtpk(P[BASE + 6], P[BASE + 7]); \
    auto r0 = __builtin_amdgcn_permlane32_swap(a0, b0, false, false); auto r1 = __builtin_amdgcn_permlane32_swap(a1, b1, false, false); \
    u32x4 w = {r0[0], r1[0], r0[1], r1[1]}; OUT = *reinterpret_cast<bf16x8*>(&w); } while (0)
    FA_PK4(p, 0, pa_lo); FA_PK4(p, 8, pa_hi);
#undef FA_PK4
    return s;
}
template <int D0> __device__ __forceinline__ void pv1(f32x16& oa, int vb, const bf16x8 (&pa)[4]) {
    const s16x4 l0 = tr_read<v_rd_off(D0, 0, 0)>(vb), h0 = tr_read<v_rd_off(D0, 0, 1)>(vb), l1 = tr_read<v_rd_off(D0, 1, 0)>(vb), h1 = tr_read<v_rd_off(D0, 1, 1)>(vb);
    const s16x4 l2 = tr_read<v_rd_off(D0, 2, 0)>(vb), h2 = tr_read<v_rd_off(D0, 2, 1)>(vb), l3 = tr_read<v_rd_off(D0, 3, 0)>(vb), h3 = tr_read<v_rd_off(D0, 3, 1)>(vb);
    asm volatile("s_waitcnt lgkmcnt(0)" ::: "memory"); FA_SBAR();
#define FA_PK(L, H) (bf16x8){L[0], L[1], L[2], L[3], H[0], H[1], H[2], H[3]}
    oa = __builtin_amdgcn_mfma_f32_32x32x16_bf16(pa[0], FA_PK(l0, h0), oa, 0, 0, 0);
    oa = __builtin_amdgcn_mfma_f32_32x32x16_bf16(pa[1], FA_PK(l1, h1), oa, 0, 0, 0);
    oa = __builtin_amdgcn_mfma_f32_32x32x16_bf16(pa[2], FA_PK(l2, h2), oa, 0, 0, 0);
    oa = __builtin_amdgcn_mfma_f32_32x32x16_bf16(pa[3], FA_PK(l3, h3), oa, 0, 0, 0);
#undef FA_PK
}

template <bool SHIFT> __device__ __forceinline__ void attn_unit(int b, int h, int j, const bf16* DQ, const bf16* DK, const bf16* DV, bf16* MIX, const float* subln_g, float lam, float mref, LAS unsigned char* lds) {
    const int tid = threadIdx.x; int lane = tid & 63; asm volatile("" : "+v"(lane));
    const int r32 = lane & 31, hi = lane >> 5; const int wave = __builtin_amdgcn_readfirstlane(tid >> 6);
    const int wq = wave & 3, comp = wave >> 2;
    const size_t rowbase = (size_t)b * SEQ;
    const bf16* DKb = DK + rowbase * (D / 2) + h * 128; const bf16* DVb = DV + rowbase * (D / 2) + h * 128;
    const DmaOff dof = dma_offsets(lane);
    issue_stage(lds, DKb, DVb, 0, wave, dof);
    bf16x8 qr[4];
    { const bf16* Qw = DQ + (rowbase + 128 * j + 32 * wq + r32) * (D / 2) + h * 128 + comp * 64 + hi * 8;
#pragma unroll
      for (int d0 = 0; d0 < 4; ++d0) qr[d0] = *(const bf16x8*)(Qw + d0 * 16); }
    f32x16 o[4];
#pragma unroll
    for (int d = 0; d < 4; ++d)
#pragma unroll
        for (int r = 0; r < 16; ++r) o[d][r] = 0.f;
    float l = 0.f; const float negm = -mref;
    const int last_tile = 2 * j + (wq >> 1);
    const unsigned lds0 = (unsigned)(uintptr_t)lds; const int sw = (r32 & 7) << 4;
    for (int s = 0; s <= j; ++s) {
        asm volatile("s_waitcnt vmcnt(0)" ::: "memory"); __builtin_amdgcn_s_barrier(); asm volatile("" ::: "memory");
        if (s < j) issue_stage(lds + ((s + 1) & 1) * STAGE_B, DKb, DVb, 128 * (s + 1), wave, dof);
#pragma unroll
        for (int ts = 0; ts < 2; ++ts) {
            if (2 * s + ts <= last_tile) {
                LAS const unsigned char* Kc = lds + (s & 1) * STAGE_B + ts * 2 * TILE_B + comp * 128;
                const int vb = (int)(lds0 + (s & 1) * STAGE_B + ts * 2 * TILE_B + TILE_B) + v_rd_base(lane);
                bf16x8 pa[4];
                l += qk_exp_pack<0, SHIFT>(pa[0], pa[1], Kc, qr, negm, r32, hi, sw); FA_SBAR(); l += qk_exp_pack<1, SHIFT>(pa[2], pa[3], Kc, qr, negm, r32, hi, sw); FA_SBAR();
                pv1<0>(o[0], vb, pa); pv1<1>(o[1], vb, pa); pv1<2>(o[2], vb, pa); pv1<3>(o[3], vb, pa);
            }
        }
    }
    asm volatile("s_waitcnt lgkmcnt(0)" ::: "memory"); __builtin_amdgcn_s_barrier(); asm volatile("" ::: "memory");
    attn_finish(o, l, wave, lam, subln_g, MIX + (rowbase + 128 * j + 32 * wq) * D + h * 128, lds);
}
__device__ __forceinline__ void attn_finish(f32x16 (&o)[4], float l, int wave, float lam, const float* subln_g, bf16* mixw, LAS unsigned char* lds) {
    int lane = threadIdx.x & 63; asm volatile("" : "+v"(lane));
    const int r32 = lane & 31, hi = lane >> 5, wq = wave & 3, comp = wave >> 2;
    LAS float* X1 = (LAS float*)lds;
    LAS float* LI = (LAS float*)(lds + XL_OFF) + wave * 32;
    l += __shfl_xor(l, 32);
    if (hi == 0) LI[r32] = (comp ? lam : 1.0f) * __builtin_amdgcn_rcpf(l);
    asm volatile("s_waitcnt lgkmcnt(0)" ::: "memory");
#pragma unroll
    for (int r = 0; r < 16; ++r) { const float inv = LI[crow(r, hi)];
#pragma unroll
        for (int d = 0; d < 4; ++d) o[d][r] *= inv; }
    if (comp == 1) {
#pragma unroll
        for (int d = 0; d < 4; ++d)
#pragma unroll
            for (int r = 0; r < 16; ++r) X1[((wq * 4 + d) * 16 + r) * 64 + lane] = o[d][r];
    }
    asm volatile("s_waitcnt lgkmcnt(0)" ::: "memory"); __builtin_amdgcn_s_barrier(); asm volatile("" ::: "memory");
    if (comp == 0) {
#pragma unroll
        for (int d = 0; d < 4; ++d)
#pragma unroll
            for (int r = 0; r < 16; ++r) { o[d][r] -= X1[((wq * 4 + d) * 16 + r) * 64 + lane]; if ((r & 3) == 3) { asm volatile("s_waitcnt lgkmcnt(0)" ::: "memory"); FA_SBAR(); } }
    }
    asm volatile("s_waitcnt lgkmcnt(0)" ::: "memory"); __builtin_amdgcn_s_barrier(); asm volatile("" ::: "memory");
    if (comp == 0) {
        LAS float* W = (LAS float*)(lds + wq * (32 * 132 * 4));
#pragma unroll
        for (int r = 0; r < 16; ++r) { const int q = crow(r, hi);
#pragma unroll
            for (int d = 0; d < 4; ++d) W[q * 132 + 32 * d + r32] = o[d][r]; }
        asm volatile("s_waitcnt lgkmcnt(0)" ::: "memory");
        const int q = lane >> 1, hf = lane & 1;
        f32x4 v[16]; float ss = 0.f;
#pragma unroll
        for (int i = 0; i < 16; ++i) { v[i] = *(LAS const f32x4*)(W + q * 132 + hf * 64 + 4 * i); ss += (v[i][0] * v[i][0] + v[i][1] * v[i][1]) + (v[i][2] * v[i][2] + v[i][3] * v[i][3]); }
        ss += __shfl_xor(ss, 1);
        const float rs = 0.8f / sqrtf(ss * (1.0f / 128.0f) + EPS);
        bf16* op = mixw + (size_t)q * D + hf * 64;
#pragma unroll
        for (int i = 0; i < 8; ++i) { const f32x4 ga = *(const f32x4*)(subln_g + hf * 64 + 8 * i), gb = *(const f32x4*)(subln_g + hf * 64 + 8 * i + 4);
            const f32x4 a = v[2 * i] * ga * rs, c = v[2 * i + 1] * gb * rs;
            u32x4 w; w.x = cvtpk(a[0], a[1]); w.y = cvtpk(a[2], a[3]); w.z = cvtpk(c[0], c[1]); w.w = cvtpk(c[2], c[3]);
            *(u32x4*)(op + 8 * i) = w; }
    }
    asm volatile("s_waitcnt lgkmcnt(0)" ::: "memory"); __builtin_amdgcn_s_barrier(); asm volatile("" ::: "memory");
}
#undef FA_SBAR
}
#endif

#ifndef HOST_EMU
namespace fg {
typedef short bf16x8 __attribute__((ext_vector_type(8)));
typedef short s16x4 __attribute__((ext_vector_type(4)));
typedef float f32x16 __attribute__((ext_vector_type(16)));
typedef float f32x4 __attribute__((ext_vector_type(4)));
typedef unsigned u32x2 __attribute__((ext_vector_type(2)));
constexpr int IMG = 16384, STAGE_B = 4 * IMG;
constexpr int DEC_OFF = 2 * STAGE_B;
constexpr int SS_OFF = DEC_OFF + 1024;
#define FG_SBAR() __builtin_amdgcn_sched_barrier(0)
__device__ __forceinline__ unsigned cvtpk(float lo, float hi) { unsigned r; asm volatile("v_cvt_pk_bf16_f32 %0, %1, %2" : "=v"(r) : "v"(lo), "v"(hi)); return r; }
__device__ __forceinline__ int v_rd_base(int lane) { return ((lane & 3) << 3) | (((lane >> 2) & 3) << 6) | (((lane >> 4) & 1) << 5) | (((lane >> 5) & 1) << 8); }
constexpr int v_rd_off(int d0, int ks, int half) { return d0 * 512 + ks * 4096 + half * 2048; }
template <int OFF> __device__ __forceinline__ s16x4 tr_read(int vb) { s16x4 r; asm volatile("ds_read_b64_tr_b16 %0, %1 offset:%2" : "=&v"(r) : "v"(vb), "i"(OFF) : "memory"); return r; }
#define FG_PK(L, H) (bf16x8){L[0], L[1], L[2], L[3], H[0], H[1], H[2], H[3]}

__device__ __forceinline__ void issue_chunk(LAS unsigned char* stage, LAS unsigned char* decl, const bf16* GQb, const bf16* KDb, const bf16* GVb, const float* DECc, int wave, int lane) {
    const int img = wave >> 1, pb = 8 * (wave & 1);
    LAS unsigned char* dst = stage + img * IMG + 1024 * pb;
    if (img == 0) {
#pragma unroll
        for (int i = 0; i < 8; ++i) { const int row = 4 * (pb + i) + (lane >> 4), ch = (lane & 15) ^ (row & 15);
            __builtin_amdgcn_global_load_lds((const unsigned*)(GQb + (size_t)row * (D / 4) + 8 * ch), (LAS unsigned*)(dst + 1024 * i), 16, 0, 0); }
    } else {
        const int w2 = (lane & 31) >> 2, kl = (w2 & 3) + 8 * (w2 >> 2), cl = (lane >> 5) * 32 + (lane & 3) * 8;
        const bf16* base = img == 1 ? KDb : GVb + (img - 2) * 128; const int pitch = img == 1 ? D / 4 : D / 2;
#pragma unroll
        for (int i = 0; i < 8; ++i) { const int p = pb + i, k = kl + 4 * ((p >> 1) & 1) + 16 * (p >> 2), cidx = cl + 64 * (p & 1);
            __builtin_amdgcn_global_load_lds((const unsigned*)(base + (size_t)k * pitch + cidx), (LAS unsigned*)(dst + 1024 * i), 16, 0, 0); }
    }
    if (wave == 0 && lane < 32) __builtin_amdgcn_global_load_lds((const unsigned*)(DECc + 4 * lane), (LAS unsigned*)decl, 16, 0, 0);
}

__device__ __forceinline__ void gla_seq(int b, int h, const bf16* GQ, const bf16* KD, const bf16* GV, const bf16* GRb, const float* DEC, const float* gout, bf16* MIX, LAS unsigned char* lds) {
    const int tid = threadIdx.x; int lane = tid & 63; asm volatile("" : "+v"(lane));
    const int r32 = lane & 31, hi = lane >> 5; const int wave = __builtin_amdgcn_readfirstlane(tid >> 6);
    const size_t t00 = (size_t)b * SEQ;
    const bf16* GQb = GQ + t00 * (D / 4) + h * 128; const bf16* KDb = KD + t00 * (D / 4) + h * 128; const bf16* GVb = GV + t00 * (D / 2) + h * 256;
    const float* DECb = DEC + (size_t)(b * NC) * (D / 4) + h * 128;
    const bf16* GRw = GRb + t00 * (D / 2) + h * 256 + 32 * wave + 4 * hi; bf16* MIXw = MIX + t00 * D + D / 2 + h * 256 + 32 * wave + 4 * hi;
    f32x4 gq[4];
#pragma unroll
    for (int g = 0; g < 4; ++g) gq[g] = *(const f32x4*)(gout + 32 * wave + 8 * g + 4 * hi);
    f32x16 S[4];
#pragma unroll
    for (int mb = 0; mb < 4; ++mb)
#pragma unroll
        for (int r = 0; r < 16; ++r) S[mb][r] = 0.f;
    const unsigned lds0 = (unsigned)(uintptr_t)lds;
    LAS float* SS = (LAS float*)(lds + SS_OFF);
    issue_chunk(lds, lds + DEC_OFF, GQb, KDb, GVb, DECb, wave, lane);
    for (int c = 0; c < NC; ++c) {
        asm volatile("s_waitcnt vmcnt(0)" ::: "memory"); __builtin_amdgcn_s_barrier(); asm volatile("" ::: "memory");
        u32x2 grv[2][4];
#pragma unroll
        for (int tb = 0; tb < 2; ++tb)
#pragma unroll
            for (int g = 0; g < 4; ++g) grv[tb][g] = *(const u32x2*)(GRw + (size_t)(64 * c + 32 * tb + r32) * (D / 2) + 8 * g);
        if (c + 1 < NC) issue_chunk(lds + ((c + 1) & 1) * STAGE_B, lds + DEC_OFF + ((c + 1) & 1) * 512, GQb + (size_t)(64 * (c + 1)) * (D / 4), KDb + (size_t)(64 * (c + 1)) * (D / 4),
                                    GVb + (size_t)(64 * (c + 1)) * (D / 2), DECb + (size_t)(c + 1) * (D / 4), wave, lane);
        LAS const unsigned char* st = lds + (c & 1) * STAGE_B;
        { LAS const float* dl = (LAS const float*)(lds + DEC_OFF + (c & 1) * 512) + 4 * hi;
#pragma unroll
          for (int mb = 0; mb < 4; ++mb)
#pragma unroll
              for (int g = 0; g < 4; ++g) { const f32x4 d4 = *(LAS const f32x4*)(dl + 32 * mb + 8 * g);
#pragma unroll
                  for (int e = 0; e < 4; ++e) S[mb][4 * g + e] *= d4[e]; } }
        { const int kb = (int)(lds0 + (c & 1) * STAGE_B + IMG) + v_rd_base(lane), vbse = (int)(lds0 + (c & 1) * STAGE_B + 2 * IMG + (wave >> 2) * IMG + (wave & 3) * 512) + v_rd_base(lane);
#define FG_KS(KS) do { const s16x4 vl = tr_read<v_rd_off(0, KS, 0)>(vbse), vh = tr_read<v_rd_off(0, KS, 1)>(vbse); \
            const s16x4 a0l = tr_read<v_rd_off(0, KS, 0)>(kb), a0h = tr_read<v_rd_off(0, KS, 1)>(kb), a1l = tr_read<v_rd_off(1, KS, 0)>(kb), a1h = tr_read<v_rd_off(1, KS, 1)>(kb); \
            const s16x4 a2l = tr_read<v_rd_off(2, KS, 0)>(kb), a2h = tr_read<v_rd_off(2, KS, 1)>(kb), a3l = tr_read<v_rd_off(3, KS, 0)>(kb), a3h = tr_read<v_rd_off(3, KS, 1)>(kb); \
            asm volatile("s_waitcnt lgkmcnt(0)" ::: "memory"); FG_SBAR(); const bf16x8 vf = FG_PK(vl, vh); \
            S[0] = __builtin_amdgcn_mfma_f32_32x32x16_bf16(FG_PK(a0l, a0h), vf, S[0], 0, 0, 0); S[1] = __builtin_amdgcn_mfma_f32_32x32x16_bf16(FG_PK(a1l, a1h), vf, S[1], 0, 0, 0); \
            S[2] = __builtin_amdgcn_mfma_f32_32x32x16_bf16(FG_PK(a2l, a2h), vf, S[2], 0, 0, 0); S[3] = __builtin_amdgcn_mfma_f32_32x32x16_bf16(FG_PK(a3l, a3h), vf, S[3], 0, 0, 0); } while (0)
          FG_KS(0); FG_KS(1); FG_KS(2); FG_KS(3);
#undef FG_KS
        }
        f32x16 ot[2];
#pragma unroll
        for (int tb = 0; tb < 2; ++tb)
#pragma unroll
            for (int r = 0; r < 16; ++r) ot[tb][r] = 0.f;
#pragma unroll
        for (int mb = 0; mb < 4; ++mb)
#pragma unroll
            for (int s = 0; s < 2; ++s) {
                typedef unsigned u32x4v __attribute__((ext_vector_type(4)));
                u32x4v w; w.x = cvtpk(S[mb][8 * s + 0], S[mb][8 * s + 1]); w.y = cvtpk(S[mb][8 * s + 2], S[mb][8 * s + 3]); w.z = cvtpk(S[mb][8 * s + 4], S[mb][8 * s + 5]); w.w = cvtpk(S[mb][8 * s + 6], S[mb][8 * s + 7]);
                const bf16x8 sa = *reinterpret_cast<bf16x8*>(&w);
                const int ch = 4 * mb + 2 * s;
#pragma unroll
                for (int tb = 0; tb < 2; ++tb) { const int row = 32 * tb + r32;
                    const u32x2 q0 = *(LAS const u32x2*)(st + row * 256 + ((ch ^ (row & 15)) << 4) + 8 * hi), q1 = *(LAS const u32x2*)(st + row * 256 + (((ch + 1) ^ (row & 15)) << 4) + 8 * hi);
                    u32x4v qw; qw.x = q0.x; qw.y = q0.y; qw.z = q1.x; qw.w = q1.y;
                    ot[tb] = __builtin_amdgcn_mfma_f32_32x32x16_bf16(sa, *reinterpret_cast<bf16x8*>(&qw), ot[tb], 0, 0, 0); } }
        float ssq[2];
#pragma unroll
        for (int tb = 0; tb < 2; ++tb) { float a = 0.f;
#pragma unroll
            for (int r = 0; r < 16; ++r) a += ot[tb][r] * ot[tb][r];
            a += __shfl_xor(a, 32); ssq[tb] = a; }
        if (hi == 0) { SS[wave * 64 + r32] = ssq[0]; SS[wave * 64 + 32 + r32] = ssq[1]; }
        asm volatile("s_waitcnt lgkmcnt(0)" ::: "memory"); __builtin_amdgcn_s_barrier(); asm volatile("" ::: "memory");
#pragma unroll
        for (int tb = 0; tb < 2; ++tb) { float a = 0.f;
#pragma unroll
            for (int w8 = 0; w8 < 8; ++w8) a += SS[w8 * 64 + 32 * tb + r32];
            const float rs = 1.0f / sqrtf(a * (1.0f / 256.0f) + EPS);
            bf16* op = MIXw + (size_t)(64 * c + 32 * tb + r32) * D;
#pragma unroll
            for (int g = 0; g < 4; ++g) { float v[4];
#pragma unroll
                for (int e = 0; e < 4; ++e) { const unsigned gw = e < 2 ? grv[tb][g].x : grv[tb][g].y; const float gr = __uint_as_float((e & 1) ? (gw & 0xffff0000u) : (gw << 16));
                    v[e] = ot[tb][4 * g + e] * rs * gq[g][e] * (gr * __builtin_amdgcn_rcpf(1.0f + __expf(-gr))); }
                u32x2 o2; o2.x = cvtpk(v[0], v[1]); o2.y = cvtpk(v[2], v[3]); *(u32x2*)(op + 8 * g) = o2; } }
    }
    asm volatile("s_waitcnt vmcnt(0) lgkmcnt(0)" ::: "memory"); __builtin_amdgcn_s_barrier(); asm volatile("" ::: "memory");
}
#undef FG_PK
#undef FG_SBAR
}
#endif

#ifndef HOST_EMU
namespace fc {
typedef short bf16x8 __attribute__((ext_vector_type(8)));
typedef float f32x16 __attribute__((ext_vector_type(16)));
typedef float f32x4 __attribute__((ext_vector_type(4)));
typedef unsigned u32x4 __attribute__((ext_vector_type(4)));
typedef unsigned u32x2 __attribute__((ext_vector_type(2)));
constexpr int KSL = 32768;
constexpr int PX_OFF = 2 * KSL;
constexpr int MX_OFF = PX_OFF + 65536;
__device__ __forceinline__ unsigned cvtpk(float lo, float hi) { unsigned r; asm volatile("v_cvt_pk_bf16_f32 %0, %1, %2" : "=v"(r) : "v"(lo), "v"(hi)); return r; }
__device__ __forceinline__ int crow(int r, int hi) { return (r & 3) + 8 * (r >> 2) + 4 * hi; }

__device__ __forceinline__ void cross_unit(int b, int h, int rb, const bf16* CQ, const float* CQSS, const bf16* CK2, const bf16* CVT, bf16* CO, LAS unsigned char* lds) {
    const int tid = threadIdx.x; int lane = tid & 63; asm volatile("" : "+v"(lane));
    const int r32 = lane & 31, hi = lane >> 5; const int wave = __builtin_amdgcn_readfirstlane(tid >> 6);
    const int wq = wave & 3, kh = wave >> 2;
    const size_t t0 = (size_t)b * SEQ + 128 * rb + 32 * wq;
    const bf16* Kb = CK2 + (size_t)(b * CH + h) * NMEM * CHD;
    const bf16* Vb = CVT + (size_t)(b * CH + h) * CHD * NMEM;
    const bf16* Qw = CQ + (t0 + r32) * D + h * CHD + hi * 8;
    const unsigned koff = (unsigned)((lane >> 3) * CHD + 8 * ((lane & 7) ^ (lane >> 3))) * 2u;
#define FC_ISSUE_K(sl, stage) do { _Pragma("unroll") for (int i_ = 0; i_ < 4; ++i_) { const int p_ = 4 * wave + i_; \
        __builtin_amdgcn_global_load_lds((const unsigned*)((const char*)(Kb + (size_t)(8 * p_) * CHD + 64 * (sl)) + koff), (LAS unsigned*)(lds + (stage) * KSL + 1024 * p_), 16, 0, 0); } } while (0)
    FC_ISSUE_K(0, 0);
    float rq; { const f32x4 a = *(const f32x4*)(CQSS + (t0 + r32) * 32 + 8 * h), c4 = *(const f32x4*)(CQSS + (t0 + r32) * 32 + 8 * h + 4);
        rq = 1.0f / sqrtf((((a[0] + a[1]) + (a[2] + a[3])) + ((c4[0] + c4[1]) + (c4[2] + c4[3]))) * (1.0f / CHD) + EPS); }
    f32x16 sc[4];
#pragma unroll
    for (int i = 0; i < 4; ++i)
#pragma unroll
        for (int r = 0; r < 16; ++r) sc[i][r] = 0.f;
    const int sw = (r32 & 7) << 4;
    for (int sl = 0; sl < 8; ++sl) {
        asm volatile("s_waitcnt vmcnt(0)" ::: "memory"); __builtin_amdgcn_s_barrier(); asm volatile("" ::: "memory");
        bf16x8 qf[4];
#pragma unroll
        for (int d0 = 0; d0 < 4; ++d0) qf[d0] = *(const bf16x8*)(Qw + 64 * sl + 16 * d0);
        if (sl + 1 < 8) FC_ISSUE_K(sl + 1, (sl + 1) & 1);
        LAS const unsigned char* Ks = lds + (sl & 1) * KSL + (128 * kh + r32) * 128;
#pragma unroll
        for (int d0 = 0; d0 < 4; ++d0) { const int cb = (16 * d0 + 8 * hi) * 2;
#pragma unroll
            for (int i = 0; i < 4; ++i) { const bf16x8 kf = *(LAS const bf16x8*)(Ks + 32 * i * 128 + (cb ^ sw));
                sc[i] = __builtin_amdgcn_mfma_f32_32x32x16_bf16(kf, qf[d0], sc[i], 0, 0, 0); } }
    }
#undef FC_ISSUE_K
    LAS float* MX = (LAS float*)(lds + MX_OFF); LAS float* LX = MX + 256;
    float mx = -3.0e38f;
#pragma unroll
    for (int i = 0; i < 4; ++i)
#pragma unroll
        for (int r = 0; r < 16; ++r) { sc[i][r] *= rq; mx = fmaxf(mx, sc[i][r]); }
    mx = fmaxf(mx, __shfl_xor(mx, 32));
    if (hi == 0) MX[wave * 32 + r32] = mx;
    asm volatile("s_waitcnt lgkmcnt(0)" ::: "memory"); __builtin_amdgcn_s_barrier(); asm volatile("" ::: "memory");
    mx = fmaxf(mx, MX[(wave ^ 4) * 32 + r32]);
    float ls = 0.f;
#pragma unroll
    for (int i = 0; i < 4; ++i)
#pragma unroll
        for (int r = 0; r < 16; ++r) { sc[i][r] = __builtin_amdgcn_exp2f(sc[i][r] - mx); ls += sc[i][r]; }
    ls += __shfl_xor(ls, 32);
    if (hi == 0) LX[wave * 32 + r32] = ls;
    bf16x8 pall[16];
    LAS unsigned char* PXw = lds + PX_OFF + wave * 8192;
#define FC_PK4(P, BASE, OUT) do { unsigned a0 = cvtpk(P[BASE + 0], P[BASE + 1]), a1 = cvtpk(P[BASE + 2], P[BASE + 3]); \
    unsigned b0 = cvtpk(P[BASE + 4], P[BASE + 5]), b1 = cvtpk(P[BASE + 6], P[BASE + 7]); \
    auto r0 = __builtin_amdgcn_permlane32_swap(a0, b0, false, false); auto r1 = __builtin_amdgcn_permlane32_swap(a1, b1, false, false); \
    u32x4 w_ = {r0[0], r1[0], r0[1], r1[1]}; OUT = *reinterpret_cast<bf16x8*>(&w_); } while (0)
#pragma unroll
    for (int i = 0; i < 4; ++i) { bf16x8 f0, f1; FC_PK4(sc[i], 0, f0); FC_PK4(sc[i], 8, f1);
        *(LAS bf16x8*)(PXw + (2 * i) * 1024 + lane * 16) = f0; *(LAS bf16x8*)(PXw + (2 * i + 1) * 1024 + lane * 16) = f1;
        if (kh == 0) { pall[2 * i] = f0; pall[2 * i + 1] = f1; } else { pall[8 + 2 * i] = f0; pall[8 + 2 * i + 1] = f1; } }
#undef FC_PK4
#define FC_ISSUE_V(blk, stage) do { _Pragma("unroll") for (int i_ = 0; i_ < 4; ++i_) { const int p_ = 4 * wave + i_, half_ = p_ >> 4, row_ = 2 * (p_ & 15) + (lane >> 5), ch_ = (lane & 31) ^ row_; \
        __builtin_amdgcn_global_load_lds((const unsigned*)(Vb + (size_t)(256 * half_ + 32 * (blk) + row_) * NMEM + 8 * ch_), (LAS unsigned*)(lds + (stage) * KSL + 1024 * p_), 16, 0, 0); } } while (0)
    FC_ISSUE_V(0, 0);
    asm volatile("s_waitcnt lgkmcnt(0)" ::: "memory"); __builtin_amdgcn_s_barrier(); asm volatile("" ::: "memory");
    { LAS const unsigned char* PXp = lds + PX_OFF + (wave ^ 4) * 8192;
#pragma unroll
      for (int f = 0; f < 8; ++f) { const bf16x8 v = *(LAS const bf16x8*)(PXp + f * 1024 + lane * 16); if (kh == 0) pall[8 + f] = v; else pall[f] = v; } }
    const float linv = __builtin_amdgcn_rcpf(ls + LX[(wave ^ 4) * 32 + r32]);
    bf16* Ow = CO + (t0 + r32) * D + h * CHD + 256 * kh + 4 * hi;
    for (int blk = 0; blk < 8; ++blk) {
        asm volatile("s_waitcnt vmcnt(0)" ::: "memory"); __builtin_amdgcn_s_barrier(); asm volatile("" ::: "memory");
        if (blk + 1 < 8) FC_ISSUE_V(blk + 1, (blk + 1) & 1);
        LAS const unsigned char* Vs = lds + (blk & 1) * KSL + kh * 16384 + r32 * 512;
        f32x16 o;
#pragma unroll
        for (int r = 0; r < 16; ++r) o[r] = 0.f;
#pragma unroll
        for (int ks = 0; ks < 16; ++ks) { const bf16x8 vf = *(LAS const bf16x8*)(Vs + (((2 * ks + hi) ^ r32) << 4));
            o = __builtin_amdgcn_mfma_f32_32x32x16_bf16(vf, pall[ks], o, 0, 0, 0); }
#pragma unroll
        for (int g = 0; g < 4; ++g) { u32x2 w2; w2.x = cvtpk(o[4 * g] * linv, o[4 * g + 1] * linv); w2.y = cvtpk(o[4 * g + 2] * linv, o[4 * g + 3] * linv);
            *(u32x2*)(Ow + 32 * blk + 8 * g) = w2; }
    }
#undef FC_ISSUE_V
    asm volatile("s_waitcnt vmcnt(0) lgkmcnt(0)" ::: "memory"); __builtin_amdgcn_s_barrier(); asm volatile("" ::: "memory");
}
}
#endif

struct Ctx {
    const float *x, *mem; const int* positions; const float *g_attn, *w_in, *q_norm_g, *k_norm_g, *lq1, *lk1, *lq2, *lk2, *subln_g, *w_a2, *b_a, *gla_out_g, *w_out, *g_cross, *g_mem, *w_cq, *w_ckv, *cq_g, *ck_g, *w_co,
        *g_ffn, *w_rg, *b_rg, *w_re, *b_re, *w_gate, *w_up, *w_down;
    float* out; char* ws;
};
#define WSP(T_, off) ((T_*)(c.ws + (off)))
#ifndef HOST_EMU
__device__ __forceinline__ void f0_wrt(const Ctx& c, bf16* WRT);
__device__ __forceinline__ void fast_prologue(const Ctx& c, LAS unsigned char* lds) {
    const int tid = threadIdx.x, lane = tid & 63, wave = __builtin_amdgcn_readfirstlane(tid >> 6);
    const int gw = blockIdx.x * 8 + wave, NGW = gridDim.x * 8;
    LAS float* scr = (LAS float*)(lds + wave * F0_SCR);
    int* ctl = WSP(int, WS_CTL); float* lamp = (float*)(ctl + 16);
    bf16 *WIN = WSP(bf16, WS_WIN), *WOUT = WSP(bf16, WS_WOUT), *WCQ = WSP(bf16, WS_WCQ), *WCKV = WSP(bf16, WS_WCKV), *WCO = WSP(bf16, WS_WCO);
    bf16 *WGU = WSP(bf16, WS_WGU), *WD = WSP(bf16, WS_WD), *XN = WSP(bf16, WS_XN), *MEMN = WSP(bf16, WS_MEMN);
    float* GLR = WSP(float, WS_SMALL + SM_GLR); int* SLOTTOK = WSP(int, WS_SMALL + SM_SLOTTOK); float* SLOTGATE = WSP(float, WS_SMALL + SM_SLOTGATE); float* ROPE = WSP(float, WS_SMALL + SM_ROPE);
    for (int it = gw; it < T / 2; it += NGW) f0_rows2<true>(c.x + (size_t)it * 2 * D, c.g_attn, XN + (size_t)it * 2 * D, c.w_in, GLR + (size_t)it * 2 * GRK, lane);
    for (int it = gw; it < B * NMEM / 2; it += NGW) f0_rows2<false>(c.mem + (size_t)it * 2 * D, c.g_mem, MEMN + (size_t)it * 2 * D, nullptr, nullptr, lane);
    constexpr int KB = D / 64, KBD = DE / 64;
    constexpr int I_WIN = (NIN / 64) * KB, I_SQ = (D / 64) * KB, I_CKV = (2 * D / 64) * KB, I_GU = NE * (2 * DE / 64) * KB, I_DN = NE * (D / 64) * KBD;
    constexpr int NITEMS = I_WIN + 3 * I_SQ + I_CKV + I_GU + I_DN;
    for (int it = gw; it < NITEMS; it += NGW) {
        int r = it;
        if (r < I_WIN) { const int kb = r % KB, n0 = (r / KB) * 64; f0_transpose_item(c.w_in + (size_t)kb * 64 * IN_COLS, IN_COLS, win_src_col(n0), win_src_col(n0 + 32), WIN + (size_t)n0 * D + kb * 64, D, scr, lane); continue; } r -= I_WIN;
        if (r < I_SQ) { const int kb = r % KB, n0 = (r / KB) * 64; f0_transpose_item(c.w_out + (size_t)kb * 64 * D, D, n0, n0 + 32, WOUT + (size_t)n0 * D + kb * 64, D, scr, lane); continue; } r -= I_SQ;
        if (r < I_SQ) { const int kb = r % KB, n0 = (r / KB) * 64; f0_transpose_item(c.w_cq + (size_t)kb * 64 * D, D, n0, n0 + 32, WCQ + (size_t)n0 * D + kb * 64, D, scr, lane); continue; } r -= I_SQ;
        if (r < I_SQ) { const int kb = r % KB, n0 = (r / KB) * 64; f0_transpose_item(c.w_co + (size_t)kb * 64 * D, D, n0, n0 + 32, WCO + (size_t)n0 * D + kb * 64, D, scr, lane); continue; } r -= I_SQ;
        if (r < I_CKV) { const int kb = r % KB, n0 = (r / KB) * 64; f0_transpose_item(c.w_ckv + (size_t)kb * 64 * 2 * D, 2 * D, n0, n0 + 32, WCKV + (size_t)n0 * D + kb * 64, D, scr, lane); continue; } r -= I_CKV;
        if (r < I_GU) { const int kb = r % KB, r0 = ((r / KB) % (2 * DE / 64)) * 64, e = r / (KB * (2 * DE / 64)); const int pn = r0 / 256, ii = r0 % 256; const float* W = (ii < 128) ? c.w_gate : c.w_up; const int col = pn * 128 + (ii & 127);
            f0_transpose_item(W + ((size_t)e * D + kb * 64) * DE, DE, col, col + 32, WGU + ((size_t)e * 2 * DE + r0) * D + kb * 64, D, scr, lane); continue; } r -= I_GU;
        { const int kb = r % KBD, n0 = ((r / KBD) % (D / 64)) * 64, e = r / (KBD * (D / 64));
          f0_transpose_item(c.w_down + ((size_t)e * DE + kb * 64) * D, D, n0, n0 + 32, WD + ((size_t)e * D + n0) * DE + kb * 64, DE, scr, lane); }
    }
    nk_rope_table(c.positions, ROPE); nk_lam(c.lq1, c.lk1, c.lq2, c.lk2, lamp); nk_mref(c.q_norm_g, c.k_norm_g, lamp + 1);
    nk_zero_bf16(XN + (size_t)T * D, (size_t)D); nk_moe_init_slots(SLOTTOK, SLOTGATE); f0_wrt(c, WSP(bf16, WS_SMALL + SM_WRT));
}
#endif
#ifndef HOST_EMU
__device__ __forceinline__ void f0_wrt(const Ctx& c, bf16* WRT) {
    for (size_t i = gtid(); i < (size_t)48 * D; i += gnth()) { const int k = (int)(i % D), j = (int)(i / D);
        const float w = j < NG ? c.w_rg[(size_t)k * NG + j] : (j < NG + NE ? c.w_re[(size_t)k * NE + (j - NG)] : 0.f); WRT[i] = f2bf(w); }
}
__device__ __forceinline__ void fast_router(const Ctx& c, LAS unsigned char* lds) {
    typedef short bf16x8 __attribute__((ext_vector_type(8)));
    const int tid = threadIdx.x, lane = tid & 63, wave = __builtin_amdgcn_readfirstlane(tid >> 6), r = lane & 15, kq = lane >> 4;
    LAS float* red = (LAS float*)lds;
    LAS float* lg = (LAS float*)(lds + 8 * 32 * 48 * 4);
    const bf16* XN = WSP(bf16, WS_XN); const bf16* WRT = WSP(bf16, WS_SMALL + SM_WRT); const float* SSP2 = WSP(float, WS_SMALL + SM_SSP2);
    int* ctl = WSP(int, WS_CTL); int* EXPERT = WSP(int, WS_SMALL + SM_EXPERT); float* GATE = WSP(float, WS_SMALL + SM_GATE); int* SLOTPOS = WSP(int, WS_SMALL + SM_SLOTPOS);
    for (int ub = blockIdx.x; ub < T / 32; ub += gridDim.x) {
        const int row0 = ub * 32, k0 = wave * 256;
        f32x4 acc[2][3];
#pragma unroll
        for (int mb = 0; mb < 2; ++mb)
#pragma unroll
            for (int nb = 0; nb < 3; ++nb) acc[mb][nb] = (f32x4){0.f, 0.f, 0.f, 0.f};
#pragma unroll
        for (int st = 0; st < 8; ++st) { bf16x8 a[2], b[3];
#pragma unroll
            for (int mb = 0; mb < 2; ++mb) a[mb] = *(const bf16x8*)(XN + (size_t)(row0 + 16 * mb + r) * D + k0 + 32 * st + 8 * kq);
#pragma unroll
            for (int nb = 0; nb < 3; ++nb) b[nb] = *(const bf16x8*)(WRT + (size_t)(16 * nb + r) * D + k0 + 32 * st + 8 * kq);
#pragma unroll
            for (int mb = 0; mb < 2; ++mb)
#pragma unroll
                for (int nb = 0; nb < 3; ++nb) acc[mb][nb] = __builtin_amdgcn_mfma_f32_16x16x32_bf16(a[mb], b[nb], acc[mb][nb], 0, 0, 0); }
#pragma unroll
        for (int mb = 0; mb < 2; ++mb)
#pragma unroll
            for (int nb = 0; nb < 3; ++nb)
#pragma unroll
                for (int q = 0; q < 4; ++q) red[(wave * 32 + 16 * mb + 4 * kq + q) * 48 + 16 * nb + r] = acc[mb][nb][q];
        __syncthreads();
        { const int row = tid >> 4, q = tid & 15;
          float ps = SSP2[(size_t)(row0 + row) * 32 + 2 * q] + SSP2[(size_t)(row0 + row) * 32 + 2 * q + 1];
          ps += __shfl_xor(ps, 1); ps += __shfl_xor(ps, 2); ps += __shfl_xor(ps, 4); ps += __shfl_xor(ps, 8);
          const float rs = 1.0f / sqrtf(ps * (1.0f / D) + EPS);
#pragma unroll
          for (int j = 0; j < 3; ++j) { const int col = q + 16 * j; float sacc = 0.f;
#pragma unroll
              for (int w = 0; w < 8; ++w) sacc += red[(w * 32 + row) * 48 + col];
              const float bias = col < NG ? c.b_rg[col] : (col < NG + NE ? c.b_re[col - NG] : 0.f);
              lg[row * 48 + col] = sacc * rs + bias; } }
        __syncthreads();
        if (tid < 32) { const int t = row0 + tid; const LAS float* L = lg + tid * 48;
            float gl[NG], el[NE];
#pragma unroll
            for (int j = 0; j < NG; ++j) gl[j] = L[j];
#pragma unroll
            for (int j = 0; j < NE; ++j) el[j] = L[NG + j];
            int grp = 0; float gm = gl[0];
#pragma unroll
            for (int j = 1; j < NG; ++j) if (gl[j] > gm) { gm = gl[j]; grp = j; }
            float gs = 0.f;
#pragma unroll
            for (int j = 0; j < NG; ++j) gs += __expf(gl[j] - gm);
            const float grp_w = 1.0f / gs;
            float e8[EPG];
#pragma unroll
            for (int j = 0; j < EPG; ++j) { float v = 0.f;
#pragma unroll
                for (int gq = 0; gq < NG; ++gq) v = (grp == gq) ? el[gq * EPG + j] : v;
                e8[j] = v; }
            int i0 = 0; float v0 = e8[0];
#pragma unroll
            for (int j = 1; j < EPG; ++j) if (e8[j] > v0) { v0 = e8[j]; i0 = j; }
            int i1 = -1; float v1 = -1e30f;
#pragma unroll
            for (int j = 0; j < EPG; ++j) if (j != i0 && e8[j] > v1) { v1 = e8[j]; i1 = j; }
            const float rr = __expf(v1 - v0); const float g0 = grp_w / (1.f + rr), g1 = grp_w * rr / (1.f + rr);
            const int e0 = grp * EPG + i0, e1 = grp * EPG + i1;
            EXPERT[t * 2] = e0; EXPERT[t * 2 + 1] = e1; GATE[t * 2] = g0; GATE[t * 2 + 1] = g1;
            SLOTPOS[t * 2] = atomicAdd(&ctl[CW_CNT + e0], 1); SLOTPOS[t * 2 + 1] = atomicAdd(&ctl[CW_CNT + e1], 1); }
        __syncthreads();
    }
}
#endif

#ifndef HOST_EMU
__device__ __forceinline__ void fast_gla_prep(const Ctx& c, LAS unsigned char* lds) {
    constexpr int W = GH * GKD; static_assert(W == 512, "one thread per gate column");
    const float* GLR = WSP(float, WS_SMALL + SM_GLR); const bf16* GK = (const bf16*)(c.ws + WS_B + B_GK); bf16* KD = WSP(bf16, WS_D); float* DEC = WSP(float, WS_SMALL + SM_DEC);
    LAS float* gl = (LAS float*)lds;
    const int j = threadIdx.x;
    float w[GRK];
#pragma unroll
    for (int r = 0; r < GRK; ++r) w[r] = c.w_a2[(size_t)r * W + j];
    const float bj = c.b_a[j];
    for (int cb = (int)blockIdx.x; cb < B * NC; cb += (int)gridDim.x) {
        __syncthreads();
        for (int i = threadIdx.x; i < CHUNK * GRK / 4; i += 512) ((LAS f32x4*)gl)[i] = ((const f32x4*)(GLR + (size_t)cb * CHUNK * GRK))[i];
        __syncthreads();
        float run = 0.f;
        for (int tt = 0; tt < CHUNK; ++tt) { float z = bj;
#pragma unroll
            for (int q = 0; q < 4; ++q) { const f32x4 g4 = ((LAS const f32x4*)gl)[tt * 4 + q]; z += g4[0] * w[4 * q] + g4[1] * w[4 * q + 1] + g4[2] * w[4 * q + 2] + g4[3] * w[4 * q + 3]; }
            run += (fminf(z, 0.f) - __logf(1.0f + __expf(-fabsf(z)))) * (1.0f / 16.0f); }
        const float end = run; DEC[(size_t)cb * W + j] = __expf(end); run = 0.f;
        for (int tt = 0; tt < CHUNK; ++tt) { const size_t t = (size_t)cb * CHUNK + tt; float z = bj;
#pragma unroll
            for (int q = 0; q < 4; ++q) { const f32x4 g4 = ((LAS const f32x4*)gl)[tt * 4 + q]; z += g4[0] * w[4 * q] + g4[1] * w[4 * q + 1] + g4[2] * w[4 * q + 2] + g4[3] * w[4 * q + 3]; }
            run += (fminf(z, 0.f) - __logf(1.0f + __expf(-fabsf(z)))) * (1.0f / 16.0f);
            KD[t * W + j] = f2bf(bf2f(GK[t * W + j]) * __expf(end - run)); }
    }
}
__device__ __forceinline__ void fast_ckv_fix(const Ctx& c) {
    const bf16* CKV = WSP(bf16, WS_SMALL + SM_CKV); bf16* CK2 = WSP(bf16, WS_SMALL + SM_CK2); bf16* CVT = WSP(bf16, WS_SMALL + SM_CVT);
    const int lane = threadIdx.x & 63, gw = blockIdx.x * 8 + (threadIdx.x >> 6), NGW = gridDim.x * 8;
    for (int it = gw; it < B * NMEM * CH; it += NGW) { const int h = it % CH, bm = it / CH, b = bm / NMEM, m = bm % NMEM;
        const u32x4 kw = *(const u32x4*)(CKV + (size_t)bm * 2 * D + h * CHD + 8 * lane), vw = *(const u32x4*)(CKV + (size_t)bm * 2 * D + D + h * CHD + 8 * lane);
        float kf[8]; const unsigned kk[4] = {kw.x, kw.y, kw.z, kw.w}; float ss = 0.f;
#pragma unroll
        for (int q = 0; q < 4; ++q) { kf[2 * q] = __uint_as_float(kk[q] << 16); kf[2 * q + 1] = __uint_as_float(kk[q] & 0xffff0000u); ss += kf[2 * q] * kf[2 * q] + kf[2 * q + 1] * kf[2 * q + 1]; }
        ss = wave_sum(ss);
        const float rs = 1.0f / sqrtf(ss * (1.0f / CHD) + EPS) * (1.0f / sqrtf((float)CHD)) * LOG2E;
        const f32x4 ka = *(const f32x4*)(c.ck_g + 8 * lane), kb = *(const f32x4*)(c.ck_g + 8 * lane + 4), qa = *(const f32x4*)(c.cq_g + 8 * lane), qb = *(const f32x4*)(c.cq_g + 8 * lane + 4);
        u32x4 o; o.x = pk2(kf[0] * rs * ka[0] * qa[0], kf[1] * rs * ka[1] * qa[1]); o.y = pk2(kf[2] * rs * ka[2] * qa[2], kf[3] * rs * ka[3] * qa[3]);
        o.z = pk2(kf[4] * rs * kb[0] * qb[0], kf[5] * rs * kb[1] * qb[1]); o.w = pk2(kf[6] * rs * kb[2] * qb[2], kf[7] * rs * kb[3] * qb[3]);
        *(u32x4*)(CK2 + (((size_t)b * CH + h) * NMEM + m) * CHD + 8 * lane) = o;
        bf16* vt = CVT + (((size_t)b * CH + h) * CHD + 8 * lane) * NMEM + m; const unsigned vv[4] = {vw.x, vw.y, vw.z, vw.w};
#pragma unroll
        for (int q = 0; q < 4; ++q) { vt[(size_t)(2 * q) * NMEM] = (bf16)(vv[q] & 0xffffu); vt[(size_t)(2 * q + 1) * NMEM] = (bf16)(vv[q] >> 16); }
    }
}
__device__ __forceinline__ void fast_moe_fill(const Ctx& c) {
    int* ctl = WSP(int, WS_CTL); const int* EXPERT = WSP(int, WS_SMALL + SM_EXPERT); const float* GATE = WSP(float, WS_SMALL + SM_GATE); int* SLOTPOS = WSP(int, WS_SMALL + SM_SLOTPOS);
    int* SLOTTOK = WSP(int, WS_SMALL + SM_SLOTTOK); float* SLOTGATE = WSP(float, WS_SMALL + SM_SLOTGATE);
    if (blockIdx.x == 0 && threadIdx.x < NE) { const int e = threadIdx.x; int base = 0, nt0 = 0;
        for (int q = 0; q < e; ++q) { const int n = (ctl[CW_CNT + q] + ETILE - 1) / ETILE; nt0 += n; base += n * ETILE; }
        const int n = (ctl[CW_CNT + e] + ETILE - 1) / ETILE; for (int q = 0; q < n; ++q) ctl[CW_TILE_E + nt0 + q] = e;
        ctl[CW_BASE + e] = base; if (e == NE - 1) { ctl[CW_BASE + NE] = base + n * ETILE; ctl[CW_NTILES] = nt0 + n; } }
    for (size_t i = gtid(); i < (size_t)T * 2; i += gnth()) { const int e = EXPERT[i]; int base = 0;
        for (int q = 0; q < e; ++q) base += ((ctl[CW_CNT + q] + ETILE - 1) / ETILE) * ETILE;
        const int dst = base + SLOTPOS[i]; SLOTTOK[dst] = (int)(i >> 1); SLOTGATE[dst] = GATE[i]; SLOTPOS[i] = dst; }
}
__device__ __forceinline__ void fast_moe_gather(const Ctx& c) {
    const int* SLOTPOS = WSP(int, WS_SMALL + SM_SLOTPOS); const bf16* Y = WSP(bf16, WS_C);
    const int lane = threadIdx.x & 63, gw = blockIdx.x * 8 + (threadIdx.x >> 6), NGW = gridDim.x * 8;
    for (int t = gw; t < T; t += NGW) { const int s0 = SLOTPOS[2 * t], s1 = SLOTPOS[2 * t + 1];
        const u32x4* y0 = (const u32x4*)(Y + (size_t)s0 * D); const u32x4* y1 = (const u32x4*)(Y + (size_t)s1 * D); f32x4* o = (f32x4*)(c.out + (size_t)t * D);
#pragma unroll
        for (int q = 0; q < 4; ++q) { const u32x4 a = y0[lane + 64 * q], b2 = y1[lane + 64 * q]; f32x4 v0 = o[2 * (lane + 64 * q)], v1 = o[2 * (lane + 64 * q) + 1];
            v0[0] += __uint_as_float(a.x << 16) + __uint_as_float(b2.x << 16); v0[1] += __uint_as_float(a.x & 0xffff0000u) + __uint_as_float(b2.x & 0xffff0000u);
            v0[2] += __uint_as_float(a.y << 16) + __uint_as_float(b2.y << 16); v0[3] += __uint_as_float(a.y & 0xffff0000u) + __uint_as_float(b2.y & 0xffff0000u);
            v1[0] += __uint_as_float(a.z << 16) + __uint_as_float(b2.z << 16); v1[1] += __uint_as_float(a.z & 0xffff0000u) + __uint_as_float(b2.z & 0xffff0000u);
            v1[2] += __uint_as_float(a.w << 16) + __uint_as_float(b2.w << 16); v1[3] += __uint_as_float(a.w & 0xffff0000u) + __uint_as_float(b2.w & 0xffff0000u);
            o[2 * (lane + 64 * q)] = v0; o[2 * (lane + 64 * q) + 1] = v1; } }
}
#endif
#ifdef HOST_EMU
#define FAST_P0 0
#define FAST_P1 0
#define FAST_P6 0
#define FAST_P13 0
#define FAST_MOE 0
#define FAST_ATT 0
#define FAST_GLA 0
#define FAST_CROSS 0
typedef unsigned char* LdsPtr;
#else
#ifndef FAST_P0
#define FAST_P0 1
#endif
#ifndef FAST_P1
#define FAST_P1 1
#endif
#ifndef FAST_P6
#define FAST_P6 1
#endif
#ifndef FAST_P13
#define FAST_P13 1
#endif
#ifndef FAST_ATT
#define FAST_ATT 1
#endif
#ifndef FAST_GLA
#define FAST_GLA 1
#endif
#ifndef FAST_CROSS
#define FAST_CROSS 1
#endif
#ifndef FAST_MOE
#define FAST_MOE 1
#endif
typedef LAS unsigned char* LdsPtr;
#endif
constexpr int N_PHASES = 18;
template <int P, int QPASS = 0> __device__ __forceinline__ void run_phase(const Ctx& c, LdsPtr lds) {
    int* ctl = WSP(int, WS_CTL); float* lamp = (float*)(ctl + 16);
    bf16 *WIN = WSP(bf16, WS_WIN), *WOUT = WSP(bf16, WS_WOUT), *WCQ = WSP(bf16, WS_WCQ), *WCKV = WSP(bf16, WS_WCKV), *WCO = WSP(bf16, WS_WCO);
    bf16 *WGU = WSP(bf16, WS_WGU), *WD = WSP(bf16, WS_WD), *XN = WSP(bf16, WS_XN), *MEMN = WSP(bf16, WS_MEMN);
    float* SSP1 = WSP(float, WS_SMALL + SM_SSP1); float* SSP2 = WSP(float, WS_SMALL + SM_SSP2); (void)SSP1; (void)SSP2;
    float* GLR = WSP(float, WS_SMALL + SM_GLR); float* CQSS = WSP(float, WS_SMALL + SM_CQSS); int* EXPERT = WSP(int, WS_SMALL + SM_EXPERT); float* GATE = WSP(float, WS_SMALL + SM_GATE);
    int* SLOTPOS = WSP(int, WS_SMALL + SM_SLOTPOS); int* SLOTTOK = WSP(int, WS_SMALL + SM_SLOTTOK); float* SLOTGATE = WSP(float, WS_SMALL + SM_SLOTGATE); float* ROPE = WSP(float, WS_SMALL + SM_ROPE);
    bf16 *CKV = WSP(bf16, WS_SMALL + SM_CKV), *CK2 = WSP(bf16, WS_SMALL + SM_CK2), *CVT = WSP(bf16, WS_SMALL + SM_CVT); float* STATS = WSP(float, WS_SMALL + SM_STATS);
    char* rb = c.ws + WS_B;
    bf16 *DQ = (bf16*)(rb + B_DQ), *DK = (bf16*)(rb + B_DK), *DV = (bf16*)(rb + B_DV), *GQ = (bf16*)(rb + B_GQ), *GK = (bf16*)(rb + B_GK), *GV = (bf16*)(rb + B_GV), *GRb = (bf16*)(rb + B_GR);
    bf16 *CQ = (bf16*)(rb + B_CQ), *CO = (bf16*)(rb + B_CO), *HE = (bf16*)(rb + B_HE);
    bf16* MIX = WSP(bf16, WS_C);
    float* TMPQK = WSP(float, WS_C);
    float* PTMP = WSP(float, WS_C);
    float* CUM = WSP(float, WS_D);
    float* OTMPD = WSP(float, WS_D + al256((size_t)T * D));
    float* OTMPG = WSP(float, WS_D + al256((size_t)T * D) * 3);
    float* out = c.out; (void)lds; (void)TMPQK; (void)WIN;
    if constexpr (P == 0) {
#if FAST_P0
        fast_prologue(c, lds);
#else
        nk_conv_win(c.w_in, WIN);
        nk_convT(c.w_out, D, 0, WOUT, D, D); nk_convT(c.w_cq, D, 0, WCQ, D, D); nk_convT(c.w_ckv, 2 * D, 0, WCKV, 2 * D, D); nk_convT(c.w_co, D, 0, WCO, D, D);
        nk_conv_gu(c.w_gate, c.w_up, WGU); nk_conv_d(c.w_down, WD);
        nk_rope_table(c.positions, ROPE); nk_lam(c.lq1, c.lk1, c.lq2, c.lk2, lamp);
        nk_zero_bf16(XN + (size_t)T * D, (size_t)D); nk_moe_init_slots(SLOTTOK, SLOTGATE);
        nk_rmsnorm_rows(c.x, c.g_attn, XN, T, D); nk_rmsnorm_rows(c.mem, c.g_mem, MEMN, B * NMEM, D);
        nk_glr(c.x, c.g_attn, c.w_in, GLR);
#endif
    } else if constexpr (P == 1) {
#if FAST_P1
        pg8::Gemm g{XN, WIN, T, NIN, D}; pg8::StaticOrder S; S.init(T, NIN, (int)gridDim.x, (int)blockIdx.x);
        pg8::EpiInProj E{rb, ROPE, c.q_norm_g, c.k_norm_g};
        pg8::gemm_phase<pg8::EpiInProj, pg8::StaticOrder, true, true>(lds, g, S, E);
#else
        { GemmP p{XN, WIN, T, NIN, D, 0, TMPQK, nullptr, (bf16*)rb, nullptr}; nk_gemm<0>(p); }
#endif
    } else if constexpr (P == 2) {
#if !FAST_P1
        nk_qk_post(TMPQK, c.q_norm_g, c.k_norm_g, ROPE, DQ, DK);
#endif
#if FAST_CROSS
        { pg8::Gemm g{MEMN, WCKV, B * NMEM, 2 * D, D}; pg8::StaticOrder S; S.init(B * NMEM, 2 * D, (int)gridDim.x, (int)blockIdx.x);
          pg8::EpiPlain E{CKV, 2 * D}; pg8::gemm_phase<pg8::EpiPlain, pg8::StaticOrder, true, true>(lds, g, S, E); }
#else
        { GemmP p{MEMN, WCKV, B * NMEM, 2 * D, D, 0, nullptr, nullptr, CKV, nullptr}; nk_gemm<2>(p); }
#endif
    } else if constexpr (P == 3) {
#if FAST_CROSS
        fast_ckv_fix(c);
#else
        nk_ckv_fix(CKV, c.cq_g, c.ck_g, CK2, CVT);
#endif
#if FAST_GLA
        fast_gla_prep(c, lds);
#else
        nk_gla_cum(GLR, c.w_a2, c.b_a, CUM);
#endif
#if !FAST_ATT
        nk_diff_stats(DQ, DK, STATS);
#endif
    } else if constexpr (P == 4) {
#if FAST_ATT
        { const float lam = lamp[0], mref = lamp[1];
#if FAST_GLA
          LAS int* qslot = (LAS int*)(lds + 143360);
          for (;;) {
              if (threadIdx.x == 0) *qslot = atomicAdd(&ctl[CW_QUEUE + 64 * QPASS], 1);
              __syncthreads(); const int item = *qslot; __syncthreads();
              if (item >= 8 + 512) break;
              if (item < 8) fg::gla_seq(item >> 2, item & 3, GQ, (const bf16*)CUM, GV, GRb, WSP(float, WS_SMALL + SM_DEC), c.gla_out_g, MIX, lds);
              else { const int u = item - 8, jq = 31 - (u >> 4), bh = u & 15;
                  if (mref <= 24.0f) fa::attn_unit<false>(bh >> 3, bh & 7, jq, DQ, DK, DV, MIX, c.subln_g, lam, mref, lds);
                  else fa::attn_unit<true>(bh >> 3, bh & 7, jq, DQ, DK, DV, MIX, c.subln_g, lam, mref, lds); } }
#else
          const int G = (int)gridDim.x;
          for (int pi = (int)blockIdx.x; pi < 256; pi += G) { const int vcu = (pi & 7) * 32 + (pi >> 3), bh = vcu >> 4, pr = vcu & 15;
              for (int k2 = 0; k2 < 2; ++k2) { const int jq = k2 ? pr : 31 - pr;
                  if (mref <= 24.0f) fa::attn_unit<false>(bh >> 3, bh & 7, jq, DQ, DK, DV, MIX, c.subln_g, lam, mref, lds);
                  else fa::attn_unit<true>(bh >> 3, bh & 7, jq, DQ, DK, DV, MIX, c.subln_g, lam, mref, lds); } }
#endif
        }
#else
        nk_diff_pv(DQ, DK, DV, STATS, lamp, OTMPD);
#endif
#if !FAST_GLA
        nk_gla_run(GQ, GK, GV, CUM, OTMPG);
#endif
    } else if constexpr (P == 5) {
#if !FAST_ATT
        nk_diff_norm(OTMPD, c.subln_g, MIX);
#endif
#if !FAST_GLA
        nk_gla_norm(OTMPG, c.gla_out_g, GRb, MIX);
#endif
    } else if constexpr (P == 6) {
#if FAST_P6
        pg8::Gemm g{MIX, WOUT, T, D, D}; pg8::StaticOrder S; S.init(T, D, (int)gridDim.x, (int)blockIdx.x);
        pg8::EpiResid E{c.x, out, XN, c.g_cross, SSP1};
        pg8::gemm_phase<pg8::EpiResid, pg8::StaticOrder, true, true>(lds, g, S, E);
#else
        GemmP p{MIX, WOUT, T, D, D, 0, out, nullptr, nullptr, c.x}; nk_gemm<1>(p);
#endif
    } else if constexpr (P == 7) {
#if !FAST_P6
        nk_rmsnorm_rows(out, c.g_cross, XN, T, D);
#endif
    } else if constexpr (P == 8) {
#if FAST_P6
        pg8::Gemm g{XN, WCQ, T, D, D}; pg8::StaticOrder S; S.init(T, D, (int)gridDim.x, (int)blockIdx.x);
        pg8::EpiCq E{SSP1, CQ, CQSS};
        pg8::gemm_phase<pg8::EpiCq, pg8::StaticOrder, true, true>(lds, g, S, E);
#else
        GemmP p{XN, WCQ, T, D, D, 0, nullptr, nullptr, CQ, nullptr}; nk_gemm<2>(p);
#endif
    } else if constexpr (P == 9) {
#if !FAST_P6
        nk_cqss(CQ, CQSS);
#endif
    } else if constexpr (P == 10) {
#if FAST_CROSS
        for (int u = (int)blockIdx.x; u < B * CH * (SEQ / 128); u += (int)gridDim.x) { const int v = (u & 7) * 32 + (u >> 3);
            fc::cross_unit(v >> 7, (v >> 5) & 3, v & 31, CQ, CQSS, CK2, CVT, CO, lds); }
#else
        nk_cross_scores(CQ, CQSS, CK2, PTMP);
#endif
    } else if constexpr (P == 11) {
#if !FAST_CROSS
        nk_cross_softmax(PTMP);
#endif
    } else if constexpr (P == 12) {
#if !FAST_CROSS
        nk_cross_pv(PTMP, CVT, CO);
#endif
    } else if constexpr (P == 13) {
#if FAST_P13
        pg8::Gemm g{CO, WCO, T, D, D}; pg8::StaticOrder S; S.init(T, D, (int)gridDim.x, (int)blockIdx.x);
        pg8::EpiResid E{out, out, XN, c.g_ffn, SSP2};
        pg8::gemm_phase<pg8::EpiResid, pg8::StaticOrder, true, true>(lds, g, S, E);
#else
        GemmP p{CO, WCO, T, D, D, 0, out, nullptr, nullptr, nullptr}; nk_gemm<4>(p);
#endif
    } else if constexpr (P == 14) {
#if FAST_MOE
        fast_router(c, lds);
#else
        nk_router(out, c.g_ffn, c.w_rg, c.b_rg, c.w_re, c.b_re, XN, EXPERT, GATE, SLOTPOS, ctl);
#endif
    } else if constexpr (P == 15) {
#if !FAST_MOE
        nk_moe_offsets(ctl);
#endif
    } else if constexpr (P == 16) {
#if FAST_MOE
        fast_moe_fill(c);
#else
        nk_moe_fill(EXPERT, GATE, SLOTPOS, ctl, SLOTTOK, SLOTGATE);
#endif
    } else if constexpr (P == 17) {
#if FAST_MOE
        pg8::Gemm g{XN, WGU, PMAX, NE * 2 * DE, D}; pg8::MoeOrder S{ctl, 4, (int)gridDim.x, (int)blockIdx.x};
        pg8::EpiGU E{SLOTTOK, SSP2, HE};
        pg8::gemm_phase_gather<pg8::EpiGU, pg8::MoeOrder, true>(lds, g, SLOTTOK, S, E);
#else
        nk_moe_gu(XN, WGU, SLOTTOK, ctl, HE);
#endif
    }
}
template <int P> __device__ __forceinline__ void run_phase_last(const Ctx& c, LdsPtr lds) {
    int* ctl = WSP(int, WS_CTL); bf16* WD = WSP(bf16, WS_WD); int* SLOTTOK = WSP(int, WS_SMALL + SM_SLOTTOK); float* SLOTGATE = WSP(float, WS_SMALL + SM_SLOTGATE); bf16* HE = (bf16*)(c.ws + WS_B + B_HE); (void)lds;
#if FAST_MOE
    pg8::Gemm g{HE, WD, PMAX, NE * D, DE}; pg8::MoeOrder S{ctl, 8, (int)gridDim.x, (int)blockIdx.x};
    pg8::EpiDown E{SLOTGATE, WSP(bf16, WS_C)};
    pg8::gemm_phase<pg8::EpiDown, pg8::MoeOrder, true, true>(lds, g, S, E);
#else
    nk_moe_down(HE, WD, SLOTTOK, SLOTGATE, ctl, c.out);
#endif
}

#ifndef HOST_EMU
#define XB_TMO      128
#define XB_XCNT(j)  (256  + 64 * (j))
#define XB_XSUB(j)  (1280 + 64 * (j))
#define XB_XGEN(j)  (2304 + 64 * (j))
#define XB_TOP      3328
#define XB_TOPGEN   3392
#define XCD_BAR_WORDS 3456
#define XB_SPIN_CAP (1u << 20)

__device__ __forceinline__ unsigned xb_ld(unsigned* p)              { return __hip_atomic_load(p, __ATOMIC_RELAXED, __HIP_MEMORY_SCOPE_AGENT); }
__device__ __forceinline__ unsigned xb_add(unsigned* p, unsigned v) { return __hip_atomic_fetch_add(p, v, __ATOMIC_RELAXED, __HIP_MEMORY_SCOPE_AGENT); }
__device__ __forceinline__ unsigned xb_xcc_id() { return (unsigned)__builtin_amdgcn_s_getreg((3 << 11) | 20) & 0xFu; }
#define XB_SPIN(cond, bar) do { unsigned _sp = 0; while (cond) { __builtin_amdgcn_s_sleep(1); \
    if ((++_sp & 255u) == 0u) { if (xb_ld(&(bar)[XB_TMO])) break; if (_sp > XB_SPIN_CAP) { atomicAdd(&(bar)[XB_TMO], 1u); break; } } } } while (0)

struct XcdBarrier {
    unsigned* bar; unsigned x;
    volatile LAS unsigned* st;
};
__device__ __forceinline__ XcdBarrier xcd_barrier_post(unsigned* bar, volatile LAS unsigned* st) {
    XcdBarrier b; b.bar = bar; b.x = xb_xcc_id(); b.st = st;
    if (threadIdx.x == 0) (void)xb_add(&bar[XB_XCNT(b.x)], 1u);
    return b;
}
__device__ __forceinline__ void xcd_barrier_complete(unsigned* bar, unsigned x, unsigned& nloc, unsigned& nx) {
    const unsigned G = gridDim.x * gridDim.y * gridDim.z;
    unsigned sum, cnt, mine, sp = 0u;
    for (;;) {
        sum = 0u; cnt = 0u; mine = 0u;
#pragma unroll
        for (unsigned j = 0; j < 16; ++j) { const unsigned c = xb_ld(&bar[XB_XCNT(j)]); sum += c; cnt += (c > 0u) ? 1u : 0u; mine = (j == x) ? c : mine; }
        if (sum == G) break;
        __builtin_amdgcn_s_sleep(1);
        if ((++sp & 255u) == 0u) { if (xb_ld(&bar[XB_TMO])) break; if (sp > XB_SPIN_CAP) { atomicAdd(&bar[XB_TMO], 1u); break; } }
    }
    nloc = mine > 0u ? mine : 1u; nx = cnt > 0u ? cnt : 1u;
}
__device__ __forceinline__ void xcd_barrier(const XcdBarrier& b) {
    asm volatile("s_waitcnt vmcnt(0)" ::: "memory");
    __syncthreads();
    if (threadIdx.x == 0) {
        unsigned* bar = b.bar;
        __builtin_amdgcn_s_waitcnt(0);
        unsigned nloc = b.st[0], nx = b.st[1];
        if (nloc == 0u) { xcd_barrier_complete(bar, b.x, nloc, nx); b.st[0] = nloc; b.st[1] = nx; }
        const unsigned old = xb_add(&bar[XB_XSUB(b.x)], 1u);
        const unsigned gen = old / nloc;
        if (old + 1u == (gen + 1u) * nloc) {
            __builtin_amdgcn_fence(__ATOMIC_RELEASE, "agent");
            asm volatile("s_waitcnt vmcnt(0)" ::: "memory");
            const unsigned og = xb_add(&bar[XB_TOP], 1u);
            const unsigned tg = og / nx;
            if (og + 1u == (tg + 1u) * nx) xb_add(&bar[XB_TOPGEN], 1u);
            else XB_SPIN(xb_ld(&bar[XB_TOPGEN]) == tg, bar);
            __builtin_amdgcn_fence(__ATOMIC_ACQUIRE, "agent");
            xb_add(&bar[XB_XGEN(b.x)], 1u);
            asm volatile("s_waitcnt vmcnt(0)" ::: "memory");
        } else {
            XB_SPIN(xb_ld(&bar[XB_XGEN(b.x)]) == gen, bar);
            __builtin_amdgcn_fence(__ATOMIC_ACQUIRE, "agent");
            asm volatile("s_waitcnt vmcnt(0)" ::: "memory");
        }
    }
    __syncthreads();
}

constexpr int NTHREADS = 512;
constexpr int LDS_BYTES = 147456;
constexpr int LDSCTL_OFF = 143360, MISC_OFF = LDSCTL_OFF + 64;
__global__ void __launch_bounds__(NTHREADS, 2) fwd_kernel(Ctx c) {
    extern __shared__ __attribute__((aligned(16))) unsigned char lds[];
    LAS unsigned char* l3 = (LAS unsigned char*)lds;
    volatile LAS unsigned* MISC = (volatile LAS unsigned*)(l3 + MISC_OFF);
    for (int u = threadIdx.x; u < (LDS_BYTES - LDSCTL_OFF) / 4; u += NTHREADS) ((LAS unsigned*)(l3 + LDSCTL_OFF))[u] = 0u;
    __syncthreads();
    XcdBarrier bar = xcd_barrier_post((unsigned*)(c.ws + WS_CTL) + CW_BAR, MISC + 8);
#ifndef PROBE_DOUBLE
#define PROBE_DOUBLE -1
#endif
#define PH(k) run_phase<k>(c, l3); xcd_barrier(bar); if (PROBE_DOUBLE == k) { run_phase<k, 1>(c, l3); xcd_barrier(bar); }
#if FAST_P0 && FAST_P1 && FAST_P6 && FAST_P13 && FAST_ATT && FAST_GLA && FAST_CROSS && FAST_MOE
    PH(0) PH(1) PH(2) PH(3) PH(4) PH(6) PH(8) PH(10) PH(13) PH(14) PH(16) PH(17)
    run_phase_last<0>(c, l3); xcd_barrier(bar);
    fast_moe_gather(c);
#else
    PH(0) PH(1) PH(2) PH(3) PH(4) PH(5) PH(6) PH(7) PH(8) PH(9) PH(10) PH(11) PH(12) PH(13) PH(14) PH(15) PH(16) PH(17)
    run_phase_last<0>(c, l3);
#if FAST_MOE
    xcd_barrier(bar); fast_moe_gather(c);
#endif
#endif
#undef PH
}
#endif

#ifdef HOST_EMU
template <int P> static void emu_phase(const Ctx& c) { const size_t nth = 4096; emu_nth = nth; for (size_t t = 0; t < nth; ++t) { emu_tid = t; run_phase<P>(c, nullptr); } }
template <int... Ps> static void emu_all(const Ctx& c, std::integer_sequence<int, Ps...>) { (emu_phase<Ps>(c), ...); }
#endif

extern "C" void kernel_launch(void* const* d_in, const int* in_sizes, int n_in, void* d_out, int out_size, void* d_ws, size_t ws_size, hipStream_t stream) {
    if (n_in != 31 || out_size != T * D || ws_size < WS_END) { fprintf(stderr, "kernel_launch: unexpected shapes (n_in %d out %d ws %zu need %zu)\n", n_in, out_size, ws_size, (size_t)WS_END); return; }
    (void)in_sizes;
    Ctx c{};
    const float** fp = (const float**)&c.x;
    c.x = (const float*)d_in[0]; c.mem = (const float*)d_in[1]; c.positions = (const int*)d_in[2];
    c.g_attn = (const float*)d_in[3]; c.w_in = (const float*)d_in[4]; c.q_norm_g = (const float*)d_in[5]; c.k_norm_g = (const float*)d_in[6];
    c.lq1 = (const float*)d_in[7]; c.lk1 = (const float*)d_in[8]; c.lq2 = (const float*)d_in[9]; c.lk2 = (const float*)d_in[10];
    c.subln_g = (const float*)d_in[11]; c.w_a2 = (const float*)d_in[12]; c.b_a = (const float*)d_in[13]; c.gla_out_g = (const float*)d_in[14];
    c.w_out = (const float*)d_in[15]; c.g_cross = (const float*)d_in[16]; c.g_mem = (const float*)d_in[17]; c.w_cq = (const float*)d_in[18];
    c.w_ckv = (const float*)d_in[19]; c.cq_g = (const float*)d_in[20]; c.ck_g = (const float*)d_in[21]; c.w_co = (const float*)d_in[22];
    c.g_ffn = (const float*)d_in[23]; c.w_rg = (const float*)d_in[24]; c.b_rg = (const float*)d_in[25]; c.w_re = (const float*)d_in[26];
    c.b_re = (const float*)d_in[27]; c.w_gate = (const float*)d_in[28]; c.w_up = (const float*)d_in[29]; c.w_down = (const float*)d_in[30];
    c.out = (float*)d_out; c.ws = (char*)d_ws; (void)fp;
#ifdef HOST_EMU
    memset(c.ws + WS_CTL, 0, CTL_BYTES);
    emu_all(c, std::make_integer_sequence<int, N_PHASES>{});
    { const size_t nth = 4096; emu_nth = nth; for (size_t t = 0; t < nth; ++t) { emu_tid = t; run_phase_last<0>(c, nullptr); } }
#else
    static int grid = 0;
    if (grid == 0) {
        int dev = 0, cus = 0, per_cu = 0;
        if (hipGetDevice(&dev) != hipSuccess || hipDeviceGetAttribute(&cus, hipDeviceAttributeMultiprocessorCount, dev) != hipSuccess) { fprintf(stderr, "kernel_launch: device query failed\n"); grid = -1; return; }
        if (hipFuncSetAttribute((const void*)fwd_kernel, hipFuncAttributeMaxDynamicSharedMemorySize, LDS_BYTES) != hipSuccess) { fprintf(stderr, "kernel_launch: hipFuncSetAttribute failed\n"); grid = -1; return; }
        if (hipOccupancyMaxActiveBlocksPerMultiprocessor(&per_cu, (const void*)fwd_kernel, NTHREADS, LDS_BYTES) != hipSuccess || per_cu < 1) { fprintf(stderr, "kernel_launch: occupancy query says %d blocks per CU\n", per_cu); }
        (void)hipGetLastError();
        grid = cus;
    }
    if (grid < 0) return;
    (void)hipMemsetAsync(c.ws + WS_CTL, 0, CTL_BYTES, stream);
    hipLaunchKernelGGL(fwd_kernel, dim3(grid), dim3(NTHREADS), LDS_BYTES, stream, c);
#endif
}
```

```cpp
#ifndef HOST_EMU
#include <hip/hip_runtime.h>
#else
#include <cstring>
struct EmuD3 { unsigned x, y, z; };
static EmuD3 blockIdx, threadIdx, blockDim, gridDim;
static size_t emu_tid, emu_nth;
#define __global__ static
#define __device__ static
#define __host__
#define __forceinline__ inline
#define __launch_bounds__(...)
typedef int hipStream_t;
static inline int atomicAdd(int* p, int v) { int o = *p; *p += v; return o; }
static inline float atomicAdd(float* p, float v) { float o = *p; *p += v; return o; }
#endif
#include <cstdint>
#include <cstdio>
#include <cmath>

#ifndef CFG_D
#define CFG_D 2048
#define CFG_SEQ 4096
#define CFG_NMEM 256
#define CFG_ETILE 256
#endif
namespace cfg {
constexpr int D = CFG_D, B = 2, SEQ = CFG_SEQ, T = B * SEQ, CHUNK = 64, NC = SEQ / CHUNK;
constexpr int DH = 8, DVD = D / 16, DQK = D / 32;
constexpr int GH = 4, GVD = D / 8, GKD = D / 16, GRK = 16;
constexpr int NMEM = CFG_NMEM, CH = 4, CHD = D / 4;
constexpr int NE = 32, EPG = 8, NG = 4, DE = D / 4;
constexpr int ETILE = CFG_ETILE, PMAX = 2 * T + NE * ETILE, NTILE = PMAX / ETILE;
constexpr int NIN = 3 * D;
constexpr int IN_COLS = 3 * D + GRK;
constexpr int O_DQ = 0, O_DK = D / 2, O_DV = D, O_GQ = 3 * D / 2, O_GK = 7 * D / 4, O_GV = 2 * D, O_LR = 5 * D / 2, O_GR = 5 * D / 2 + GRK;
constexpr float EPS = 1e-6f;
constexpr float LOG2E = 1.4426950408889634f;
}
using namespace cfg;
typedef unsigned short bf16;

constexpr size_t al256(size_t x) { return (x + 255) & ~(size_t)255; }
constexpr size_t WS_CTL = 0, CTL_BYTES = 1u << 20;
constexpr size_t WS_WIN = WS_CTL + CTL_BYTES;
constexpr size_t WS_WLR = WS_WIN + al256((size_t)NIN * D * 2);
constexpr size_t WS_WOUT = WS_WLR + al256((size_t)GRK * D * 2);
constexpr size_t WS_WCQ = WS_WOUT + al256((size_t)D * D * 2);
constexpr size_t WS_WCKV = WS_WCQ + al256((size_t)D * D * 2);
constexpr size_t WS_WCO = WS_WCKV + al256((size_t)2 * D * D * 2);
constexpr size_t WS_WGU = WS_WCO + al256((size_t)D * D * 2);
constexpr size_t WS_WD = WS_WGU + al256((size_t)NE * 2 * DE * D * 2);
constexpr size_t WS_XN = WS_WD + al256((size_t)NE * D * DE * 2);
constexpr size_t WS_MEMN = WS_XN + al256((size_t)(T + 1) * D * 2);
constexpr size_t WS_SMALL = WS_MEMN + al256((size_t)B * NMEM * D * 2);
constexpr size_t SM_GLR = 0;
constexpr size_t SM_CQSS = SM_GLR + al256((size_t)T * GRK * 4);
constexpr size_t SM_SSP1 = SM_CQSS + al256((size_t)T * 32 * 4);
constexpr size_t SM_SSP2 = SM_SSP1 + al256((size_t)T * 32 * 4);
constexpr size_t SM_EXPERT = SM_SSP2 + al256((size_t)T * 32 * 4);
constexpr size_t SM_GATE = SM_EXPERT + al256((size_t)T * 2 * 4);
constexpr size_t SM_SLOTPOS = SM_GATE + al256((size_t)T * 2 * 4);
constexpr size_t SM_SLOTTOK = SM_SLOTPOS + al256((size_t)T * 2 * 4);
constexpr size_t SM_SLOTGATE = SM_SLOTTOK + al256((size_t)PMAX * 4);
constexpr size_t SM_ROPE = SM_SLOTGATE + al256((size_t)PMAX * 4);
constexpr size_t SM_CKV = SM_ROPE + al256((size_t)T * DQK * 4);
constexpr size_t SM_CK2 = SM_CKV + al256((size_t)B * NMEM * 2 * D * 2);
constexpr size_t SM_CVT = SM_CK2 + al256((size_t)B * NMEM * D * 2);
constexpr size_t SM_WRT = SM_CVT + al256((size_t)B * NMEM * D * 2);
constexpr size_t SM_DEC = SM_WRT + al256((size_t)48 * D * 2);
constexpr size_t SM_STATS = SM_DEC + al256((size_t)B * NC * GH * GKD * 4);
constexpr size_t SM_END = SM_STATS + al256((size_t)T * DH * 4 * 4);
constexpr size_t WS_B = WS_SMALL + al256(SM_END);
constexpr size_t B_DQ = 0, B_DK = B_DQ + (size_t)T * (D / 2) * 2, B_DV = B_DK + (size_t)T * (D / 2) * 2;
constexpr size_t B_GQ = B_DV + (size_t)T * (D / 2) * 2, B_GK = B_GQ + (size_t)T * (D / 4) * 2, B_GV = B_GK + (size_t)T * (D / 4) * 2, B_GR = B_GV + (size_t)T * (D / 2) * 2;
constexpr size_t B_END1 = B_GR + (size_t)T * (D / 2) * 2;
constexpr size_t B_CQ = 0, B_CO = B_CQ + (size_t)T * D * 2, B_HE = B_CO + (size_t)T * D * 2, B_END2 = B_HE + (size_t)PMAX * DE * 2;
constexpr size_t B_BYTES = al256(B_END1 > B_END2 ? B_END1 : B_END2);
constexpr size_t WS_C = WS_B + B_BYTES;
constexpr size_t WS_D = WS_C + al256((size_t)T * D * 2);
constexpr size_t WS_END = WS_D + al256((size_t)T * D * 5);

constexpr int CW_CNT = 64;
constexpr int CW_BASE = 128;
constexpr int CW_TILE_E = 256;
constexpr int CW_NTILES = 512;
constexpr int CW_BAR = 4096;
constexpr int CW_QUEUE = 1024;

__device__ __forceinline__ bf16 f2bf(float f) { unsigned u; memcpy(&u, &f, 4); u = (u + 0x7fffu + ((u >> 16) & 1u)) >> 16; return (bf16)u; }
__device__ __forceinline__ float bf2f(bf16 b) { unsigned u = ((unsigned)b) << 16; float f; memcpy(&f, &u, 4); return f; }
__device__ __forceinline__ float silu_f(float x) { return x / (1.f + expf(-x)); }
#ifdef HOST_EMU
static inline size_t gtid() { return emu_tid; }
static inline size_t gnth() { return emu_nth; }
#else
__device__ __forceinline__ size_t gtid() { return (size_t)blockIdx.x * blockDim.x + threadIdx.x; }
__device__ __forceinline__ size_t gnth() { return (size_t)gridDim.x * blockDim.x; }
#endif
struct bf16x8s { bf16 v[8]; };
__host__ __device__ __forceinline__ int win_logical(int np) {
    if (np >= D) return np; const int t = np & ~255, p = np & 255; return t + 64 * ((p & 127) >> 5) + 32 * (p >> 7) + (p & 31);
}
__host__ __device__ __forceinline__ int win_src_col(int np) { const int l = win_logical(np); return l < O_LR ? l : l + GRK; }

__device__ __forceinline__ void nk_rmsnorm_rows(const float* x, const float* g, bf16* out, int rows, int d) {
    for (size_t r = gtid(); r < (size_t)(rows); r += gnth()) {
    const float* xr = x + r * d; float ss = 0.f;
    for (int i = 0; i < d; ++i) ss += xr[i] * xr[i];
    const float rs = 1.0f / sqrtf(ss / d + EPS);
    for (int i = 0; i < d; ++i) out[r * d + i] = f2bf(xr[i] * rs * g[i]);
}}
__device__ __forceinline__ void nk_glr(const float* x, const float* g, const float* w_in, float* GLR) {
    for (size_t i = gtid(); i < (size_t)T * GRK; i += gnth()) { const int cc = (int)(i % GRK), t = (int)(i / GRK); const float* xr = x + (size_t)t * D; float ss = 0.f;
        for (int k = 0; k < D; ++k) ss += xr[k] * xr[k]; const float rs = 1.0f / sqrtf(ss / D + EPS); float a = 0.f;
        for (int k = 0; k < D; ++k) a += xr[k] * rs * g[k] * w_in[(size_t)k * IN_COLS + O_LR + cc]; GLR[i] = a; }
}
__device__ __forceinline__ void nk_zero_bf16(bf16* p, size_t n) { for (size_t i = gtid(); i < n; i += gnth()) p[i] = 0; }
__device__ __forceinline__ void nk_convT(const float* W, int ldw, int col0, bf16* WT, int N, int K) {
    for (size_t i = gtid(); i < (size_t)(N * K); i += gnth()) {
    const int n = (int)(i / K), k = (int)(i % K);
    WT[i] = f2bf(W[(size_t)k * ldw + col0 + n]);
}}
__device__ __forceinline__ void nk_conv_win(const float* W, bf16* WT) {
    for (size_t i = gtid(); i < (size_t)NIN * D; i += gnth()) { const int n = (int)(i / D), k = (int)(i % D); WT[i] = f2bf(W[(size_t)k * IN_COLS + win_src_col(n)]); }
}
constexpr int GUH = (DE >= 128) ? 128 : DE;
__device__ __forceinline__ void nk_conv_gu(const float* Wg, const float* Wu, bf16* WGU) {
    for (size_t i = gtid(); i < (size_t)(NE * 2 * DE * D); i += gnth()) {
    const int k = (int)(i % D); const int r = (int)((i / D) % (2 * DE)); const int e = (int)(i / ((size_t)D * 2 * DE));
    const int pn = r / (2 * GUH), ii = r % (2 * GUH); const int j = pn * GUH + (ii % GUH);
    const float* W = (ii < GUH) ? Wg : Wu;
    WGU[i] = f2bf(W[((size_t)e * D + k) * DE + j]);
}}
__device__ __forceinline__ void nk_conv_d(const float* Wd, bf16* WD) {
    for (size_t i = gtid(); i < (size_t)(NE * D * DE); i += gnth()) {
    const int j = (int)(i % DE); const int n = (int)((i / DE) % D); const int e = (int)(i / ((size_t)D * DE));
    WD[i] = f2bf(Wd[((size_t)e * DE + j) * D + n]);
}}
__device__ __forceinline__ void nk_rope_table(const int* positions, float* tab) {
    constexpr int half = DQK / 2; for (size_t i = gtid(); i < (size_t)(T * half); i += gnth()) {
    const int t = (int)(i / half), j = (int)(i % half);
    const float freq = powf(10000.0f, -(float)j / (float)half);
    const float ang = (float)positions[t] * freq;
    tab[i * 2] = cosf(ang); tab[i * 2 + 1] = sinf(ang);
}}

struct GemmP { const bf16* A; const bf16* Bt; int M, N, K, pad; float* f0; float* f1; bf16* b0; const float* x; };
template <int MODE> __device__ __forceinline__ void gemm_epi(const GemmP& p, int m, int n, float acc) {
    if constexpr (MODE == 0) {
        bf16* Bb = p.b0; n = win_logical(n);
        if (n < D) { p.f0[(size_t)m * D + n] = acc; return; }
        if (n < O_GQ) { ((bf16*)((char*)Bb + B_DV))[(size_t)m * (D / 2) + (n - O_DV)] = f2bf(acc); return; }
        if (n < O_GK) { ((bf16*)((char*)Bb + B_GQ))[(size_t)m * (D / 4) + (n - O_GQ)] = f2bf(acc * (1.0f / sqrtf((float)GKD))); return; }
        if (n < O_GV) { ((bf16*)((char*)Bb + B_GK))[(size_t)m * (D / 4) + (n - O_GK)] = f2bf(acc); return; }
        if (n < O_LR) { ((bf16*)((char*)Bb + B_GV))[(size_t)m * (D / 2) + (n - O_GV)] = f2bf(acc); return; }
        ((bf16*)((char*)Bb + B_GR))[(size_t)m * (D / 2) + (n - O_LR)] = f2bf(acc);
    } else if constexpr (MODE == 1) { p.f0[(size_t)m * p.N + n] = p.x[(size_t)m * p.N + n] + acc;
    } else if constexpr (MODE == 2) { p.b0[(size_t)m * p.N + n] = f2bf(acc);
    } else if constexpr (MODE == 4) { p.f0[(size_t)m * p.N + n] += acc;
    } else { p.f0[(size_t)m * p.N + n] = acc; }
}
template <int MODE> __device__ __forceinline__ void nk_gemm(GemmP p) {
    const int nb = p.N / 4; for (size_t idx = gtid(); idx < (size_t)(p.M / 4) * nb; idx += gnth()) {
    const int m0 = 4 * (int)(idx / nb), n0 = 4 * (int)(idx % nb);
    float acc[4][4];
#pragma unroll
    for (int i = 0; i < 4; ++i)
#pragma unroll
        for (int j = 0; j < 4; ++j) acc[i][j] = 0.f;
    for (int k = 0; k < p.K; k += 8) {
        bf16x8s a[4], b[4];
#pragma unroll
        for (int i = 0; i < 4; ++i) { a[i] = *(const bf16x8s*)(p.A + (size_t)(m0 + i) * p.K + k); b[i] = *(const bf16x8s*)(p.Bt + (size_t)(n0 + i) * p.K + k); }
#pragma unroll
        for (int kk = 0; kk < 8; ++kk) {
            float af[4], bfv[4];
#pragma unroll
            for (int i = 0; i < 4; ++i) { af[i] = bf2f(a[i].v[kk]); bfv[i] = bf2f(b[i].v[kk]); }
#pragma unroll
            for (int i = 0; i < 4; ++i)
#pragma unroll
                for (int j = 0; j < 4; ++j) acc[i][j] += af[i] * bfv[j];
        }
    }
#pragma unroll
    for (int i = 0; i < 4; ++i)
#pragma unroll
        for (int j = 0; j < 4; ++j) gemm_epi<MODE>(p, m0 + i, n0 + j, acc[i][j]);
}}

__device__ __forceinline__ void nk_qk_post(const float* tmpqk, const float* qg, const float* kg, const float* rope, bf16* DQ, bf16* DK) {
    for (size_t i = gtid(); i < (size_t)(T * 2 * DH * 2); i += gnth()) {
    const int c = (int)(i % 2), h = (int)((i / 2) % DH), which = (int)((i / (2 * DH)) % 2), t = (int)(i / (4 * DH));
    const float* src = tmpqk + (size_t)t * D + which * (D / 2) + h * 2 * DQK + c * DQK;
    const float* g = which ? kg : qg; bf16* dst = (which ? DK : DQ) + (size_t)t * (D / 2) + h * 2 * DQK + c * DQK;
    float ss = 0.f; for (int d = 0; d < DQK; ++d) ss += src[d] * src[d];
    const float rs = 1.0f / sqrtf(ss / DQK + EPS); constexpr int half = DQK / 2;
    const float sc = which ? 1.0f : (1.0f / sqrtf((float)DQK)) * LOG2E;
    for (int d = 0; d < half; ++d) {
        const float t1 = src[d] * rs * g[d], t2 = src[d + half] * rs * g[d + half];
        const float cs = rope[((size_t)t * half + d) * 2], sn = rope[((size_t)t * half + d) * 2 + 1];
        dst[d] = f2bf((t1 * cs - t2 * sn) * sc); dst[d + half] = f2bf((t2 * cs + t1 * sn) * sc);
    }
}}
__device__ __forceinline__ void nk_lam(const float* q1, const float* k1, const float* q2, const float* k2, float* out) {
    if (gtid() != 0) return; float a = 0.f, b = 0.f; for (int i = 0; i < DQK; ++i) { a += q1[i] * k1[i]; b += q2[i] * k2[i]; }
    out[0] = expf(a) - expf(b) + 0.2f;
}
__device__ __forceinline__ void nk_mref(const float* qg, const float* kg, float* out) {
    if (gtid() != 0) return; float mq = 0.f, mk = 0.f; for (int i = 0; i < DQK; ++i) { mq = fmaxf(mq, fabsf(qg[i])); mk = fmaxf(mk, fabsf(kg[i])); }
    out[0] = (float)DQK * mq * mk * (1.0f / sqrtf((float)DQK)) * LOG2E * 1.02f;
}
__device__ __forceinline__ void nk_diff_stats(const bf16* DQ, const bf16* DK, float* stats) {
    for (size_t i = gtid(); i < (size_t)(T * DH * 2); i += gnth()) {
    const int c = (int)(i % 2), h = (int)((i / 2) % DH), t = (int)(i / (2 * DH)); const int b = t / SEQ, s = t % SEQ;
    const int nk = (s / CHUNK + 1) * CHUNK;
    float q[DQK]; const bf16* qp = DQ + (size_t)t * (D / 2) + h * 2 * DQK + c * DQK;
#pragma unroll
    for (int d = 0; d < DQK; ++d) q[d] = bf2f(qp[d]);
    float mx = -1e30f;
    for (int k = 0; k < nk; ++k) { const bf16* kp = DK + (size_t)(b * SEQ + k) * (D / 2) + h * 2 * DQK + c * DQK; float sdot = 0.f;
#pragma unroll
        for (int d = 0; d < DQK; ++d) sdot += q[d] * bf2f(kp[d]);
        mx = fmaxf(mx, sdot); }
    float sum = 0.f;
    for (int k = 0; k < nk; ++k) { const bf16* kp = DK + (size_t)(b * SEQ + k) * (D / 2) + h * 2 * DQK + c * DQK; float sdot = 0.f;
#pragma unroll
        for (int d = 0; d < DQK; ++d) sdot += q[d] * bf2f(kp[d]);
        sum += exp2f(sdot - mx); }
    stats[i * 2] = mx; stats[i * 2 + 1] = sum;
}}
__device__ __forceinline__ void nk_diff_pv(const bf16* DQ, const bf16* DK, const bf16* DV, const float* stats, const float* lamp, float* otmp) {
    constexpr int NDG = 8, DG = DVD / NDG;
    for (size_t i = gtid(); i < (size_t)(T * DH * NDG); i += gnth()) {
    const int dg = (int)(i % NDG), h = (int)((i / NDG) % DH), t = (int)(i / (NDG * DH)); const int b = t / SEQ, s = t % SEQ;
    const int nk = (s / CHUNK + 1) * CHUNK; const float lam = lamp[0];
    float q[2 * DQK]; const bf16* qp = DQ + (size_t)t * (D / 2) + h * 2 * DQK;
#pragma unroll
    for (int d = 0; d < 2 * DQK; ++d) q[d] = bf2f(qp[d]);
    const float m0 = stats[((size_t)(t * DH + h) * 2 + 0) * 2], l0 = stats[((size_t)(t * DH + h) * 2 + 0) * 2 + 1];
    const float m1 = stats[((size_t)(t * DH + h) * 2 + 1) * 2], l1 = stats[((size_t)(t * DH + h) * 2 + 1) * 2 + 1];
    float acc[DG];
#pragma unroll
    for (int d = 0; d < DG; ++d) acc[d] = 0.f;
    for (int k = 0; k < nk; ++k) { const bf16* kp = DK + (size_t)(b * SEQ + k) * (D / 2) + h * 2 * DQK; float s0 = 0.f, s1 = 0.f;
#pragma unroll
        for (int d = 0; d < DQK; ++d) { s0 += q[d] * bf2f(kp[d]); s1 += q[DQK + d] * bf2f(kp[DQK + d]); }
        const float a = exp2f(s0 - m0) / l0 - lam * exp2f(s1 - m1) / l1;
        const bf16* vp = DV + (size_t)(b * SEQ + k) * (D / 2) + h * DVD + dg * DG;
#pragma unroll
        for (int d = 0; d < DG; ++d) acc[d] += a * bf2f(vp[d]); }
#pragma unroll
    for (int d = 0; d < DG; ++d) otmp[(size_t)t * (D / 2) + h * DVD + dg * DG + d] = acc[d];
}}
__device__ __forceinline__ void nk_diff_norm(const float* otmp, const float* g, bf16* MIX) {
    for (size_t i = gtid(); i < (size_t)(T * DH); i += gnth()) { const int h = (int)(i % DH), t = (int)(i / DH);
    const float* o = otmp + (size_t)t * (D / 2) + h * DVD; float ss = 0.f; for (int d = 0; d < DVD; ++d) ss += o[d] * o[d];
    const float rs = 1.0f / sqrtf(ss / DVD + EPS);
    for (int d = 0; d < DVD; ++d) MIX[(size_t)t * D + h * DVD + d] = f2bf(o[d] * rs * g[d] * 0.8f);
}}
__device__ __forceinline__ void nk_gla_cum(const float* GLR, const float* wa2, const float* ba, float* CUM) {
    constexpr int W = GH * GKD; for (size_t i = gtid(); i < (size_t)(B * NC * W); i += gnth()) {
    const int j = (int)(i % W), cb = (int)(i / W); float run = 0.f;
    for (int tt = 0; tt < CHUNK; ++tt) { const int t = cb * CHUNK + tt; float z = ba[j];
        for (int r = 0; r < GRK; ++r) z += GLR[(size_t)t * GRK + r] * wa2[(size_t)r * W + j];
        const float ls = fminf(z, 0.f) - log1pf(expf(-fabsf(z)));
        run += ls * (1.0f / 16.0f); CUM[(size_t)t * W + j] = run; }
}}
__device__ __forceinline__ void nk_gla_prep(const float* GLR, const float* wa2, const float* ba, const bf16* GK, bf16* KD, float* DEC) {
    constexpr int W = GH * GKD;
    for (size_t i = gtid(); i < (size_t)B * NC * W; i += gnth()) { const int j = (int)(i % W), cb = (int)(i / W);
        float w[GRK];
#pragma unroll
        for (int r = 0; r < GRK; ++r) w[r] = wa2[(size_t)r * W + j];
        const float bj = ba[j]; float run = 0.f;
        for (int tt = 0; tt < CHUNK; ++tt) { const float* gl = GLR + (size_t)(cb * CHUNK + tt) * GRK; float z = bj;
#pragma unroll
            for (int r = 0; r < GRK; ++r) z += gl[r] * w[r];
            run += (fminf(z, 0.f) - log1pf(expf(-fabsf(z)))) * (1.0f / 16.0f); }
        const float end = run; DEC[i] = expf(end); run = 0.f;
        for (int tt = 0; tt < CHUNK; ++tt) { const int t = cb * CHUNK + tt; const float* gl = GLR + (size_t)t * GRK; float z = bj;
#pragma unroll
            for (int r = 0; r < GRK; ++r) z += gl[r] * w[r];
            run += (fminf(z, 0.f) - log1pf(expf(-fabsf(z)))) * (1.0f / 16.0f);
            KD[(size_t)t * W + j] = f2bf(bf2f(GK[(size_t)t * W + j]) * expf(end - run)); } }
}
__device__ __forceinline__ void nk_gla_run(const bf16* GQ, const bf16* GK, const bf16* GV, const float* CUM, float* otmp) {
    constexpr int KH = GKD / 2;
    for (size_t i = gtid(); i < (size_t)(B * GH * GVD); i += gnth()) {
    const int v = (int)(i % GVD), h = (int)((i / GVD) % GH), b = (int)(i / (GVD * GH)); constexpr int W = GH * GKD;
    for (int kh = 0; kh < 2; ++kh) {
    float S[KH];
#pragma unroll
    for (int k = 0; k < KH; ++k) S[k] = 0.f;
    for (int c = 0; c < NC; ++c) { const int t0 = b * SEQ + c * CHUNK; const float* ce = CUM + (size_t)(t0 + CHUNK - 1) * W + h * GKD + kh * KH;
#pragma unroll
        for (int k = 0; k < KH; ++k) S[k] *= expf(ce[k]);
        for (int tt = 0; tt < CHUNK; ++tt) { const int t = t0 + tt; const float vv = bf2f(GV[(size_t)t * (D / 2) + h * GVD + v]);
            const bf16* kp = GK + (size_t)t * (D / 4) + h * GKD + kh * KH; const float* cp = CUM + (size_t)t * W + h * GKD + kh * KH;
#pragma unroll
            for (int k = 0; k < KH; ++k) S[k] += bf2f(kp[k]) * expf(ce[k] - cp[k]) * vv; }
        for (int tt = 0; tt < CHUNK; ++tt) { const int t = t0 + tt; const bf16* qp = GQ + (size_t)t * (D / 4) + h * GKD + kh * KH; float o = 0.f;
#pragma unroll
            for (int k = 0; k < KH; ++k) o += bf2f(qp[k]) * S[k];
            float* op = otmp + (size_t)t * (D / 2) + h * GVD + v; if (kh == 0) *op = o; else *op += o; } }
    } }
}
__device__ __forceinline__ void nk_gla_norm(const float* otmp, const float* g, const bf16* GR, bf16* MIX) {
    for (size_t i = gtid(); i < (size_t)(T * GH); i += gnth()) { const int h = (int)(i % GH), t = (int)(i / GH);
    const float* o = otmp + (size_t)t * (D / 2) + h * GVD; float ss = 0.f; for (int d = 0; d < GVD; ++d) ss += o[d] * o[d];
    const float rs = 1.0f / sqrtf(ss / GVD + EPS);
    for (int d = 0; d < GVD; ++d) MIX[(size_t)t * D + D / 2 + h * GVD + d] = f2bf(o[d] * rs * g[d] * silu_f(bf2f(GR[(size_t)t * (D / 2) + h * GVD + d])));
}}
__device__ __forceinline__ void nk_cqss(const bf16* CQ, float* CQSS) {
    for (size_t i = gtid(); i < (size_t)T * 32; i += gnth()) { const int j = (int)(i % 32), t = (int)(i / 32);
    float ss = 0.f; for (int d = 0; d < D / 32; ++d) { const float v = bf2f(CQ[(size_t)t * D + j * (D / 32) + d]); ss += v * v; } CQSS[i] = ss; }
}
__device__ __forceinline__ void nk_ckv_fix(const bf16* CKV, const float* qg, const float* kg, bf16* CK2, bf16* CVT) {
    for (size_t i = gtid(); i < (size_t)(B * NMEM * CH); i += gnth()) { const int h = (int)(i % CH), bm = (int)(i / CH); const int b = bm / NMEM, m = bm % NMEM;
    const bf16* kp = CKV + (size_t)bm * 2 * D + h * CHD; const bf16* vp = CKV + (size_t)bm * 2 * D + D + h * CHD;
    float ss = 0.f; for (int d = 0; d < CHD; ++d) { const float v = bf2f(kp[d]); ss += v * v; }
    const float rs = 1.0f / sqrtf(ss / CHD + EPS) * (1.0f / sqrtf((float)CHD)) * LOG2E;
    for (int d = 0; d < CHD; ++d) { CK2[(((size_t)b * CH + h) * NMEM + m) * CHD + d] = f2bf(bf2f(kp[d]) * rs * kg[d] * qg[d]);
        CVT[(((size_t)b * CH + h) * CHD + d) * NMEM + m] = vp[d]; }
}}
__device__ __forceinline__ void nk_cross_scores(const bf16* CQ, const float* CQSS, const bf16* CK2, float* P) {
    for (size_t i = gtid(); i < (size_t)(T * CH * NMEM); i += gnth()) { const int m = (int)(i % NMEM), h = (int)((i / NMEM) % CH), t = (int)(i / (NMEM * CH)); const int b = t / SEQ;
    float qs = 0.f; for (int j = 0; j < 8; ++j) qs += CQSS[(size_t)t * 32 + 8 * h + j];
    const float rq = 1.0f / sqrtf(qs / CHD + EPS);
    const bf16* qp = CQ + (size_t)t * D + h * CHD; const bf16* kp = CK2 + (((size_t)b * CH + h) * NMEM + m) * CHD; float s = 0.f;
    for (int d = 0; d < CHD; ++d) s += bf2f(qp[d]) * bf2f(kp[d]);
    P[i] = s * rq;
}}
__device__ __forceinline__ void nk_cross_softmax(float* P) {
    for (size_t i = gtid(); i < (size_t)(T * CH); i += gnth()) { float* p = P + i * NMEM; float mx = -1e30f;
    for (int m = 0; m < NMEM; ++m) mx = fmaxf(mx, p[m]); float sum = 0.f;
    for (int m = 0; m < NMEM; ++m) { p[m] = exp2f(p[m] - mx); sum += p[m]; }
    for (int m = 0; m < NMEM; ++m) p[m] /= sum;
}}
__device__ __forceinline__ void nk_cross_pv(const float* P, const bf16* CVT, bf16* CO) {
    for (size_t i = gtid(); i < (size_t)(T * D); i += gnth()) { const int d = (int)(i % CHD), h = (int)((i / CHD) % CH), t = (int)(i / D); const int b = t / SEQ;
    const float* p = P + ((size_t)t * CH + h) * NMEM; const bf16* vp = CVT + (((size_t)b * CH + h) * CHD + d) * NMEM; float o = 0.f;
    for (int m = 0; m < NMEM; ++m) o += p[m] * bf2f(vp[m]);
    CO[i] = f2bf(o);
}}
__device__ __forceinline__ void nk_router(const float* h2, const float* g, const float* wrg, const float* brg, const float* wre, const float* bre, bf16* XN, int* EXPERT, float* GATE, int* SLOTPOS, int* ctl) {
    for (size_t t = gtid(); t < (size_t)(T); t += gnth()) { const float* xr = h2 + t * D; float ss = 0.f;
    for (int i = 0; i < D; ++i) ss += xr[i] * xr[i]; const float rs = 1.0f / sqrtf(ss / D + EPS);
    float gl[NG], el[NE];
#pragma unroll
    for (int j = 0; j < NG; ++j) gl[j] = brg[j];
#pragma unroll
    for (int j = 0; j < NE; ++j) el[j] = bre[j];
    for (int i = 0; i < D; ++i) { const float xv = xr[i] * rs * g[i]; XN[t * D + i] = f2bf(xv);
#pragma unroll
        for (int j = 0; j < NG; ++j) gl[j] += xv * wrg[(size_t)i * NG + j];
#pragma unroll
        for (int j = 0; j < NE; ++j) el[j] += xv * wre[(size_t)i * NE + j]; }
    int grp = 0; float gm = gl[0];
#pragma unroll
    for (int j = 1; j < NG; ++j) if (gl[j] > gm) { gm = gl[j]; grp = j; }
    float gs = 0.f;
#pragma unroll
    for (int j = 0; j < NG; ++j) gs += expf(gl[j] - gm);
    const float grp_w = 1.0f / gs;
    float e8[EPG];
#pragma unroll
    for (int j = 0; j < EPG; ++j) { float v = 0.f;
#pragma unroll
        for (int gq = 0; gq < NG; ++gq) v = (grp == gq) ? el[gq * EPG + j] : v;
        e8[j] = v; }
    int i0 = 0; float v0 = e8[0];
#pragma unroll
    for (int j = 1; j < EPG; ++j) if (e8[j] > v0) { v0 = e8[j]; i0 = j; }
    int i1 = -1; float v1 = -1e30f;
#pragma unroll
    for (int j = 0; j < EPG; ++j) if (j != i0 && e8[j] > v1) { v1 = e8[j]; i1 = j; }
    const float r = expf(v1 - v0); const float g0 = grp_w / (1.f + r), g1 = grp_w * r / (1.f + r);
    const int e0 = grp * EPG + i0, e1 = grp * EPG + i1;
    EXPERT[t * 2] = e0; EXPERT[t * 2 + 1] = e1; GATE[t * 2] = g0; GATE[t * 2 + 1] = g1;
    SLOTPOS[t * 2] = atomicAdd(&ctl[CW_CNT + e0], 1); SLOTPOS[t * 2 + 1] = atomicAdd(&ctl[CW_CNT + e1], 1);
}}
__device__ __forceinline__ void nk_moe_offsets(int* ctl) {
    if (gtid() != 0) return; int base = 0, nt = 0;
    for (int e = 0; e < NE; ++e) { ctl[CW_BASE + e] = base; const int n = (ctl[CW_CNT + e] + ETILE - 1) / ETILE; for (int j = 0; j < n; ++j) ctl[CW_TILE_E + nt + j] = e; nt += n; base += n * ETILE; }
    ctl[CW_BASE + NE] = base; ctl[CW_NTILES] = nt; for (int j = nt; j < NTILE; ++j) ctl[CW_TILE_E + j] = -1;
}
__device__ __forceinline__ void nk_moe_init_slots(int* SLOTTOK, float* SLOTGATE) { for (size_t i = gtid(); i < (size_t)PMAX; i += gnth()) { SLOTTOK[i] = T; SLOTGATE[i] = 0.f; } }
__device__ __forceinline__ void nk_moe_fill(const int* EXPERT, const float* GATE, const int* SLOTPOS, const int* ctl, int* SLOTTOK, float* SLOTGATE) {
    for (size_t i = gtid(); i < (size_t)(T * 2); i += gnth()) { const int e = EXPERT[i]; const int dst = ctl[CW_BASE + e] + SLOTPOS[i];
    SLOTTOK[dst] = (int)(i / 2); SLOTGATE[dst] = GATE[i];
}}
__device__ __forceinline__ void nk_moe_gu(const bf16* XN, const bf16* WGU, const int* SLOTTOK, const int* ctl, bf16* HE) {
    for (size_t i = gtid(); i < (size_t)(PMAX * DE); i += gnth()) { const int j = (int)(i % DE), p = (int)(i / DE); const int e = ctl[CW_TILE_E + p / ETILE];
    if (e < 0) continue; const int tok = SLOTTOK[p];
    const int pn = j / GUH, jj = j % GUH; const bf16* wg = WGU + ((size_t)e * 2 * DE + pn * 2 * GUH + jj) * D; const bf16* wu = wg + (size_t)GUH * D;
    const bf16* xr = XN + (size_t)tok * D; float g = 0.f, u = 0.f;
    for (int k = 0; k < D; ++k) { const float xv = bf2f(xr[k]); g += xv * bf2f(wg[k]); u += xv * bf2f(wu[k]); }
    HE[i] = f2bf(silu_f(g) * u);
}}
__device__ __forceinline__ void nk_moe_down(const bf16* HE, const bf16* WD, const int* SLOTTOK, const float* SLOTGATE, const int* ctl, float* out) {
    for (size_t i = gtid(); i < (size_t)(PMAX * D); i += gnth()) { const int n = (int)(i % D), p = (int)(i / D); const int e = ctl[CW_TILE_E + p / ETILE];
    if (e < 0) continue; const int tok = SLOTTOK[p]; if (tok >= T) continue;
    const bf16* hr = HE + (size_t)p * DE; const bf16* wr = WD + ((size_t)e * D + n) * DE; float y = 0.f;
    for (int k = 0; k < DE; ++k) y += bf2f(hr[k]) * bf2f(wr[k]);
    atomicAdd(&out[(size_t)tok * D + n], y * SLOTGATE[p]);
}}


#ifndef HOST_EMU
static_assert(D == 2048 && SEQ == 4096 && NMEM == 256 && ETILE == 256, "the fast phases are written for the real shapes");
#define LAS __attribute__((address_space(3)))
#define GAS __attribute__((address_space(1)))
#define LDS_WAIT() asm volatile("s_waitcnt lgkmcnt(0)" ::: "memory")
#define VM_WAIT() asm volatile("s_waitcnt vmcnt(0)" ::: "memory")
namespace pg8 {
#define PG8_LAS __attribute__((address_space(3)))
typedef unsigned short bf16_t;
typedef short bf16x8 __attribute__((ext_vector_type(8)));
typedef float f32x4 __attribute__((ext_vector_type(4)));
typedef unsigned u32x4 __attribute__((ext_vector_type(4)));
constexpr int BM = 256, BK = 64, HALF = 128, HTB = HALF * BK * 2  , STAGE_BYTES = 8 * HTB, NXCD = 8, WGM = 8;

__host__ __device__ __forceinline__ int lds_byte(int r, int c) { const int st = (r >> 4) * 2 + (c >> 5), rr = r & 15, cc = c & 31, ob = rr * 64 + cc * 2; return st * 1024 + (ob ^ (((ob >> 9) & 1) << 5)); }
__host__ __device__ __forceinline__ void stage_rc(int b, int& R, int& C) { const int st = b / 1024, sb = b % 1024, swz = sb ^ (((sb >> 9) & 1) << 5); R = (st >> 1) * 16 + swz / 64; C = (st & 1) * 32 + (swz % 64) / 2; }
__host__ __device__ __forceinline__ int perm32(int rho) { const int n = rho >> 4, i = rho & 15; return 8 * (i >> 2) + 4 * n + (i & 3); }

struct Unit { int pm, pn; };
struct Gemm { const bf16_t* A; const bf16_t* Bt; int M, N, K; };

struct StaticOrder {
    int nM, nN, nwg, G, c;
    __host__ __device__ void init(int M, int N, int G_, int c_) { nM = M / BM; nN = N / BM; nwg = nM * nN; G = G_; c = c_; }
    __host__ __device__ bool next(int i, Unit& u) const {
        const long L = (long)i * G + c; if (L >= nwg) return false;
        int wgid = (int)L; { const int q = nwg / NXCD, r = nwg % NXCD, xcd = wgid % NXCD, off = wgid / NXCD; wgid = (xcd < r ? xcd * (q + 1) : r * (q + 1) + (xcd - r) * q) + off; }
        const int nig = WGM * nN, gid = wgid / nig, fm = gid * WGM, gsz = (nM - fm) < WGM ? (nM - fm) : WGM;
        u.pm = fm + ((wgid % nig) % gsz); u.pn = (wgid % nig) / gsz; return true;
    }
    __device__ __forceinline__ void a_ready(const Unit&) const {}
    __device__ __forceinline__ void done(const Unit&) const {}
};
__device__ __forceinline__ unsigned cvt_pk_bf16(float lo, float hi) { unsigned r; asm volatile("v_cvt_pk_bf16_f32 %0, %1, %2" : "=v"(r) : "v"(lo), "v"(hi)); return r; }
__device__ __forceinline__ float dot4(const f32x4 a) { return (a[0] * a[0] + a[1] * a[1]) + (a[2] * a[2] + a[3] * a[3]); }
struct EpiInProj {
    static constexpr bool PERM = true, AFTER_DRAIN = false;
    char* rb; const float* rope; const float* qg; const float* kg;
    __device__ __forceinline__ void operator()(const f32x4 (&acc)[2][2][4][2], const Unit& u, int wr, int wc, int fr, int fq) const {
        const int row0 = u.pm * BM + wr * 64 + fr;
        if (u.pn < 8) {
            const bool isk = u.pn >= 4; const float* g = isk ? kg : qg;
            bf16_t* dst = (bf16_t*)(rb + (isk ? B_DK : B_DQ)) + ((u.pn & 3) * 4 + wc) * 64 + 8 * fq;
            const float sc = isk ? 1.0f : 0.125f * LOG2E;
            const f32x4 ga0 = *(const f32x4*)(g + 8 * fq), ga1 = *(const f32x4*)(g + 8 * fq + 4), gb0 = *(const f32x4*)(g + 32 + 8 * fq), gb1 = *(const f32x4*)(g + 36 + 8 * fq);
#pragma unroll
            for (int ai = 0; ai < 2; ++ai)
#pragma unroll
                for (int m = 0; m < 4; ++m) {
                    const int row = row0 + ai * HALF + m * 16;
                    const f32x4 a0 = acc[ai][0][m][0], a1 = acc[ai][0][m][1], b0 = acc[ai][1][m][0], b1 = acc[ai][1][m][1];
                    float ss = (dot4(a0) + dot4(a1)) + (dot4(b0) + dot4(b1));
                    ss += __shfl_xor(ss, 16); ss += __shfl_xor(ss, 32);
                    const float rs = sc / sqrtf(ss * (1.0f / 64.0f) + EPS);
                    const f32x4* rp = (const f32x4*)(rope + ((size_t)row * 32 + 8 * fq) * 2);
                    const f32x4 r0 = rp[0], r1 = rp[1], r2 = rp[2], r3 = rp[3];
                    const f32x4 t1a = a0 * ga0 * rs, t1b = a1 * ga1 * rs, t2a = b0 * gb0 * rs, t2b = b1 * gb1 * rs;
                    u32x4 w1, w2;
                    w1.x = cvt_pk_bf16(t1a[0] * r0[0] - t2a[0] * r0[1], t1a[1] * r0[2] - t2a[1] * r0[3]); w1.y = cvt_pk_bf16(t1a[2] * r1[0] - t2a[2] * r1[1], t1a[3] * r1[2] - t2a[3] * r1[3]);
                    w1.z = cvt_pk_bf16(t1b[0] * r2[0] - t2b[0] * r2[1], t1b[1] * r2[2] - t2b[1] * r2[3]); w1.w = cvt_pk_bf16(t1b[2] * r3[0] - t2b[2] * r3[1], t1b[3] * r3[2] - t2b[3] * r3[3]);
                    w2.x = cvt_pk_bf16(t2a[0] * r0[0] + t1a[0] * r0[1], t2a[1] * r0[2] + t1a[1] * r0[3]); w2.y = cvt_pk_bf16(t2a[2] * r1[0] + t1a[2] * r1[1], t2a[3] * r1[2] + t1a[3] * r1[3]);
                    w2.z = cvt_pk_bf16(t2b[0] * r2[0] + t1b[0] * r2[1], t2b[1] * r2[2] + t1b[1] * r2[3]); w2.w = cvt_pk_bf16(t2b[2] * r3[0] + t1b[2] * r3[1], t2b[3] * r3[2] + t1b[3] * r3[3]);
                    bf16_t* rowp = dst + (size_t)row * (D / 2);
                    *(u32x4*)rowp = w1; *(u32x4*)(rowp + 32) = w2;
                }
        } else {
            const int pn = u.pn; bf16_t* base; int ldc, colt; float sc = 1.0f;
            if (pn < 12) { base = (bf16_t*)(rb + B_DV); ldc = D / 2; colt = (pn - 8) * BM; }
            else if (pn < 14) { base = (bf16_t*)(rb + B_GQ); ldc = D / 4; colt = (pn - 12) * BM; sc = 0.08838834764831845f; }
            else if (pn < 16) { base = (bf16_t*)(rb + B_GK); ldc = D / 4; colt = (pn - 14) * BM; }
            else if (pn < 20) { base = (bf16_t*)(rb + B_GV); ldc = D / 2; colt = (pn - 16) * BM; }
            else { base = (bf16_t*)(rb + B_GR); ldc = D / 2; colt = (pn - 20) * BM; }
            const int col0 = colt + wc * 32 + 8 * fq;
#pragma unroll
            for (int ai = 0; ai < 2; ++ai)
#pragma unroll
                for (int m = 0; m < 4; ++m) { bf16_t* rowp = base + (size_t)(row0 + ai * HALF + m * 16) * ldc + col0;
#pragma unroll
                    for (int bj = 0; bj < 2; ++bj) { const f32x4 v0 = acc[ai][bj][m][0] * sc, v1 = acc[ai][bj][m][1] * sc;
                        u32x4 w; w.x = cvt_pk_bf16(v0[0], v0[1]); w.y = cvt_pk_bf16(v0[2], v0[3]); w.z = cvt_pk_bf16(v1[0], v1[1]); w.w = cvt_pk_bf16(v1[2], v1[3]);
                        *(u32x4*)(rowp + bj * HALF) = w; } }
        }
    }
};
struct EpiResid {
    static constexpr bool PERM = true, AFTER_DRAIN = false;
    const float* base; float* out; bf16_t* xn; const float* g; float* ssp;
    __device__ __forceinline__ void operator()(const f32x4 (&acc)[2][2][4][2], const Unit& u, int wr, int wc, int fr, int fq) const {
        const int row0 = u.pm * BM + wr * 64 + fr, col0 = u.pn * BM + wc * 32 + 8 * fq;
        f32x4 gv[2][2];
#pragma unroll
        for (int bj = 0; bj < 2; ++bj)
#pragma unroll
            for (int n = 0; n < 2; ++n) gv[bj][n] = *(const f32x4*)(g + col0 + bj * HALF + 4 * n);
#pragma unroll
        for (int ai = 0; ai < 2; ++ai)
#pragma unroll
            for (int m = 0; m < 4; ++m) { const int row = row0 + ai * HALF + m * 16; const size_t off = (size_t)row * D + col0; float ss = 0.f;
#pragma unroll
                for (int bj = 0; bj < 2; ++bj) { const f32x4 b0 = *(const f32x4*)(base + off + bj * HALF), b1 = *(const f32x4*)(base + off + bj * HALF + 4);
                    const f32x4 v0 = acc[ai][bj][m][0] + b0, v1 = acc[ai][bj][m][1] + b1;
                    *(f32x4*)(out + off + bj * HALF) = v0; *(f32x4*)(out + off + bj * HALF + 4) = v1; ss += dot4(v0) + dot4(v1);
                    const f32x4 x0 = v0 * gv[bj][0], x1 = v1 * gv[bj][1];
                    u32x4 w; w.x = cvt_pk_bf16(x0[0], x0[1]); w.y = cvt_pk_bf16(x0[2], x0[3]); w.z = cvt_pk_bf16(x1[0], x1[1]); w.w = cvt_pk_bf16(x1[2], x1[3]);
                    *(u32x4*)(xn + off + bj * HALF) = w; }
                ss += __shfl_xor(ss, 16); ss += __shfl_xor(ss, 32);
                if (fq == 0) ssp[(size_t)row * 32 + u.pn * 4 + wc] = ss;
                if (m & 1) asm volatile("" ::: "memory"); }
    }
};
struct EpiCq {
    static constexpr bool PERM = true, AFTER_DRAIN = false;
    const float* ssp_in; bf16_t* cq; float* cqss;
    __device__ __forceinline__ void operator()(const f32x4 (&acc)[2][2][4][2], const Unit& u, int wr, int wc, int fr, int fq) const {
        const int lane = fr + 16 * fq, row0 = u.pm * BM + wr * 64 + fr, col0 = u.pn * BM + wc * 32 + 8 * fq;
        float rs2[2];
#pragma unroll
        for (int ai = 0; ai < 2; ++ai) { const f32x4* p = (const f32x4*)(ssp_in + (size_t)(u.pm * BM + ai * HALF + wr * 64 + lane) * 32); f32x4 s4 = p[0];
#pragma unroll
            for (int j = 1; j < 8; ++j) s4 += p[j];
            rs2[ai] = 1.0f / sqrtf(((s4[0] + s4[1]) + (s4[2] + s4[3])) * (1.0f / D) + EPS); }
#pragma unroll
        for (int ai = 0; ai < 2; ++ai)
#pragma unroll
            for (int m = 0; m < 4; ++m) { const int row = row0 + ai * HALF + m * 16; const size_t off = (size_t)row * D + col0; float ss = 0.f;
                const float rsr = __shfl(rs2[ai], 16 * m + fr);
#pragma unroll
                for (int bj = 0; bj < 2; ++bj) { const f32x4 v0 = acc[ai][bj][m][0] * rsr, v1 = acc[ai][bj][m][1] * rsr; ss += dot4(v0) + dot4(v1);
                    u32x4 w; w.x = cvt_pk_bf16(v0[0], v0[1]); w.y = cvt_pk_bf16(v0[2], v0[3]); w.z = cvt_pk_bf16(v1[0], v1[1]); w.w = cvt_pk_bf16(v1[2], v1[3]);
                    *(u32x4*)(cq + off + bj * HALF) = w; }
                ss += __shfl_xor(ss, 16); ss += __shfl_xor(ss, 32);
                if (fq == 0) cqss[(size_t)row * 32 + u.pn * 4 + wc] = ss; }
    }
};

struct EpiPlain {
    static constexpr bool PERM = true, AFTER_DRAIN = false;
    bf16_t* out; int ldc;
    __device__ __forceinline__ void operator()(const f32x4 (&acc)[2][2][4][2], const Unit& u, int wr, int wc, int fr, int fq) const {
        const int row0 = u.pm * BM + wr * 64 + fr, col0 = u.pn * BM + wc * 32 + 8 * fq;
#pragma unroll
        for (int ai = 0; ai < 2; ++ai)
#pragma unroll
            for (int m = 0; m < 4; ++m) { bf16_t* rowp = out + (size_t)(row0 + ai * HALF + m * 16) * ldc + col0;
#pragma unroll
                for (int bj = 0; bj < 2; ++bj) { const f32x4 v0 = acc[ai][bj][m][0], v1 = acc[ai][bj][m][1];
                    u32x4 w; w.x = cvt_pk_bf16(v0[0], v0[1]); w.y = cvt_pk_bf16(v0[2], v0[3]); w.z = cvt_pk_bf16(v1[0], v1[1]); w.w = cvt_pk_bf16(v1[2], v1[3]);
                    *(u32x4*)(rowp + bj * HALF) = w; } }
    }
};
struct OneUnit {
    int pm, pn;
    __device__ __forceinline__ bool next(int i, Unit& u) const { if (i) return false; u.pm = pm; u.pn = pn; return true; }
    __device__ __forceinline__ void a_ready(const Unit&) const {}
    __device__ __forceinline__ void done(const Unit&) const {}
};
struct MoeOrder {
    const int* ctl; int NP, G, c;
    __device__ __forceinline__ bool next(int i, Unit& u) const { const int nt = ctl[CW_NTILES]; const int L = i * G + c; if (L >= nt * NP) return false;
        const int rt = L / NP; u.pm = rt; u.pn = ctl[CW_TILE_E + rt] * NP + (L - rt * NP); return true; }
    __device__ __forceinline__ void a_ready(const Unit&) const {}
    __device__ __forceinline__ void done(const Unit&) const {}
};
__device__ __forceinline__ float silu_fast(float x) { return x * __builtin_amdgcn_rcpf(1.0f + __expf(-x)); }
struct EpiGU {
    static constexpr bool PERM = true, AFTER_DRAIN = false;
    const int* slottok; const float* ssp; bf16_t* he;
    __device__ __forceinline__ void operator()(const f32x4 (&acc)[2][2][4][2], const Unit& u, int wr, int wc, int fr, int fq) const {
        const int lane = fr + 16 * fq, p0 = u.pm * BM + wr * 64, ct = u.pn & 3;
        float rs2[2];
#pragma unroll
        for (int ai = 0; ai < 2; ++ai) { const int tok = slottok[p0 + ai * HALF + lane]; float rs = 0.f;
            if (tok < T) { const f32x4* p = (const f32x4*)(ssp + (size_t)tok * 32); f32x4 s4 = p[0];
#pragma unroll
                for (int j = 1; j < 8; ++j) s4 += p[j];
                rs = 1.0f / sqrtf(((s4[0] + s4[1]) + (s4[2] + s4[3])) * (1.0f / D) + EPS); }
            rs2[ai] = rs; }
#pragma unroll
        for (int ai = 0; ai < 2; ++ai)
#pragma unroll
            for (int m = 0; m < 4; ++m) { const float rsr = __shfl(rs2[ai], 16 * m + fr);
                bf16_t* rowp = he + (size_t)(p0 + ai * HALF + 16 * m + fr) * DE + ct * 128 + wc * 32 + 8 * fq;
                const f32x4 g0 = acc[ai][0][m][0] * rsr, g1 = acc[ai][0][m][1] * rsr, u0 = acc[ai][1][m][0] * rsr, u1 = acc[ai][1][m][1] * rsr;
                u32x4 w; w.x = cvt_pk_bf16(silu_fast(g0[0]) * u0[0], silu_fast(g0[1]) * u0[1]); w.y = cvt_pk_bf16(silu_fast(g0[2]) * u0[2], silu_fast(g0[3]) * u0[3]);
                w.z = cvt_pk_bf16(silu_fast(g1[0]) * u1[0], silu_fast(g1[1]) * u1[1]); w.w = cvt_pk_bf16(silu_fast(g1[2]) * u1[2], silu_fast(g1[3]) * u1[3]);
                *(u32x4*)rowp = w; }
    }
};
struct EpiDown {
    static constexpr bool PERM = true, AFTER_DRAIN = false;
    const float* slotgate; bf16_t* y;
    __device__ __forceinline__ void operator()(const f32x4 (&acc)[2][2][4][2], const Unit& u, int wr, int wc, int fr, int fq) const {
        const int lane = fr + 16 * fq, p0 = u.pm * BM + wr * 64, ct = u.pn & 7;
        float gt2[2];
#pragma unroll
        for (int ai = 0; ai < 2; ++ai) gt2[ai] = slotgate[p0 + ai * HALF + lane];
#pragma unroll
        for (int ai = 0; ai < 2; ++ai)
#pragma unroll
            for (int m = 0; m < 4; ++m) { const float gt = __shfl(gt2[ai], 16 * m + fr);
                bf16_t* rowp = y + (size_t)(p0 + ai * HALF + 16 * m + fr) * D + ct * BM + wc * 32 + 8 * fq;
#pragma unroll
                for (int bj = 0; bj < 2; ++bj) { const f32x4 v0 = acc[ai][bj][m][0] * gt, v1 = acc[ai][bj][m][1] * gt;
                    u32x4 w; w.x = cvt_pk_bf16(v0[0], v0[1]); w.y = cvt_pk_bf16(v0[2], v0[3]); w.z = cvt_pk_bf16(v1[0], v1[1]); w.w = cvt_pk_bf16(v1[2], v1[3]);
                    *(u32x4*)(rowp + bj * HALF) = w; } }
    }
};
template <class Epi, class Sched, bool ALIGN_EPI = false, bool SP2 = false>
__device__ __forceinline__ void gemm_phase(PG8_LAS unsigned char* lds, const Gemm g, const Sched& S, const Epi& E) {
    int tid = threadIdx.x; asm volatile("" : "+v"(tid));
    const int wid = __builtin_amdgcn_readfirstlane(tid >> 6), lane = tid & 63, wr = wid >> 2, wc = wid & 3, fr = lane & 15, fq = lane >> 4;
    const int K = g.K, nt = K / BK;
    unsigned voffA[2], voffB[2];
#pragma unroll
    for (int i = 0; i < 2; ++i) { int R, C; stage_rc(tid * 16 + i * 8192, R, C); const int Rb = Epi::PERM ? ((R & ~31) + perm32(R & 31)) : R;
        voffA[i] = (unsigned)(R * K + C) * 2u; voffB[i] = (unsigned)(Rb * K + C) * 2u; }
    const size_t kstep = (size_t)(BK * 2);
    const size_t hstep = (size_t)HALF * K * 2;
    const size_t tstep = 2 * hstep;
    const unsigned ldsw = (unsigned)wid * 1024u;
    const int aoff = lds_byte(wr * 64 + fr, fq * 8), boff = lds_byte(wc * 32 + fr, fq * 8);
#define PG8_SA(b, h) (((b) * 2 + (h)) * HTB)
#define PG8_SB(b, h) ((4 + (b) * 2 + (h)) * HTB)
#define PG8_STAGE(bufoff, gbase, voff) do { _Pragma("unroll") for (int _i = 0; _i < 2; ++_i) \
        __builtin_amdgcn_global_load_lds((const unsigned*)((const char*)(gbase) + (voff)[_i]), (PG8_LAS unsigned*)(lds + (bufoff) + ldsw + _i * 8192), 16, 0, 0); } while (0)
#define PG8_LDA(dst, b, h) do { _Pragma("unroll") for (int m = 0; m < 4; ++m) _Pragma("unroll") for (int k = 0; k < 2; ++k) dst[m][k] = *(const PG8_LAS bf16x8*)(lds + PG8_SA(b, h) + aoff + m * 2048 + k * 1024); } while (0)
#define PG8_LDB(dst, b, h) do { _Pragma("unroll") for (int n = 0; n < 2; ++n) _Pragma("unroll") for (int k = 0; k < 2; ++k) dst[n][k] = *(const PG8_LAS bf16x8*)(lds + PG8_SB(b, h) + boff + n * 2048 + k * 1024); } while (0)
#define PG8_MMA(ai, bj, At, Bt) do { __builtin_amdgcn_s_setprio(1); _Pragma("unroll") for (int m = 0; m < 4; ++m) _Pragma("unroll") for (int n = 0; n < 2; ++n) _Pragma("unroll") for (int k = 0; k < 2; ++k) \
        acc[ai][bj][m][n] = __builtin_amdgcn_mfma_f32_16x16x32_bf16(Bt[n][k], At[m][k], acc[ai][bj][m][n], 0, 0, 0); __builtin_amdgcn_s_setprio(0); } while (0)
#define PG8_WAIT_V(n) asm volatile("s_waitcnt vmcnt(" #n ")" ::: "memory")
#define PG8_WAIT_L(n) asm volatile("s_waitcnt lgkmcnt(" #n ")" ::: "memory")
#define PG8_BAR __builtin_amdgcn_s_barrier()
#define PG8_SCHED __builtin_amdgcn_sched_barrier(0)
    Unit cur, nxt; int ui = 0;
    if (!S.next(0, cur)) return;
    f32x4 acc[2][2][4][2];
#pragma unroll
    for (int a = 0; a < 2; ++a)
#pragma unroll
        for (int b = 0; b < 2; ++b)
#pragma unroll
            for (int m = 0; m < 4; ++m)
#pragma unroll
                for (int n = 0; n < 2; ++n) acc[a][b][m][n] = (f32x4){0.f, 0.f, 0.f, 0.f};
    bf16x8 At[4][2], B0[2][2], B1[2][2];
    const char* cA = (const char*)g.A + (size_t)cur.pm * tstep; const char* cB = (const char*)g.Bt + (size_t)cur.pn * tstep;
    S.a_ready(cur);
    if constexpr (SP2) {
        PG8_STAGE(PG8_SB(0, 0), cB, voffB); PG8_STAGE(PG8_SB(0, 1), cB + hstep, voffB); PG8_STAGE(PG8_SA(0, 0), cA, voffA); PG8_STAGE(PG8_SA(0, 1), cA + hstep, voffA);
        if (wr == 1) PG8_BAR;
        PG8_WAIT_V(2); PG8_BAR;
        PG8_STAGE(PG8_SB(1, 0), cB + kstep, voffB); PG8_STAGE(PG8_SA(1, 0), cA + kstep, voffA); PG8_STAGE(PG8_SB(1, 1), cB + hstep + kstep, voffB);
        PG8_WAIT_V(6); PG8_BAR;
    } else {
        PG8_STAGE(PG8_SB(0, 0), cB, voffB); PG8_STAGE(PG8_SA(0, 0), cA, voffA); PG8_STAGE(PG8_SB(0, 1), cB + hstep, voffB); PG8_STAGE(PG8_SA(0, 1), cA + hstep, voffA);
        if (wr == 1) PG8_BAR;
        PG8_WAIT_V(4); PG8_BAR;
        PG8_STAGE(PG8_SB(1, 0), cB + kstep, voffB); PG8_STAGE(PG8_SA(1, 0), cA + kstep, voffA); PG8_STAGE(PG8_SB(1, 1), cB + hstep + kstep, voffB);
        PG8_WAIT_V(6); PG8_BAR;
    }
    for (;;) {
        const bool has_next = S.next(ui + 1, nxt);
        const char* nA = has_next ? (const char*)g.A + (size_t)nxt.pm * tstep : cA; const char* nB = has_next ? (const char*)g.Bt + (size_t)nxt.pn * tstep : cB;
        for (int t = 0; t < nt; t += 2) {
            const bool last = (t == nt - 2);
            const char* a1 = cA + (size_t)(t + 1) * kstep;
            const char* a2 = last ? nA : cA + (size_t)(t + 2) * kstep; const char* b2 = last ? nB : cB + (size_t)(t + 2) * kstep;
            const char* a3 = a2 + kstep; const char* b3 = b2 + kstep;
            if (last && has_next) S.a_ready(nxt);
            if constexpr (SP2) {
            PG8_LDB(B0, 0, 0); PG8_LDB(B1, 0, 1); PG8_SCHED; PG8_LDA(At, 0, 0); PG8_STAGE(PG8_SA(1, 1), a1 + hstep, voffA);
            PG8_WAIT_V(8); PG8_WAIT_L(0); PG8_BAR; PG8_MMA(0, 0, At, B0); PG8_MMA(0, 1, At, B1); PG8_BAR; PG8_SCHED;
            PG8_LDA(At, 0, 1); PG8_STAGE(PG8_SB(0, 0), b2, voffB); PG8_STAGE(PG8_SB(0, 1), b2 + hstep, voffB); PG8_STAGE(PG8_SA(0, 0), a2, voffA);
            PG8_WAIT_V(8); PG8_WAIT_L(0); PG8_BAR; PG8_MMA(1, 0, At, B0); PG8_MMA(1, 1, At, B1); PG8_BAR; PG8_SCHED;
            PG8_LDB(B0, 1, 0); PG8_LDB(B1, 1, 1); PG8_SCHED; PG8_LDA(At, 1, 0); PG8_STAGE(PG8_SA(0, 1), a2 + hstep, voffA);
            PG8_WAIT_V(8); PG8_WAIT_L(0); PG8_BAR; PG8_MMA(0, 0, At, B0); PG8_MMA(0, 1, At, B1); PG8_BAR; PG8_SCHED;
            PG8_LDA(At, 1, 1); PG8_STAGE(PG8_SB(1, 0), b3, voffB); PG8_STAGE(PG8_SB(1, 1), b3 + hstep, voffB); PG8_STAGE(PG8_SA(1, 0), a3, voffA);
            PG8_WAIT_V(8); PG8_WAIT_L(0); PG8_BAR; PG8_MMA(1, 0, At, B0); PG8_MMA(1, 1, At, B1); PG8_BAR; PG8_SCHED;
            } else {
            PG8_LDB(B0, 0, 0); PG8_SCHED; PG8_LDA(At, 0, 0); PG8_STAGE(PG8_SA(1, 1), a1 + hstep, voffA);
            PG8_WAIT_L(8); PG8_BAR; PG8_WAIT_L(0); PG8_MMA(0, 0, At, B0); PG8_BAR; PG8_SCHED;
            PG8_LDB(B1, 0, 1); PG8_STAGE(PG8_SB(0, 0), b2, voffB);
            PG8_BAR; PG8_WAIT_L(0); PG8_MMA(0, 1, At, B1); PG8_BAR;
            PG8_LDA(At, 0, 1); PG8_STAGE(PG8_SA(0, 0), a2, voffA);
            PG8_BAR; PG8_WAIT_L(0); PG8_MMA(1, 0, At, B0); PG8_BAR; PG8_SCHED;
            PG8_STAGE(PG8_SB(0, 1), b2 + hstep, voffB);
            PG8_WAIT_V(6); PG8_BAR; PG8_MMA(1, 1, At, B1); PG8_BAR;
            PG8_LDB(B0, 1, 0); PG8_SCHED; PG8_LDA(At, 1, 0); PG8_STAGE(PG8_SA(0, 1), a2 + hstep, voffA);
            PG8_WAIT_L(8); PG8_BAR; PG8_WAIT_L(0); PG8_MMA(0, 0, At, B0); PG8_BAR; PG8_SCHED;
            PG8_LDB(B1, 1, 1); PG8_STAGE(PG8_SB(1, 0), b3, voffB);
            PG8_BAR; PG8_WAIT_L(0); PG8_MMA(0, 1, At, B1); PG8_BAR;
            PG8_LDA(At, 1, 1); PG8_STAGE(PG8_SA(1, 0), a3, voffA);
            PG8_BAR; PG8_WAIT_L(0); PG8_MMA(1, 0, At, B0); PG8_BAR; PG8_SCHED;
            PG8_STAGE(PG8_SB(1, 1), b3 + hstep, voffB);
            PG8_WAIT_V(6); PG8_BAR; PG8_MMA(1, 1, At, B1); PG8_BAR;
            }
        }
        if constexpr (ALIGN_EPI) { if (wr == 0) PG8_BAR; }
        if constexpr (!Epi::AFTER_DRAIN) { E(acc, cur, wr, wc, fr, fq); S.done(cur); }
        if (!has_next) break;
#pragma unroll
        for (int a = 0; a < 2; ++a)
#pragma unroll
            for (int b = 0; b < 2; ++b)
#pragma unroll
                for (int m = 0; m < 4; ++m)
#pragma unroll
                    for (int n = 0; n < 2; ++n) acc[a][b][m][n] = (f32x4){0.f, 0.f, 0.f, 0.f};
        cur = nxt; cA = nA; cB = nB; ++ui;
        if constexpr (ALIGN_EPI) { if (wr == 1) PG8_BAR; }
    }
    PG8_WAIT_V(0);
    if constexpr (!ALIGN_EPI) { if (wr == 0) PG8_BAR; }
    PG8_BAR;
    if constexpr (Epi::AFTER_DRAIN) { E.fused(acc, cur, wr, wc, fr, fq, lds, wid, lane); S.done(cur); }
#undef PG8_SA
#undef PG8_SB
#undef PG8_STAGE
#undef PG8_LDA
#undef PG8_LDB
#undef PG8_MMA
#undef PG8_WAIT_V
#undef PG8_WAIT_L
#undef PG8_BAR
#undef PG8_SCHED
}
template <class Epi, class Sched, bool ALIGN_EPI = true>
__device__ __forceinline__ void gemm_phase_gather(PG8_LAS unsigned char* lds, const Gemm g, const int* rowidx, const Sched& S, const Epi& E) {
    constexpr bool SP2 = true;
    int tid = threadIdx.x; asm volatile("" : "+v"(tid));
    const int wid = __builtin_amdgcn_readfirstlane(tid >> 6), lane = tid & 63, wr = wid >> 2, wc = wid & 3, fr = lane & 15, fq = lane >> 4;
    const int K = g.K, nt = K / BK;
    unsigned voffB[2]; int RA[2], CA[2];
#pragma unroll
    for (int i = 0; i < 2; ++i) { int R, C; stage_rc(tid * 16 + i * 8192, R, C); const int Rb = Epi::PERM ? ((R & ~31) + perm32(R & 31)) : R;
        RA[i] = R; CA[i] = C; voffB[i] = (unsigned)(Rb * K + C) * 2u; }
    unsigned vc[2][2], vn[2][2];
#define PG8_GOFF(dst, pm_) do { _Pragma("unroll") for (int h_ = 0; h_ < 2; ++h_) _Pragma("unroll") for (int i_ = 0; i_ < 2; ++i_) \
        dst[h_][i_] = ((unsigned)rowidx[(pm_) * BM + h_ * HALF + RA[i_]] * (unsigned)K + (unsigned)CA[i_]) * 2u; } while (0)
#define PG8_STAGE_A(bufoff, gbase, v0, v1) do { \
        __builtin_amdgcn_global_load_lds((const unsigned*)((const char*)(gbase) + (v0)), (PG8_LAS unsigned*)(lds + (bufoff) + ldsw), 16, 0, 0); \
        __builtin_amdgcn_global_load_lds((const unsigned*)((const char*)(gbase) + (v1)), (PG8_LAS unsigned*)(lds + (bufoff) + ldsw + 8192), 16, 0, 0); } while (0)
    const size_t kstep = (size_t)(BK * 2);
    const size_t hstep = (size_t)HALF * K * 2;
    const size_t tstep = 2 * hstep;
    const unsigned ldsw = (unsigned)wid * 1024u;
    const int aoff = lds_byte(wr * 64 + fr, fq * 8), boff = lds_byte(wc * 32 + fr, fq * 8);
#define PG8_SA(b, h) (((b) * 2 + (h)) * HTB)
#define PG8_SB(b, h) ((4 + (b) * 2 + (h)) * HTB)
#define PG8_STAGE(bufoff, gbase, voff) do { _Pragma("unroll") for (int _i = 0; _i < 2; ++_i) \
        __builtin_amdgcn_global_load_lds((const unsigned*)((const char*)(gbase) + (voff)[_i]), (PG8_LAS unsigned*)(lds + (bufoff) + ldsw + _i * 8192), 16, 0, 0); } while (0)
#define PG8_LDA(dst, b, h) do { _Pragma("unroll") for (int m = 0; m < 4; ++m) _Pragma("unroll") for (int k = 0; k < 2; ++k) dst[m][k] = *(const PG8_LAS bf16x8*)(lds + PG8_SA(b, h) + aoff + m * 2048 + k * 1024); } while (0)
#define PG8_LDB(dst, b, h) do { _Pragma("unroll") for (int n = 0; n < 2; ++n) _Pragma("unroll") for (int k = 0; k < 2; ++k) dst[n][k] = *(const PG8_LAS bf16x8*)(lds + PG8_SB(b, h) + boff + n * 2048 + k * 1024); } while (0)
#define PG8_MMA(ai, bj, At, Bt) do { __builtin_amdgcn_s_setprio(1); _Pragma("unroll") for (int m = 0; m < 4; ++m) _Pragma("unroll") for (int n = 0; n < 2; ++n) _Pragma("unroll") for (int k = 0; k < 2; ++k) \
        acc[ai][bj][m][n] = __builtin_amdgcn_mfma_f32_16x16x32_bf16(Bt[n][k], At[m][k], acc[ai][bj][m][n], 0, 0, 0); __builtin_amdgcn_s_setprio(0); } while (0)
#define PG8_WAIT_V(n) asm volatile("s_waitcnt vmcnt(" #n ")" ::: "memory")
#define PG8_WAIT_L(n) asm volatile("s_waitcnt lgkmcnt(" #n ")" ::: "memory")
#define PG8_BAR __builtin_amdgcn_s_barrier()
#define PG8_SCHED __builtin_amdgcn_sched_barrier(0)
    Unit cur, nxt; int ui = 0;
    if (!S.next(0, cur)) return;
    f32x4 acc[2][2][4][2];
#pragma unroll
    for (int a = 0; a < 2; ++a)
#pragma unroll
        for (int b = 0; b < 2; ++b)
#pragma unroll
            for (int m = 0; m < 4; ++m)
#pragma unroll
                for (int n = 0; n < 2; ++n) acc[a][b][m][n] = (f32x4){0.f, 0.f, 0.f, 0.f};
    bf16x8 At[4][2], B0[2][2], B1[2][2];
    const char* cA = (const char*)g.A; PG8_GOFF(vc, cur.pm); const char* cB = (const char*)g.Bt + (size_t)cur.pn * tstep;
    S.a_ready(cur);
    if constexpr (SP2) {
        PG8_STAGE(PG8_SB(0, 0), cB, voffB); PG8_STAGE(PG8_SB(0, 1), cB + hstep, voffB); PG8_STAGE_A(PG8_SA(0, 0), cA, vc[0][0], vc[0][1]); PG8_STAGE_A(PG8_SA(0, 1), cA, vc[1][0], vc[1][1]);
        if (wr == 1) PG8_BAR;
        PG8_WAIT_V(2); PG8_BAR;
        PG8_STAGE(PG8_SB(1, 0), cB + kstep, voffB); PG8_STAGE_A(PG8_SA(1, 0), cA + kstep, vc[0][0], vc[0][1]); PG8_STAGE(PG8_SB(1, 1), cB + hstep + kstep, voffB);
        PG8_WAIT_V(6); PG8_BAR;
    }
    for (;;) {
        const bool has_next = S.next(ui + 1, nxt);
        const char* nA = cA; if (has_next) PG8_GOFF(vn, nxt.pm); else { vn[0][0] = vc[0][0]; vn[0][1] = vc[0][1]; vn[1][0] = vc[1][0]; vn[1][1] = vc[1][1]; } const char* nB = has_next ? (const char*)g.Bt + (size_t)nxt.pn * tstep : cB;
        for (int t = 0; t < nt; t += 2) {
            const bool last = (t == nt - 2);
            const char* a1 = cA + (size_t)(t + 1) * kstep;
            const char* a2 = last ? nA : cA + (size_t)(t + 2) * kstep; const char* b2 = last ? nB : cB + (size_t)(t + 2) * kstep;
            const char* a3 = a2 + kstep; const char* b3 = b2 + kstep;
            const unsigned o00 = last ? vn[0][0] : vc[0][0], o01 = last ? vn[0][1] : vc[0][1], o10 = last ? vn[1][0] : vc[1][0], o11 = last ? vn[1][1] : vc[1][1];
            if (last && has_next) S.a_ready(nxt);
            if constexpr (SP2) {
            PG8_LDB(B0, 0, 0); PG8_LDB(B1, 0, 1); PG8_SCHED; PG8_LDA(At, 0, 0); PG8_STAGE_A(PG8_SA(1, 1), a1, vc[1][0], vc[1][1]);
            PG8_WAIT_V(8); PG8_WAIT_L(0); PG8_BAR; PG8_MMA(0, 0, At, B0); PG8_MMA(0, 1, At, B1); PG8_BAR; PG8_SCHED;
            PG8_LDA(At, 0, 1); PG8_STAGE(PG8_SB(0, 0), b2, voffB); PG8_STAGE(PG8_SB(0, 1), b2 + hstep, voffB); PG8_STAGE_A(PG8_SA(0, 0), a2, o00, o01);
            PG8_WAIT_V(8); PG8_WAIT_L(0); PG8_BAR; PG8_MMA(1, 0, At, B0); PG8_MMA(1, 1, At, B1); PG8_BAR; PG8_SCHED;
            PG8_LDB(B0, 1, 0); PG8_LDB(B1, 1, 1); PG8_SCHED; PG8_LDA(At, 1, 0); PG8_STAGE_A(PG8_SA(0, 1), a2, o10, o11);
            PG8_WAIT_V(8); PG8_WAIT_L(0); PG8_BAR; PG8_MMA(0, 0, At, B0); PG8_MMA(0, 1, At, B1); PG8_BAR; PG8_SCHED;
            PG8_LDA(At, 1, 1); PG8_STAGE(PG8_SB(1, 0), b3, voffB); PG8_STAGE(PG8_SB(1, 1), b3 + hstep, voffB); PG8_STAGE_A(PG8_SA(1, 0), a3, o00, o01);
            PG8_WAIT_V(8); PG8_WAIT_L(0); PG8_BAR; PG8_MMA(1, 0, At, B0); PG8_MMA(1, 1, At, B1); PG8_BAR; PG8_SCHED;
            }
        }
        if constexpr (ALIGN_EPI) { if (wr == 0) PG8_BAR; }
        if constexpr (!Epi::AFTER_DRAIN) { E(acc, cur, wr, wc, fr, fq); S.done(cur); }
        if (!has_next) break;
#pragma unroll
        for (int a = 0; a < 2; ++a)
#pragma unroll
            for (int b = 0; b < 2; ++b)
#pragma unroll
                for (int m = 0; m < 4; ++m)
#pragma unroll
                    for (int n = 0; n < 2; ++n) acc[a][b][m][n] = (f32x4){0.f, 0.f, 0.f, 0.f};
        cur = nxt; cA = nA; cB = nB; ++ui; vc[0][0] = vn[0][0]; vc[0][1] = vn[0][1]; vc[1][0] = vn[1][0]; vc[1][1] = vn[1][1];
        if constexpr (ALIGN_EPI) { if (wr == 1) PG8_BAR; }
    }
    PG8_WAIT_V(0);
    if constexpr (!ALIGN_EPI) { if (wr == 0) PG8_BAR; }
    PG8_BAR;
    if constexpr (Epi::AFTER_DRAIN) { E.fused(acc, cur, wr, wc, fr, fq, lds, wid, lane); S.done(cur); }
#undef PG8_GOFF
#undef PG8_STAGE_A
#undef PG8_SA
#undef PG8_SB
#undef PG8_STAGE
#undef PG8_LDA
#undef PG8_LDB
#undef PG8_MMA
#undef PG8_WAIT_V
#undef PG8_WAIT_L
#undef PG8_BAR
#undef PG8_SCHED
}
}

typedef float f32x4 __attribute__((ext_vector_type(4)));
typedef unsigned u32x4 __attribute__((ext_vector_type(4)));
typedef unsigned u32x2 __attribute__((ext_vector_type(2)));
__device__ __forceinline__ unsigned pk2(float lo, float hi) { unsigned r; asm volatile("v_cvt_pk_bf16_f32 %0, %1, %2" : "=v"(r) : "v"(lo), "v"(hi)); return r; }
__device__ __forceinline__ float wave_sum(float v) {
#pragma unroll
    for (int o = 1; o < 64; o <<= 1) v += __shfl_xor(v, o);
    return v;
}
constexpr int F0_SCR = 64 * 65 * 4;
__device__ __forceinline__ void f0_transpose_item(const float* src, int ldw, int c0, int c1, bf16* dst, int K, LAS float* scr, int lane) {
    const float* sp = src + ((lane >> 5) ? c1 : c0) + (lane & 31);
    float v[64];
#pragma unroll
    for (int kk = 0; kk < 64; ++kk) v[kk] = sp[(size_t)kk * ldw];
#pragma unroll
    for (int kk = 0; kk < 64; ++kk) scr[kk * 65 + lane] = v[kk];
    LDS_WAIT(); asm volatile("" ::: "memory");
    const int c = lane & 7;
#pragma unroll
    for (int j = 0; j < 8; ++j) { const int n = (lane >> 3) + 8 * j; const LAS float* s = scr + (8 * c) * 65 + n;
        u32x4 o; o.x = pk2(s[0 * 65], s[1 * 65]); o.y = pk2(s[2 * 65], s[3 * 65]); o.z = pk2(s[4 * 65], s[5 * 65]); o.w = pk2(s[6 * 65], s[7 * 65]);
        *(u32x4*)(dst + (size_t)n * K + 8 * c) = o; }
    LDS_WAIT(); asm volatile("" ::: "memory");
}
template <bool WITH_LR> __device__ __forceinline__ void f0_rows2(const float* x0, const float* g, bf16* o0, const float* w_in, float* glr0, int lane) {
    f32x4 v[2][8]; float ss[2] = {0.f, 0.f};
#pragma unroll
    for (int r = 0; r < 2; ++r)
#pragma unroll
        for (int j = 0; j < 8; ++j) { v[r][j] = ((const f32x4*)(x0 + (size_t)r * D))[lane + 64 * j]; ss[r] += (v[r][j][0] * v[r][j][0] + v[r][j][1] * v[r][j][1]) + (v[r][j][2] * v[r][j][2] + v[r][j][3] * v[r][j][3]); }
    const float rs0 = 1.0f / sqrtf(wave_sum(ss[0]) * (1.0f / D) + EPS), rs1 = 1.0f / sqrtf(wave_sum(ss[1]) * (1.0f / D) + EPS);
    float acc[2][16];
    if (WITH_LR) {
#pragma unroll
        for (int r = 0; r < 2; ++r)
#pragma unroll
            for (int cc = 0; cc < 16; ++cc) acc[r][cc] = 0.f;
    }
#pragma unroll
    for (int j = 0; j < 8; ++j) { const f32x4 gv = ((const f32x4*)g)[lane + 64 * j];
        v[0][j] = v[0][j] * gv * rs0; v[1][j] = v[1][j] * gv * rs1;
        u32x2 w0, w1; w0.x = pk2(v[0][j][0], v[0][j][1]); w0.y = pk2(v[0][j][2], v[0][j][3]); w1.x = pk2(v[1][j][0], v[1][j][1]); w1.y = pk2(v[1][j][2], v[1][j][3]);
        ((u32x2*)o0)[lane + 64 * j] = w0; ((u32x2*)(o0 + D))[lane + 64 * j] = w1;
        if (WITH_LR) {
#pragma unroll
            for (int e = 0; e < 4; ++e) { const float* wp = w_in + (size_t)(4 * (lane + 64 * j) + e) * IN_COLS + O_LR;
                const f32x4 wa = *(const f32x4*)wp, wb = *(const f32x4*)(wp + 4), wc_ = *(const f32x4*)(wp + 8), wd = *(const f32x4*)(wp + 12);
#pragma unroll
                for (int r = 0; r < 2; ++r) { const float xv = v[r][j][e];
#pragma unroll
                    for (int q = 0; q < 4; ++q) { acc[r][q] += xv * wa[q]; acc[r][4 + q] += xv * wb[q]; acc[r][8 + q] += xv * wc_[q]; acc[r][12 + q] += xv * wd[q]; } } }
        }
    }
    if (WITH_LR) {
        float a16[16];
#pragma unroll
        for (int i = 0; i < 16; ++i) { const bool up = (lane & 32) != 0; const float keep = up ? acc[1][i] : acc[0][i], send = up ? acc[0][i] : acc[1][i]; a16[i] = keep + __shfl_xor(send, 32); }
        float a8[8];
#pragma unroll
        for (int i = 0; i < 8; ++i) { const bool up = (lane & 16) != 0; const float keep = up ? a16[8 + i] : a16[i], send = up ? a16[i] : a16[8 + i]; a8[i] = keep + __shfl_xor(send, 16); }
        float a4[4];
#pragma unroll
        for (int i = 0; i < 4; ++i) { const bool up = (lane & 8) != 0; const float keep = up ? a8[4 + i] : a8[i], send = up ? a8[i] : a8[4 + i]; a4[i] = keep + __shfl_xor(send, 8); }
        float a2[2];
#pragma unroll
        for (int i = 0; i < 2; ++i) { const bool up = (lane & 4) != 0; const float keep = up ? a4[2 + i] : a4[i], send = up ? a4[i] : a4[2 + i]; a2[i] = keep + __shfl_xor(send, 4); }
        float a1; { const bool up = (lane & 2) != 0; const float keep = up ? a2[1] : a2[0], send = up ? a2[0] : a2[1]; a1 = keep + __shfl_xor(send, 2); }
        a1 += __shfl_xor(a1, 1);
        if ((lane & 1) == 0) { const int idx = (lane >> 1) & 31; glr0[(size_t)(idx >> 4) * GRK + (idx & 15)] = a1; }
    }
}
struct Ctx;
__device__ __forceinline__ void fast_prologue(const Ctx& c, LAS unsigned char* lds);
#endif

#ifndef HOST_EMU
namespace fa {
typedef short bf16x8 __attribute__((ext_vector_type(8)));
typedef short s16x4 __attribute__((ext_vector_type(4)));
typedef float f32x16 __attribute__((ext_vector_type(16)));
typedef float f32x4 __attribute__((ext_vector_type(4)));
typedef unsigned u32x4 __attribute__((ext_vector_type(4)));
constexpr int TILE_B = 16384;
constexpr int STAGE_B = 4 * TILE_B;
constexpr int XL_OFF = 2 * STAGE_B;
#define FA_SBAR() __builtin_amdgcn_sched_barrier(0)
__device__ __forceinline__ int crow(int r, int hi) { return (r & 3) + 8 * (r >> 2) + 4 * hi; }
__device__ __forceinline__ unsigned cvtpk(float lo, float hi) { unsigned r; asm volatile("v_cvt_pk_bf16_f32 %0, %1, %2" : "=v"(r) : "v"(lo), "v"(hi)); return r; }
__device__ __forceinline__ int v_rd_base(int lane) { return ((lane & 3) << 3) | (((lane >> 2) & 3) << 6) | (((lane >> 4) & 1) << 5) | (((lane >> 5) & 1) << 8); }
constexpr int v_rd_off(int d0, int ks, int half) { return d0 * 512 + ks * 4096 + half * 2048; }
template <int OFF> __device__ __forceinline__ s16x4 tr_read(int vb) { s16x4 r; asm volatile("ds_read_b64_tr_b16 %0, %1 offset:%2" : "=&v"(r) : "v"(vb), "i"(OFF) : "memory"); return r; }

struct DmaOff { unsigned koff0, koff1, voff; };
__device__ __forceinline__ DmaOff dma_offsets(int lane) {
    const int l4 = lane >> 4, c16 = lane & 15, w2 = (lane & 31) >> 2, l5 = lane >> 5; DmaOff o;
    o.koff0 = (unsigned)(l4 * (D / 2) + 8 * (c16 ^ l4)) * 2u; o.koff1 = (unsigned)(l4 * (D / 2) + 8 * (c16 ^ (4 + l4))) * 2u;
    o.voff = (unsigned)(((w2 & 3) + 8 * (w2 >> 2)) * (D / 2) + l5 * 32 + (lane & 3) * 8) * 2u;
    return o;
}
__device__ __forceinline__ void issue_stage(LAS unsigned char* stage, const bf16* DKb, const bf16* DVb, int key_e, int wave, const DmaOff& o) {
    const int tsel = wave >> 2, kv = (wave >> 1) & 1, pb = 8 * (wave & 1), key0 = key_e + 64 * tsel;
    LAS unsigned char* dst = stage + tsel * 2 * TILE_B + kv * TILE_B + 1024 * pb;
    if (kv == 0) {
        const char* base = (const char*)(DKb + (size_t)(key0 + 4 * pb) * (D / 2));
#pragma unroll
        for (int i = 0; i < 8; ++i)
            __builtin_amdgcn_global_load_lds((const unsigned*)(base + (size_t)(4 * i) * (D / 2) * 2 + ((i & 1) ? o.koff1 : o.koff0)), (LAS unsigned*)(dst + 1024 * i), 16, 0, 0);
    } else {
#pragma unroll
        for (int i = 0; i < 8; ++i) { const int p = pb + i, ku = 4 * ((p >> 1) & 1) + 16 * (p >> 2);
            const char* base = (const char*)(DVb + (size_t)(key0 + ku) * (D / 2) + 64 * (p & 1));
            __builtin_amdgcn_global_load_lds((const unsigned*)(base + o.voff), (LAS unsigned*)(dst + 1024 * i), 16, 0, 0); }
    }
}
__device__ __forceinline__ void attn_finish(f32x16 (&o)[4], float l, int wave, float lam, const float* subln_g, bf16* mixw, LAS unsigned char* lds);
template <int KH, bool SHIFT> __device__ __forceinline__ float qk_exp_pack(bf16x8& pa_lo, bf16x8& pa_hi, LAS const unsigned char* Kc  , const bf16x8 (&qr)[4], float negm, int r32, int hi, int sw) {
    f32x16 p;
#pragma unroll
    for (int r = 0; r < 16; ++r) p[r] = 0.f;
#pragma unroll
    for (int d0 = 0; d0 < 4; ++d0) { const int cb = (d0 * 16 + hi * 8) * 2;
        const bf16x8 kf = *(LAS const bf16x8*)(Kc + (32 * KH + r32) * 256 + (cb ^ sw));
        p = __builtin_amdgcn_mfma_f32_32x32x16_bf16(kf, qr[d0], p, 0, 0, 0); }
    float s = 0.f;
#pragma unroll
    for (int r = 0; r < 16; ++r) { p[r] = __builtin_amdgcn_exp2f(SHIFT ? p[r] + negm : p[r]); s += p[r]; }
#define FA_PK4(P, BASE, OUT) do { unsigned a0 = cvtpk(P[BASE + 0], P[BASE + 1]), a1 = cvtpk(P[BASE + 2], P[BASE + 3]); \
    unsigned b0 = cvtpk(P[BASE + 4], P[BASE + 5]), b1 = cvtpk(P[BASE + 6], P[BASE + 7]); \
    auto r0 = __builtin_amdgcn_permlane32_swap(a0, b0, false, false); auto r1 = __builtin_amdgcn_permlane32_swap(a1, b1, false, false); \
    u32x4 w = {r0[0], r1[0], r0[1], r1[1]}; OUT = *reinterpret_cast<bf16x8*>(&w); } while (0)
    FA_PK4(p, 0, pa_lo); FA_PK4(p, 8, pa_hi);
#undef FA_PK4
    return s;
}
template <int D0> __device__ __forceinline__ void pv1(f32x16& oa, int vb, const bf16x8 (&pa)[4]) {
    const s16x4 l0 = tr_read<v_rd_off(D0, 0, 0)>(vb), h0 = tr_read<v_rd_off(D0, 0, 1)>(vb), l1 = tr_read<v_rd_off(D0, 1, 0)>(vb), h1 = tr_read<v_rd_off(D0, 1, 1)>(vb);
    const s16x4 l2 = tr_read<v_rd_off(D0, 2, 0)>(vb), h2 = tr_read<v_rd_off(D0, 2, 1)>(vb), l3 = tr_read<v_rd_off(D0, 3, 0)>(vb), h3 = tr_read<v_rd_off(D0, 3, 1)>(vb);
    asm volatile("s_waitcnt lgkmcnt(0)" ::: "memory"); FA_SBAR();
#define FA_PK(L, H) (bf16x8){L[0], L[1], L[2], L[3], H[0], H[1], H[2], H[3]}
    oa = __builtin_amdgcn_mfma_f32_32x32x16_bf16(pa[0], FA_PK(l0, h0), oa, 0, 0, 0);
    oa = __builtin_amdgcn_mfma_f32_32x32x16_bf16(pa[1], FA_PK(l1, h1), oa, 0, 0, 0);
    oa = __builtin_amdgcn_mfma_f32_32x32x16_bf16(pa[2], FA_PK(l2, h2), oa, 0, 0, 0);
    oa = __builtin_amdgcn_mfma_f32_32x32x16_bf16(pa[3], FA_PK(l3, h3), oa, 0, 0, 0);
#undef FA_PK
}

template <bool SHIFT> __device__ __forceinline__ void attn_unit(int b, int h, int j, const bf16* DQ, const bf16* DK, const bf16* DV, bf16* MIX, const float* subln_g, float lam, float mref, LAS unsigned char* lds) {
    const int tid = threadIdx.x; int lane = tid & 63; asm volatile("" : "+v"(lane));
    const int r32 = lane & 31, hi = lane >> 5; const int wave = __builtin_amdgcn_readfirstlane(tid >> 6);
    const int wq = wave & 3, comp = wave >> 2;
    const size_t rowbase = (size_t)b * SEQ;
    const bf16* DKb = DK + rowbase * (D / 2) + h * 128; const bf16* DVb = DV + rowbase * (D / 2) + h * 128;
    const DmaOff dof = dma_offsets(lane);
    issue_stage(lds, DKb, DVb, 0, wave, dof);
    bf16x8 qr[4];
    { const bf16* Qw = DQ + (rowbase + 128 * j + 32 * wq + r32) * (D / 2) + h * 128 + comp * 64 + hi * 8;
#pragma unroll
      for (int d0 = 0; d0 < 4; ++d0) qr[d0] = *(const bf16x8*)(Qw + d0 * 16); }
    f32x16 o[4];
#pragma unroll
    for (int d = 0; d < 4; ++d)
#pragma unroll
        for (int r = 0; r < 16; ++r) o[d][r] = 0.f;
    float l = 0.f; const float negm = -mref;
    const int last_tile = 2 * j + (wq >> 1);
    const unsigned lds0 = (unsigned)(uintptr_t)lds; const int sw = (r32 & 7) << 4;
    for (int s = 0; s <= j; ++s) {
        asm volatile("s_waitcnt vmcnt(0)" ::: "memory"); __builtin_amdgcn_s_barrier(); asm volatile("" ::: "memory");
        if (s < j) issue_stage(lds + ((s + 1) & 1) * STAGE_B, DKb, DVb, 128 * (s + 1), wave, dof);
#pragma unroll
        for (int ts = 0; ts < 2; ++ts) {
            if (2 * s + ts <= last_tile) {
                LAS const unsigned char* Kc = lds + (s & 1) * STAGE_B + ts * 2 * TILE_B + comp * 128;
                const int vb = (int)(lds0 + (s & 1) * STAGE_B + ts * 2 * TILE_B + TILE_B) + v_rd_base(lane);
                bf16x8 pa[4];
                l += qk_exp_pack<0, SHIFT>(pa[0], pa[1], Kc, qr, negm, r32, hi, sw); FA_SBAR(); l += qk_exp_pack<1, SHIFT>(pa[2], pa[3], Kc, qr, negm, r32, hi, sw); FA_SBAR();
                pv1<0>(o[0], vb, pa); pv1<1>(o[1], vb, pa); pv1<2>(o[2], vb, pa); pv1<3>(o[3], vb, pa);
            }
        }
    }
    asm volatile("s_waitcnt lgkmcnt(0)" ::: "memory"); __builtin_amdgcn_s_barrier(); asm volatile("" ::: "memory");
    attn_finish(o, l, wave, lam, subln_g, MIX + (rowbase + 128 * j + 32 * wq) * D + h * 128, lds);
}
__device__ __forceinline__ void attn_finish(f32x16 (&o)[4], float l, int wave, float lam, const float* subln_g, bf16* mixw, LAS unsigned char* lds) {
    int lane = threadIdx.x & 63; asm volatile("" : "+v"(lane));
    const int r32 = lane & 31, hi = lane >> 5, wq = wave & 3, comp = wave >> 2;
    LAS float* X1 = (LAS float*)lds;
    LAS float* LI = (LAS float*)(lds + XL_OFF) + wave * 32;
    l += __shfl_xor(l, 32);
    if (hi == 0) LI[r32] = (comp ? lam : 1.0f) * __builtin_amdgcn_rcpf(l);
    asm volatile("s_waitcnt lgkmcnt(0)" ::: "memory");
#pragma unroll
    for (int r = 0; r < 16; ++r) { const float inv = LI[crow(r, hi)];
#pragma unroll
        for (int d = 0; d < 4; ++d) o[d][r] *= inv; }
    if (comp == 1) {
#pragma unroll
        for (int d = 0; d < 4; ++d)
#pragma unroll
            for (int r = 0; r < 16; ++r) X1[((wq * 4 + d) * 16 + r) * 64 + lane] = o[d][r];
    }
    asm volatile("s_waitcnt lgkmcnt(0)" ::: "memory"); __builtin_amdgcn_s_barrier(); asm volatile("" ::: "memory");
    if (comp == 0) {
#pragma unroll
        for (int d = 0; d < 4; ++d)
#pragma unroll
            for (int r = 0; r < 16; ++r) { o[d][r] -= X1[((wq * 4 + d) * 16 + r) * 64 + lane]; if ((r & 3) == 3) { asm volatile("s_waitcnt lgkmcnt(0)" ::: "memory"); FA_SBAR(); } }
    }
    asm volatile("s_waitcnt lgkmcnt(0)" ::: "memory"); __builtin_amdgcn_s_barrier(); asm volatile("" ::: "memory");
    if (comp == 0) {
        LAS float* W = (LAS float*)(lds + wq * (32 * 132 * 4));
#pragma unroll
        for (int r = 0; r < 16; ++r) { const int q = crow(r, hi);
#pragma unroll
            for (int d = 0; d < 4; ++d) W[q * 132 + 32 * d + r32] = o[d][r]; }
        asm volatile("s_waitcnt lgkmcnt(0)" ::: "memory");
        const int q = lane >> 1, hf = lane & 1;
        f32x4 v[16]; float ss = 0.f;
#pragma unroll
        for (int i = 0; i < 16; ++i) { v[i] = *(LAS const f32x4*)(W + q * 132 + hf * 64 + 4 * i); ss += (v[i][0] * v[i][0] + v[i][1] * v[i][1]) + (v[i][2] * v[i][2] + v[i][3] * v[i][3]); }
        ss += __shfl_xor(ss, 1);
        const float rs = 0.8f / sqrtf(ss * (1.0f / 128.0f) + EPS);
        bf16* op = mixw + (size_t)q * D + hf * 64;
#pragma unroll
        for (int i = 0; i < 8; ++i) { const f32x4 ga = *(const f32x4*)(subln_g + hf * 64 + 8 * i), gb = *(const f32x4*)(subln_g + hf * 64 + 8 * i + 4);
            const f32x4 a = v[2 * i] * ga * rs, c = v[2 * i + 1] * gb * rs;
            u32x4 w; w.x = cvtpk(a[0], a[1]); w.y = cvtpk(a[2], a[3]); w.z = cvtpk(c[0], c[1]); w.w = cvtpk(c[2], c[3]);
            *(u32x4*)(op + 8 * i) = w; }
    }
    asm volatile("s_waitcnt lgkmcnt(0)" ::: "memory"); __builtin_amdgcn_s_barrier(); asm volatile("" ::: "memory");
}
#undef FA_SBAR
}
#endif

#ifndef HOST_EMU
namespace fg {
typedef short bf16x8 __attribute__((ext_vector_type(8)));
typedef short s16x4 __attribute__((ext_vector_type(4)));
typedef float f32x16 __attribute__((ext_vector_type(16)));
typedef float f32x4 __attribute__((ext_vector_type(4)));
typedef unsigned u32x2 __attribute__((ext_vector_type(2)));
constexpr int IMG = 16384, STAGE_B = 4 * IMG;
constexpr int DEC_OFF = 2 * STAGE_B;
constexpr int SS_OFF = DEC_OFF + 1024;
#define FG_SBAR() __builtin_amdgcn_sched_barrier(0)
__device__ __forceinline__ unsigned cvtpk(float lo, float hi) { unsigned r; asm volatile("v_cvt_pk_bf16_f32 %0, %1, %2" : "=v"(r) : "v"(lo), "v"(hi)); return r; }
__device__ __forceinline__ int v_rd_base(int lane) { return ((lane & 3) << 3) | (((lane >> 2) & 3) << 6) | (((lane >> 4) & 1) << 5) | (((lane >> 5) & 1) << 8); }
constexpr int v_rd_off(int d0, int ks, int half) { return d0 * 512 + ks * 4096 + half * 2048; }
template <int OFF> __device__ __forceinline__ s16x4 tr_read(int vb) { s16x4 r; asm volatile("ds_read_b64_tr_b16 %0, %1 offset:%2" : "=&v"(r) : "v"(vb), "i"(OFF) : "memory"); return r; }
#define FG_PK(L, H) (bf16x8){L[0], L[1], L[2], L[3], H[0], H[1], H[2], H[3]}

__device__ __forceinline__ void issue_chunk(LAS unsigned char* stage, LAS unsigned char* decl, const bf16* GQb, const bf16* KDb, const bf16* GVb, const float* DECc, int wave, int lane) {
    const int img = wave >> 1, pb = 8 * (wave & 1);
    LAS unsigned char* dst = stage + img * IMG + 1024 * pb;
    if (img == 0) {
#pragma unroll
        for (int i = 0; i < 8; ++i) { const int row = 4 * (pb + i) + (lane >> 4), ch = (lane & 15) ^ (row & 15);
            __builtin_amdgcn_global_load_lds((const unsigned*)(GQb + (size_t)row * (D / 4) + 8 * ch), (LAS unsigned*)(dst + 1024 * i), 16, 0, 0); }
    } else {
        const int w2 = (lane & 31) >> 2, kl = (w2 & 3) + 8 * (w2 >> 2), cl = (lane >> 5) * 32 + (lane & 3) * 8;
        const bf16* base = img == 1 ? KDb : GVb + (img - 2) * 128; const int pitch = img == 1 ? D / 4 : D / 2;
#pragma unroll
        for (int i = 0; i < 8; ++i) { const int p = pb + i, k = kl + 4 * ((p >> 1) & 1) + 16 * (p >> 2), cidx = cl + 64 * (p & 1);
            __builtin_amdgcn_global_load_lds((const unsigned*)(base + (size_t)k * pitch + cidx), (LAS unsigned*)(dst + 1024 * i), 16, 0, 0); }
    }
    if (wave == 0 && lane < 32) __builtin_amdgcn_global_load_lds((const unsigned*)(DECc + 4 * lane), (LAS unsigned*)decl, 16, 0, 0);
}

__device__ __forceinline__ void gla_seq(int b, int h, const bf16* GQ, const bf16* KD, const bf16* GV, const bf16* GRb, const float* DEC, const float* gout, bf16* MIX, LAS unsigned char* lds) {
    const int tid = threadIdx.x; int lane = tid & 63; asm volatile("" : "+v"(lane));
    const int r32 = lane & 31, hi = lane >> 5; const int wave = __builtin_amdgcn_readfirstlane(tid >> 6);
    const size_t t00 = (size_t)b * SEQ;
    const bf16* GQb = GQ + t00 * (D / 4) + h * 128; const bf16* KDb = KD + t00 * (D / 4) + h * 128; const bf16* GVb = GV + t00 * (D / 2) + h * 256;
    const float* DECb = DEC + (size_t)(b * NC) * (D / 4) + h * 128;
    const bf16* GRw = GRb + t00 * (D / 2) + h * 256 + 32 * wave + 4 * hi; bf16* MIXw = MIX + t00 * D + D / 2 + h * 256 + 32 * wave + 4 * hi;
    f32x4 gq[4];
#pragma unroll
    for (int g = 0; g < 4; ++g) gq[g] = *(const f32x4*)(gout + 32 * wave + 8 * g + 4 * hi);
    f32x16 S[4];
#pragma unroll
    for (int mb = 0; mb < 4; ++mb)
#pragma unroll
        for (int r = 0; r < 16; ++r) S[mb][r] = 0.f;
    const unsigned lds0 = (unsigned)(uintptr_t)lds;
    LAS float* SS = (LAS float*)(lds + SS_OFF);
    issue_chunk(lds, lds + DEC_OFF, GQb, KDb, GVb, DECb, wave, lane);
    for (int c = 0; c < NC; ++c) {
        if (c == 0) asm volatile("s_waitcnt vmcnt(0)" ::: "memory"); else asm volatile("s_waitcnt vmcnt(8)" ::: "memory");
        __builtin_amdgcn_s_barrier(); asm volatile("" ::: "memory");
        u32x2 grv[2][4];
#pragma unroll
        for (int tb = 0; tb < 2; ++tb)
#pragma unroll
            for (int g = 0; g < 4; ++g) grv[tb][g] = *(const u32x2*)(GRw + (size_t)(64 * c + 32 * tb + r32) * (D / 2) + 8 * g);
        if (c + 1 < NC) issue_chunk(lds + ((c + 1) & 1) * STAGE_B, lds + DEC_OFF + ((c + 1) & 1) * 512, GQb + (size_t)(64 * (c + 1)) * (D / 4), KDb + (size_t)(64 * (c + 1)) * (D / 4),
                                    GVb + (size_t)(64 * (c + 1)) * (D / 2), DECb + (size_t)(c + 1) * (D / 4), wave, lane);
        LAS const unsigned char* st = lds + (c & 1) * STAGE_B;
        { LAS const float* dl = (LAS const float*)(lds + DEC_OFF + (c & 1) * 512) + 4 * hi;
#pragma unroll
          for (int mb = 0; mb < 4; ++mb)
#pragma unroll
              for (int g = 0; g < 4; ++g) { const f32x4 d4 = *(LAS const f32x4*)(dl + 32 * mb + 8 * g);
#pragma unroll
                  for (int e = 0; e < 4; ++e) S[mb][4 * g + e] *= d4[e]; } }
        { const int kb = (int)(lds0 + (c & 1) * STAGE_B + IMG) + v_rd_base(lane), vbse = (int)(lds0 + (c & 1) * STAGE_B + 2 * IMG + (wave >> 2) * IMG + (wave & 3) * 512) + v_rd_base(lane);
#define FG_KS(KS) do { const s16x4 vl = tr_read<v_rd_off(0, KS, 0)>(vbse), vh = tr_read<v_rd_off(0, KS, 1)>(vbse); \
            const s16x4 a0l = tr_read<v_rd_off(0, KS, 0)>(kb), a0h = tr_read<v_rd_off(0, KS, 1)>(kb), a1l = tr_read<v_rd_off(1, KS, 0)>(kb), a1h = tr_read<v_rd_off(1, KS, 1)>(kb); \
            const s16x4 a2l = tr_read<v_rd_off(2, KS, 0)>(kb), a2h = tr_read<v_rd_off(2, KS, 1)>(kb), a3l = tr_read<v_rd_off(3, KS, 0)>(kb), a3h = tr_read<v_rd_off(3, KS, 1)>(kb); \
            asm volatile("s_waitcnt lgkmcnt(0)" ::: "memory"); FG_SBAR(); const bf16x8 vf = FG_PK(vl, vh); \
            S[0] = __builtin_amdgcn_mfma_f32_32x32x16_bf16(FG_PK(a0l, a0h), vf, S[0], 0, 0, 0); S[1] = __builtin_amdgcn_mfma_f32_32x32x16_bf16(FG_PK(a1l, a1h), vf, S[1], 0, 0, 0); \
            S[2] = __builtin_amdgcn_mfma_f32_32x32x16_bf16(FG_PK(a2l, a2h), vf, S[2], 0, 0, 0); S[3] = __builtin_amdgcn_mfma_f32_32x32x16_bf16(FG_PK(a3l, a3h), vf, S[3], 0, 0, 0); } while (0)
          FG_KS(0); FG_KS(1); FG_KS(2); FG_KS(3);
#undef FG_KS
        }
        f32x16 ot[2];
#pragma unroll
        for (int tb = 0; tb < 2; ++tb)
#pragma unroll
            for (int r = 0; r < 16; ++r) ot[tb][r] = 0.f;
#pragma unroll
        for (int mb = 0; mb < 4; ++mb)
#pragma unroll
            for (int s = 0; s < 2; ++s) {
                typedef unsigned u32x4v __attribute__((ext_vector_type(4)));
                u32x4v w; w.x = cvtpk(S[mb][8 * s + 0], S[mb][8 * s + 1]); w.y = cvtpk(S[mb][8 * s + 2], S[mb][8 * s + 3]); w.z = cvtpk(S[mb][8 * s + 4], S[mb][8 * s + 5]); w.w = cvtpk(S[mb][8 * s + 6], S[mb][8 * s + 7]);
                const bf16x8 sa = *reinterpret_cast<bf16x8*>(&w);
                const int ch = 4 * mb + 2 * s;
#pragma unroll
                for (int tb = 0; tb < 2; ++tb) { const int row = 32 * tb + r32;
                    const u32x2 q0 = *(LAS const u32x2*)(st + row * 256 + ((ch ^ (row & 15)) << 4) + 8 * hi), q1 = *(LAS const u32x2*)(st + row * 256 + (((ch + 1) ^ (row & 15)) << 4) + 8 * hi);
                    u32x4v qw; qw.x = q0.x; qw.y = q0.y; qw.z = q1.x; qw.w = q1.y;
                    ot[tb] = __builtin_amdgcn_mfma_f32_32x32x16_bf16(sa, *reinterpret_cast<bf16x8*>(&qw), ot[tb], 0, 0, 0); } }
        float ssq[2];
#pragma unroll
        for (int tb = 0; tb < 2; ++tb) { float a = 0.f;
#pragma unroll
            for (int r = 0; r < 16; ++r) a += ot[tb][r] * ot[tb][r];
            a += __shfl_xor(a, 32); ssq[tb] = a; }
        if (hi == 0) { SS[wave * 64 + r32] = ssq[0]; SS[wave * 64 + 32 + r32] = ssq[1]; }
        asm volatile("s_waitcnt lgkmcnt(0)" ::: "memory"); __builtin_amdgcn_s_barrier(); asm volatile("" ::: "memory");
#pragma unroll
        for (int tb = 0; tb < 2; ++tb) { float a = 0.f;
#pragma unroll
            for (int w8 = 0; w8 < 8; ++w8) a += SS[w8 * 64 + 32 * tb + r32];
            const float rs = 1.0f / sqrtf(a * (1.0f / 256.0f) + EPS);
            bf16* op = MIXw + (size_t)(64 * c + 32 * tb + r32) * D;
#pragma unroll
            for (int g = 0; g < 4; ++g) { float v[4];
#pragma unroll
                for (int e = 0; e < 4; ++e) { const unsigned gw = e < 2 ? grv[tb][g].x : grv[tb][g].y; const float gr = __uint_as_float((e & 1) ? (gw & 0xffff0000u) : (gw << 16));
                    v[e] = ot[tb][4 * g + e] * rs * gq[g][e] * (gr * __builtin_amdgcn_rcpf(1.0f + __expf(-gr))); }
                u32x2 o2; o2.x = cvtpk(v[0], v[1]); o2.y = cvtpk(v[2], v[3]); *(u32x2*)(op + 8 * g) = o2; } }
    }
    asm volatile("s_waitcnt vmcnt(0) lgkmcnt(0)" ::: "memory"); __builtin_amdgcn_s_barrier(); asm volatile("" ::: "memory");
}
#undef FG_PK
#undef FG_SBAR
}
#endif

#ifndef HOST_EMU
namespace fc {
typedef short bf16x8 __attribute__((ext_vector_type(8)));
typedef float f32x16 __attribute__((ext_vector_type(16)));
typedef float f32x4 __attribute__((ext_vector_type(4)));
typedef unsigned u32x4 __attribute__((ext_vector_type(4)));
typedef unsigned u32x2 __attribute__((ext_vector_type(2)));
constexpr int KSL = 32768;
constexpr int PX_OFF = 2 * KSL;
constexpr int MX_OFF = PX_OFF + 65536;
__device__ __forceinline__ unsigned cvtpk(float lo, float hi) { unsigned r; asm volatile("v_cvt_pk_bf16_f32 %0, %1, %2" : "=v"(r) : "v"(lo), "v"(hi)); return r; }
__device__ __forceinline__ int crow(int r, int hi) { return (r & 3) + 8 * (r >> 2) + 4 * hi; }

__device__ __forceinline__ void cross_unit(int b, int h, int rb, const bf16* CQ, const float* CQSS, const bf16* CK2, const bf16* CVT, bf16* CO, LAS unsigned char* lds) {
    const int tid = threadIdx.x; int lane = tid & 63; asm volatile("" : "+v"(lane));
    const int r32 = lane & 31, hi = lane >> 5; const int wave = __builtin_amdgcn_readfirstlane(tid >> 6);
    const int wq = wave & 3, kh = wave >> 2;
    const size_t t0 = (size_t)b * SEQ + 128 * rb + 32 * wq;
    const bf16* Kb = CK2 + (size_t)(b * CH + h) * NMEM * CHD;
    const bf16* Vb = CVT + (size_t)(b * CH + h) * CHD * NMEM;
    const bf16* Qw = CQ + (t0 + r32) * D + h * CHD + hi * 8;
    const unsigned koff = (unsigned)((lane >> 3) * CHD + 8 * ((lane & 7) ^ (lane >> 3))) * 2u;
#define FC_ISSUE_K(sl, stage) do { _Pragma("unroll") for (int i_ = 0; i_ < 4; ++i_) { const int p_ = 4 * wave + i_; \
        __builtin_amdgcn_global_load_lds((const unsigned*)((const char*)(Kb + (size_t)(8 * p_) * CHD + 64 * (sl)) + koff), (LAS unsigned*)(lds + (stage) * KSL + 1024 * p_), 16, 0, 0); } } while (0)
    FC_ISSUE_K(0, 0);
    float rq; { const f32x4 a = *(const f32x4*)(CQSS + (t0 + r32) * 32 + 8 * h), c4 = *(const f32x4*)(CQSS + (t0 + r32) * 32 + 8 * h + 4);
        rq = 1.0f / sqrtf((((a[0] + a[1]) + (a[2] + a[3])) + ((c4[0] + c4[1]) + (c4[2] + c4[3]))) * (1.0f / CHD) + EPS); }
    f32x16 sc[4];
#pragma unroll
    for (int i = 0; i < 4; ++i)
#pragma unroll
        for (int r = 0; r < 16; ++r) sc[i][r] = 0.f;
    const int sw = (r32 & 7) << 4;
    for (int sl = 0; sl < 8; ++sl) {
        asm volatile("s_waitcnt vmcnt(0)" ::: "memory"); __builtin_amdgcn_s_barrier(); asm volatile("" ::: "memory");
        bf16x8 qf[4];
#pragma unroll
        for (int d0 = 0; d0 < 4; ++d0) qf[d0] = *(const bf16x8*)(Qw + 64 * sl + 16 * d0);
        if (sl + 1 < 8) FC_ISSUE_K(sl + 1, (sl + 1) & 1);
        LAS const unsigned char* Ks = lds + (sl & 1) * KSL + (128 * kh + r32) * 128;
#pragma unroll
        for (int d0 = 0; d0 < 4; ++d0) { const int cb = (16 * d0 + 8 * hi) * 2;
#pragma unroll
            for (int i = 0; i < 4; ++i) { const bf16x8 kf = *(LAS const bf16x8*)(Ks + 32 * i * 128 + (cb ^ sw));
                sc[i] = __builtin_amdgcn_mfma_f32_32x32x16_bf16(kf, qf[d0], sc[i], 0, 0, 0); } }
    }
#undef FC_ISSUE_K
    LAS float* MX = (LAS float*)(lds + MX_OFF); LAS float* LX = MX + 256;
    float mx = -3.0e38f;
#pragma unroll
    for (int i = 0; i < 4; ++i)
#pragma unroll
        for (int r = 0; r < 16; ++r) { sc[i][r] *= rq; mx = fmaxf(mx, sc[i][r]); }
    mx = fmaxf(mx, __shfl_xor(mx, 32));
    if (hi == 0) MX[wave * 32 + r32] = mx;
    asm volatile("s_waitcnt lgkmcnt(0)" ::: "memory"); __builtin_amdgcn_s_barrier(); asm volatile("" ::: "memory");
    mx = fmaxf(mx, MX[(wave ^ 4) * 32 + r32]);
    float ls = 0.f;
#pragma unroll
    for (int i = 0; i < 4; ++i)
#pragma unroll
        for (int r = 0; r < 16; ++r) { sc[i][r] = __builtin_amdgcn_exp2f(sc[i][r] - mx); ls += sc[i][r]; }
    ls += __shfl_xor(ls, 32);
    if (hi == 0) LX[wave * 32 + r32] = ls;
    bf16x8 pall[16];
    LAS unsigned char* PXw = lds + PX_OFF + wave * 8192;
#define FC_PK4(P, BASE, OUT) do { unsigned a0 = cvtpk(P[BASE + 0], P[BASE + 1]), a1 = cvtpk(P[BASE + 2], P[BASE + 3]); \
    unsigned b0 = cvtpk(P[BASE + 4], P[BASE + 5]), b1 = cvtpk(P[BASE + 6], P[BASE + 7]); \
    auto r0 = __builtin_amdgcn_permlane32_swap(a0, b0, false, false); auto r1 = __builtin_amdgcn_permlane32_swap(a1, b1, false, false); \
    u32x4 w_ = {r0[0], r1[0], r0[1], r1[1]}; OUT = *reinterpret_cast<bf16x8*>(&w_); } while (0)
#pragma unroll
    for (int i = 0; i < 4; ++i) { bf16x8 f0, f1; FC_PK4(sc[i], 0, f0); FC_PK4(sc[i], 8, f1);
        *(LAS bf16x8*)(PXw + (2 * i) * 1024 + lane * 16) = f0; *(LAS bf16x8*)(PXw + (2 * i + 1) * 1024 + lane * 16) = f1;
        if (kh == 0) { pall[2 * i] = f0; pall[2 * i + 1] = f1; } else { pall[8 + 2 * i] = f0; pall[8 + 2 * i + 1] = f1; } }
#undef FC_PK4
#define FC_ISSUE_V(blk, stage) do { _Pragma("unroll") for (int i_ = 0; i_ < 4; ++i_) { const int p_ = 4 * wave + i_, half_ = p_ >> 4, row_ = 2 * (p_ & 15) + (lane >> 5), ch_ = (lane & 31) ^ row_; \
        __builtin_amdgcn_global_load_lds((const unsigned*)(Vb + (size_t)(256 * half_ + 32 * (blk) + row_) * NMEM + 8 * ch_), (LAS unsigned*)(lds + (stage) * KSL + 1024 * p_), 16, 0, 0); } } while (0)
    FC_ISSUE_V(0, 0);
    asm volatile("s_waitcnt lgkmcnt(0)" ::: "memory"); __builtin_amdgcn_s_barrier(); asm volatile("" ::: "memory");
    { LAS const unsigned char* PXp = lds + PX_OFF + (wave ^ 4) * 8192;
#pragma unroll
      for (int f = 0; f < 8; ++f) { const bf16x8 v = *(LAS const bf16x8*)(PXp + f * 1024 + lane * 16); if (kh == 0) pall[8 + f] = v; else pall[f] = v; } }
    const float linv = __builtin_amdgcn_rcpf(ls + LX[(wave ^ 4) * 32 + r32]);
    bf16* Ow = CO + (t0 + r32) * D + h * CHD + 256 * kh + 4 * hi;
    for (int blk = 0; blk < 8; ++blk) {
        if (blk == 0) asm volatile("s_waitcnt vmcnt(0)" ::: "memory"); else asm volatile("s_waitcnt vmcnt(4)" ::: "memory");
        __builtin_amdgcn_s_barrier(); asm volatile("" ::: "memory");
        if (blk + 1 < 8) FC_ISSUE_V(blk + 1, (blk + 1) & 1);
        LAS const unsigned char* Vs = lds + (blk & 1) * KSL + kh * 16384 + r32 * 512;
        f32x16 o;
#pragma unroll
        for (int r = 0; r < 16; ++r) o[r] = 0.f;
#pragma unroll
        for (int ks = 0; ks < 16; ++ks) { const bf16x8 vf = *(LAS const bf16x8*)(Vs + (((2 * ks + hi) ^ r32) << 4));
            o = __builtin_amdgcn_mfma_f32_32x32x16_bf16(vf, pall[ks], o, 0, 0, 0); }
#pragma unroll
        for (int g = 0; g < 4; ++g) { u32x2 w2; w2.x = cvtpk(o[4 * g] * linv, o[4 * g + 1] * linv); w2.y = cvtpk(o[4 * g + 2] * linv, o[4 * g + 3] * linv);
            *(u32x2*)(Ow + 32 * blk + 8 * g) = w2; }
    }
#undef FC_ISSUE_V
    asm volatile("s_waitcnt vmcnt(0) lgkmcnt(0)" ::: "memory"); __builtin_amdgcn_s_barrier(); asm volatile("" ::: "memory");
}
}
#endif

struct Ctx {
    const float *x, *mem; const int* positions; const float *g_attn, *w_in, *q_norm_g, *k_norm_g, *lq1, *lk1, *lq2, *lk2, *subln_g, *w_a2, *b_a, *gla_out_g, *w_out, *g_cross, *g_mem, *w_cq, *w_ckv, *cq_g, *ck_g, *w_co,
        *g_ffn, *w_rg, *b_rg, *w_re, *b_re, *w_gate, *w_up, *w_down;
    float* out; char* ws;
};
#define WSP(T_, off) ((T_*)(c.ws + (off)))
#ifndef HOST_EMU
__device__ __forceinline__ void f0_wrt(const Ctx& c, bf16* WRT);
__device__ __forceinline__ void fast_prologue(const Ctx& c, LAS unsigned char* lds) {
    const int tid = threadIdx.x, lane = tid & 63, wave = __builtin_amdgcn_readfirstlane(tid >> 6);
    const int gw = blockIdx.x * 8 + wave, NGW = gridDim.x * 8;
    LAS float* scr = (LAS float*)(lds + wave * F0_SCR);
    int* ctl = WSP(int, WS_CTL); float* lamp = (float*)(ctl + 16);
    bf16 *WIN = WSP(bf16, WS_WIN), *WOUT = WSP(bf16, WS_WOUT), *WCQ = WSP(bf16, WS_WCQ), *WCKV = WSP(bf16, WS_WCKV), *WCO = WSP(bf16, WS_WCO);
    bf16 *WGU = WSP(bf16, WS_WGU), *WD = WSP(bf16, WS_WD), *XN = WSP(bf16, WS_XN), *MEMN = WSP(bf16, WS_MEMN);
    float* GLR = WSP(float, WS_SMALL + SM_GLR); int* SLOTTOK = WSP(int, WS_SMALL + SM_SLOTTOK); float* SLOTGATE = WSP(float, WS_SMALL + SM_SLOTGATE); float* ROPE = WSP(float, WS_SMALL + SM_ROPE);
    for (int it = gw; it < T / 2; it += NGW) f0_rows2<true>(c.x + (size_t)it * 2 * D, c.g_attn, XN + (size_t)it * 2 * D, c.w_in, GLR + (size_t)it * 2 * GRK, lane);
    for (int it = gw; it < B * NMEM / 2; it += NGW) f0_rows2<false>(c.mem + (size_t)it * 2 * D, c.g_mem, MEMN + (size_t)it * 2 * D, nullptr, nullptr, lane);
    constexpr int KB = D / 64, KBD = DE / 64;
    constexpr int I_WIN = (NIN / 64) * KB, I_SQ = (D / 64) * KB, I_CKV = (2 * D / 64) * KB, I_GU = NE * (2 * DE / 64) * KB, I_DN = NE * (D / 64) * KBD;
    constexpr int NITEMS = I_WIN + 3 * I_SQ + I_CKV;
    (void)I_GU; (void)I_DN; (void)WGU; (void)WD;
    for (int it = gw; it < NITEMS; it += NGW) {
        int r = it;
        if (r < I_WIN) { const int kb = r % KB, n0 = (r / KB) * 64; f0_transpose_item(c.w_in + (size_t)kb * 64 * IN_COLS, IN_COLS, win_src_col(n0), win_src_col(n0 + 32), WIN + (size_t)n0 * D + kb * 64, D, scr, lane); continue; } r -= I_WIN;
        if (r < I_SQ) { const int kb = r % KB, n0 = (r / KB) * 64; f0_transpose_item(c.w_out + (size_t)kb * 64 * D, D, n0, n0 + 32, WOUT + (size_t)n0 * D + kb * 64, D, scr, lane); continue; } r -= I_SQ;
        if (r < I_SQ) { const int kb = r % KB, n0 = (r / KB) * 64; f0_transpose_item(c.w_cq + (size_t)kb * 64 * D, D, n0, n0 + 32, WCQ + (size_t)n0 * D + kb * 64, D, scr, lane); continue; } r -= I_SQ;
        if (r < I_SQ) { const int kb = r % KB, n0 = (r / KB) * 64; f0_transpose_item(c.w_co + (size_t)kb * 64 * D, D, n0, n0 + 32, WCO + (size_t)n0 * D + kb * 64, D, scr, lane); continue; } r -= I_SQ;
        { const int kb = r % KB, n0 = (r / KB) * 64; f0_transpose_item(c.w_ckv + (size_t)kb * 64 * 2 * D, 2 * D, n0, n0 + 32, WCKV + (size_t)n0 * D + kb * 64, D, scr, lane); }
    }
    nk_rope_table(c.positions, ROPE); nk_lam(c.lq1, c.lk1, c.lq2, c.lk2, lamp); nk_mref(c.q_norm_g, c.k_norm_g, lamp + 1);
    nk_zero_bf16(XN + (size_t)T * D, (size_t)D); nk_moe_init_slots(SLOTTOK, SLOTGATE); f0_wrt(c, WSP(bf16, WS_SMALL + SM_WRT));
}
#endif
#ifndef HOST_EMU
constexpr int EXP_ITEMS = NE * (2 * DE / 64) * (D / 64) + NE * (D / 64) * (DE / 64);
__device__ __forceinline__ void f0_expert_items(const Ctx& c, LAS unsigned char* lds, int first, int count) {
    const int tid = threadIdx.x, lane = tid & 63, wave = __builtin_amdgcn_readfirstlane(tid >> 6);
    LAS float* scr = (LAS float*)(lds + wave * F0_SCR);
    bf16 *WGU = WSP(bf16, WS_WGU), *WD = WSP(bf16, WS_WD);
    constexpr int KB = D / 64, KBD = DE / 64, I_GU = NE * (2 * DE / 64) * KB;
    for (int q = wave; q < count; q += 8) { int r = first + q;
        if (r < I_GU) { const int kb = r % KB, r0 = ((r / KB) % (2 * DE / 64)) * 64, e = r / (KB * (2 * DE / 64)); const int pn = r0 / 256, ii = r0 % 256; const float* W = (ii < 128) ? c.w_gate : c.w_up; const int col = pn * 128 + (ii & 127);
            f0_transpose_item(W + ((size_t)e * D + kb * 64) * DE, DE, col, col + 32, WGU + ((size_t)e * 2 * DE + r0) * D + kb * 64, D, scr, lane); continue; } r -= I_GU;
        { const int kb = r % KBD, n0 = ((r / KBD) % (D / 64)) * 64, e = r / (KBD * (D / 64));
          f0_transpose_item(c.w_down + ((size_t)e * DE + kb * 64) * D, D, n0, n0 + 32, WD + ((size_t)e * D + n0) * DE + kb * 64, DE, scr, lane); }
    }
}
__device__ __forceinline__ void f0_wrt(const Ctx& c, bf16* WRT) {
    for (size_t i = gtid(); i < (size_t)48 * D; i += gnth()) { const int k = (int)(i % D), j = (int)(i / D);
        const float w = j < NG ? c.w_rg[(size_t)k * NG + j] : (j < NG + NE ? c.w_re[(size_t)k * NE + (j - NG)] : 0.f); WRT[i] = f2bf(w); }
}
__device__ __forceinline__ void fast_router(const Ctx& c, LAS unsigned char* lds) {
    typedef short bf16x8 __attribute__((ext_vector_type(8)));
    const int tid = threadIdx.x, lane = tid & 63, wave = __builtin_amdgcn_readfirstlane(tid >> 6), r = lane & 15, kq = lane >> 4;
    LAS float* red = (LAS float*)lds;
    LAS float* lg = (LAS float*)(lds + 8 * 32 * 48 * 4);
    const bf16* XN = WSP(bf16, WS_XN); const bf16* WRT = WSP(bf16, WS_SMALL + SM_WRT); const float* SSP2 = WSP(float, WS_SMALL + SM_SSP2);
    int* ctl = WSP(int, WS_CTL); int* EXPERT = WSP(int, WS_SMALL + SM_EXPERT); float* GATE = WSP(float, WS_SMALL + SM_GATE); int* SLOTPOS = WSP(int, WS_SMALL + SM_SLOTPOS);
    for (int ub = blockIdx.x; ub < T / 32; ub += gridDim.x) {
        const int row0 = ub * 32, k0 = wave * 256;
        f32x4 acc[2][3];
#pragma unroll
        for (int mb = 0; mb < 2; ++mb)
#pragma unroll
            for (int nb = 0; nb < 3; ++nb) acc[mb][nb] = (f32x4){0.f, 0.f, 0.f, 0.f};
#pragma unroll
        for (int st = 0; st < 8; ++st) { bf16x8 a[2], b[3];
#pragma unroll
            for (int mb = 0; mb < 2; ++mb) a[mb] = *(const bf16x8*)(XN + (size_t)(row0 + 16 * mb + r) * D + k0 + 32 * st + 8 * kq);
#pragma unroll
            for (int nb = 0; nb < 3; ++nb) b[nb] = *(const bf16x8*)(WRT + (size_t)(16 * nb + r) * D + k0 + 32 * st + 8 * kq);
#pragma unroll
            for (int mb = 0; mb < 2; ++mb)
#pragma unroll
                for (int nb = 0; nb < 3; ++nb) acc[mb][nb] = __builtin_amdgcn_mfma_f32_16x16x32_bf16(a[mb], b[nb], acc[mb][nb], 0, 0, 0); }
#pragma unroll
        for (int mb = 0; mb < 2; ++mb)
#pragma unroll
            for (int nb = 0; nb < 3; ++nb)
#pragma unroll
                for (int q = 0; q < 4; ++q) red[(wave * 32 + 16 * mb + 4 * kq + q) * 48 + 16 * nb + r] = acc[mb][nb][q];
        __syncthreads();
        { const int row = tid >> 4, q = tid & 15;
          float ps = SSP2[(size_t)(row0 + row) * 32 + 2 * q] + SSP2[(size_t)(row0 + row) * 32 + 2 * q + 1];
          ps += __shfl_xor(ps, 1); ps += __shfl_xor(ps, 2); ps += __shfl_xor(ps, 4); ps += __shfl_xor(ps, 8);
          const float rs = 1.0f / sqrtf(ps * (1.0f / D) + EPS);
#pragma unroll
          for (int j = 0; j < 3; ++j) { const int col = q + 16 * j; float sacc = 0.f;
#pragma unroll
              for (int w = 0; w < 8; ++w) sacc += red[(w * 32 + row) * 48 + col];
              const float bias = col < NG ? c.b_rg[col] : (col < NG + NE ? c.b_re[col - NG] : 0.f);
              lg[row * 48 + col] = sacc * rs + bias; } }
        __syncthreads();
        if (tid < 32) { const int t = row0 + tid; const LAS float* L = lg + tid * 48;
            float gl[NG], el[NE];
#pragma unroll
            for (int j = 0; j < NG; ++j) gl[j] = L[j];
#pragma unroll
            for (int j = 0; j < NE; ++j) el[j] = L[NG + j];
            int grp = 0; float gm = gl[0];
#pragma unroll
            for (int j = 1; j < NG; ++j) if (gl[j] > gm) { gm = gl[j]; grp = j; }
            float gs = 0.f;
#pragma unroll
            for (int j = 0; j < NG; ++j) gs += __expf(gl[j] - gm);
            const float grp_w = 1.0f / gs;
            float e8[EPG];
#pragma unroll
            for (int j = 0; j < EPG; ++j) { float v = 0.f;
#pragma unroll
                for (int gq = 0; gq < NG; ++gq) v = (grp == gq) ? el[gq * EPG + j] : v;
                e8[j] = v; }
            int i0 = 0; float v0 = e8[0];
#pragma unroll
            for (int j = 1; j < EPG; ++j) if (e8[j] > v0) { v0 = e8[j]; i0 = j; }
            int i1 = -1; float v1 = -1e30f;
#pragma unroll
            for (int j = 0; j < EPG; ++j) if (j != i0 && e8[j] > v1) { v1 = e8[j]; i1 = j; }
            const float rr = __expf(v1 - v0); const float g0 = grp_w / (1.f + rr), g1 = grp_w * rr / (1.f + rr);
            const int e0 = grp * EPG + i0, e1 = grp * EPG + i1;
            EXPERT[t * 2] = e0; EXPERT[t * 2 + 1] = e1; GATE[t * 2] = g0; GATE[t * 2 + 1] = g1;
            SLOTPOS[t * 2] = atomicAdd(&ctl[CW_CNT + e0], 1); SLOTPOS[t * 2 + 1] = atomicAdd(&ctl[CW_CNT + e1], 1); }
        __syncthreads();
    }
}
#endif

#ifndef HOST_EMU
__device__ __forceinline__ void fast_gla_prep(const Ctx& c, LAS unsigned char* lds) {
    constexpr int W = GH * GKD; static_assert(W == 512, "one thread per gate column");
    const float* GLR = WSP(float, WS_SMALL + SM_GLR); const bf16* GK = (const bf16*)(c.ws + WS_B + B_GK); bf16* KD = WSP(bf16, WS_D); float* DEC = WSP(float, WS_SMALL + SM_DEC);
    LAS float* gl = (LAS float*)lds;
    const int j = threadIdx.x;
    float w[GRK];
#pragma unroll
    for (int r = 0; r < GRK; ++r) w[r] = c.w_a2[(size_t)r * W + j];
    const float bj = c.b_a[j];
    for (int cb = (int)blockIdx.x; cb < B * NC; cb += (int)gridDim.x) {
        __syncthreads();
        for (int i = threadIdx.x; i < CHUNK * GRK / 4; i += 512) ((LAS f32x4*)gl)[i] = ((const f32x4*)(GLR + (size_t)cb * CHUNK * GRK))[i];
        __syncthreads();
        float run = 0.f;
        for (int tt = 0; tt < CHUNK; ++tt) { float z = bj;
#pragma unroll
            for (int q = 0; q < 4; ++q) { const f32x4 g4 = ((LAS const f32x4*)gl)[tt * 4 + q]; z += g4[0] * w[4 * q] + g4[1] * w[4 * q + 1] + g4[2] * w[4 * q + 2] + g4[3] * w[4 * q + 3]; }
            run += (fminf(z, 0.f) - __logf(1.0f + __expf(-fabsf(z)))) * (1.0f / 16.0f); }
        const float end = run; DEC[(size_t)cb * W + j] = __expf(end); run = 0.f;
        for (int tt = 0; tt < CHUNK; ++tt) { const size_t t = (size_t)cb * CHUNK + tt; float z = bj;
#pragma unroll
            for (int q = 0; q < 4; ++q) { const f32x4 g4 = ((LAS const f32x4*)gl)[tt * 4 + q]; z += g4[0] * w[4 * q] + g4[1] * w[4 * q + 1] + g4[2] * w[4 * q + 2] + g4[3] * w[4 * q + 3]; }
            run += (fminf(z, 0.f) - __logf(1.0f + __expf(-fabsf(z)))) * (1.0f / 16.0f);
            KD[t * W + j] = f2bf(bf2f(GK[t * W + j]) * __expf(end - run)); }
    }
}
__device__ __forceinline__ void fast_ckv_fix(const Ctx& c) {
    const bf16* CKV = WSP(bf16, WS_SMALL + SM_CKV); bf16* CK2 = WSP(bf16, WS_SMALL + SM_CK2); bf16* CVT = WSP(bf16, WS_SMALL + SM_CVT);
    const int lane = threadIdx.x & 63, gw = blockIdx.x * 8 + (threadIdx.x >> 6), NGW = gridDim.x * 8;
    for (int it = gw; it < B * NMEM * CH; it += NGW) { const int h = it % CH, bm = it / CH, b = bm / NMEM, m = bm % NMEM;
        const u32x4 kw = *(const u32x4*)(CKV + (size_t)bm * 2 * D + h * CHD + 8 * lane), vw = *(const u32x4*)(CKV + (size_t)bm * 2 * D + D + h * CHD + 8 * lane);
        float kf[8]; const unsigned kk[4] = {kw.x, kw.y, kw.z, kw.w}; float ss = 0.f;
#pragma unroll
        for (int q = 0; q < 4; ++q) { kf[2 * q] = __uint_as_float(kk[q] << 16); kf[2 * q + 1] = __uint_as_float(kk[q] & 0xffff0000u); ss += kf[2 * q] * kf[2 * q] + kf[2 * q + 1] * kf[2 * q + 1]; }
        ss = wave_sum(ss);
        const float rs = 1.0f / sqrtf(ss * (1.0f / CHD) + EPS) * (1.0f / sqrtf((float)CHD)) * LOG2E;
        const f32x4 ka = *(const f32x4*)(c.ck_g + 8 * lane), kb = *(const f32x4*)(c.ck_g + 8 * lane + 4), qa = *(const f32x4*)(c.cq_g + 8 * lane), qb = *(const f32x4*)(c.cq_g + 8 * lane + 4);
        u32x4 o; o.x = pk2(kf[0] * rs * ka[0] * qa[0], kf[1] * rs * ka[1] * qa[1]); o.y = pk2(kf[2] * rs * ka[2] * qa[2], kf[3] * rs * ka[3] * qa[3]);
        o.z = pk2(kf[4] * rs * kb[0] * qb[0], kf[5] * rs * kb[1] * qb[1]); o.w = pk2(kf[6] * rs * kb[2] * qb[2], kf[7] * rs * kb[3] * qb[3]);
        *(u32x4*)(CK2 + (((size_t)b * CH + h) * NMEM + m) * CHD + 8 * lane) = o;
        bf16* vt = CVT + (((size_t)b * CH + h) * CHD + 8 * lane) * NMEM + m; const unsigned vv[4] = {vw.x, vw.y, vw.z, vw.w};
#pragma unroll
        for (int q = 0; q < 4; ++q) { vt[(size_t)(2 * q) * NMEM] = (bf16)(vv[q] & 0xffffu); vt[(size_t)(2 * q + 1) * NMEM] = (bf16)(vv[q] >> 16); }
    }
}
__device__ __forceinline__ void fast_moe_fill(const Ctx& c) {
    int* ctl = WSP(int, WS_CTL); const int* EXPERT = WSP(int, WS_SMALL + SM_EXPERT); const float* GATE = WSP(float, WS_SMALL + SM_GATE); int* SLOTPOS = WSP(int, WS_SMALL + SM_SLOTPOS);
    int* SLOTTOK = WSP(int, WS_SMALL + SM_SLOTTOK); float* SLOTGATE = WSP(float, WS_SMALL + SM_SLOTGATE);
    if (blockIdx.x == 0 && threadIdx.x < NE) { const int e = threadIdx.x; int base = 0, nt0 = 0;
        for (int q = 0; q < e; ++q) { const int n = (ctl[CW_CNT + q] + ETILE - 1) / ETILE; nt0 += n; base += n * ETILE; }
        const int n = (ctl[CW_CNT + e] + ETILE - 1) / ETILE; for (int q = 0; q < n; ++q) ctl[CW_TILE_E + nt0 + q] = e;
        ctl[CW_BASE + e] = base; if (e == NE - 1) { ctl[CW_BASE + NE] = base + n * ETILE; ctl[CW_NTILES] = nt0 + n; } }
    for (size_t i = gtid(); i < (size_t)T * 2; i += gnth()) { const int e = EXPERT[i]; int base = 0;
        for (int q = 0; q < e; ++q) base += ((ctl[CW_CNT + q] + ETILE - 1) / ETILE) * ETILE;
        const int dst = base + SLOTPOS[i]; SLOTTOK[dst] = (int)(i >> 1); SLOTGATE[dst] = GATE[i]; SLOTPOS[i] = dst; }
}
__device__ __forceinline__ void fast_moe_gather(const Ctx& c) {
    const int* SLOTPOS = WSP(int, WS_SMALL + SM_SLOTPOS); const bf16* Y = WSP(bf16, WS_C);
    const int lane = threadIdx.x & 63, gw = blockIdx.x * 8 + (threadIdx.x >> 6), NGW = gridDim.x * 8;
    for (int t = gw; t < T; t += NGW) { const int s0 = SLOTPOS[2 * t], s1 = SLOTPOS[2 * t + 1];
        const u32x4* y0 = (const u32x4*)(Y + (size_t)s0 * D); const u32x4* y1 = (const u32x4*)(Y + (size_t)s1 * D); f32x4* o = (f32x4*)(c.out + (size_t)t * D);
#pragma unroll
        for (int q = 0; q < 4; ++q) { const u32x4 a = y0[lane + 64 * q], b2 = y1[lane + 64 * q]; f32x4 v0 = o[2 * (lane + 64 * q)], v1 = o[2 * (lane + 64 * q) + 1];
            v0[0] += __uint_as_float(a.x << 16) + __uint_as_float(b2.x << 16); v0[1] += __uint_as_float(a.x & 0xffff0000u) + __uint_as_float(b2.x & 0xffff0000u);
            v0[2] += __uint_as_float(a.y << 16) + __uint_as_float(b2.y << 16); v0[3] += __uint_as_float(a.y & 0xffff0000u) + __uint_as_float(b2.y & 0xffff0000u);
            v1[0] += __uint_as_float(a.z << 16) + __uint_as_float(b2.z << 16); v1[1] += __uint_as_float(a.z & 0xffff0000u) + __uint_as_float(b2.z & 0xffff0000u);
            v1[2] += __uint_as_float(a.w << 16) + __uint_as_float(b2.w << 16); v1[3] += __uint_as_float(a.w & 0xffff0000u) + __uint_as_float(b2.w & 0xffff0000u);
            o[2 * (lane + 64 * q)] = v0; o[2 * (lane + 64 * q) + 1] = v1; } }
}
#endif
#ifdef HOST_EMU
#define FAST_P0 0
#define FAST_P1 0
#define FAST_P6 0
#define FAST_P13 0
#define FAST_MOE 0
#define FAST_ATT 0
#define FAST_GLA 0
#define FAST_CROSS 0
typedef unsigned char* LdsPtr;
#else
#ifndef FAST_P0
#define FAST_P0 1
#endif
#ifndef FAST_P1
#define FAST_P1 1
#endif
#ifndef FAST_P6
#define FAST_P6 1
#endif
#ifndef FAST_P13
#define FAST_P13 1
#endif
#ifndef FAST_ATT
#define FAST_ATT 1
#endif
#ifndef FAST_GLA
#define FAST_GLA 1
#endif
#ifndef FAST_CROSS
#define FAST_CROSS 1
#endif
#ifndef FAST_MOE
#define FAST_MOE 1
#endif
typedef LAS unsigned char* LdsPtr;
#endif
constexpr int N_PHASES = 18;
template <int P, int QPASS = 0> __device__ __forceinline__ void run_phase(const Ctx& c, LdsPtr lds) {
    int* ctl = WSP(int, WS_CTL); float* lamp = (float*)(ctl + 16);
    bf16 *WIN = WSP(bf16, WS_WIN), *WOUT = WSP(bf16, WS_WOUT), *WCQ = WSP(bf16, WS_WCQ), *WCKV = WSP(bf16, WS_WCKV), *WCO = WSP(bf16, WS_WCO);
    bf16 *WGU = WSP(bf16, WS_WGU), *WD = WSP(bf16, WS_WD), *XN = WSP(bf16, WS_XN), *MEMN = WSP(bf16, WS_MEMN);
    float* SSP1 = WSP(float, WS_SMALL + SM_SSP1); float* SSP2 = WSP(float, WS_SMALL + SM_SSP2); (void)SSP1; (void)SSP2;
    float* GLR = WSP(float, WS_SMALL + SM_GLR); float* CQSS = WSP(float, WS_SMALL + SM_CQSS); int* EXPERT = WSP(int, WS_SMALL + SM_EXPERT); float* GATE = WSP(float, WS_SMALL + SM_GATE);
    int* SLOTPOS = WSP(int, WS_SMALL + SM_SLOTPOS); int* SLOTTOK = WSP(int, WS_SMALL + SM_SLOTTOK); float* SLOTGATE = WSP(float, WS_SMALL + SM_SLOTGATE); float* ROPE = WSP(float, WS_SMALL + SM_ROPE);
    bf16 *CKV = WSP(bf16, WS_SMALL + SM_CKV), *CK2 = WSP(bf16, WS_SMALL + SM_CK2), *CVT = WSP(bf16, WS_SMALL + SM_CVT); float* STATS = WSP(float, WS_SMALL + SM_STATS);
    char* rb = c.ws + WS_B;
    bf16 *DQ = (bf16*)(rb + B_DQ), *DK = (bf16*)(rb + B_DK), *DV = (bf16*)(rb + B_DV), *GQ = (bf16*)(rb + B_GQ), *GK = (bf16*)(rb + B_GK), *GV = (bf16*)(rb + B_GV), *GRb = (bf16*)(rb + B_GR);
    bf16 *CQ = (bf16*)(rb + B_CQ), *CO = (bf16*)(rb + B_CO), *HE = (bf16*)(rb + B_HE);
    bf16* MIX = WSP(bf16, WS_C);
    float* TMPQK = WSP(float, WS_C);
    float* PTMP = WSP(float, WS_C);
    float* CUM = WSP(float, WS_D);
    float* OTMPD = WSP(float, WS_D + al256((size_t)T * D));
    float* OTMPG = WSP(float, WS_D + al256((size_t)T * D) * 3);
    float* out = c.out; (void)lds; (void)TMPQK; (void)WIN;
    if constexpr (P == 0) {
#if FAST_P0
        fast_prologue(c, lds);
#else
        nk_conv_win(c.w_in, WIN);
        nk_convT(c.w_out, D, 0, WOUT, D, D); nk_convT(c.w_cq, D, 0, WCQ, D, D); nk_convT(c.w_ckv, 2 * D, 0, WCKV, 2 * D, D); nk_convT(c.w_co, D, 0, WCO, D, D);
        nk_conv_gu(c.w_gate, c.w_up, WGU); nk_conv_d(c.w_down, WD);
        nk_rope_table(c.positions, ROPE); nk_lam(c.lq1, c.lk1, c.lq2, c.lk2, lamp);
        nk_zero_bf16(XN + (size_t)T * D, (size_t)D); nk_moe_init_slots(SLOTTOK, SLOTGATE);
        nk_rmsnorm_rows(c.x, c.g_attn, XN, T, D); nk_rmsnorm_rows(c.mem, c.g_mem, MEMN, B * NMEM, D);
        nk_glr(c.x, c.g_attn, c.w_in, GLR);
#endif
    } else if constexpr (P == 1) {
#if FAST_P1
        pg8::Gemm g{XN, WIN, T, NIN, D}; pg8::StaticOrder S; S.init(T, NIN, (int)gridDim.x, (int)blockIdx.x);
        pg8::EpiInProj E{rb, ROPE, c.q_norm_g, c.k_norm_g};
        pg8::gemm_phase<pg8::EpiInProj, pg8::StaticOrder, true, true>(lds, g, S, E);
#else
        { GemmP p{XN, WIN, T, NIN, D, 0, TMPQK, nullptr, (bf16*)rb, nullptr}; nk_gemm<0>(p); }
#endif
    } else if constexpr (P == 2) {
#if !FAST_P1
        nk_qk_post(TMPQK, c.q_norm_g, c.k_norm_g, ROPE, DQ, DK);
#endif
#if FAST_CROSS
        { pg8::Gemm g{MEMN, WCKV, B * NMEM, 2 * D, D}; pg8::StaticOrder S; S.init(B * NMEM, 2 * D, (int)gridDim.x, (int)blockIdx.x);
          pg8::EpiPlain E{CKV, 2 * D}; pg8::gemm_phase<pg8::EpiPlain, pg8::StaticOrder, true, true>(lds, g, S, E); }
#else
        { GemmP p{MEMN, WCKV, B * NMEM, 2 * D, D, 0, nullptr, nullptr, CKV, nullptr}; nk_gemm<2>(p); }
#endif
    } else if constexpr (P == 3) {
#if FAST_CROSS
        fast_ckv_fix(c);
#else
        nk_ckv_fix(CKV, c.cq_g, c.ck_g, CK2, CVT);
#endif
#if FAST_GLA
        fast_gla_prep(c, lds);
#else
        nk_gla_cum(GLR, c.w_a2, c.b_a, CUM);
#endif
#if !FAST_ATT
        nk_diff_stats(DQ, DK, STATS);
#endif
    } else if constexpr (P == 4) {
#if FAST_ATT
        { const float lam = lamp[0], mref = lamp[1];
#if FAST_GLA
          LAS int* qslot = (LAS int*)(lds + 143360);
          for (;;) {
              if (threadIdx.x == 0) *qslot = atomicAdd(&ctl[CW_QUEUE + 64 * QPASS], 1);
              __syncthreads(); const int item = *qslot; __syncthreads();
              if (item >= 8 + 512) break;
              if (item < 8) fg::gla_seq(item >> 2, item & 3, GQ, (const bf16*)CUM, GV, GRb, WSP(float, WS_SMALL + SM_DEC), c.gla_out_g, MIX, lds);
              else { const int u = item - 8, jq = 31 - (u >> 4), bh = u & 15;
                  if (mref <= 24.0f) fa::attn_unit<false>(bh >> 3, bh & 7, jq, DQ, DK, DV, MIX, c.subln_g, lam, mref, lds);
                  else fa::attn_unit<true>(bh >> 3, bh & 7, jq, DQ, DK, DV, MIX, c.subln_g, lam, mref, lds); } }
          if (QPASS == 0) for (;;) {
              if (threadIdx.x == 0) *qslot = atomicAdd(&ctl[CW_QUEUE + 128], 1);
              __syncthreads(); const int item = *qslot; __syncthreads();
              if (item * 64 >= EXP_ITEMS) break;
              f0_expert_items(c, lds, item * 64, 64); }
#else
          const int G = (int)gridDim.x;
          for (int pi = (int)blockIdx.x; pi < 256; pi += G) { const int vcu = (pi & 7) * 32 + (pi >> 3), bh = vcu >> 4, pr = vcu & 15;
              for (int k2 = 0; k2 < 2; ++k2) { const int jq = k2 ? pr : 31 - pr;
                  if (mref <= 24.0f) fa::attn_unit<false>(bh >> 3, bh & 7, jq, DQ, DK, DV, MIX, c.subln_g, lam, mref, lds);
                  else fa::attn_unit<true>(bh >> 3, bh & 7, jq, DQ, DK, DV, MIX, c.subln_g, lam, mref, lds); } }
#endif
        }
#else
        nk_diff_pv(DQ, DK, DV, STATS, lamp, OTMPD);
#endif
#if !FAST_GLA
        nk_gla_run(GQ, GK, GV, CUM, OTMPG);
#endif
    } else if constexpr (P == 5) {
#if !FAST_ATT
        nk_diff_norm(OTMPD, c.subln_g, MIX);
#endif
#if !FAST_GLA
        nk_gla_norm(OTMPG, c.gla_out_g, GRb, MIX);
#endif
    } else if constexpr (P == 6) {
#if FAST_P6
        pg8::Gemm g{MIX, WOUT, T, D, D}; pg8::StaticOrder S; S.init(T, D, (int)gridDim.x, (int)blockIdx.x);
        pg8::EpiResid E{c.x, out, XN, c.g_cross, SSP1};
        pg8::gemm_phase<pg8::EpiResid, pg8::StaticOrder, true, true>(lds, g, S, E);
#else
        GemmP p{MIX, WOUT, T, D, D, 0, out, nullptr, nullptr, c.x}; nk_gemm<1>(p);
#endif
    } else if constexpr (P == 7) {
#if !FAST_P6
        nk_rmsnorm_rows(out, c.g_cross, XN, T, D);
#endif
    } else if constexpr (P == 8) {
#if FAST_P6
        pg8::Gemm g{XN, WCQ, T, D, D}; pg8::StaticOrder S; S.init(T, D, (int)gridDim.x, (int)blockIdx.x);
        pg8::EpiCq E{SSP1, CQ, CQSS};
        pg8::gemm_phase<pg8::EpiCq, pg8::StaticOrder, true, true>(lds, g, S, E);
#else
        GemmP p{XN, WCQ, T, D, D, 0, nullptr, nullptr, CQ, nullptr}; nk_gemm<2>(p);
#endif
    } else if constexpr (P == 9) {
#if !FAST_P6
        nk_cqss(CQ, CQSS);
#endif
    } else if constexpr (P == 10) {
#if FAST_CROSS
        for (int u = (int)blockIdx.x; u < B * CH * (SEQ / 128); u += (int)gridDim.x) { const int v = (u & 7) * 32 + (u >> 3);
            fc::cross_unit(v >> 7, (v >> 5) & 3, v & 31, CQ, CQSS, CK2, CVT, CO, lds); }
#else
        nk_cross_scores(CQ, CQSS, CK2, PTMP);
#endif
    } else if constexpr (P == 11) {
#if !FAST_CROSS
        nk_cross_softmax(PTMP);
#endif
    } else if constexpr (P == 12) {
#if !FAST_CROSS
        nk_cross_pv(PTMP, CVT, CO);
#endif
    } else if constexpr (P == 13) {
#if FAST_P13
        pg8::Gemm g{CO, WCO, T, D, D}; pg8::StaticOrder S; S.init(T, D, (int)gridDim.x, (int)blockIdx.x);
        pg8::EpiResid E{out, out, XN, c.g_ffn, SSP2};
        pg8::gemm_phase<pg8::EpiResid, pg8::StaticOrder, true, true>(lds, g, S, E);
#else
        GemmP p{CO, WCO, T, D, D, 0, out, nullptr, nullptr, nullptr}; nk_gemm<4>(p);
#endif
    } else if constexpr (P == 14) {
#if FAST_MOE
        fast_router(c, lds);
#else
        nk_router(out, c.g_ffn, c.w_rg, c.b_rg, c.w_re, c.b_re, XN, EXPERT, GATE, SLOTPOS, ctl);
#endif
    } else if constexpr (P == 15) {
#if !FAST_MOE
        nk_moe_offsets(ctl);
#endif
    } else if constexpr (P == 16) {
#if FAST_MOE
        fast_moe_fill(c);
#else
        nk_moe_fill(EXPERT, GATE, SLOTPOS, ctl, SLOTTOK, SLOTGATE);
#endif
    } else if constexpr (P == 17) {
#if FAST_MOE
        pg8::Gemm g{XN, WGU, PMAX, NE * 2 * DE, D}; pg8::MoeOrder S{ctl, 4, (int)gridDim.x, (int)blockIdx.x};
        pg8::EpiGU E{SLOTTOK, SSP2, HE};
        pg8::gemm_phase_gather<pg8::EpiGU, pg8::MoeOrder, true>(lds, g, SLOTTOK, S, E);
#else
        nk_moe_gu(XN, WGU, SLOTTOK, ctl, HE);
#endif
    }
}
template <int P> __device__ __forceinline__ void run_phase_last(const Ctx& c, LdsPtr lds) {
    int* ctl = WSP(int, WS_CTL); bf16* WD = WSP(bf16, WS_WD); int* SLOTTOK = WSP(int, WS_SMALL + SM_SLOTTOK); float* SLOTGATE = WSP(float, WS_SMALL + SM_SLOTGATE); bf16* HE = (bf16*)(c.ws + WS_B + B_HE); (void)lds;
#if FAST_MOE
    pg8::Gemm g{HE, WD, PMAX, NE * D, DE}; pg8::MoeOrder S{ctl, 8, (int)gridDim.x, (int)blockIdx.x};
    pg8::EpiDown E{SLOTGATE, WSP(bf16, WS_C)};
    pg8::gemm_phase<pg8::EpiDown, pg8::MoeOrder, true, true>(lds, g, S, E);
#else
    nk_moe_down(HE, WD, SLOTTOK, SLOTGATE, ctl, c.out);
#endif
}

#ifndef HOST_EMU
#define XB_TMO      128
#define XB_XCNT(j)  (256  + 64 * (j))
#define XB_XSUB(j)  (1280 + 64 * (j))
#define XB_XGEN(j)  (2304 + 64 * (j))
#define XB_TOP      3328
#define XB_TOPGEN   3392
#define XCD_BAR_WORDS 3456
#define XB_SPIN_CAP (1u << 20)

__device__ __forceinline__ unsigned xb_ld(unsigned* p)              { return __hip_atomic_load(p, __ATOMIC_RELAXED, __HIP_MEMORY_SCOPE_AGENT); }
__device__ __forceinline__ unsigned xb_add(unsigned* p, unsigned v) { return __hip_atomic_fetch_add(p, v, __ATOMIC_RELAXED, __HIP_MEMORY_SCOPE_AGENT); }
__device__ __forceinline__ unsigned xb_xcc_id() { return (unsigned)__builtin_amdgcn_s_getreg((3 << 11) | 20) & 0xFu; }
#define XB_SPIN(cond, bar) do { unsigned _sp = 0; while (cond) { __builtin_amdgcn_s_sleep(1); \
    if ((++_sp & 255u) == 0u) { if (xb_ld(&(bar)[XB_TMO])) break; if (_sp > XB_SPIN_CAP) { atomicAdd(&(bar)[XB_TMO], 1u); break; } } } } while (0)

struct XcdBarrier {
    unsigned* bar; unsigned x;
    volatile LAS unsigned* st;
};
__device__ __forceinline__ XcdBarrier xcd_barrier_post(unsigned* bar, volatile LAS unsigned* st) {
    XcdBarrier b; b.bar = bar; b.x = xb_xcc_id(); b.st = st;
    if (threadIdx.x == 0) (void)xb_add(&bar[XB_XCNT(b.x)], 1u);
    return b;
}
__device__ __forceinline__ void xcd_barrier_complete(unsigned* bar, unsigned x, unsigned& nloc, unsigned& nx) {
    const unsigned G = gridDim.x * gridDim.y * gridDim.z;
    unsigned sum, cnt, mine, sp = 0u;
    for (;;) {
        sum = 0u; cnt = 0u; mine = 0u;
#pragma unroll
        for (unsigned j = 0; j < 16; ++j) { const unsigned c = xb_ld(&bar[XB_XCNT(j)]); sum += c; cnt += (c > 0u) ? 1u : 0u; mine = (j == x) ? c : mine; }
        if (sum == G) break;
        __builtin_amdgcn_s_sleep(1);
        if ((++sp & 255u) == 0u) { if (xb_ld(&bar[XB_TMO])) break; if (sp > XB_SPIN_CAP) { atomicAdd(&bar[XB_TMO], 1u); break; } }
    }
    nloc = mine > 0u ? mine : 1u; nx = cnt > 0u ? cnt : 1u;
}
__device__ __forceinline__ void xcd_barrier(const XcdBarrier& b) {
    asm volatile("s_waitcnt vmcnt(0)" ::: "memory");
    __syncthreads();
    if (threadIdx.x == 0) {
        unsigned* bar = b.bar;
        __builtin_amdgcn_s_waitcnt(0);
        unsigned nloc = b.st[0], nx = b.st[1];
        if (nloc == 0u) { xcd_barrier_complete(bar, b.x, nloc, nx); b.st[0] = nloc; b.st[1] = nx; }
        const unsigned old = xb_add(&bar[XB_XSUB(b.x)], 1u);
        const unsigned gen = old / nloc;
        if (old + 1u == (gen + 1u) * nloc) {
            __builtin_amdgcn_fence(__ATOMIC_RELEASE, "agent");
            asm volatile("s_waitcnt vmcnt(0)" ::: "memory");
            const unsigned og = xb_add(&bar[XB_TOP], 1u);
            const unsigned tg = og / nx;
            if (og + 1u == (tg + 1u) * nx) xb_add(&bar[XB_TOPGEN], 1u);
            else XB_SPIN(xb_ld(&bar[XB_TOPGEN]) == tg, bar);
            __builtin_amdgcn_fence(__ATOMIC_ACQUIRE, "agent");
            xb_add(&bar[XB_XGEN(b.x)], 1u);
            asm volatile("s_waitcnt vmcnt(0)" ::: "memory");
        } else {
            XB_SPIN(xb_ld(&bar[XB_XGEN(b.x)]) == gen, bar);
            __builtin_amdgcn_fence(__ATOMIC_ACQUIRE, "agent");
            asm volatile("s_waitcnt vmcnt(0)" ::: "memory");
        }
    }
    __syncthreads();
}

constexpr int NTHREADS = 512;
constexpr int LDS_BYTES = 147456;
constexpr int LDSCTL_OFF = 143360, MISC_OFF = LDSCTL_OFF + 64;
__global__ void __launch_bounds__(NTHREADS, 2) fwd_kernel(Ctx c) {
    extern __shared__ __attribute__((aligned(16))) unsigned char lds[];
    LAS unsigned char* l3 = (LAS unsigned char*)lds;
    volatile LAS unsigned* MISC = (volatile LAS unsigned*)(l3 + MISC_OFF);
    for (int u = threadIdx.x; u < (LDS_BYTES - LDSCTL_OFF) / 4; u += NTHREADS) ((LAS unsigned*)(l3 + LDSCTL_OFF))[u] = 0u;
    __syncthreads();
    XcdBarrier bar = xcd_barrier_post((unsigned*)(c.ws + WS_CTL) + CW_BAR, MISC + 8);
#ifndef PROBE_DOUBLE
#define PROBE_DOUBLE -1
#endif
#ifndef PROBE_SPLIT4
#define PROBE_SPLIT4 0
#endif
#define PH(k) if (PROBE_SPLIT4 && k == 4) { run_phase<k, 2>(c, l3); xcd_barrier(bar); run_phase<k, 3>(c, l3); xcd_barrier(bar); } else { run_phase<k>(c, l3); xcd_barrier(bar); } if (PROBE_DOUBLE == k) { run_phase<k, 1>(c, l3); xcd_barrier(bar); }
#if FAST_P0 && FAST_P1 && FAST_P6 && FAST_P13 && FAST_ATT && FAST_GLA && FAST_CROSS && FAST_MOE
    PH(0) PH(1) PH(2) PH(3) PH(4) PH(6) PH(8) PH(10) PH(13) PH(14) PH(16) PH(17)
    run_phase_last<0>(c, l3); xcd_barrier(bar);
    fast_moe_gather(c);
#else
    PH(0) PH(1) PH(2) PH(3) PH(4) PH(5) PH(6) PH(7) PH(8) PH(9) PH(10) PH(11) PH(12) PH(13) PH(14) PH(15) PH(16) PH(17)
    run_phase_last<0>(c, l3);
#if FAST_MOE
    xcd_barrier(bar); fast_moe_gather(c);
#endif
#endif
#undef PH
}
#endif

#ifdef HOST_EMU
template <int P> static void emu_phase(const Ctx& c) { const size_t nth = 4096; emu_nth = nth; for (size_t t = 0; t < nth; ++t) { emu_tid = t; run_phase<P>(c, nullptr); } }
template <int... Ps> static void emu_all(const Ctx& c, std::integer_sequence<int, Ps...>) { (emu_phase<Ps>(c), ...); }
#endif

extern "C" void kernel_launch(void* const* d_in, const int* in_sizes, int n_in, void* d_out, int out_size, void* d_ws, size_t ws_size, hipStream_t stream) {
    if (n_in != 31 || out_size != T * D || ws_size < WS_END) { fprintf(stderr, "kernel_launch: unexpected shapes (n_in %d out %d ws %zu need %zu)\n", n_in, out_size, ws_size, (size_t)WS_END); return; }
    (void)in_sizes;
    Ctx c{};
    const float** fp = (const float**)&c.x;
    c.x = (const float*)d_in[0]; c.mem = (const float*)d_in[1]; c.positions = (const int*)d_in[2];
    c.g_attn = (const float*)d_in[3]; c.w_in = (const float*)d_in[4]; c.q_norm_g = (const float*)d_in[5]; c.k_norm_g = (const float*)d_in[6];
    c.lq1 = (const float*)d_in[7]; c.lk1 = (const float*)d_in[8]; c.lq2 = (const float*)d_in[9]; c.lk2 = (const float*)d_in[10];
    c.subln_g = (const float*)d_in[11]; c.w_a2 = (const float*)d_in[12]; c.b_a = (const float*)d_in[13]; c.gla_out_g = (const float*)d_in[14];
    c.w_out = (const float*)d_in[15]; c.g_cross = (const float*)d_in[16]; c.g_mem = (const float*)d_in[17]; c.w_cq = (const float*)d_in[18];
    c.w_ckv = (const float*)d_in[19]; c.cq_g = (const float*)d_in[20]; c.ck_g = (const float*)d_in[21]; c.w_co = (const float*)d_in[22];
    c.g_ffn = (const float*)d_in[23]; c.w_rg = (const float*)d_in[24]; c.b_rg = (const float*)d_in[25]; c.w_re = (const float*)d_in[26];
    c.b_re = (const float*)d_in[27]; c.w_gate = (const float*)d_in[28]; c.w_up = (const float*)d_in[29]; c.w_down = (const float*)d_in[30];
    c.out = (float*)d_out; c.ws = (char*)d_ws; (void)fp;
#ifdef HOST_EMU
    memset(c.ws + WS_CTL, 0, CTL_BYTES);
    emu_all(c, std::make_integer_sequence<int, N_PHASES>{});
    { const size_t nth = 4096; emu_nth = nth; for (size_t t = 0; t < nth; ++t) { emu_tid = t; run_phase_last<0>(c, nullptr); } }
#else
    static int grid = 0;
    if (grid == 0) {
        int dev = 0, cus = 0, per_cu = 0;
        if (hipGetDevice(&dev) != hipSuccess || hipDeviceGetAttribute(&cus, hipDeviceAttributeMultiprocessorCount, dev) != hipSuccess) { fprintf(stderr, "kernel_launch: device query failed\n"); grid = -1; return; }
        if (hipFuncSetAttribute((const void*)fwd_kernel, hipFuncAttributeMaxDynamicSharedMemorySize, LDS_BYTES) != hipSuccess) { fprintf(stderr, "kernel_launch: hipFuncSetAttribute failed\n"); grid = -1; return; }
        if (hipOccupancyMaxActiveBlocksPerMultiprocessor(&per_cu, (const void*)fwd_kernel, NTHREADS, LDS_BYTES) != hipSuccess || per_cu < 1) { fprintf(stderr, "kernel_launch: occupancy query says %d blocks per CU\n", per_cu); }
        (void)hipGetLastError();
        grid = cus;
    }
    if (grid < 0) return;
    (void)hipMemsetAsync(c.ws + WS_CTL, 0, CTL_BYTES, stream);
    hipLaunchKernelGGL(fwd_kernel, dim3(grid), dim3(NTHREADS), LDS_BYTES, stream, c);
#endif
}
```

```cpp
#ifndef HOST_EMU
#include <hip/hip_runtime.h>
#else
#include <cstring>
struct EmuD3 { unsigned x, y, z; };
static EmuD3 blockIdx, threadIdx, blockDim, gridDim;
static size_t emu_tid, emu_nth;
#define __global__ static
#define __device__ static
#define __host__
#define __forceinline__ inline
#define __launch_bounds__(...)
typedef int hipStream_t;
static inline int atomicAdd(int* p, int v) { int o = *p; *p += v; return o; }
static inline float atomicAdd(float* p, float v) { float o = *p; *p += v; return o; }
#endif
#include <cstdint>
#include <cstdio>
#include <cmath>

#ifndef CFG_D
#define CFG_D 2048
#define CFG_SEQ 4096
#define CFG_NMEM 256
#define CFG_ETILE 256
#endif
namespace cfg {
constexpr int D = CFG_D, B = 2, SEQ = CFG_SEQ, T = B * SEQ, CHUNK = 64, NC = SEQ / CHUNK;
constexpr int DH = 8, DVD = D / 16, DQK = D / 32;
constexpr int GH = 4, GVD = D / 8, GKD = D / 16, GRK = 16;
constexpr int NMEM = CFG_NMEM, CH = 4, CHD = D / 4;
constexpr int NE = 32, EPG = 8, NG = 4, DE = D / 4;
constexpr int ETILE = CFG_ETILE, PMAX = 2 * T + NE * ETILE, NTILE = PMAX / ETILE;
constexpr int NIN = 3 * D;
constexpr int IN_COLS = 3 * D + GRK;
constexpr int O_DQ = 0, O_DK = D / 2, O_DV = D, O_GQ = 3 * D / 2, O_GK = 7 * D / 4, O_GV = 2 * D, O_LR = 5 * D / 2, O_GR = 5 * D / 2 + GRK;
constexpr float EPS = 1e-6f;
constexpr float LOG2E = 1.4426950408889634f;
}
using namespace cfg;
typedef unsigned short bf16;

constexpr size_t al256(size_t x) { return (x + 255) & ~(size_t)255; }
constexpr size_t WS_CTL = 0, CTL_BYTES = 1u << 20;
constexpr size_t WS_WIN = WS_CTL + CTL_BYTES;
constexpr size_t WS_WLR = WS_WIN + al256((size_t)NIN * D * 2);
constexpr size_t WS_WOUT = WS_WLR + al256((size_t)GRK * D * 2);
constexpr size_t WS_WCQ = WS_WOUT + al256((size_t)D * D * 2);
constexpr size_t WS_WCKV = WS_WCQ + al256((size_t)D * D * 2);
constexpr size_t WS_WCO = WS_WCKV + al256((size_t)2 * D * D * 2);
constexpr size_t WS_WGU = WS_WCO + al256((size_t)D * D * 2);
constexpr size_t WS_WD = WS_WGU + al256((size_t)NE * 2 * DE * D * 2);
constexpr size_t WS_XN = WS_WD + al256((size_t)NE * D * DE * 2);
constexpr size_t WS_MEMN = WS_XN + al256((size_t)(T + 1) * D * 2);
constexpr size_t WS_SMALL = WS_MEMN + al256((size_t)B * NMEM * D * 2);
constexpr size_t SM_GLR = 0;
constexpr size_t SM_CQSS = SM_GLR + al256((size_t)T * GRK * 4);
constexpr size_t SM_SSP1 = SM_CQSS + al256((size_t)T * 32 * 4);
constexpr size_t SM_SSP2 = SM_SSP1 + al256((size_t)T * 32 * 4);
constexpr size_t SM_EXPERT = SM_SSP2 + al256((size_t)T * 32 * 4);
constexpr size_t SM_GATE = SM_EXPERT + al256((size_t)T * 2 * 4);
constexpr size_t SM_SLOTPOS = SM_GATE + al256((size_t)T * 2 * 4);
constexpr size_t SM_SLOTTOK = SM_SLOTPOS + al256((size_t)T * 2 * 4);
constexpr size_t SM_SLOTGATE = SM_SLOTTOK + al256((size_t)PMAX * 4);
constexpr size_t SM_ROPE = SM_SLOTGATE + al256((size_t)PMAX * 4);
constexpr size_t SM_CKV = SM_ROPE + al256((size_t)T * DQK * 4);
constexpr size_t SM_CK2 = SM_CKV + al256((size_t)B * NMEM * 2 * D * 2);
constexpr size_t SM_CVT = SM_CK2 + al256((size_t)B * NMEM * D * 2);
constexpr size_t SM_WRT = SM_CVT + al256((size_t)B * NMEM * D * 2);
constexpr size_t SM_DEC = SM_WRT + al256((size_t)48 * D * 2);
constexpr size_t SM_STATS = SM_DEC + al256((size_t)B * NC * GH * GKD * 4);
constexpr size_t SM_END = SM_STATS + al256((size_t)T * DH * 4 * 4);
constexpr size_t WS_B = WS_SMALL + al256(SM_END);
constexpr size_t B_DQ = 0, B_DK = B_DQ + (size_t)T * (D / 2) * 2, B_DV = B_DK + (size_t)T * (D / 2) * 2;
constexpr size_t B_GQ = B_DV + (size_t)T * (D / 2) * 2, B_GK = B_GQ + (size_t)T * (D / 4) * 2, B_GV = B_GK + (size_t)T * (D / 4) * 2, B_GR = B_GV + (size_t)T * (D / 2) * 2;
constexpr size_t B_END1 = B_GR + (size_t)T * (D / 2) * 2;
constexpr size_t B_CQ = 0, B_CO = B_CQ + (size_t)T * D * 2, B_HE = B_CO + (size_t)T * D * 2, B_END2 = B_HE + (size_t)PMAX * DE * 2;
constexpr size_t B_BYTES = al256(B_END1 > B_END2 ? B_END1 : B_END2);
constexpr size_t WS_C = WS_B + B_BYTES;
constexpr size_t WS_D = WS_C + al256((size_t)T * D * 2);
constexpr size_t WS_END = WS_D + al256((size_t)T * D * 5);

constexpr int CW_CNT = 64;
constexpr int CW_BASE = 128;
constexpr int CW_TILE_E = 256;
constexpr int CW_NTILES = 512;
constexpr int CW_BAR = 4096;
constexpr int CW_DIAG = 2048;
constexpr int CW_QUEUE = 1024;

__device__ __forceinline__ bf16 f2bf(float f) { unsigned u; memcpy(&u, &f, 4); u = (u + 0x7fffu + ((u >> 16) & 1u)) >> 16; return (bf16)u; }
__device__ __forceinline__ float bf2f(bf16 b) { unsigned u = ((unsigned)b) << 16; float f; memcpy(&f, &u, 4); return f; }
__device__ __forceinline__ float silu_f(float x) { return x / (1.f + expf(-x)); }
#ifdef HOST_EMU
static inline size_t gtid() { return emu_tid; }
static inline size_t gnth() { return emu_nth; }
#else
__device__ __forceinline__ size_t gtid() { return (size_t)blockIdx.x * blockDim.x + threadIdx.x; }
__device__ __forceinline__ size_t gnth() { return (size_t)gridDim.x * blockDim.x; }
#endif
struct bf16x8s { bf16 v[8]; };
__host__ __device__ __forceinline__ int win_logical(int np) {
    if (np >= D) return np; const int t = np & ~255, p = np & 255; return t + 64 * ((p & 127) >> 5) + 32 * (p >> 7) + (p & 31);
}
__host__ __device__ __forceinline__ int win_src_col(int np) { const int l = win_logical(np); return l < O_LR ? l : l + GRK; }

__device__ __forceinline__ void nk_rmsnorm_rows(const float* x, const float* g, bf16* out, int rows, int d) {
    for (size_t r = gtid(); r < (size_t)(rows); r += gnth()) {
    const float* xr = x + r * d; float ss = 0.f;
    for (int i = 0; i < d; ++i) ss += xr[i] * xr[i];
    const float rs = 1.0f / sqrtf(ss / d + EPS);
    for (int i = 0; i < d; ++i) out[r * d + i] = f2bf(xr[i] * rs * g[i]);
}}
__device__ __forceinline__ void nk_glr(const float* x, const float* g, const float* w_in, float* GLR) {
    for (size_t i = gtid(); i < (size_t)T * GRK; i += gnth()) { const int cc = (int)(i % GRK), t = (int)(i / GRK); const float* xr = x + (size_t)t * D; float ss = 0.f;
        for (int k = 0; k < D; ++k) ss += xr[k] * xr[k]; const float rs = 1.0f / sqrtf(ss / D + EPS); float a = 0.f;
        for (int k = 0; k < D; ++k) a += xr[k] * rs * g[k] * w_in[(size_t)k * IN_COLS + O_LR + cc]; GLR[i] = a; }
}
__device__ __forceinline__ void nk_zero_bf16(bf16* p, size_t n) { for (size_t i = gtid(); i < n; i += gnth()) p[i] = 0; }
__device__ __forceinline__ void nk_convT(const float* W, int ldw, int col0, bf16* WT, int N, int K) {
    for (size_t i = gtid(); i < (size_t)(N * K); i += gnth()) {
    const int n = (int)(i / K), k = (int)(i % K);
    WT[i] = f2bf(W[(size_t)k * ldw + col0 + n]);
}}
__device__ __forceinline__ void nk_conv_win(const float* W, bf16* WT) {
    for (size_t i = gtid(); i < (size_t)NIN * D; i += gnth()) { const int n = (int)(i / D), k = (int)(i % D); WT[i] = f2bf(W[(size_t)k * IN_COLS + win_src_col(n)]); }
}
constexpr int GUH = (DE >= 128) ? 128 : DE;
__device__ __forceinline__ void nk_conv_gu(const float* Wg, const float* Wu, bf16* WGU) {
    for (size_t i = gtid(); i < (size_t)(NE * 2 * DE * D); i += gnth()) {
    const int k = (int)(i % D); const int r = (int)((i / D) % (2 * DE)); const int e = (int)(i / ((size_t)D * 2 * DE));
    const int pn = r / (2 * GUH), ii = r % (2 * GUH); const int j = pn * GUH + (ii % GUH);
    const float* W = (ii < GUH) ? Wg : Wu;
    WGU[i] = f2bf(W[((size_t)e * D + k) * DE + j]);
}}
__device__ __forceinline__ void nk_conv_d(const float* Wd, bf16* WD) {
    for (size_t i = gtid(); i < (size_t)(NE * D * DE); i += gnth()) {
    const int j = (int)(i % DE); const int n = (int)((i / DE) % D); const int e = (int)(i / ((size_t)D * DE));
    WD[i] = f2bf(Wd[((size_t)e * DE + j) * D + n]);
}}
__device__ __forceinline__ void nk_rope_table(const int* positions, float* tab) {
    constexpr int half = DQK / 2; for (size_t i = gtid(); i < (size_t)(T * half); i += gnth()) {
    const int t = (int)(i / half), j = (int)(i % half);
    const float freq = powf(10000.0f, -(float)j / (float)half);
    const float ang = (float)positions[t] * freq;
    tab[i * 2] = cosf(ang); tab[i * 2 + 1] = sinf(ang);
}}

struct GemmP { const bf16* A; const bf16* Bt; int M, N, K, pad; float* f0; float* f1; bf16* b0; const float* x; };
template <int MODE> __device__ __forceinline__ void gemm_epi(const GemmP& p, int m, int n, float acc) {
    if constexpr (MODE == 0) {
        bf16* Bb = p.b0; n = win_logical(n);
        if (n < D) { p.f0[(size_t)m * D + n] = acc; return; }
        if (n < O_GQ) { ((bf16*)((char*)Bb + B_DV))[(size_t)m * (D / 2) + (n - O_DV)] = f2bf(acc); return; }
        if (n < O_GK) { ((bf16*)((char*)Bb + B_GQ))[(size_t)m * (D / 4) + (n - O_GQ)] = f2bf(acc * (1.0f / sqrtf((float)GKD))); return; }
        if (n < O_GV) { ((bf16*)((char*)Bb + B_GK))[(size_t)m * (D / 4) + (n - O_GK)] = f2bf(acc); return; }
        if (n < O_LR) { ((bf16*)((char*)Bb + B_GV))[(size_t)m * (D / 2) + (n - O_GV)] = f2bf(acc); return; }
        ((bf16*)((char*)Bb + B_GR))[(size_t)m * (D / 2) + (n - O_LR)] = f2bf(acc);
    } else if constexpr (MODE == 1) { p.f0[(size_t)m * p.N + n] = p.x[(size_t)m * p.N + n] + acc;
    } else if constexpr (MODE == 2) { p.b0[(size_t)m * p.N + n] = f2bf(acc);
    } else if constexpr (MODE == 4) { p.f0[(size_t)m * p.N + n] += acc;
    } else { p.f0[(size_t)m * p.N + n] = acc; }
}
template <int MODE> __device__ __forceinline__ void nk_gemm(GemmP p) {
    const int nb = p.N / 4; for (size_t idx = gtid(); idx < (size_t)(p.M / 4) * nb; idx += gnth()) {
    const int m0 = 4 * (int)(idx / nb), n0 = 4 * (int)(idx % nb);
    float acc[4][4];
#pragma unroll
    for (int i = 0; i < 4; ++i)
#pragma unroll
        for (int j = 0; j < 4; ++j) acc[i][j] = 0.f;
    for (int k = 0; k < p.K; k += 8) {
        bf16x8s a[4], b[4];
#pragma unroll
        for (int i = 0; i < 4; ++i) { a[i] = *(const bf16x8s*)(p.A + (size_t)(m0 + i) * p.K + k); b[i] = *(const bf16x8s*)(p.Bt + (size_t)(n0 + i) * p.K + k); }
#pragma unroll
        for (int kk = 0; kk < 8; ++kk) {
            float af[4], bfv[4];
#pragma unroll
            for (int i = 0; i < 4; ++i) { af[i] = bf2f(a[i].v[kk]); bfv[i] = bf2f(b[i].v[kk]); }
#pragma unroll
            for (int i = 0; i < 4; ++i)
#pragma unroll
                for (int j = 0; j < 4; ++j) acc[i][j] += af[i] * bfv[j];
        }
    }
#pragma unroll
    for (int i = 0; i < 4; ++i)
#pragma unroll
        for (int j = 0; j < 4; ++j) gemm_epi<MODE>(p, m0 + i, n0 + j, acc[i][j]);
}}

__device__ __forceinline__ void nk_qk_post(const float* tmpqk, const float* qg, const float* kg, const float* rope, bf16* DQ, bf16* DK) {
    for (size_t i = gtid(); i < (size_t)(T * 2 * DH * 2); i += gnth()) {
    const int c = (int)(i % 2), h = (int)((i / 2) % DH), which = (int)((i / (2 * DH)) % 2), t = (int)(i / (4 * DH));
    const float* src = tmpqk + (size_t)t * D + which * (D / 2) + h * 2 * DQK + c * DQK;
    const float* g = which ? kg : qg; bf16* dst = (which ? DK : DQ) + (size_t)t * (D / 2) + h * 2 * DQK + c * DQK;
    float ss = 0.f; for (int d = 0; d < DQK; ++d) ss += src[d] * src[d];
    const float rs = 1.0f / sqrtf(ss / DQK + EPS); constexpr int half = DQK / 2;
    const float sc = which ? 1.0f : (1.0f / sqrtf((float)DQK)) * LOG2E;
    for (int d = 0; d < half; ++d) {
        const float t1 = src[d] * rs * g[d], t2 = src[d + half] * rs * g[d + half];
        const float cs = rope[((size_t)t * half + d) * 2], sn = rope[((size_t)t * half + d) * 2 + 1];
        dst[d] = f2bf((t1 * cs - t2 * sn) * sc); dst[d + half] = f2bf((t2 * cs + t1 * sn) * sc);
    }
}}
__device__ __forceinline__ void nk_lam(const float* q1, const float* k1, const float* q2, const float* k2, float* out) {
    if (gtid() != 0) return; float a = 0.f, b = 0.f; for (int i = 0; i < DQK; ++i) { a += q1[i] * k1[i]; b += q2[i] * k2[i]; }
    out[0] = expf(a) - expf(b) + 0.2f;
}
__device__ __forceinline__ void nk_mref(const float* qg, const float* kg, float* out) {
    if (gtid() != 0) return; float mq = 0.f, mk = 0.f; for (int i = 0; i < DQK; ++i) { mq = fmaxf(mq, fabsf(qg[i])); mk = fmaxf(mk, fabsf(kg[i])); }
    out[0] = (float)DQK * mq * mk * (1.0f / sqrtf((float)DQK)) * LOG2E * 1.02f;
}
__device__ __forceinline__ void nk_diff_stats(const bf16* DQ, const bf16* DK, float* stats) {
    for (size_t i = gtid(); i < (size_t)(T * DH * 2); i += gnth()) {
    const int c = (int)(i % 2), h = (int)((i / 2) % DH), t = (int)(i / (2 * DH)); const int b = t / SEQ, s = t % SEQ;
    const int nk = (s / CHUNK + 1) * CHUNK;
    float q[DQK]; const bf16* qp = DQ + (size_t)t * (D / 2) + h * 2 * DQK + c * DQK;
#pragma unroll
    for (int d = 0; d < DQK; ++d) q[d] = bf2f(qp[d]);
    float mx = -1e30f;
    for (int k = 0; k < nk; ++k) { const bf16* kp = DK + (size_t)(b * SEQ + k) * (D / 2) + h * 2 * DQK + c * DQK; float sdot = 0.f;
#pragma unroll
        for (int d = 0; d < DQK; ++d) sdot += q[d] * bf2f(kp[d]);
        mx = fmaxf(mx, sdot); }
    float sum = 0.f;
    for (int k = 0; k < nk; ++k) { const bf16* kp = DK + (size_t)(b * SEQ + k) * (D / 2) + h * 2 * DQK + c * DQK; float sdot = 0.f;
#pragma unroll
        for (int d = 0; d < DQK; ++d) sdot += q[d] * bf2f(kp[d]);
        sum += exp2f(sdot - mx); }
    stats[i * 2] = mx; stats[i * 2 + 1] = sum;
}}
__device__ __forceinline__ void nk_diff_pv(const bf16* DQ, const bf16* DK, const bf16* DV, const float* stats, const float* lamp, float* otmp) {
    constexpr int NDG = 8, DG = DVD / NDG;
    for (size_t i = gtid(); i < (size_t)(T * DH * NDG); i += gnth()) {
    const int dg = (int)(i % NDG), h = (int)((i / NDG) % DH), t = (int)(i / (NDG * DH)); const int b = t / SEQ, s = t % SEQ;
    const int nk = (s / CHUNK + 1) * CHUNK; const float lam = lamp[0];
    float q[2 * DQK]; const bf16* qp = DQ + (size_t)t * (D / 2) + h * 2 * DQK;
#pragma unroll
    for (int d = 0; d < 2 * DQK; ++d) q[d] = bf2f(qp[d]);
    const float m0 = stats[((size_t)(t * DH + h) * 2 + 0) * 2], l0 = stats[((size_t)(t * DH + h) * 2 + 0) * 2 + 1];
    const float m1 = stats[((size_t)(t * DH + h) * 2 + 1) * 2], l1 = stats[((size_t)(t * DH + h) * 2 + 1) * 2 + 1];
    float acc[DG];
#pragma unroll
    for (int d = 0; d < DG; ++d) acc[d] = 0.f;
    for (int k = 0; k < nk; ++k) { const bf16* kp = DK + (size_t)(b * SEQ + k) * (D / 2) + h * 2 * DQK; float s0 = 0.f, s1 = 0.f;
#pragma unroll
        for (int d = 0; d < DQK; ++d) { s0 += q[d] * bf2f(kp[d]); s1 += q[DQK + d] * bf2f(kp[DQK + d]); }
        const float a = exp2f(s0 - m0) / l0 - lam * exp2f(s1 - m1) / l1;
        const bf16* vp = DV + (size_t)(b * SEQ + k) * (D / 2) + h * DVD + dg * DG;
#pragma unroll
        for (int d = 0; d < DG; ++d) acc[d] += a * bf2f(vp[d]); }
#pragma unroll
    for (int d = 0; d < DG; ++d) otmp[(size_t)t * (D / 2) + h * DVD + dg * DG + d] = acc[d];
}}
__device__ __forceinline__ void nk_diff_norm(const float* otmp, const float* g, bf16* MIX) {
    for (size_t i = gtid(); i < (size_t)(T * DH); i += gnth()) { const int h = (int)(i % DH), t = (int)(i / DH);
    const float* o = otmp + (size_t)t * (D / 2) + h * DVD; float ss = 0.f; for (int d = 0; d < DVD; ++d) ss += o[d] * o[d];
    const float rs = 1.0f / sqrtf(ss / DVD + EPS);
    for (int d = 0; d < DVD; ++d) MIX[(size_t)t * D + h * DVD + d] = f2bf(o[d] * rs * g[d] * 0.8f);
}}
__device__ __forceinline__ void nk_gla_cum(const float* GLR, const float* wa2, const float* ba, float* CUM) {
    constexpr int W = GH * GKD; for (size_t i = gtid(); i < (size_t)(B * NC * W); i += gnth()) {
    const int j = (int)(i % W), cb = (int)(i / W); float run = 0.f;
    for (int tt = 0; tt < CHUNK; ++tt) { const int t = cb * CHUNK + tt; float z = ba[j];
        for (int r = 0; r < GRK; ++r) z += GLR[(size_t)t * GRK + r] * wa2[(size_t)r * W + j];
        const float ls = fminf(z, 0.f) - log1pf(expf(-fabsf(z)));
        run += ls * (1.0f / 16.0f); CUM[(size_t)t * W + j] = run; }
}}
__device__ __forceinline__ void nk_gla_prep(const float* GLR, const float* wa2, const float* ba, const bf16* GK, bf16* KD, float* DEC) {
    constexpr int W = GH * GKD;
    for (size_t i = gtid(); i < (size_t)B * NC * W; i += gnth()) { const int j = (int)(i % W), cb = (int)(i / W);
        float w[GRK];
#pragma unroll
        for (int r = 0; r < GRK; ++r) w[r] = wa2[(size_t)r * W + j];
        const float bj = ba[j]; float run = 0.f;
        for (int tt = 0; tt < CHUNK; ++tt) { const float* gl = GLR + (size_t)(cb * CHUNK + tt) * GRK; float z = bj;
#pragma unroll
            for (int r = 0; r < GRK; ++r) z += gl[r] * w[r];
            run += (fminf(z, 0.f) - log1pf(expf(-fabsf(z)))) * (1.0f / 16.0f); }
        const float end = run; DEC[i] = expf(end); run = 0.f;
        for (int tt = 0; tt < CHUNK; ++tt) { const int t = cb * CHUNK + tt; const float* gl = GLR + (size_t)t * GRK; float z = bj;
#pragma unroll
            for (int r = 0; r < GRK; ++r) z += gl[r] * w[r];
            run += (fminf(z, 0.f) - log1pf(expf(-fabsf(z)))) * (1.0f / 16.0f);
            KD[(size_t)t * W + j] = f2bf(bf2f(GK[(size_t)t * W + j]) * expf(end - run)); } }
}
__device__ __forceinline__ void nk_gla_run(const bf16* GQ, const bf16* GK, const bf16* GV, const float* CUM, float* otmp) {
    constexpr int KH = GKD / 2;
    for (size_t i = gtid(); i < (size_t)(B * GH * GVD); i += gnth()) {
    const int v = (int)(i % GVD), h = (int)((i / GVD) % GH), b = (int)(i / (GVD * GH)); constexpr int W = GH * GKD;
    for (int kh = 0; kh < 2; ++kh) {
    float S[KH];
#pragma unroll
    for (int k = 0; k < KH; ++k) S[k] = 0.f;
    for (int c = 0; c < NC; ++c) { const int t0 = b * SEQ + c * CHUNK; const float* ce = CUM + (size_t)(t0 + CHUNK - 1) * W + h * GKD + kh * KH;
#pragma unroll
        for (int k = 0; k < KH; ++k) S[k] *= expf(ce[k]);
        for (int tt = 0; tt < CHUNK; ++tt) { const int t = t0 + tt; const float vv = bf2f(GV[(size_t)t * (D / 2) + h * GVD + v]);
            const bf16* kp = GK + (size_t)t * (D / 4) + h * GKD + kh * KH; const float* cp = CUM + (size_t)t * W + h * GKD + kh * KH;
#pragma unroll
            for (int k = 0; k < KH; ++k) S[k] += bf2f(kp[k]) * expf(ce[k] - cp[k]) * vv; }
        for (int tt = 0; tt < CHUNK; ++tt) { const int t = t0 + tt; const bf16* qp = GQ + (size_t)t * (D / 4) + h * GKD + kh * KH; float o = 0.f;
#pragma unroll
            for (int k = 0; k < KH; ++k) o += bf2f(qp[k]) * S[k];
            float* op = otmp + (size_t)t * (D / 2) + h * GVD + v; if (kh == 0) *op = o; else *op += o; } }
    } }
}
__device__ __forceinline__ void nk_gla_norm(const float* otmp, const float* g, const bf16* GR, bf16* MIX) {
    for (size_t i = gtid(); i < (size_t)(T * GH); i += gnth()) { const int h = (int)(i % GH), t = (int)(i / GH);
    const float* o = otmp + (size_t)t * (D / 2) + h * GVD; float ss = 0.f; for (int d = 0; d < GVD; ++d) ss += o[d] * o[d];
    const float rs = 1.0f / sqrtf(ss / GVD + EPS);
    for (int d = 0; d < GVD; ++d) MIX[(size_t)t * D + D / 2 + h * GVD + d] = f2bf(o[d] * rs * g[d] * silu_f(bf2f(GR[(size_t)t * (D / 2) + h * GVD + d])));
}}
__device__ __forceinline__ void nk_cqss(const bf16* CQ, float* CQSS) {
    for (size_t i = gtid(); i < (size_t)T * 32; i += gnth()) { const int j = (int)(i % 32), t = (int)(i / 32);
    float ss = 0.f; for (int d = 0; d < D / 32; ++d) { const float v = bf2f(CQ[(size_t)t * D + j * (D / 32) + d]); ss += v * v; } CQSS[i] = ss; }
}
__device__ __forceinline__ void nk_ckv_fix(const bf16* CKV, const float* qg, const float* kg, bf16* CK2, bf16* CVT) {
    for (size_t i = gtid(); i < (size_t)(B * NMEM * CH); i += gnth()) { const int h = (int)(i % CH), bm = (int)(i / CH); const int b = bm / NMEM, m = bm % NMEM;
    const bf16* kp = CKV + (size_t)bm * 2 * D + h * CHD; const bf16* vp = CKV + (size_t)bm * 2 * D + D + h * CHD;
    float ss = 0.f; for (int d = 0; d < CHD; ++d) { const float v = bf2f(kp[d]); ss += v * v; }
    const float rs = 1.0f / sqrtf(ss / CHD + EPS) * (1.0f / sqrtf((float)CHD)) * LOG2E;
    for (int d = 0; d < CHD; ++d) { CK2[(((size_t)b * CH + h) * NMEM + m) * CHD + d] = f2bf(bf2f(kp[d]) * rs * kg[d] * qg[d]);
        CVT[(((size_t)b * CH + h) * CHD + d) * NMEM + m] = vp[d]; }
}}
__device__ __forceinline__ void nk_cross_scores(const bf16* CQ, const float* CQSS, const bf16* CK2, float* P) {
    for (size_t i = gtid(); i < (size_t)(T * CH * NMEM); i += gnth()) { const int m = (int)(i % NMEM), h = (int)((i / NMEM) % CH), t = (int)(i / (NMEM * CH)); const int b = t / SEQ;
    float qs = 0.f; for (int j = 0; j < 8; ++j) qs += CQSS[(size_t)t * 32 + 8 * h + j];
    const float rq = 1.0f / sqrtf(qs / CHD + EPS);
    const bf16* qp = CQ + (size_t)t * D + h * CHD; const bf16* kp = CK2 + (((size_t)b * CH + h) * NMEM + m) * CHD; float s = 0.f;
    for (int d = 0; d < CHD; ++d) s += bf2f(qp[d]) * bf2f(kp[d]);
    P[i] = s * rq;
}}
__device__ __forceinline__ void nk_cross_softmax(float* P) {
    for (size_t i = gtid(); i < (size_t)(T * CH); i += gnth()) { float* p = P + i * NMEM; float mx = -1e30f;
    for (int m = 0; m < NMEM; ++m) mx = fmaxf(mx, p[m]); float sum = 0.f;
    for (int m = 0; m < NMEM; ++m) { p[m] = exp2f(p[m] - mx); sum += p[m]; }
    for (int m = 0; m < NMEM; ++m) p[m] /= sum;
}}
__device__ __forceinline__ void nk_cross_pv(const float* P, const bf16* CVT, bf16* CO) {
    for (size_t i = gtid(); i < (size_t)(T * D); i += gnth()) { const int d = (int)(i % CHD), h = (int)((i / CHD) % CH), t = (int)(i / D); const int b = t / SEQ;
    const float* p = P + ((size_t)t * CH + h) * NMEM; const bf16* vp = CVT + (((size_t)b * CH + h) * CHD + d) * NMEM; float o = 0.f;
    for (int m = 0; m < NMEM; ++m) o += p[m] * bf2f(vp[m]);
    CO[i] = f2bf(o);
}}
__device__ __forceinline__ void nk_router(const float* h2, const float* g, const float* wrg, const float* brg, const float* wre, const float* bre, bf16* XN, int* EXPERT, float* GATE, int* SLOTPOS, int* ctl) {
    for (size_t t = gtid(); t < (size_t)(T); t += gnth()) { const float* xr = h2 + t * D; float ss = 0.f;
    for (int i = 0; i < D; ++i) ss += xr[i] * xr[i]; const float rs = 1.0f / sqrtf(ss / D + EPS);
    float gl[NG], el[NE];
#pragma unroll
    for (int j = 0; j < NG; ++j) gl[j] = brg[j];
#pragma unroll
    for (int j = 0; j < NE; ++j) el[j] = bre[j];
    for (int i = 0; i < D; ++i) { const float xv = xr[i] * rs * g[i]; XN[t * D + i] = f2bf(xv);
#pragma unroll
        for (int j = 0; j < NG; ++j) gl[j] += xv * wrg[(size_t)i * NG + j];
#pragma unroll
        for (int j = 0; j < NE; ++j) el[j] += xv * wre[(size_t)i * NE + j]; }
    int grp = 0; float gm = gl[0];
#pragma unroll
    for (int j = 1; j < NG; ++j) if (gl[j] > gm) { gm = gl[j]; grp = j; }
    float gs = 0.f;
#pragma unroll
    for (int j = 0; j < NG; ++j) gs += expf(gl[j] - gm);
    const float grp_w = 1.0f / gs;
    float e8[EPG];
#pragma unroll
    for (int j = 0; j < EPG; ++j) { float v = 0.f;
#pragma unroll
        for (int gq = 0; gq < NG; ++gq) v = (grp == gq) ? el[gq * EPG + j] : v;
        e8[j] = v; }
    int i0 = 0; float v0 = e8[0];
#pragma unroll
    for (int j = 1; j < EPG; ++j) if (e8[j] > v0) { v0 = e8[j]; i0 = j; }
    int i1 = -1; float v1 = -1e30f;
#pragma unroll
    for (int j = 0; j < EPG; ++j) if (j != i0 && e8[j] > v1) { v1 = e8[j]; i1 = j; }
    const float r = expf(v1 - v0); const float g0 = grp_w / (1.f + r), g1 = grp_w * r / (1.f + r);
    const int e0 = grp * EPG + i0, e1 = grp * EPG + i1;
    EXPERT[t * 2] = e0; EXPERT[t * 2 + 1] = e1; GATE[t * 2] = g0; GATE[t * 2 + 1] = g1;
    SLOTPOS[t * 2] = atomicAdd(&ctl[CW_CNT + e0], 1); SLOTPOS[t * 2 + 1] = atomicAdd(&ctl[CW_CNT + e1], 1);
}}
__device__ __forceinline__ void nk_moe_offsets(int* ctl) {
    if (gtid() != 0) return; int base = 0, nt = 0;
    for (int e = 0; e < NE; ++e) { ctl[CW_BASE + e] = base; const int n = (ctl[CW_CNT + e] + ETILE - 1) / ETILE; for (int j = 0; j < n; ++j) ctl[CW_TILE_E + nt + j] = e; nt += n; base += n * ETILE; }
    ctl[CW_BASE + NE] = base; ctl[CW_NTILES] = nt; for (int j = nt; j < NTILE; ++j) ctl[CW_TILE_E + j] = -1;
}
__device__ __forceinline__ void nk_moe_init_slots(int* SLOTTOK, float* SLOTGATE) { for (size_t i = gtid(); i < (size_t)PMAX; i += gnth()) { SLOTTOK[i] = T; SLOTGATE[i] = 0.f; } }
__device__ __forceinline__ void nk_moe_fill(const int* EXPERT, const float* GATE, const int* SLOTPOS, const int* ctl, int* SLOTTOK, float* SLOTGATE) {
    for (size_t i = gtid(); i < (size_t)(T * 2); i += gnth()) { const int e = EXPERT[i]; const int dst = ctl[CW_BASE + e] + SLOTPOS[i];
    SLOTTOK[dst] = (int)(i / 2); SLOTGATE[dst] = GATE[i];
}}
__device__ __forceinline__ void nk_moe_gu(const bf16* XN, const bf16* WGU, const int* SLOTTOK, const int* ctl, bf16* HE) {
    for (size_t i = gtid(); i < (size_t)(PMAX * DE); i += gnth()) { const int j = (int)(i % DE), p = (int)(i / DE); const int e = ctl[CW_TILE_E + p / ETILE];
    if (e < 0) continue; const int tok = SLOTTOK[p];
    const int pn = j / GUH, jj = j % GUH; const bf16* wg = WGU + ((size_t)e * 2 * DE + pn * 2 * GUH + jj) * D; const bf16* wu = wg + (size_t)GUH * D;
    const bf16* xr = XN + (size_t)tok * D; float g = 0.f, u = 0.f;
    for (int k = 0; k < D; ++k) { const float xv = bf2f(xr[k]); g += xv * bf2f(wg[k]); u += xv * bf2f(wu[k]); }
    HE[i] = f2bf(silu_f(g) * u);
}}
__device__ __forceinline__ void nk_moe_down(const bf16* HE, const bf16* WD, const int* SLOTTOK, const float* SLOTGATE, const int* ctl, float* out) {
    for (size_t i = gtid(); i < (size_t)(PMAX * D); i += gnth()) { const int n = (int)(i % D), p = (int)(i / D); const int e = ctl[CW_TILE_E + p / ETILE];
    if (e < 0) continue; const int tok = SLOTTOK[p]; if (tok >= T) continue;
    const bf16* hr = HE + (size_t)p * DE; const bf16* wr = WD + ((size_t)e * D + n) * DE; float y = 0.f;
    for (int k = 0; k < DE; ++k) y += bf2f(hr[k]) * bf2f(wr[k]);
    atomicAdd(&out[(size_t)tok * D + n], y * SLOTGATE[p]);
}}


#ifndef HOST_EMU
static_assert(D == 2048 && SEQ == 4096 && NMEM == 256 && ETILE == 256, "the fast phases are written for the real shapes");
#define LAS __attribute__((address_space(3)))
#define GAS __attribute__((address_space(1)))
#define LDS_WAIT() asm volatile("s_waitcnt lgkmcnt(0)" ::: "memory")
#define VM_WAIT() asm volatile("s_waitcnt vmcnt(0)" ::: "memory")
namespace pg8 {
#define PG8_LAS __attribute__((address_space(3)))
typedef unsigned short bf16_t;
typedef short bf16x8 __attribute__((ext_vector_type(8)));
typedef float f32x4 __attribute__((ext_vector_type(4)));
typedef unsigned u32x4 __attribute__((ext_vector_type(4)));
constexpr int BM = 256, BK = 64, HALF = 128, HTB = HALF * BK * 2  , STAGE_BYTES = 8 * HTB, NXCD = 8, WGM = 8;

__host__ __device__ __forceinline__ int lds_byte(int r, int c) { const int st = (r >> 4) * 2 + (c >> 5), rr = r & 15, cc = c & 31, ob = rr * 64 + cc * 2; return st * 1024 + (ob ^ (((ob >> 9) & 1) << 5)); }
__host__ __device__ __forceinline__ void stage_rc(int b, int& R, int& C) { const int st = b / 1024, sb = b % 1024, swz = sb ^ (((sb >> 9) & 1) << 5); R = (st >> 1) * 16 + swz / 64; C = (st & 1) * 32 + (swz % 64) / 2; }
__host__ __device__ __forceinline__ int perm32(int rho) { const int n = rho >> 4, i = rho & 15; return 8 * (i >> 2) + 4 * n + (i & 3); }

struct Unit { int pm, pn; };
struct Gemm { const bf16_t* A; const bf16_t* Bt; int M, N, K; };

struct StaticOrder {
    int nM, nN, nwg, G, c;
    __host__ __device__ void init(int M, int N, int G_, int c_) { nM = M / BM; nN = N / BM; nwg = nM * nN; G = G_; c = c_; }
    __host__ __device__ bool next(int i, Unit& u) const {
        const long L = (long)i * G + c; if (L >= nwg) return false;
        int wgid = (int)L; { const int q = nwg / NXCD, r = nwg % NXCD, xcd = wgid % NXCD, off = wgid / NXCD; wgid = (xcd < r ? xcd * (q + 1) : r * (q + 1) + (xcd - r) * q) + off; }
        const int nig = WGM * nN, gid = wgid / nig, fm = gid * WGM, gsz = (nM - fm) < WGM ? (nM - fm) : WGM;
        u.pm = fm + ((wgid % nig) % gsz); u.pn = (wgid % nig) / gsz; return true;
    }
    __device__ __forceinline__ void a_ready(const Unit&) const {}
    __device__ __forceinline__ void done(const Unit&) const {}
};
__device__ __forceinline__ unsigned cvt_pk_bf16(float lo, float hi) { unsigned r; asm volatile("v_cvt_pk_bf16_f32 %0, %1, %2" : "=v"(r) : "v"(lo), "v"(hi)); return r; }
__device__ __forceinline__ float dot4(const f32x4 a) { return (a[0] * a[0] + a[1] * a[1]) + (a[2] * a[2] + a[3] * a[3]); }
struct EpiInProj {
    static constexpr bool PERM = true, AFTER_DRAIN = false;
    char* rb; const float* rope; const float* qg; const float* kg;
    __device__ __forceinline__ void operator()(const f32x4 (&acc)[2][2][4][2], const Unit& u, int wr, int wc, int fr, int fq) const {
        const int row0 = u.pm * BM + wr * 64 + fr;
        if (u.pn < 8) {
            const bool isk = u.pn >= 4; const float* g = isk ? kg : qg;
            bf16_t* dst = (bf16_t*)(rb + (isk ? B_DK : B_DQ)) + ((u.pn & 3) * 4 + wc) * 64 + 8 * fq;
            const float sc = isk ? 1.0f : 0.125f * LOG2E;
            const f32x4 ga0 = *(const f32x4*)(g + 8 * fq), ga1 = *(const f32x4*)(g + 8 * fq + 4), gb0 = *(const f32x4*)(g + 32 + 8 * fq), gb1 = *(const f32x4*)(g + 36 + 8 * fq);
#pragma unroll
            for (int ai = 0; ai < 2; ++ai)
#pragma unroll
                for (int m = 0; m < 4; ++m) {
                    const int row = row0 + ai * HALF + m * 16;
                    const f32x4 a0 = acc[ai][0][m][0], a1 = acc[ai][0][m][1], b0 = acc[ai][1][m][0], b1 = acc[ai][1][m][1];
                    float ss = (dot4(a0) + dot4(a1)) + (dot4(b0) + dot4(b1));
                    ss += __shfl_xor(ss, 16); ss += __shfl_xor(ss, 32);
                    const float rs = sc / sqrtf(ss * (1.0f / 64.0f) + EPS);
                    const f32x4* rp = (const f32x4*)(rope + ((size_t)row * 32 + 8 * fq) * 2);
                    const f32x4 r0 = rp[0], r1 = rp[1], r2 = rp[2], r3 = rp[3];
                    const f32x4 t1a = a0 * ga0 * rs, t1b = a1 * ga1 * rs, t2a = b0 * gb0 * rs, t2b = b1 * gb1 * rs;
                    u32x4 w1, w2;
                    w1.x = cvt_pk_bf16(t1a[0] * r0[0] - t2a[0] * r0[1], t1a[1] * r0[2] - t2a[1] * r0[3]); w1.y = cvt_pk_bf16(t1a[2] * r1[0] - t2a[2] * r1[1], t1a[3] * r1[2] - t2a[3] * r1[3]);
                    w1.z = cvt_pk_bf16(t1b[0] * r2[0] - t2b[0] * r2[1], t1b[1] * r2[2] - t2b[1] * r2[3]); w1.w = cvt_pk_bf16(t1b[2] * r3[0] - t2b[2] * r3[1], t1b[3] * r3[2] - t2b[3] * r3[3]);
                    w2.x = cvt_pk_bf16(t2a[0] * r0[0] + t1a[0] * r0[1], t2a[1] * r0[2] + t1a[1] * r0[3]); w2.y = cvt_pk_bf16(t2a[2] * r1[0] + t1a[2] * r1[1], t2a[3] * r1[2] + t1a[3] * r1[3]);
                    w2.z = cvt_pk_bf16(t2b[0] * r2[0] + t1b[0] * r2[1], t2b[1] * r2[2] + t1b[1] * r2[3]); w2.w = cvt_pk_bf16(t2b[2] * r3[0] + t1b[2] * r3[1], t2b[3] * r3[2] + t1b[3] * r3[3]);
                    bf16_t* rowp = dst + (size_t)row * (D / 2);
                    *(u32x4*)rowp = w1; *(u32x4*)(rowp + 32) = w2;
                }
        } else {
            const int pn = u.pn; bf16_t* base; int ldc, colt; float sc = 1.0f;
            if (pn < 12) { base = (bf16_t*)(rb + B_DV); ldc = D / 2; colt = (pn - 8) * BM; }
            else if (pn < 14) { base = (bf16_t*)(rb + B_GQ); ldc = D / 4; colt = (pn - 12) * BM; sc = 0.08838834764831845f; }
            else if (pn < 16) { base = (bf16_t*)(rb + B_GK); ldc = D / 4; colt = (pn - 14) * BM; }
            else if (pn < 20) { base = (bf16_t*)(rb + B_GV); ldc = D / 2; colt = (pn - 16) * BM; }
            else { base = (bf16_t*)(rb + B_GR); ldc = D / 2; colt = (pn - 20) * BM; }
            const int col0 = colt + wc * 32 + 8 * fq;
#pragma unroll
            for (int ai = 0; ai < 2; ++ai)
#pragma unroll
                for (int m = 0; m < 4; ++m) { bf16_t* rowp = base + (size_t)(row0 + ai * HALF + m * 16) * ldc + col0;
#pragma unroll
                    for (int bj = 0; bj < 2; ++bj) { const f32x4 v0 = acc[ai][bj][m][0] * sc, v1 = acc[ai][bj][m][1] * sc;
                        u32x4 w; w.x = cvt_pk_bf16(v0[0], v0[1]); w.y = cvt_pk_bf16(v0[2], v0[3]); w.z = cvt_pk_bf16(v1[0], v1[1]); w.w = cvt_pk_bf16(v1[2], v1[3]);
                        *(u32x4*)(rowp + bj * HALF) = w; } }
        }
    }
};
struct EpiResid {
    static constexpr bool PERM = true, AFTER_DRAIN = false;
    const float* base; float* out; bf16_t* xn; const float* g; float* ssp;
    __device__ __forceinline__ void operator()(const f32x4 (&acc)[2][2][4][2], const Unit& u, int wr, int wc, int fr, int fq) const {
        const int row0 = u.pm * BM + wr * 64 + fr, col0 = u.pn * BM + wc * 32 + 8 * fq;
        f32x4 gv[2][2];
#pragma unroll
        for (int bj = 0; bj < 2; ++bj)
#pragma unroll
            for (int n = 0; n < 2; ++n) gv[bj][n] = *(const f32x4*)(g + col0 + bj * HALF + 4 * n);
#pragma unroll
        for (int ai = 0; ai < 2; ++ai)
#pragma unroll
            for (int m = 0; m < 4; ++m) { const int row = row0 + ai * HALF + m * 16; const size_t off = (size_t)row * D + col0; float ss = 0.f;
#pragma unroll
                for (int bj = 0; bj < 2; ++bj) { const f32x4 b0 = *(const f32x4*)(base + off + bj * HALF), b1 = *(const f32x4*)(base + off + bj * HALF + 4);
                    const f32x4 v0 = acc[ai][bj][m][0] + b0, v1 = acc[ai][bj][m][1] + b1;
                    *(f32x4*)(out + off + bj * HALF) = v0; *(f32x4*)(out + off + bj * HALF + 4) = v1; ss += dot4(v0) + dot4(v1);
                    const f32x4 x0 = v0 * gv[bj][0], x1 = v1 * gv[bj][1];
                    u32x4 w; w.x = cvt_pk_bf16(x0[0], x0[1]); w.y = cvt_pk_bf16(x0[2], x0[3]); w.z = cvt_pk_bf16(x1[0], x1[1]); w.w = cvt_pk_bf16(x1[2], x1[3]);
                    *(u32x4*)(xn + off + bj * HALF) = w; }
                ss += __shfl_xor(ss, 16); ss += __shfl_xor(ss, 32);
                if (fq == 0) ssp[(size_t)row * 32 + u.pn * 4 + wc] = ss;
                if (m & 1) asm volatile("" ::: "memory"); }
    }
};
struct EpiCq {
    static constexpr bool PERM = true, AFTER_DRAIN = false;
    const float* ssp_in; bf16_t* cq; float* cqss;
    __device__ __forceinline__ void operator()(const f32x4 (&acc)[2][2][4][2], const Unit& u, int wr, int wc, int fr, int fq) const {
        const int lane = fr + 16 * fq, row0 = u.pm * BM + wr * 64 + fr, col0 = u.pn * BM + wc * 32 + 8 * fq;
        float rs2[2];
#pragma unroll
        for (int ai = 0; ai < 2; ++ai) { const f32x4* p = (const f32x4*)(ssp_in + (size_t)(u.pm * BM + ai * HALF + wr * 64 + lane) * 32); f32x4 s4 = p[0];
#pragma unroll
            for (int j = 1; j < 8; ++j) s4 += p[j];
            rs2[ai] = 1.0f / sqrtf(((s4[0] + s4[1]) + (s4[2] + s4[3])) * (1.0f / D) + EPS); }
#pragma unroll
        for (int ai = 0; ai < 2; ++ai)
#pragma unroll
            for (int m = 0; m < 4; ++m) { const int row = row0 + ai * HALF + m * 16; const size_t off = (size_t)row * D + col0; float ss = 0.f;
                const float rsr = __shfl(rs2[ai], 16 * m + fr);
#pragma unroll
                for (int bj = 0; bj < 2; ++bj) { const f32x4 v0 = acc[ai][bj][m][0] * rsr, v1 = acc[ai][bj][m][1] * rsr; ss += dot4(v0) + dot4(v1);
                    u32x4 w; w.x = cvt_pk_bf16(v0[0], v0[1]); w.y = cvt_pk_bf16(v0[2], v0[3]); w.z = cvt_pk_bf16(v1[0], v1[1]); w.w = cvt_pk_bf16(v1[2], v1[3]);
                    *(u32x4*)(cq + off + bj * HALF) = w; }
                ss += __shfl_xor(ss, 16); ss += __shfl_xor(ss, 32);
                if (fq == 0) cqss[(size_t)row * 32 + u.pn * 4 + wc] = ss; }
    }
};

struct EpiPlain {
    static constexpr bool PERM = true, AFTER_DRAIN = false;
    bf16_t* out; int ldc;
    __device__ __forceinline__ void operator()(const f32x4 (&acc)[2][2][4][2], const Unit& u, int wr, int wc, int fr, int fq) const {
        const int row0 = u.pm * BM + wr * 64 + fr, col0 = u.pn * BM + wc * 32 + 8 * fq;
#pragma unroll
        for (int ai = 0; ai < 2; ++ai)
#pragma unroll
            for (int m = 0; m < 4; ++m) { bf16_t* rowp = out + (size_t)(row0 + ai * HALF + m * 16) * ldc + col0;
#pragma unroll
                for (int bj = 0; bj < 2; ++bj) { const f32x4 v0 = acc[ai][bj][m][0], v1 = acc[ai][bj][m][1];
                    u32x4 w; w.x = cvt_pk_bf16(v0[0], v0[1]); w.y = cvt_pk_bf16(v0[2], v0[3]); w.z = cvt_pk_bf16(v1[0], v1[1]); w.w = cvt_pk_bf16(v1[2], v1[3]);
                    *(u32x4*)(rowp + bj * HALF) = w; } }
    }
};
struct OneUnit {
    int pm, pn;
    __device__ __forceinline__ bool next(int i, Unit& u) const { if (i) return false; u.pm = pm; u.pn = pn; return true; }
    __device__ __forceinline__ void a_ready(const Unit&) const {}
    __device__ __forceinline__ void done(const Unit&) const {}
};
struct MoeOrder {
    const int* ctl; int NP, G, c;
    __device__ __forceinline__ bool next(int i, Unit& u) const { const int nt = ctl[CW_NTILES]; const int L = i * G + c; if (L >= nt * NP) return false;
        const int rt = L / NP; u.pm = rt; u.pn = ctl[CW_TILE_E + rt] * NP + (L - rt * NP); return true; }
    __device__ __forceinline__ void a_ready(const Unit&) const {}
    __device__ __forceinline__ void done(const Unit&) const {}
};
__device__ __forceinline__ float silu_fast(float x) { return x * __builtin_amdgcn_rcpf(1.0f + __expf(-x)); }
struct EpiGU {
    static constexpr bool PERM = true, AFTER_DRAIN = false;
    const int* slottok; const float* ssp; bf16_t* he;
    __device__ __forceinline__ void operator()(const f32x4 (&acc)[2][2][4][2], const Unit& u, int wr, int wc, int fr, int fq) const {
        const int lane = fr + 16 * fq, p0 = u.pm * BM + wr * 64, ct = u.pn & 3;
        float rs2[2];
#pragma unroll
        for (int ai = 0; ai < 2; ++ai) { const int tok = slottok[p0 + ai * HALF + lane]; float rs = 0.f;
            if (tok < T) { const f32x4* p = (const f32x4*)(ssp + (size_t)tok * 32); f32x4 s4 = p[0];
#pragma unroll
                for (int j = 1; j < 8; ++j) s4 += p[j];
                rs = 1.0f / sqrtf(((s4[0] + s4[1]) + (s4[2] + s4[3])) * (1.0f / D) + EPS); }
            rs2[ai] = rs; }
#pragma unroll
        for (int ai = 0; ai < 2; ++ai)
#pragma unroll
            for (int m = 0; m < 4; ++m) { const float rsr = __shfl(rs2[ai], 16 * m + fr);
                bf16_t* rowp = he + (size_t)(p0 + ai * HALF + 16 * m + fr) * DE + ct * 128 + wc * 32 + 8 * fq;
                const f32x4 g0 = acc[ai][0][m][0] * rsr, g1 = acc[ai][0][m][1] * rsr, u0 = acc[ai][1][m][0] * rsr, u1 = acc[ai][1][m][1] * rsr;
                u32x4 w; w.x = cvt_pk_bf16(silu_fast(g0[0]) * u0[0], silu_fast(g0[1]) * u0[1]); w.y = cvt_pk_bf16(silu_fast(g0[2]) * u0[2], silu_fast(g0[3]) * u0[3]);
                w.z = cvt_pk_bf16(silu_fast(g1[0]) * u1[0], silu_fast(g1[1]) * u1[1]); w.w = cvt_pk_bf16(silu_fast(g1[2]) * u1[2], silu_fast(g1[3]) * u1[3]);
                *(u32x4*)rowp = w; }
    }
};
struct EpiDown {
    static constexpr bool PERM = true, AFTER_DRAIN = false;
    const float* slotgate; bf16_t* y;
    __device__ __forceinline__ void operator()(const f32x4 (&acc)[2][2][4][2], const Unit& u, int wr, int wc, int fr, int fq) const {
        const int lane = fr + 16 * fq, p0 = u.pm * BM + wr * 64, ct = u.pn & 7;
        float gt2[2];
#pragma unroll
        for (int ai = 0; ai < 2; ++ai) gt2[ai] = slotgate[p0 + ai * HALF + lane];
#pragma unroll
        for (int ai = 0; ai < 2; ++ai)
#pragma unroll
            for (int m = 0; m < 4; ++m) { const float gt = __shfl(gt2[ai], 16 * m + fr);
                bf16_t* rowp = y + (size_t)(p0 + ai * HALF + 16 * m + fr) * D + ct * BM + wc * 32 + 8 * fq;
#pragma unroll
                for (int bj = 0; bj < 2; ++bj) { const f32x4 v0 = acc[ai][bj][m][0] * gt, v1 = acc[ai][bj][m][1] * gt;
                    u32x4 w; w.x = cvt_pk_bf16(v0[0], v0[1]); w.y = cvt_pk_bf16(v0[2], v0[3]); w.z = cvt_pk_bf16(v1[0], v1[1]); w.w = cvt_pk_bf16(v1[2], v1[3]);
                    *(u32x4*)(rowp + bj * HALF) = w; } }
    }
};
template <class Epi, class Sched, bool ALIGN_EPI = false, bool SP2 = false>
__device__ __forceinline__ void gemm_phase(PG8_LAS unsigned char* lds, const Gemm g, const Sched& S, const Epi& E) {
    int tid = threadIdx.x; asm volatile("" : "+v"(tid));
    const int wid = __builtin_amdgcn_readfirstlane(tid >> 6), lane = tid & 63, wr = wid >> 2, wc = wid & 3, fr = lane & 15, fq = lane >> 4;
    const int K = g.K, nt = K / BK;
    unsigned voffA[2], voffB[2];
#pragma unroll
    for (int i = 0; i < 2; ++i) { int R, C; stage_rc(tid * 16 + i * 8192, R, C); const int Rb = Epi::PERM ? ((R & ~31) + perm32(R & 31)) : R;
        voffA[i] = (unsigned)(R * K + C) * 2u; voffB[i] = (unsigned)(Rb * K + C) * 2u; }
    const size_t kstep = (size_t)(BK * 2);
    const size_t hstep = (size_t)HALF * K * 2;
    const size_t tstep = 2 * hstep;
    const unsigned ldsw = (unsigned)wid * 1024u;
    const int aoff = lds_byte(wr * 64 + fr, fq * 8), boff = lds_byte(wc * 32 + fr, fq * 8);
#define PG8_SA(b, h) (((b) * 2 + (h)) * HTB)
#define PG8_SB(b, h) ((4 + (b) * 2 + (h)) * HTB)
#define PG8_STAGE(bufoff, gbase, voff) do { _Pragma("unroll") for (int _i = 0; _i < 2; ++_i) \
        __builtin_amdgcn_global_load_lds((const unsigned*)((const char*)(gbase) + (voff)[_i]), (PG8_LAS unsigned*)(lds + (bufoff) + ldsw + _i * 8192), 16, 0, 0); } while (0)
#define PG8_LDA(dst, b, h) do { _Pragma("unroll") for (int m = 0; m < 4; ++m) _Pragma("unroll") for (int k = 0; k < 2; ++k) dst[m][k] = *(const PG8_LAS bf16x8*)(lds + PG8_SA(b, h) + aoff + m * 2048 + k * 1024); } while (0)
#define PG8_LDB(dst, b, h) do { _Pragma("unroll") for (int n = 0; n < 2; ++n) _Pragma("unroll") for (int k = 0; k < 2; ++k) dst[n][k] = *(const PG8_LAS bf16x8*)(lds + PG8_SB(b, h) + boff + n * 2048 + k * 1024); } while (0)
#define PG8_MMA(ai, bj, At, Bt) do { __builtin_amdgcn_s_setprio(1); _Pragma("unroll") for (int m = 0; m < 4; ++m) _Pragma("unroll") for (int n = 0; n < 2; ++n) _Pragma("unroll") for (int k = 0; k < 2; ++k) \
        acc[ai][bj][m][n] = __builtin_amdgcn_mfma_f32_16x16x32_bf16(Bt[n][k], At[m][k], acc[ai][bj][m][n], 0, 0, 0); __builtin_amdgcn_s_setprio(0); } while (0)
#define PG8_WAIT_V(n) asm volatile("s_waitcnt vmcnt(" #n ")" ::: "memory")
#define PG8_WAIT_L(n) asm volatile("s_waitcnt lgkmcnt(" #n ")" ::: "memory")
#define PG8_BAR __builtin_amdgcn_s_barrier()
#define PG8_SCHED __builtin_amdgcn_sched_barrier(0)
    Unit cur, nxt; int ui = 0;
    if (!S.next(0, cur)) return;
    f32x4 acc[2][2][4][2];
#pragma unroll
    for (int a = 0; a < 2; ++a)
#pragma unroll
        for (int b = 0; b < 2; ++b)
#pragma unroll
            for (int m = 0; m < 4; ++m)
#pragma unroll
                for (int n = 0; n < 2; ++n) acc[a][b][m][n] = (f32x4){0.f, 0.f, 0.f, 0.f};
    bf16x8 At[4][2], B0[2][2], B1[2][2];
    const char* cA = (const char*)g.A + (size_t)cur.pm * tstep; const char* cB = (const char*)g.Bt + (size_t)cur.pn * tstep;
    S.a_ready(cur);
    if constexpr (SP2) {
        PG8_STAGE(PG8_SB(0, 0), cB, voffB); PG8_STAGE(PG8_SB(0, 1), cB + hstep, voffB); PG8_STAGE(PG8_SA(0, 0), cA, voffA); PG8_STAGE(PG8_SA(0, 1), cA + hstep, voffA);
        if (wr == 1) PG8_BAR;
        PG8_WAIT_V(2); PG8_BAR;
        PG8_STAGE(PG8_SB(1, 0), cB + kstep, voffB); PG8_STAGE(PG8_SA(1, 0), cA + kstep, voffA); PG8_STAGE(PG8_SB(1, 1), cB + hstep + kstep, voffB);
        PG8_WAIT_V(6); PG8_BAR;
    } else {
        PG8_STAGE(PG8_SB(0, 0), cB, voffB); PG8_STAGE(PG8_SA(0, 0), cA, voffA); PG8_STAGE(PG8_SB(0, 1), cB + hstep, voffB); PG8_STAGE(PG8_SA(0, 1), cA + hstep, voffA);
        if (wr == 1) PG8_BAR;
        PG8_WAIT_V(4); PG8_BAR;
        PG8_STAGE(PG8_SB(1, 0), cB + kstep, voffB); PG8_STAGE(PG8_SA(1, 0), cA + kstep, voffA); PG8_STAGE(PG8_SB(1, 1), cB + hstep + kstep, voffB);
        PG8_WAIT_V(6); PG8_BAR;
    }
    for (;;) {
        const bool has_next = S.next(ui + 1, nxt);
        const char* nA = has_next ? (const char*)g.A + (size_t)nxt.pm * tstep : cA; const char* nB = has_next ? (const char*)g.Bt + (size_t)nxt.pn * tstep : cB;
        for (int t = 0; t < nt; t += 2) {
            const bool last = (t == nt - 2);
            const char* a1 = cA + (size_t)(t + 1) * kstep;
            const char* a2 = last ? nA : cA + (size_t)(t + 2) * kstep; const char* b2 = last ? nB : cB + (size_t)(t + 2) * kstep;
            const char* a3 = a2 + kstep; const char* b3 = b2 + kstep;
            if (last && has_next) S.a_ready(nxt);
            if constexpr (SP2) {
            PG8_LDB(B0, 0, 0); PG8_LDB(B1, 0, 1); PG8_SCHED; PG8_LDA(At, 0, 0); PG8_STAGE(PG8_SA(1, 1), a1 + hstep, voffA);
            PG8_WAIT_V(8); PG8_WAIT_L(0); PG8_BAR; PG8_MMA(0, 0, At, B0); PG8_MMA(0, 1, At, B1); PG8_BAR; PG8_SCHED;
            PG8_LDA(At, 0, 1); PG8_STAGE(PG8_SB(0, 0), b2, voffB); PG8_STAGE(PG8_SB(0, 1), b2 + hstep, voffB); PG8_STAGE(PG8_SA(0, 0), a2, voffA);
            PG8_WAIT_V(8); PG8_WAIT_L(0); PG8_BAR; PG8_MMA(1, 0, At, B0); PG8_MMA(1, 1, At, B1); PG8_BAR; PG8_SCHED;
            PG8_LDB(B0, 1, 0); PG8_LDB(B1, 1, 1); PG8_SCHED; PG8_LDA(At, 1, 0); PG8_STAGE(PG8_SA(0, 1), a2 + hstep, voffA);
            PG8_WAIT_V(8); PG8_WAIT_L(0); PG8_BAR; PG8_MMA(0, 0, At, B0); PG8_MMA(0, 1, At, B1); PG8_BAR; PG8_SCHED;
            PG8_LDA(At, 1, 1); PG8_STAGE(PG8_SB(1, 0), b3, voffB); PG8_STAGE(PG8_SB(1, 1), b3 + hstep, voffB); PG8_STAGE(PG8_SA(1, 0), a3, voffA);
            PG8_WAIT_V(8); PG8_WAIT_L(0); PG8_BAR; PG8_MMA(1, 0, At, B0); PG8_MMA(1, 1, At, B1); PG8_BAR; PG8_SCHED;
            } else {
            PG8_LDB(B0, 0, 0); PG8_SCHED; PG8_LDA(At, 0, 0); PG8_STAGE(PG8_SA(1, 1), a1 + hstep, voffA);
            PG8_WAIT_L(8); PG8_BAR; PG8_WAIT_L(0); PG8_MMA(0, 0, At, B0); PG8_BAR; PG8_SCHED;
            PG8_LDB(B1, 0, 1); PG8_STAGE(PG8_SB(0, 0), b2, voffB);
            PG8_BAR; PG8_WAIT_L(0); PG8_MMA(0, 1, At, B1); PG8_BAR;
            PG8_LDA(At, 0, 1); PG8_STAGE(PG8_SA(0, 0), a2, voffA);
            PG8_BAR; PG8_WAIT_L(0); PG8_MMA(1, 0, At, B0); PG8_BAR; PG8_SCHED;
            PG8_STAGE(PG8_SB(0, 1), b2 + hstep, voffB);
            PG8_WAIT_V(6); PG8_BAR; PG8_MMA(1, 1, At, B1); PG8_BAR;
            PG8_LDB(B0, 1, 0); PG8_SCHED; PG8_LDA(At, 1, 0); PG8_STAGE(PG8_SA(0, 1), a2 + hstep, voffA);
            PG8_WAIT_L(8); PG8_BAR; PG8_WAIT_L(0); PG8_MMA(0, 0, At, B0); PG8_BAR; PG8_SCHED;
            PG8_LDB(B1, 1, 1); PG8_STAGE(PG8_SB(1, 0), b3, voffB);
            PG8_BAR; PG8_WAIT_L(0); PG8_MMA(0, 1, At, B1); PG8_BAR;
            PG8_LDA(At, 1, 1); PG8_STAGE(PG8_SA(1, 0), a3, voffA);
            PG8_BAR; PG8_WAIT_L(0); PG8_MMA(1, 0, At, B0); PG8_BAR; PG8_SCHED;
            PG8_STAGE(PG8_SB(1, 1), b3 + hstep, voffB);
            PG8_WAIT_V(6); PG8_BAR; PG8_MMA(1, 1, At, B1); PG8_BAR;
            }
        }
        if constexpr (ALIGN_EPI) { if (wr == 0) PG8_BAR; }
        if constexpr (!Epi::AFTER_DRAIN) { E(acc, cur, wr, wc, fr, fq); S.done(cur); }
        if (!has_next) break;
#pragma unroll
        for (int a = 0; a < 2; ++a)
#pragma unroll
            for (int b = 0; b < 2; ++b)
#pragma unroll
                for (int m = 0; m < 4; ++m)
#pragma unroll
                    for (int n = 0; n < 2; ++n) acc[a][b][m][n] = (f32x4){0.f, 0.f, 0.f, 0.f};
        cur = nxt; cA = nA; cB = nB; ++ui;
        if constexpr (ALIGN_EPI) { if (wr == 1) PG8_BAR; }
    }
    PG8_WAIT_V(0);
    if constexpr (!ALIGN_EPI) { if (wr == 0) PG8_BAR; }
    PG8_BAR;
    if constexpr (Epi::AFTER_DRAIN) { E.fused(acc, cur, wr, wc, fr, fq, lds, wid, lane); S.done(cur); }
#undef PG8_SA
#undef PG8_SB
#undef PG8_STAGE
#undef PG8_LDA
#undef PG8_LDB
#undef PG8_MMA
#undef PG8_WAIT_V
#undef PG8_WAIT_L
#undef PG8_BAR
#undef PG8_SCHED
}
template <class Epi, class Sched, bool ALIGN_EPI = true>
__device__ __forceinline__ void gemm_phase_gather(PG8_LAS unsigned char* lds, const Gemm g, const int* rowidx, const Sched& S, const Epi& E) {
    constexpr bool SP2 = true;
    int tid = threadIdx.x; asm volatile("" : "+v"(tid));
    const int wid = __builtin_amdgcn_readfirstlane(tid >> 6), lane = tid & 63, wr = wid >> 2, wc = wid & 3, fr = lane & 15, fq = lane >> 4;
    const int K = g.K, nt = K / BK;
    unsigned voffB[2]; int RA[2], CA[2];
#pragma unroll
    for (int i = 0; i < 2; ++i) { int R, C; stage_rc(tid * 16 + i * 8192, R, C); const int Rb = Epi::PERM ? ((R & ~31) + perm32(R & 31)) : R;
        RA[i] = R; CA[i] = C; voffB[i] = (unsigned)(Rb * K + C) * 2u; }
    unsigned vc[2][2], vn[2][2];
#define PG8_GOFF(dst, pm_) do { _Pragma("unroll") for (int h_ = 0; h_ < 2; ++h_) _Pragma("unroll") for (int i_ = 0; i_ < 2; ++i_) \
        dst[h_][i_] = ((unsigned)rowidx[(pm_) * BM + h_ * HALF + RA[i_]] * (unsigned)K + (unsigned)CA[i_]) * 2u; } while (0)
#define PG8_STAGE_A(bufoff, gbase, v0, v1) do { \
        __builtin_amdgcn_global_load_lds((const unsigned*)((const char*)(gbase) + (v0)), (PG8_LAS unsigned*)(lds + (bufoff) + ldsw), 16, 0, 0); \
        __builtin_amdgcn_global_load_lds((const unsigned*)((const char*)(gbase) + (v1)), (PG8_LAS unsigned*)(lds + (bufoff) + ldsw + 8192), 16, 0, 0); } while (0)
    const size_t kstep = (size_t)(BK * 2);
    const size_t hstep = (size_t)HALF * K * 2;
    const size_t tstep = 2 * hstep;
    const unsigned ldsw = (unsigned)wid * 1024u;
    const int aoff = lds_byte(wr * 64 + fr, fq * 8), boff = lds_byte(wc * 32 + fr, fq * 8);
#define PG8_SA(b, h) (((b) * 2 + (h)) * HTB)
#define PG8_SB(b, h) ((4 + (b) * 2 + (h)) * HTB)
#define PG8_STAGE(bufoff, gbase, voff) do { _Pragma("unroll") for (int _i = 0; _i < 2; ++_i) \
        __builtin_amdgcn_global_load_lds((const unsigned*)((const char*)(gbase) + (voff)[_i]), (PG8_LAS unsigned*)(lds + (bufoff) + ldsw + _i * 8192), 16, 0, 0); } while (0)
#define PG8_LDA(dst, b, h) do { _Pragma("unroll") for (int m = 0; m < 4; ++m) _Pragma("unroll") for (int k = 0; k < 2; ++k) dst[m][k] = *(const PG8_LAS bf16x8*)(lds + PG8_SA(b, h) + aoff + m * 2048 + k * 1024); } while (0)
#define PG8_LDB(dst, b, h) do { _Pragma("unroll") for (int n = 0; n < 2; ++n) _Pragma("unroll") for (int k = 0; k < 2; ++k) dst[n][k] = *(const PG8_LAS bf16x8*)(lds + PG8_SB(b, h) + boff + n * 2048 + k * 1024); } while (0)
#define PG8_MMA(ai, bj, At, Bt) do { __builtin_amdgcn_s_setprio(1); _Pragma("unroll") for (int m = 0; m < 4; ++m) _Pragma("unroll") for (int n = 0; n < 2; ++n) _Pragma("unroll") for (int k = 0; k < 2; ++k) \
        acc[ai][bj][m][n] = __builtin_amdgcn_mfma_f32_16x16x32_bf16(Bt[n][k], At[m][k], acc[ai][bj][m][n], 0, 0, 0); __builtin_amdgcn_s_setprio(0); } while (0)
#define PG8_WAIT_V(n) asm volatile("s_waitcnt vmcnt(" #n ")" ::: "memory")
#define PG8_WAIT_L(n) asm volatile("s_waitcnt lgkmcnt(" #n ")" ::: "memory")
#define PG8_BAR __builtin_amdgcn_s_barrier()
#define PG8_SCHED __builtin_amdgcn_sched_barrier(0)
    Unit cur, nxt; int ui = 0;
    if (!S.next(0, cur)) return;
    f32x4 acc[2][2][4][2];
#pragma unroll
    for (int a = 0; a < 2; ++a)
#pragma unroll
        for (int b = 0; b < 2; ++b)
#pragma unroll
            for (int m = 0; m < 4; ++m)
#pragma unroll
                for (int n = 0; n < 2; ++n) acc[a][b][m][n] = (f32x4){0.f, 0.f, 0.f, 0.f};
    bf16x8 At[4][2], B0[2][2], B1[2][2];
    const char* cA = (const char*)g.A; PG8_GOFF(vc, cur.pm); const char* cB = (const char*)g.Bt + (size_t)cur.pn * tstep;
    S.a_ready(cur);
    if constexpr (SP2) {
        PG8_STAGE(PG8_SB(0, 0), cB, voffB); PG8_STAGE(PG8_SB(0, 1), cB + hstep, voffB); PG8_STAGE_A(PG8_SA(0, 0), cA, vc[0][0], vc[0][1]); PG8_STAGE_A(PG8_SA(0, 1), cA, vc[1][0], vc[1][1]);
        if (wr == 1) PG8_BAR;
        PG8_WAIT_V(2); PG8_BAR;
        PG8_STAGE(PG8_SB(1, 0), cB + kstep, voffB); PG8_STAGE_A(PG8_SA(1, 0), cA + kstep, vc[0][0], vc[0][1]); PG8_STAGE(PG8_SB(1, 1), cB + hstep + kstep, voffB);
        PG8_WAIT_V(6); PG8_BAR;
    }
    for (;;) {
        const bool has_next = S.next(ui + 1, nxt);
        const char* nA = cA; if (has_next) PG8_GOFF(vn, nxt.pm); else { vn[0][0] = vc[0][0]; vn[0][1] = vc[0][1]; vn[1][0] = vc[1][0]; vn[1][1] = vc[1][1]; } const char* nB = has_next ? (const char*)g.Bt + (size_t)nxt.pn * tstep : cB;
        for (int t = 0; t < nt; t += 2) {
            const bool last = (t == nt - 2);
            const char* a1 = cA + (size_t)(t + 1) * kstep;
            const char* a2 = last ? nA : cA + (size_t)(t + 2) * kstep; const char* b2 = last ? nB : cB + (size_t)(t + 2) * kstep;
            const char* a3 = a2 + kstep; const char* b3 = b2 + kstep;
            const unsigned o00 = last ? vn[0][0] : vc[0][0], o01 = last ? vn[0][1] : vc[0][1], o10 = last ? vn[1][0] : vc[1][0], o11 = last ? vn[1][1] : vc[1][1];
            if (last && has_next) S.a_ready(nxt);
            if constexpr (SP2) {
            PG8_LDB(B0, 0, 0); PG8_LDB(B1, 0, 1); PG8_SCHED; PG8_LDA(At, 0, 0); PG8_STAGE_A(PG8_SA(1, 1), a1, vc[1][0], vc[1][1]);
            PG8_WAIT_V(8); PG8_WAIT_L(0); PG8_BAR; PG8_MMA(0, 0, At, B0); PG8_MMA(0, 1, At, B1); PG8_BAR; PG8_SCHED;
            PG8_LDA(At, 0, 1); PG8_STAGE(PG8_SB(0, 0), b2, voffB); PG8_STAGE(PG8_SB(0, 1), b2 + hstep, voffB); PG8_STAGE_A(PG8_SA(0, 0), a2, o00, o01);
            PG8_WAIT_V(8); PG8_WAIT_L(0); PG8_BAR; PG8_MMA(1, 0, At, B0); PG8_MMA(1, 1, At, B1); PG8_BAR; PG8_SCHED;
            PG8_LDB(B0, 1, 0); PG8_LDB(B1, 1, 1); PG8_SCHED; PG8_LDA(At, 1, 0); PG8_STAGE_A(PG8_SA(0, 1), a2, o10, o11);
            PG8_WAIT_V(8); PG8_WAIT_L(0); PG8_BAR; PG8_MMA(0, 0, At, B0); PG8_MMA(0, 1, At, B1); PG8_BAR; PG8_SCHED;
            PG8_LDA(At, 1, 1); PG8_STAGE(PG8_SB(1, 0), b3, voffB); PG8_STAGE(PG8_SB(1, 1), b3 + hstep, voffB); PG8_STAGE_A(PG8_SA(1, 0), a3, o00, o01);
            PG8_WAIT_V(8); PG8_WAIT_L(0); PG8_BAR; PG8_MMA(1, 0, At, B0); PG8_MMA(1, 1, At, B1); PG8_BAR; PG8_SCHED;
            }
        }
        if constexpr (ALIGN_EPI) { if (wr == 0) PG8_BAR; }
        if constexpr (!Epi::AFTER_DRAIN) { E(acc, cur, wr, wc, fr, fq); S.done(cur); }
        if (!has_next) break;
#pragma unroll
        for (int a = 0; a < 2; ++a)
#pragma unroll
            for (int b = 0; b < 2; ++b)
#pragma unroll
                for (int m = 0; m < 4; ++m)
#pragma unroll
                    for (int n = 0; n < 2; ++n) acc[a][b][m][n] = (f32x4){0.f, 0.f, 0.f, 0.f};
        cur = nxt; cA = nA; cB = nB; ++ui; vc[0][0] = vn[0][0]; vc[0][1] = vn[0][1]; vc[1][0] = vn[1][0]; vc[1][1] = vn[1][1];
        if constexpr (ALIGN_EPI) { if (wr == 1) PG8_BAR; }
    }
    PG8_WAIT_V(0);
    if constexpr (!ALIGN_EPI) { if (wr == 0) PG8_BAR; }
    PG8_BAR;
    if constexpr (Epi::AFTER_DRAIN) { E.fused(acc, cur, wr, wc, fr, fq, lds, wid, lane); S.done(cur); }
#undef PG8_GOFF
#undef PG8_STAGE_A
#undef PG8_SA
#undef PG8_SB
#undef PG8_STAGE
#undef PG8_LDA
#undef PG8_LDB
#undef PG8_MMA
#undef PG8_WAIT_V
#undef PG8_WAIT_L
#undef PG8_BAR
#undef PG8_SCHED
}
}

typedef float f32x4 __attribute__((ext_vector_type(4)));
typedef unsigned u32x4 __attribute__((ext_vector_type(4)));
typedef unsigned u32x2 __attribute__((ext_vector_type(2)));
__device__ __forceinline__ unsigned pk2(float lo, float hi) { unsigned r; asm volatile("v_cvt_pk_bf16_f32 %0, %1, %2" : "=v"(r) : "v"(lo), "v"(hi)); return r; }
__device__ __forceinline__ float wave_sum(float v) {
#pragma unroll
    for (int o = 1; o < 64; o <<= 1) v += __shfl_xor(v, o);
    return v;
}
constexpr int F0_SCR = 64 * 65 * 4;
__device__ __forceinline__ void f0_transpose_item(const float* src, int ldw, int c0, int c1, bf16* dst, int K, LAS float* scr, int lane) {
    const float* sp = src + ((lane >> 5) ? c1 : c0) + (lane & 31);
    float v[64];
#pragma unroll
    for (int kk = 0; kk < 64; ++kk) v[kk] = sp[(size_t)kk * ldw];
#pragma unroll
    for (int kk = 0; kk < 64; ++kk) scr[kk * 65 + lane] = v[kk];
    LDS_WAIT(); asm volatile("" ::: "memory");
    const int c = lane & 7;
#pragma unroll
    for (int j = 0; j < 8; ++j) { const int n = (lane >> 3) + 8 * j; const LAS float* s = scr + (8 * c) * 65 + n;
        u32x4 o; o.x = pk2(s[0 * 65], s[1 * 65]); o.y = pk2(s[2 * 65], s[3 * 65]); o.z = pk2(s[4 * 65], s[5 * 65]); o.w = pk2(s[6 * 65], s[7 * 65]);
        *(u32x4*)(dst + (size_t)n * K + 8 * c) = o; }
    LDS_WAIT(); asm volatile("" ::: "memory");
}
template <bool WITH_LR> __device__ __forceinline__ void f0_rows2(const float* x0, const float* g, bf16* o0, const float* w_in, float* glr0, int lane) {
    f32x4 v[2][8]; float ss[2] = {0.f, 0.f};
#pragma unroll
    for (int r = 0; r < 2; ++r)
#pragma unroll
        for (int j = 0; j < 8; ++j) { v[r][j] = ((const f32x4*)(x0 + (size_t)r * D))[lane + 64 * j]; ss[r] += (v[r][j][0] * v[r][j][0] + v[r][j][1] * v[r][j][1]) + (v[r][j][2] * v[r][j][2] + v[r][j][3] * v[r][j][3]); }
    const float rs0 = 1.0f / sqrtf(wave_sum(ss[0]) * (1.0f / D) + EPS), rs1 = 1.0f / sqrtf(wave_sum(ss[1]) * (1.0f / D) + EPS);
    float acc[2][16];
    if (WITH_LR) {
#pragma unroll
        for (int r = 0; r < 2; ++r)
#pragma unroll
            for (int cc = 0; cc < 16; ++cc) acc[r][cc] = 0.f;
    }
#pragma unroll
    for (int j = 0; j < 8; ++j) { const f32x4 gv = ((const f32x4*)g)[lane + 64 * j];
        v[0][j] = v[0][j] * gv * rs0; v[1][j] = v[1][j] * gv * rs1;
        u32x2 w0, w1; w0.x = pk2(v[0][j][0], v[0][j][1]); w0.y = pk2(v[0][j][2], v[0][j][3]); w1.x = pk2(v[1][j][0], v[1][j][1]); w1.y = pk2(v[1][j][2], v[1][j][3]);
        ((u32x2*)o0)[lane + 64 * j] = w0; ((u32x2*)(o0 + D))[lane + 64 * j] = w1;
        if (WITH_LR) {
#pragma unroll
            for (int e = 0; e < 4; ++e) { const float* wp = w_in + (size_t)(4 * (lane + 64 * j) + e) * IN_COLS + O_LR;
                const f32x4 wa = *(const f32x4*)wp, wb = *(const f32x4*)(wp + 4), wc_ = *(const f32x4*)(wp + 8), wd = *(const f32x4*)(wp + 12);
#pragma unroll
                for (int r = 0; r < 2; ++r) { const float xv = v[r][j][e];
#pragma unroll
                    for (int q = 0; q < 4; ++q) { acc[r][q] += xv * wa[q]; acc[r][4 + q] += xv * wb[q]; acc[r][8 + q] += xv * wc_[q]; acc[r][12 + q] += xv * wd[q]; } } }
        }
    }
    if (WITH_LR) {
        float a16[16];
#pragma unroll
        for (int i = 0; i < 16; ++i) { const bool up = (lane & 32) != 0; const float keep = up ? acc[1][i] : acc[0][i], send = up ? acc[0][i] : acc[1][i]; a16[i] = keep + __shfl_xor(send, 32); }
        float a8[8];
#pragma unroll
        for (int i = 0; i < 8; ++i) { const bool up = (lane & 16) != 0; const float keep = up ? a16[8 + i] : a16[i], send = up ? a16[i] : a16[8 + i]; a8[i] = keep + __shfl_xor(send, 16); }
        float a4[4];
#pragma unroll
        for (int i = 0; i < 4; ++i) { const bool up = (lane & 8) != 0; const float keep = up ? a8[4 + i] : a8[i], send = up ? a8[i] : a8[4 + i]; a4[i] = keep + __shfl_xor(send, 8); }
        float a2[2];
#pragma unroll
        for (int i = 0; i < 2; ++i) { const bool up = (lane & 4) != 0; const float keep = up ? a4[2 + i] : a4[i], send = up ? a4[i] : a4[2 + i]; a2[i] = keep + __shfl_xor(send, 4); }
        float a1; { const bool up = (lane & 2) != 0; const float keep = up ? a2[1] : a2[0], send = up ? a2[0] : a2[1]; a1 = keep + __shfl_xor(send, 2); }
        a1 += __shfl_xor(a1, 1);
        if ((lane & 1) == 0) { const int idx = (lane >> 1) & 31; glr0[(size_t)(idx >> 4) * GRK + (idx & 15)] = a1; }
    }
}
struct Ctx;
__device__ __forceinline__ void fast_prologue(const Ctx& c, LAS unsigned char* lds);
#endif

#ifndef HOST_EMU
namespace fa {
typedef short bf16x8 __attribute__((ext_vector_type(8)));
typedef short s16x4 __attribute__((ext_vector_type(4)));
typedef float f32x16 __attribute__((ext_vector_type(16)));
typedef float f32x4 __attribute__((ext_vector_type(4)));
typedef unsigned u32x4 __attribute__((ext_vector_type(4)));
constexpr int TILE_B = 16384;
constexpr int STAGE_B = 4 * TILE_B;
constexpr int XL_OFF = 2 * STAGE_B;
#define FA_SBAR() __builtin_amdgcn_sched_barrier(0)
__device__ __forceinline__ int crow(int r, int hi) { return (r & 3) + 8 * (r >> 2) + 4 * hi; }
__device__ __forceinline__ unsigned cvtpk(float lo, float hi) { unsigned r; asm volatile("v_cvt_pk_bf16_f32 %0, %1, %2" : "=v"(r) : "v"(lo), "v"(hi)); return r; }
__device__ __forceinline__ int v_rd_base(int lane) { return ((lane & 3) << 3) | (((lane >> 2) & 3) << 6) | (((lane >> 4) & 1) << 5) | (((lane >> 5) & 1) << 8); }
constexpr int v_rd_off(int d0, int ks, int half) { return d0 * 512 + ks * 4096 + half * 2048; }
template <int OFF> __device__ __forceinline__ s16x4 tr_read(int vb) { s16x4 r; asm volatile("ds_read_b64_tr_b16 %0, %1 offset:%2" : "=&v"(r) : "v"(vb), "i"(OFF) : "memory"); return r; }

struct DmaOff { unsigned koff0, koff1, voff; };
__device__ __forceinline__ DmaOff dma_offsets(int lane) {
    const int l4 = lane >> 4, c16 = lane & 15, w2 = (lane & 31) >> 2, l5 = lane >> 5; DmaOff o;
    o.koff0 = (unsigned)(l4 * (D / 2) + 8 * (c16 ^ l4)) * 2u; o.koff1 = (unsigned)(l4 * (D / 2) + 8 * (c16 ^ (4 + l4))) * 2u;
    o.voff = (unsigned)(((w2 & 3) + 8 * (w2 >> 2)) * (D / 2) + l5 * 32 + (lane & 3) * 8) * 2u;
    return o;
}
__device__ __forceinline__ void issue_stage(LAS unsigned char* stage, const bf16* DKb, const bf16* DVb, int key_e, int wave, const DmaOff& o) {
    const int tsel = wave >> 2, kv = (wave >> 1) & 1, pb = 8 * (wave & 1), key0 = key_e + 64 * tsel;
    LAS unsigned char* dst = stage + tsel * 2 * TILE_B + kv * TILE_B + 1024 * pb;
    if (kv == 0) {
        const char* base = (const char*)(DKb + (size_t)(key0 + 4 * pb) * (D / 2));
#pragma unroll
        for (int i = 0; i < 8; ++i)
            __builtin_amdgcn_global_load_lds((const unsigned*)(base + (size_t)(4 * i) * (D / 2) * 2 + ((i & 1) ? o.koff1 : o.koff0)), (LAS unsigned*)(dst + 1024 * i), 16, 0, 0);
    } else {
#pragma unroll
        for (int i = 0; i < 8; ++i) { const int p = pb + i, ku = 4 * ((p >> 1) & 1) + 16 * (p >> 2);
            const char* base = (const char*)(DVb + (size_t)(key0 + ku) * (D / 2) + 64 * (p & 1));
            __builtin_amdgcn_global_load_lds((const unsigned*)(base + o.voff), (LAS unsigned*)(dst + 1024 * i), 16, 0, 0); }
    }
}
__device__ __forceinline__ void attn_finish(f32x16 (&o)[4], float l, int wave, float lam, const float* subln_g, bf16* mixw, LAS unsigned char* lds);
template <int KH, bool SHIFT> __device__ __forceinline__ float qk_exp_pack(bf16x8& pa_lo, bf16x8& pa_hi, LAS const unsigned char* Kc  , const bf16x8 (&qr)[4], float negm, int r32, int hi, int sw) {
    f32x16 p;
#pragma unroll
    for (int r = 0; r < 16; ++r) p[r] = 0.f;
#pragma unroll
    for (int d0 = 0; d0 < 4; ++d0) { const int cb = (d0 * 16 + hi * 8) * 2;
        const bf16x8 kf = *(LAS const bf16x8*)(Kc + (32 * KH + r32) * 256 + (cb ^ sw));
        p = __builtin_amdgcn_mfma_f32_32x32x16_bf16(kf, qr[d0], p, 0, 0, 0); }
    float s = 0.f;
#pragma unroll
    for (int r = 0; r < 16; ++r) { p[r] = __builtin_amdgcn_exp2f(SHIFT ? p[r] + negm : p[r]); s += p[r]; }
#define FA_PK4(P, BASE, OUT) do { unsigned a0 = cvtpk(P[BASE + 0], P[BASE + 1]), a1 = cvtpk(P[BASE + 2], P[BASE + 3]); \
    unsigned b0 = cvtpk(P[BASE + 4], P[BASE + 5]), b1 = cvtpk(P[BASE + 6], P[BASE + 7]); \
    auto r0 = __builtin_amdgcn_permlane32_swap(a0, b0, false, false); auto r1 = __builtin_amdgcn_permlane32_swap(a1, b1, false, false); \
    u32x4 w = {r0[0], r1[0], r0[1], r1[1]}; OUT = *reinterpret_cast<bf16x8*>(&w); } while (0)
    FA_PK4(p, 0, pa_lo); FA_PK4(p, 8, pa_hi);
#undef FA_PK4
    return s;
}
template <int D0> __device__ __forceinline__ void pv1(f32x16& oa, int vb, const bf16x8 (&pa)[4]) {
    const s16x4 l0 = tr_read<v_rd_off(D0, 0, 0)>(vb), h0 = tr_read<v_rd_off(D0, 0, 1)>(vb), l1 = tr_read<v_rd_off(D0, 1, 0)>(vb), h1 = tr_read<v_rd_off(D0, 1, 1)>(vb);
    const s16x4 l2 = tr_read<v_rd_off(D0, 2, 0)>(vb), h2 = tr_read<v_rd_off(D0, 2, 1)>(vb), l3 = tr_read<v_rd_off(D0, 3, 0)>(vb), h3 = tr_read<v_rd_off(D0, 3, 1)>(vb);
    asm volatile("s_waitcnt lgkmcnt(0)" ::: "memory"); FA_SBAR();
#define FA_PK(L, H) (bf16x8){L[0], L[1], L[2], L[3], H[0], H[1], H[2], H[3]}
    oa = __builtin_amdgcn_mfma_f32_32x32x16_bf16(pa[0], FA_PK(l0, h0), oa, 0, 0, 0);
    oa = __builtin_amdgcn_mfma_f32_32x32x16_bf16(pa[1], FA_PK(l1, h1), oa, 0, 0, 0);
    oa = __builtin_amdgcn_mfma_f32_32x32x16_bf16(pa[2], FA_PK(l2, h2), oa, 0, 0, 0);
    oa = __builtin_amdgcn_mfma_f32_32x32x16_bf16(pa[3], FA_PK(l3, h3), oa, 0, 0, 0);
#undef FA_PK
}

template <bool SHIFT> __device__ __forceinline__ void attn_unit(int b, int h, int j, const bf16* DQ, const bf16* DK, const bf16* DV, bf16* MIX, const float* subln_g, float lam, float mref, LAS unsigned char* lds) {
    const int tid = threadIdx.x; int lane = tid & 63; asm volatile("" : "+v"(lane));
    const int r32 = lane & 31, hi = lane >> 5; const int wave = __builtin_amdgcn_readfirstlane(tid >> 6);
    const int wq = wave & 3, comp = wave >> 2;
    const size_t rowbase = (size_t)b * SEQ;
    const bf16* DKb = DK + rowbase * (D / 2) + h * 128; const bf16* DVb = DV + rowbase * (D / 2) + h * 128;
    const DmaOff dof = dma_offsets(lane);
    issue_stage(lds, DKb, DVb, 0, wave, dof);
    bf16x8 qr[4];
    { const bf16* Qw = DQ + (rowbase + 128 * j + 32 * wq + r32) * (D / 2) + h * 128 + comp * 64 + hi * 8;
#pragma unroll
      for (int d0 = 0; d0 < 4; ++d0) qr[d0] = *(const bf16x8*)(Qw + d0 * 16); }
    f32x16 o[4];
#pragma unroll
    for (int d = 0; d < 4; ++d)
#pragma unroll
        for (int r = 0; r < 16; ++r) o[d][r] = 0.f;
    float l = 0.f; const float negm = -mref;
    const int last_tile = 2 * j + (wq >> 1);
    const unsigned lds0 = (unsigned)(uintptr_t)lds; const int sw = (r32 & 7) << 4;
    for (int s = 0; s <= j; ++s) {
        asm volatile("s_waitcnt vmcnt(0)" ::: "memory"); __builtin_amdgcn_s_barrier(); asm volatile("" ::: "memory");
        if (s < j) issue_stage(lds + ((s + 1) & 1) * STAGE_B, DKb, DVb, 128 * (s + 1), wave, dof);
#pragma unroll
        for (int ts = 0; ts < 2; ++ts) {
            if (2 * s + ts <= last_tile) {
                LAS const unsigned char* Kc = lds + (s & 1) * STAGE_B + ts * 2 * TILE_B + comp * 128;
                const int vb = (int)(lds0 + (s & 1) * STAGE_B + ts * 2 * TILE_B + TILE_B) + v_rd_base(lane);
                bf16x8 pa[4];
                l += qk_exp_pack<0, SHIFT>(pa[0], pa[1], Kc, qr, negm, r32, hi, sw); FA_SBAR(); l += qk_exp_pack<1, SHIFT>(pa[2], pa[3], Kc, qr, negm, r32, hi, sw); FA_SBAR();
                pv1<0>(o[0], vb, pa); pv1<1>(o[1], vb, pa); pv1<2>(o[2], vb, pa); pv1<3>(o[3], vb, pa);
            }
        }
    }
    asm volatile("s_waitcnt lgkmcnt(0)" ::: "memory"); __builtin_amdgcn_s_barrier(); asm volatile("" ::: "memory");
    attn_finish(o, l, wave, lam, subln_g, MIX + (rowbase + 128 * j + 32 * wq) * D + h * 128, lds);
}
__device__ __forceinline__ void attn_finish(f32x16 (&o)[4], float l, int wave, float lam, const float* subln_g, bf16* mixw, LAS unsigned char* lds) {
    int lane = threadIdx.x & 63; asm volatile("" : "+v"(lane));
    const int r32 = lane & 31, hi = lane >> 5, wq = wave & 3, comp = wave >> 2;
    LAS float* X1 = (LAS float*)lds;
    LAS float* LI = (LAS float*)(lds + XL_OFF) + wave * 32;
    l += __shfl_xor(l, 32);
    if (hi == 0) LI[r32] = (comp ? lam : 1.0f) * __builtin_amdgcn_rcpf(l);
    asm volatile("s_waitcnt lgkmcnt(0)" ::: "memory");
#pragma unroll
    for (int r = 0; r < 16; ++r) { const float inv = LI[crow(r, hi)];
#pragma unroll
        for (int d = 0; d < 4; ++d) o[d][r] *= inv; }
    if (comp == 1) {
#pragma unroll
        for (int d = 0; d < 4; ++d)
#pragma unroll
            for (int r = 0; r < 16; ++r) X1[((wq * 4 + d) * 16 + r) * 64 + lane] = o[d][r];
    }
    asm volatile("s_waitcnt lgkmcnt(0)" ::: "memory"); __builtin_amdgcn_s_barrier(); asm volatile("" ::: "memory");
    if (comp == 0) {
#pragma unroll
        for (int d = 0; d < 4; ++d)
#pragma unroll
            for (int r = 0; r < 16; ++r) { o[d][r] -= X1[((wq * 4 + d) * 16 + r) * 64 + lane]; if ((r & 3) == 3) { asm volatile("s_waitcnt lgkmcnt(0)" ::: "memory"); FA_SBAR(); } }
    }
    asm volatile("s_waitcnt lgkmcnt(0)" ::: "memory"); __builtin_amdgcn_s_barrier(); asm volatile("" ::: "memory");
    if (comp == 0) {
        LAS float* W = (LAS float*)(lds + wq * (32 * 132 * 4));
#pragma unroll
        for (int r = 0; r < 16; ++r) { const int q = crow(r, hi);
#pragma unroll
            for (int d = 0; d < 4; ++d) W[q * 132 + 32 * d + r32] = o[d][r]; }
        asm volatile("s_waitcnt lgkmcnt(0)" ::: "memory");
        const int q = lane >> 1, hf = lane & 1;
        f32x4 v[16]; float ss = 0.f;
#pragma unroll
        for (int i = 0; i < 16; ++i) { v[i] = *(LAS const f32x4*)(W + q * 132 + hf * 64 + 4 * i); ss += (v[i][0] * v[i][0] + v[i][1] * v[i][1]) + (v[i][2] * v[i][2] + v[i][3] * v[i][3]); }
        ss += __shfl_xor(ss, 1);
        const float rs = 0.8f / sqrtf(ss * (1.0f / 128.0f) + EPS);
        bf16* op = mixw + (size_t)q * D + hf * 64;
#pragma unroll
        for (int i = 0; i < 8; ++i) { const f32x4 ga = *(const f32x4*)(subln_g + hf * 64 + 8 * i), gb = *(const f32x4*)(subln_g + hf * 64 + 8 * i + 4);
            const f32x4 a = v[2 * i] * ga * rs, c = v[2 * i + 1] * gb * rs;
            u32x4 w; w.x = cvtpk(a[0], a[1]); w.y = cvtpk(a[2], a[3]); w.z = cvtpk(c[0], c[1]); w.w = cvtpk(c[2], c[3]);
            *(u32x4*)(op + 8 * i) = w; }
    }
    asm volatile("s_waitcnt lgkmcnt(0)" ::: "memory"); __builtin_amdgcn_s_barrier(); asm volatile("" ::: "memory");
}
#undef FA_SBAR
}
#endif

#ifndef HOST_EMU
namespace fg {
typedef short bf16x8 __attribute__((ext_vector_type(8)));
typedef short s16x4 __attribute__((ext_vector_type(4)));
typedef float f32x16 __attribute__((ext_vector_type(16)));
typedef float f32x4 __attribute__((ext_vector_type(4)));
typedef unsigned u32x2 __attribute__((ext_vector_type(2)));
constexpr int IMG = 16384, STAGE_B = 4 * IMG;
constexpr int DEC_OFF = 2 * STAGE_B;
constexpr int SS_OFF = DEC_OFF + 1024;
#define FG_SBAR() __builtin_amdgcn_sched_barrier(0)
__device__ __forceinline__ unsigned cvtpk(float lo, float hi) { unsigned r; asm volatile("v_cvt_pk_bf16_f32 %0, %1, %2" : "=v"(r) : "v"(lo), "v"(hi)); return r; }
__device__ __forceinline__ int v_rd_base(int lane) { return ((lane & 3) << 3) | (((lane >> 2) & 3) << 6) | (((lane >> 4) & 1) << 5) | (((lane >> 5) & 1) << 8); }
constexpr int v_rd_off(int d0, int ks, int half) { return d0 * 512 + ks * 4096 + half * 2048; }
template <int OFF> __device__ __forceinline__ s16x4 tr_read(int vb) { s16x4 r; asm volatile("ds_read_b64_tr_b16 %0, %1 offset:%2" : "=&v"(r) : "v"(vb), "i"(OFF) : "memory"); return r; }
#define FG_PK(L, H) (bf16x8){L[0], L[1], L[2], L[3], H[0], H[1], H[2], H[3]}

__device__ __forceinline__ void issue_chunk(LAS unsigned char* stage, LAS unsigned char* decl, const bf16* GQb, const bf16* KDb, const bf16* GVb, const float* DECc, int wave, int lane) {
    const int img = wave >> 1, pb = 8 * (wave & 1);
    LAS unsigned char* dst = stage + img * IMG + 1024 * pb;
    if (img == 0) {
#pragma unroll
        for (int i = 0; i < 8; ++i) { const int row = 4 * (pb + i) + (lane >> 4), ch = (lane & 15) ^ (row & 15);
            __builtin_amdgcn_global_load_lds((const unsigned*)(GQb + (size_t)row * (D / 4) + 8 * ch), (LAS unsigned*)(dst + 1024 * i), 16, 0, 0); }
    } else {
        const int w2 = (lane & 31) >> 2, kl = (w2 & 3) + 8 * (w2 >> 2), cl = (lane >> 5) * 32 + (lane & 3) * 8;
        const bf16* base = img == 1 ? KDb : GVb + (img - 2) * 128; const int pitch = img == 1 ? D / 4 : D / 2;
#pragma unroll
        for (int i = 0; i < 8; ++i) { const int p = pb + i, k = kl + 4 * ((p >> 1) & 1) + 16 * (p >> 2), cidx = cl + 64 * (p & 1);
            __builtin_amdgcn_global_load_lds((const unsigned*)(base + (size_t)k * pitch + cidx), (LAS unsigned*)(dst + 1024 * i), 16, 0, 0); }
    }
    if (wave == 0 && lane < 32) __builtin_amdgcn_global_load_lds((const unsigned*)(DECc + 4 * lane), (LAS unsigned*)decl, 16, 0, 0);
}

__device__ __forceinline__ void gla_seq(int b, int h, const bf16* GQ, const bf16* KD, const bf16* GV, const bf16* GRb, const float* DEC, const float* gout, bf16* MIX, LAS unsigned char* lds) {
    const int tid = threadIdx.x; int lane = tid & 63; asm volatile("" : "+v"(lane));
    const int r32 = lane & 31, hi = lane >> 5; const int wave = __builtin_amdgcn_readfirstlane(tid >> 6);
    const size_t t00 = (size_t)b * SEQ;
    const bf16* GQb = GQ + t00 * (D / 4) + h * 128; const bf16* KDb = KD + t00 * (D / 4) + h * 128; const bf16* GVb = GV + t00 * (D / 2) + h * 256;
    const float* DECb = DEC + (size_t)(b * NC) * (D / 4) + h * 128;
    const bf16* GRw = GRb + t00 * (D / 2) + h * 256 + 32 * wave + 4 * hi; bf16* MIXw = MIX + t00 * D + D / 2 + h * 256 + 32 * wave + 4 * hi;
    f32x4 gq[4];
#pragma unroll
    for (int g = 0; g < 4; ++g) gq[g] = *(const f32x4*)(gout + 32 * wave + 8 * g + 4 * hi);
    f32x16 S[4];
#pragma unroll
    for (int mb = 0; mb < 4; ++mb)
#pragma unroll
        for (int r = 0; r < 16; ++r) S[mb][r] = 0.f;
    const unsigned lds0 = (unsigned)(uintptr_t)lds;
    LAS float* SS = (LAS float*)(lds + SS_OFF);
    issue_chunk(lds, lds + DEC_OFF, GQb, KDb, GVb, DECb, wave, lane);
    for (int c = 0; c < NC; ++c) {
        if (c == 0) asm volatile("s_waitcnt vmcnt(0)" ::: "memory"); else asm volatile("s_waitcnt vmcnt(8)" ::: "memory");
        __builtin_amdgcn_s_barrier(); asm volatile("" ::: "memory");
        u32x2 grv[2][4];
#pragma unroll
        for (int tb = 0; tb < 2; ++tb)
#pragma unroll
            for (int g = 0; g < 4; ++g) grv[tb][g] = *(const u32x2*)(GRw + (size_t)(64 * c + 32 * tb + r32) * (D / 2) + 8 * g);
        if (c + 1 < NC) issue_chunk(lds + ((c + 1) & 1) * STAGE_B, lds + DEC_OFF + ((c + 1) & 1) * 512, GQb + (size_t)(64 * (c + 1)) * (D / 4), KDb + (size_t)(64 * (c + 1)) * (D / 4),
                                    GVb + (size_t)(64 * (c + 1)) * (D / 2), DECb + (size_t)(c + 1) * (D / 4), wave, lane);
        LAS const unsigned char* st = lds + (c & 1) * STAGE_B;
        { LAS const float* dl = (LAS const float*)(lds + DEC_OFF + (c & 1) * 512) + 4 * hi;
#pragma unroll
          for (int mb = 0; mb < 4; ++mb)
#pragma unroll
              for (int g = 0; g < 4; ++g) { const f32x4 d4 = *(LAS const f32x4*)(dl + 32 * mb + 8 * g);
#pragma unroll
                  for (int e = 0; e < 4; ++e) S[mb][4 * g + e] *= d4[e]; } }
        { const int kb = (int)(lds0 + (c & 1) * STAGE_B + IMG) + v_rd_base(lane), vbse = (int)(lds0 + (c & 1) * STAGE_B + 2 * IMG + (wave >> 2) * IMG + (wave & 3) * 512) + v_rd_base(lane);
#define FG_KS(KS) do { const s16x4 vl = tr_read<v_rd_off(0, KS, 0)>(vbse), vh = tr_read<v_rd_off(0, KS, 1)>(vbse); \
            const s16x4 a0l = tr_read<v_rd_off(0, KS, 0)>(kb), a0h = tr_read<v_rd_off(0, KS, 1)>(kb), a1l = tr_read<v_rd_off(1, KS, 0)>(kb), a1h = tr_read<v_rd_off(1, KS, 1)>(kb); \
            const s16x4 a2l = tr_read<v_rd_off(2, KS, 0)>(kb), a2h = tr_read<v_rd_off(2, KS, 1)>(kb), a3l = tr_read<v_rd_off(3, KS, 0)>(kb), a3h = tr_read<v_rd_off(3, KS, 1)>(kb); \
            asm volatile("s_waitcnt lgkmcnt(0)" ::: "memory"); FG_SBAR(); const bf16x8 vf = FG_PK(vl, vh); \
            S[0] = __builtin_amdgcn_mfma_f32_32x32x16_bf16(FG_PK(a0l, a0h), vf, S[0], 0, 0, 0); S[1] = __builtin_amdgcn_mfma_f32_32x32x16_bf16(FG_PK(a1l, a1h), vf, S[1], 0, 0, 0); \
            S[2] = __builtin_amdgcn_mfma_f32_32x32x16_bf16(FG_PK(a2l, a2h), vf, S[2], 0, 0, 0); S[3] = __builtin_amdgcn_mfma_f32_32x32x16_bf16(FG_PK(a3l, a3h), vf, S[3], 0, 0, 0); } while (0)
          FG_KS(0); FG_KS(1); FG_KS(2); FG_KS(3);
#undef FG_KS
        }
        f32x16 ot[2];
#pragma unroll
        for (int tb = 0; tb < 2; ++tb)
#pragma unroll
            for (int r = 0; r < 16; ++r) ot[tb][r] = 0.f;
#pragma unroll
        for (int mb = 0; mb < 4; ++mb)
#pragma unroll
            for (int s = 0; s < 2; ++s) {
                typedef unsigned u32x4v __attribute__((ext_vector_type(4)));
                u32x4v w; w.x = cvtpk(S[mb][8 * s + 0], S[mb][8 * s + 1]); w.y = cvtpk(S[mb][8 * s + 2], S[mb][8 * s + 3]); w.z = cvtpk(S[mb][8 * s + 4], S[mb][8 * s + 5]); w.w = cvtpk(S[mb][8 * s + 6], S[mb][8 * s + 7]);
                const bf16x8 sa = *reinterpret_cast<bf16x8*>(&w);
                const int ch = 4 * mb + 2 * s;
#pragma unroll
                for (int tb = 0; tb < 2; ++tb) { const int row = 32 * tb + r32;
                    const u32x2 q0 = *(LAS const u32x2*)(st + row * 256 + ((ch ^ (row & 15)) << 4) + 8 * hi), q1 = *(LAS const u32x2*)(st + row * 256 + (((ch + 1) ^ (row & 15)) << 4) + 8 * hi);
                    u32x4v qw; qw.x = q0.x; qw.y = q0.y; qw.z = q1.x; qw.w = q1.y;
                    ot[tb] = __builtin_amdgcn_mfma_f32_32x32x16_bf16(sa, *reinterpret_cast<bf16x8*>(&qw), ot[tb], 0, 0, 0); } }
        float ssq[2];
#pragma unroll
        for (int tb = 0; tb < 2; ++tb) { float a = 0.f;
#pragma unroll
            for (int r = 0; r < 16; ++r) a += ot[tb][r] * ot[tb][r];
            a += __shfl_xor(a, 32); ssq[tb] = a; }
        if (hi == 0) { SS[wave * 64 + r32] = ssq[0]; SS[wave * 64 + 32 + r32] = ssq[1]; }
        asm volatile("s_waitcnt lgkmcnt(0)" ::: "memory"); __builtin_amdgcn_s_barrier(); asm volatile("" ::: "memory");
#pragma unroll
        for (int tb = 0; tb < 2; ++tb) { float a = 0.f;
#pragma unroll
            for (int w8 = 0; w8 < 8; ++w8) a += SS[w8 * 64 + 32 * tb + r32];
            const float rs = 1.0f / sqrtf(a * (1.0f / 256.0f) + EPS);
            bf16* op = MIXw + (size_t)(64 * c + 32 * tb + r32) * D;
#pragma unroll
            for (int g = 0; g < 4; ++g) { float v[4];
#pragma unroll
                for (int e = 0; e < 4; ++e) { const unsigned gw = e < 2 ? grv[tb][g].x : grv[tb][g].y; const float gr = __uint_as_float((e & 1) ? (gw & 0xffff0000u) : (gw << 16));
                    v[e] = ot[tb][4 * g + e] * rs * gq[g][e] * (gr * __builtin_amdgcn_rcpf(1.0f + __expf(-gr))); }
                u32x2 o2; o2.x = cvtpk(v[0], v[1]); o2.y = cvtpk(v[2], v[3]); *(u32x2*)(op + 8 * g) = o2; } }
    }
    asm volatile("s_waitcnt vmcnt(0) lgkmcnt(0)" ::: "memory"); __builtin_amdgcn_s_barrier(); asm volatile("" ::: "memory");
}
#undef FG_PK
#undef FG_SBAR
}
#endif

#ifndef HOST_EMU
namespace fc {
typedef short bf16x8 __attribute__((ext_vector_type(8)));
typedef float f32x16 __attribute__((ext_vector_type(16)));
typedef float f32x4 __attribute__((ext_vector_type(4)));
typedef unsigned u32x4 __attribute__((ext_vector_type(4)));
typedef unsigned u32x2 __attribute__((ext_vector_type(2)));
constexpr int KSL = 32768;
constexpr int PX_OFF = 2 * KSL;
constexpr int MX_OFF = PX_OFF + 65536;
__device__ __forceinline__ unsigned cvtpk(float lo, float hi) { unsigned r; asm volatile("v_cvt_pk_bf16_f32 %0, %1, %2" : "=v"(r) : "v"(lo), "v"(hi)); return r; }
__device__ __forceinline__ int crow(int r, int hi) { return (r & 3) + 8 * (r >> 2) + 4 * hi; }

__device__ __forceinline__ void cross_unit(int b, int h, int rb, const bf16* CQ, const float* CQSS, const bf16* CK2, const bf16* CVT, bf16* CO, LAS unsigned char* lds) {
    const int tid = threadIdx.x; int lane = tid & 63; asm volatile("" : "+v"(lane));
    const int r32 = lane & 31, hi = lane >> 5; const int wave = __builtin_amdgcn_readfirstlane(tid >> 6);
    const int wq = wave & 3, kh = wave >> 2;
    const size_t t0 = (size_t)b * SEQ + 128 * rb + 32 * wq;
    const bf16* Kb = CK2 + (size_t)(b * CH + h) * NMEM * CHD;
    const bf16* Vb = CVT + (size_t)(b * CH + h) * CHD * NMEM;
    const bf16* Qw = CQ + (t0 + r32) * D + h * CHD + hi * 8;
    const unsigned koff = (unsigned)((lane >> 3) * CHD + 8 * ((lane & 7) ^ (lane >> 3))) * 2u;
#define FC_ISSUE_K(sl, stage) do { _Pragma("unroll") for (int i_ = 0; i_ < 4; ++i_) { const int p_ = 4 * wave + i_; \
        __builtin_amdgcn_global_load_lds((const unsigned*)((const char*)(Kb + (size_t)(8 * p_) * CHD + 64 * (sl)) + koff), (LAS unsigned*)(lds + (stage) * KSL + 1024 * p_), 16, 0, 0); } } while (0)
    FC_ISSUE_K(0, 0);
    float rq; { const f32x4 a = *(const f32x4*)(CQSS + (t0 + r32) * 32 + 8 * h), c4 = *(const f32x4*)(CQSS + (t0 + r32) * 32 + 8 * h + 4);
        rq = 1.0f / sqrtf((((a[0] + a[1]) + (a[2] + a[3])) + ((c4[0] + c4[1]) + (c4[2] + c4[3]))) * (1.0f / CHD) + EPS); }
    f32x16 sc[4];
#pragma unroll
    for (int i = 0; i < 4; ++i)
#pragma unroll
        for (int r = 0; r < 16; ++r) sc[i][r] = 0.f;
    const int sw = (r32 & 7) << 4;
    for (int sl = 0; sl < 8; ++sl) {
        asm volatile("s_waitcnt vmcnt(0)" ::: "memory"); __builtin_amdgcn_s_barrier(); asm volatile("" ::: "memory");
        bf16x8 qf[4];
#pragma unroll
        for (int d0 = 0; d0 < 4; ++d0) qf[d0] = *(const bf16x8*)(Qw + 64 * sl + 16 * d0);
        if (sl + 1 < 8) FC_ISSUE_K(sl + 1, (sl + 1) & 1);
        LAS const unsigned char* Ks = lds + (sl & 1) * KSL + (128 * kh + r32) * 128;
#pragma unroll
        for (int d0 = 0; d0 < 4; ++d0) { const int cb = (16 * d0 + 8 * hi) * 2;
#pragma unroll
            for (int i = 0; i < 4; ++i) { const bf16x8 kf = *(LAS const bf16x8*)(Ks + 32 * i * 128 + (cb ^ sw));
                sc[i] = __builtin_amdgcn_mfma_f32_32x32x16_bf16(kf, qf[d0], sc[i], 0, 0, 0); } }
    }
#undef FC_ISSUE_K
    LAS float* MX = (LAS float*)(lds + MX_OFF); LAS float* LX = MX + 256;
    float mx = -3.0e38f;
#pragma unroll
    for (int i = 0; i < 4; ++i)
#pragma unroll
        for (int r = 0; r < 16; ++r) { sc[i][r] *= rq; mx = fmaxf(mx, sc[i][r]); }
    mx = fmaxf(mx, __shfl_xor(mx, 32));
    if (hi == 0) MX[wave * 32 + r32] = mx;
    asm volatile("s_waitcnt lgkmcnt(0)" ::: "memory"); __builtin_amdgcn_s_barrier(); asm volatile("" ::: "memory");
    mx = fmaxf(mx, MX[(wave ^ 4) * 32 + r32]);
    float ls = 0.f;
#pragma unroll
    for (int i = 0; i < 4; ++i)
#pragma unroll
        for (int r = 0; r < 16; ++r) { sc[i][r] = __builtin_amdgcn_exp2f(sc[i][r] - mx); ls += sc[i][r]; }
    ls += __shfl_xor(ls, 32);
    if (hi == 0) LX[wave * 32 + r32] = ls;
    bf16x8 pall[16];
    LAS unsigned char* PXw = lds + PX_OFF + wave * 8192;
#define FC_PK4(P, BASE, OUT) do { unsigned a0 = cvtpk(P[BASE + 0], P[BASE + 1]), a1 = cvtpk(P[BASE + 2], P[BASE + 3]); \
    unsigned b0 = cvtpk(P[BASE + 4], P[BASE + 5]), b1 = cvtpk(P[BASE + 6], P[BASE + 7]); \
    auto r0 = __builtin_amdgcn_permlane32_swap(a0, b0, false, false); auto r1 = __builtin_amdgcn_permlane32_swap(a1, b1, false, false); \
    u32x4 w_ = {r0[0], r1[0], r0[1], r1[1]}; OUT = *reinterpret_cast<bf16x8*>(&w_); } while (0)
#pragma unroll
    for (int i = 0; i < 4; ++i) { bf16x8 f0, f1; FC_PK4(sc[i], 0, f0); FC_PK4(sc[i], 8, f1);
        *(LAS bf16x8*)(PXw + (2 * i) * 1024 + lane * 16) = f0; *(LAS bf16x8*)(PXw + (2 * i + 1) * 1024 + lane * 16) = f1;
        if (kh == 0) { pall[2 * i] = f0; pall[2 * i + 1] = f1; } else { pall[8 + 2 * i] = f0; pall[8 + 2 * i + 1] = f1; } }
#undef FC_PK4
#define FC_ISSUE_V(blk, stage) do { _Pragma("unroll") for (int i_ = 0; i_ < 4; ++i_) { const int p_ = 4 * wave + i_, half_ = p_ >> 4, row_ = 2 * (p_ & 15) + (lane >> 5), ch_ = (lane & 31) ^ row_; \
        __builtin_amdgcn_global_load_lds((const unsigned*)(Vb + (size_t)(256 * half_ + 32 * (blk) + row_) * NMEM + 8 * ch_), (LAS unsigned*)(lds + (stage) * KSL + 1024 * p_), 16, 0, 0); } } while (0)
    FC_ISSUE_V(0, 0);
    asm volatile("s_waitcnt lgkmcnt(0)" ::: "memory"); __builtin_amdgcn_s_barrier(); asm volatile("" ::: "memory");
    { LAS const unsigned char* PXp = lds + PX_OFF + (wave ^ 4) * 8192;
#pragma unroll
      for (int f = 0; f < 8; ++f) { const bf16x8 v = *(LAS const bf16x8*)(PXp + f * 1024 + lane * 16); if (kh == 0) pall[8 + f] = v; else pall[f] = v; } }
    const float linv = __builtin_amdgcn_rcpf(ls + LX[(wave ^ 4) * 32 + r32]);
    bf16* Ow = CO + (t0 + r32) * D + h * CHD + 256 * kh + 4 * hi;
    for (int blk = 0; blk < 8; ++blk) {
        if (blk == 0) asm volatile("s_waitcnt vmcnt(0)" ::: "memory"); else asm volatile("s_waitcnt vmcnt(4)" ::: "memory");
        __builtin_amdgcn_s_barrier(); asm volatile("" ::: "memory");
        if (blk + 1 < 8) FC_ISSUE_V(blk + 1, (blk + 1) & 1);
        LAS const unsigned char* Vs = lds + (blk & 1) * KSL + kh * 16384 + r32 * 512;
        f32x16 o;
#pragma unroll
        for (int r = 0; r < 16; ++r) o[r] = 0.f;
#pragma unroll
        for (int ks = 0; ks < 16; ++ks) { const bf16x8 vf = *(LAS const bf16x8*)(Vs + (((2 * ks + hi) ^ r32) << 4));
            o = __builtin_amdgcn_mfma_f32_32x32x16_bf16(vf, pall[ks], o, 0, 0, 0); }
#pragma unroll
        for (int g = 0; g < 4; ++g) { u32x2 w2; w2.x = cvtpk(o[4 * g] * linv, o[4 * g + 1] * linv); w2.y = cvtpk(o[4 * g + 2] * linv, o[4 * g + 3] * linv);
            *(u32x2*)(Ow + 32 * blk + 8 * g) = w2; }
    }
#undef FC_ISSUE_V
    asm volatile("s_waitcnt vmcnt(0) lgkmcnt(0)" ::: "memory"); __builtin_amdgcn_s_barrier(); asm volatile("" ::: "memory");
}
}
#endif

struct Ctx {
    const float *x, *mem; const int* positions; const float *g_attn, *w_in, *q_norm_g, *k_norm_g, *lq1, *lk1, *lq2, *lk2, *subln_g, *w_a2, *b_a, *gla_out_g, *w_out, *g_cross, *g_mem, *w_cq, *w_ckv, *cq_g, *ck_g, *w_co,
        *g_ffn, *w_rg, *b_rg, *w_re, *b_re, *w_gate, *w_up, *w_down;
    float* out; char* ws;
};
#define WSP(T_, off) ((T_*)(c.ws + (off)))
#ifndef HOST_EMU
__device__ __forceinline__ void f0_wrt(const Ctx& c, bf16* WRT);
__device__ __forceinline__ void fast_prologue(const Ctx& c, LAS unsigned char* lds) {
    const int tid = threadIdx.x, lane = tid & 63, wave = __builtin_amdgcn_readfirstlane(tid >> 6);
    const int gw = blockIdx.x * 8 + wave, NGW = gridDim.x * 8;
    LAS float* scr = (LAS float*)(lds + wave * F0_SCR);
    int* ctl = WSP(int, WS_CTL); float* lamp = (float*)(ctl + 16);
    bf16 *WIN = WSP(bf16, WS_WIN), *WOUT = WSP(bf16, WS_WOUT), *WCQ = WSP(bf16, WS_WCQ), *WCKV = WSP(bf16, WS_WCKV), *WCO = WSP(bf16, WS_WCO);
    bf16 *WGU = WSP(bf16, WS_WGU), *WD = WSP(bf16, WS_WD), *XN = WSP(bf16, WS_XN), *MEMN = WSP(bf16, WS_MEMN);
    float* GLR = WSP(float, WS_SMALL + SM_GLR); int* SLOTTOK = WSP(int, WS_SMALL + SM_SLOTTOK); float* SLOTGATE = WSP(float, WS_SMALL + SM_SLOTGATE); float* ROPE = WSP(float, WS_SMALL + SM_ROPE);
    for (int it = gw; it < T / 2; it += NGW) f0_rows2<true>(c.x + (size_t)it * 2 * D, c.g_attn, XN + (size_t)it * 2 * D, c.w_in, GLR + (size_t)it * 2 * GRK, lane);
    for (int it = gw; it < B * NMEM / 2; it += NGW) f0_rows2<false>(c.mem + (size_t)it * 2 * D, c.g_mem, MEMN + (size_t)it * 2 * D, nullptr, nullptr, lane);
    constexpr int KB = D / 64, KBD = DE / 64;
    constexpr int I_WIN = (NIN / 64) * KB, I_SQ = (D / 64) * KB, I_CKV = (2 * D / 64) * KB, I_GU = NE * (2 * DE / 64) * KB, I_DN = NE * (D / 64) * KBD;
    constexpr int NITEMS = I_WIN + 3 * I_SQ + I_CKV;
    (void)I_GU; (void)I_DN; (void)WGU; (void)WD;
    for (int it = gw; it < NITEMS; it += NGW) {
        int r = it;
        if (r < I_WIN) { const int kb = r % KB, n0 = (r / KB) * 64; f0_transpose_item(c.w_in + (size_t)kb * 64 * IN_COLS, IN_COLS, win_src_col(n0), win_src_col(n0 + 32), WIN + (size_t)n0 * D + kb * 64, D, scr, lane); continue; } r -= I_WIN;
        if (r < I_SQ) { const int kb = r % KB, n0 = (r / KB) * 64; f0_transpose_item(c.w_out + (size_t)kb * 64 * D, D, n0, n0 + 32, WOUT + (size_t)n0 * D + kb * 64, D, scr, lane); continue; } r -= I_SQ;
        if (r < I_SQ) { const int kb = r % KB, n0 = (r / KB) * 64; f0_transpose_item(c.w_cq + (size_t)kb * 64 * D, D, n0, n0 + 32, WCQ + (size_t)n0 * D + kb * 64, D, scr, lane); continue; } r -= I_SQ;
        if (r < I_SQ) { const int kb = r % KB, n0 = (r / KB) * 64; f0_transpose_item(c.w_co + (size_t)kb * 64 * D, D, n0, n0 + 32, WCO + (size_t)n0 * D + kb * 64, D, scr, lane); continue; } r -= I_SQ;
        { const int kb = r % KB, n0 = (r / KB) * 64; f0_transpose_item(c.w_ckv + (size_t)kb * 64 * 2 * D, 2 * D, n0, n0 + 32, WCKV + (size_t)n0 * D + kb * 64, D, scr, lane); }
    }
    nk_rope_table(c.positions, ROPE); nk_lam(c.lq1, c.lk1, c.lq2, c.lk2, lamp); nk_mref(c.q_norm_g, c.k_norm_g, lamp + 1);
    nk_zero_bf16(XN + (size_t)T * D, (size_t)D); nk_moe_init_slots(SLOTTOK, SLOTGATE); f0_wrt(c, WSP(bf16, WS_SMALL + SM_WRT));
}
#endif
#ifndef HOST_EMU
constexpr int EXP_ITEMS = NE * (2 * DE / 64) * (D / 64) + NE * (D / 64) * (DE / 64);
__device__ __forceinline__ void f0_expert_items(const Ctx& c, LAS unsigned char* lds, int first, int count) {
    const int tid = threadIdx.x, lane = tid & 63, wave = __builtin_amdgcn_readfirstlane(tid >> 6);
    LAS float* scr = (LAS float*)(lds + wave * F0_SCR);
    bf16 *WGU = WSP(bf16, WS_WGU), *WD = WSP(bf16, WS_WD);
    constexpr int KB = D / 64, KBD = DE / 64, I_GU = NE * (2 * DE / 64) * KB;
    for (int q = wave; q < count; q += 8) { int r = first + q;
        if (r < I_GU) { const int kb = r % KB, r0 = ((r / KB) % (2 * DE / 64)) * 64, e = r / (KB * (2 * DE / 64)); const int pn = r0 / 256, ii = r0 % 256; const float* W = (ii < 128) ? c.w_gate : c.w_up; const int col = pn * 128 + (ii & 127);
            f0_transpose_item(W + ((size_t)e * D + kb * 64) * DE, DE, col, col + 32, WGU + ((size_t)e * 2 * DE + r0) * D + kb * 64, D, scr, lane); continue; } r -= I_GU;
        { const int kb = r % KBD, n0 = ((r / KBD) % (D / 64)) * 64, e = r / (KBD * (D / 64));
          f0_transpose_item(c.w_down + ((size_t)e * DE + kb * 64) * D, D, n0, n0 + 32, WD + ((size_t)e * D + n0) * DE + kb * 64, DE, scr, lane); }
    }
}
__device__ __forceinline__ void f0_wrt(const Ctx& c, bf16* WRT) {
    for (size_t i = gtid(); i < (size_t)48 * D; i += gnth()) { const int k = (int)(i % D), j = (int)(i / D);
        const float w = j < NG ? c.w_rg[(size_t)k * NG + j] : (j < NG + NE ? c.w_re[(size_t)k * NE + (j - NG)] : 0.f); WRT[i] = f2bf(w); }
}
__device__ __forceinline__ void fast_router(const Ctx& c, LAS unsigned char* lds) {
    typedef short bf16x8 __attribute__((ext_vector_type(8)));
    const int tid = threadIdx.x, lane = tid & 63, wave = __builtin_amdgcn_readfirstlane(tid >> 6), r = lane & 15, kq = lane >> 4;
    LAS float* red = (LAS float*)lds;
    LAS float* lg = (LAS float*)(lds + 8 * 32 * 48 * 4);
    const bf16* XN = WSP(bf16, WS_XN); const bf16* WRT = WSP(bf16, WS_SMALL + SM_WRT); const float* SSP2 = WSP(float, WS_SMALL + SM_SSP2);
    int* ctl = WSP(int, WS_CTL); int* EXPERT = WSP(int, WS_SMALL + SM_EXPERT); float* GATE = WSP(float, WS_SMALL + SM_GATE); int* SLOTPOS = WSP(int, WS_SMALL + SM_SLOTPOS);
    for (int ub = blockIdx.x; ub < T / 32; ub += gridDim.x) {
        const int row0 = ub * 32, k0 = wave * 256;
        f32x4 acc[2][3];
#pragma unroll
        for (int mb = 0; mb < 2; ++mb)
#pragma unroll
            for (int nb = 0; nb < 3; ++nb) acc[mb][nb] = (f32x4){0.f, 0.f, 0.f, 0.f};
#pragma unroll
        for (int st = 0; st < 8; ++st) { bf16x8 a[2], b[3];
#pragma unroll
            for (int mb = 0; mb < 2; ++mb) a[mb] = *(const bf16x8*)(XN + (size_t)(row0 + 16 * mb + r) * D + k0 + 32 * st + 8 * kq);
#pragma unroll
            for (int nb = 0; nb < 3; ++nb) b[nb] = *(const bf16x8*)(WRT + (size_t)(16 * nb + r) * D + k0 + 32 * st + 8 * kq);
#pragma unroll
            for (int mb = 0; mb < 2; ++mb)
#pragma unroll
                for (int nb = 0; nb < 3; ++nb) acc[mb][nb] = __builtin_amdgcn_mfma_f32_16x16x32_bf16(a[mb], b[nb], acc[mb][nb], 0, 0, 0); }
#pragma unroll
        for (int mb = 0; mb < 2; ++mb)
#pragma unroll
            for (int nb = 0; nb < 3; ++nb)
#pragma unroll
                for (int q = 0; q < 4; ++q) red[(wave * 32 + 16 * mb + 4 * kq + q) * 48 + 16 * nb + r] = acc[mb][nb][q];
        __syncthreads();
        { const int row = tid >> 4, q = tid & 15;
          float ps = SSP2[(size_t)(row0 + row) * 32 + 2 * q] + SSP2[(size_t)(row0 + row) * 32 + 2 * q + 1];
          ps += __shfl_xor(ps, 1); ps += __shfl_xor(ps, 2); ps += __shfl_xor(ps, 4); ps += __shfl_xor(ps, 8);
          const float rs = 1.0f / sqrtf(ps * (1.0f / D) + EPS);
#pragma unroll
          for (int j = 0; j < 3; ++j) { const int col = q + 16 * j; float sacc = 0.f;
#pragma unroll
              for (int w = 0; w < 8; ++w) sacc += red[(w * 32 + row) * 48 + col];
              const float bias = col < NG ? c.b_rg[col] : (col < NG + NE ? c.b_re[col - NG] : 0.f);
              lg[row * 48 + col] = sacc * rs + bias; } }
        __syncthreads();
        if (tid < 32) { const int t = row0 + tid; const LAS float* L = lg + tid * 48;
            float gl[NG], el[NE];
#pragma unroll
            for (int j = 0; j < NG; ++j) gl[j] = L[j];
#pragma unroll
            for (int j = 0; j < NE; ++j) el[j] = L[NG + j];
            int grp = 0; float gm = gl[0];
#pragma unroll
            for (int j = 1; j < NG; ++j) if (gl[j] > gm) { gm = gl[j]; grp = j; }
            float gs = 0.f;
#pragma unroll
            for (int j = 0; j < NG; ++j) gs += __expf(gl[j] - gm);
            const float grp_w = 1.0f / gs;
            float e8[EPG];
#pragma unroll
            for (int j = 0; j < EPG; ++j) { float v = 0.f;
#pragma unroll
                for (int gq = 0; gq < NG; ++gq) v = (grp == gq) ? el[gq * EPG + j] : v;
                e8[j] = v; }
            int i0 = 0; float v0 = e8[0];
#pragma unroll
            for (int j = 1; j < EPG; ++j) if (e8[j] > v0) { v0 = e8[j]; i0 = j; }
            int i1 = -1; float v1 = -1e30f;
#pragma unroll
            for (int j = 0; j < EPG; ++j) if (j != i0 && e8[j] > v1) { v1 = e8[j]; i1 = j; }
            const float rr = __expf(v1 - v0); const float g0 = grp_w / (1.f + rr), g1 = grp_w * rr / (1.f + rr);
            const int e0 = grp * EPG + i0, e1 = grp * EPG + i1;
            EXPERT[t * 2] = e0; EXPERT[t * 2 + 1] = e1; GATE[t * 2] = g0; GATE[t * 2 + 1] = g1;
            SLOTPOS[t * 2] = atomicAdd(&ctl[CW_CNT + e0], 1); SLOTPOS[t * 2 + 1] = atomicAdd(&ctl[CW_CNT + e1], 1); }
        __syncthreads();
    }
}
#endif

#ifndef HOST_EMU
__device__ __forceinline__ void fast_gla_prep(const Ctx& c, LAS unsigned char* lds) {
    constexpr int W = GH * GKD; static_assert(W == 512, "one thread per gate column");
    const float* GLR = WSP(float, WS_SMALL + SM_GLR); const bf16* GK = (const bf16*)(c.ws + WS_B + B_GK); bf16* KD = WSP(bf16, WS_D); float* DEC = WSP(float, WS_SMALL + SM_DEC);
    LAS float* gl = (LAS float*)lds;
    const int j = threadIdx.x;
    float w[GRK];
#pragma unroll
    for (int r = 0; r < GRK; ++r) w[r] = c.w_a2[(size_t)r * W + j];
    const float bj = c.b_a[j];
    for (int cb = (int)blockIdx.x; cb < B * NC; cb += (int)gridDim.x) {
        __syncthreads();
        for (int i = threadIdx.x; i < CHUNK * GRK / 4; i += 512) ((LAS f32x4*)gl)[i] = ((const f32x4*)(GLR + (size_t)cb * CHUNK * GRK))[i];
        __syncthreads();
        float run = 0.f;
        for (int tt = 0; tt < CHUNK; ++tt) { float z = bj;
#pragma unroll
            for (int q = 0; q < 4; ++q) { const f32x4 g4 = ((LAS const f32x4*)gl)[tt * 4 + q]; z += g4[0] * w[4 * q] + g4[1] * w[4 * q + 1] + g4[2] * w[4 * q + 2] + g4[3] * w[4 * q + 3]; }
            run += (fminf(z, 0.f) - __logf(1.0f + __expf(-fabsf(z)))) * (1.0f / 16.0f); }
        const float end = run; DEC[(size_t)cb * W + j] = __expf(end); run = 0.f;
        for (int tt = 0; tt < CHUNK; ++tt) { const size_t t = (size_t)cb * CHUNK + tt; float z = bj;
#pragma unroll
            for (int q = 0; q < 4; ++q) { const f32x4 g4 = ((LAS const f32x4*)gl)[tt * 4 + q]; z += g4[0] * w[4 * q] + g4[1] * w[4 * q + 1] + g4[2] * w[4 * q + 2] + g4[3] * w[4 * q + 3]; }
            run += (fminf(z, 0.f) - __logf(1.0f + __expf(-fabsf(z)))) * (1.0f / 16.0f);
            KD[t * W + j] = f2bf(bf2f(GK[t * W + j]) * __expf(end - run)); }
    }
}
__device__ __forceinline__ void fast_ckv_fix(const Ctx& c) {
    const bf16* CKV = WSP(bf16, WS_SMALL + SM_CKV); bf16* CK2 = WSP(bf16, WS_SMALL + SM_CK2); bf16* CVT = WSP(bf16, WS_SMALL + SM_CVT);
    const int lane = threadIdx.x & 63, gw = blockIdx.x * 8 + (threadIdx.x >> 6), NGW = gridDim.x * 8;
    for (int it = gw; it < B * NMEM * CH; it += NGW) { const int h = it % CH, bm = it / CH, b = bm / NMEM, m = bm % NMEM;
        const u32x4 kw = *(const u32x4*)(CKV + (size_t)bm * 2 * D + h * CHD + 8 * lane), vw = *(const u32x4*)(CKV + (size_t)bm * 2 * D + D + h * CHD + 8 * lane);
        float kf[8]; const unsigned kk[4] = {kw.x, kw.y, kw.z, kw.w}; float ss = 0.f;
#pragma unroll
        for (int q = 0; q < 4; ++q) { kf[2 * q] = __uint_as_float(kk[q] << 16); kf[2 * q + 1] = __uint_as_float(kk[q] & 0xffff0000u); ss += kf[2 * q] * kf[2 * q] + kf[2 * q + 1] * kf[2 * q + 1]; }
        ss = wave_sum(ss);
        const float rs = 1.0f / sqrtf(ss * (1.0f / CHD) + EPS) * (1.0f / sqrtf((float)CHD)) * LOG2E;
        const f32x4 ka = *(const f32x4*)(c.ck_g + 8 * lane), kb = *(const f32x4*)(c.ck_g + 8 * lane + 4), qa = *(const f32x4*)(c.cq_g + 8 * lane), qb = *(const f32x4*)(c.cq_g + 8 * lane + 4);
        u32x4 o; o.x = pk2(kf[0] * rs * ka[0] * qa[0], kf[1] * rs * ka[1] * qa[1]); o.y = pk2(kf[2] * rs * ka[2] * qa[2], kf[3] * rs * ka[3] * qa[3]);
        o.z = pk2(kf[4] * rs * kb[0] * qb[0], kf[5] * rs * kb[1] * qb[1]); o.w = pk2(kf[6] * rs * kb[2] * qb[2], kf[7] * rs * kb[3] * qb[3]);
        *(u32x4*)(CK2 + (((size_t)b * CH + h) * NMEM + m) * CHD + 8 * lane) = o;
        bf16* vt = CVT + (((size_t)b * CH + h) * CHD + 8 * lane) * NMEM + m; const unsigned vv[4] = {vw.x, vw.y, vw.z, vw.w};
#pragma unroll
        for (int q = 0; q < 4; ++q) { vt[(size_t)(2 * q) * NMEM] = (bf16)(vv[q] & 0xffffu); vt[(size_t)(2 * q + 1) * NMEM] = (bf16)(vv[q] >> 16); }
    }
}
__device__ __forceinline__ void fast_moe_fill(const Ctx& c) {
    int* ctl = WSP(int, WS_CTL); const int* EXPERT = WSP(int, WS_SMALL + SM_EXPERT); const float* GATE = WSP(float, WS_SMALL + SM_GATE); int* SLOTPOS = WSP(int, WS_SMALL + SM_SLOTPOS);
    int* SLOTTOK = WSP(int, WS_SMALL + SM_SLOTTOK); float* SLOTGATE = WSP(float, WS_SMALL + SM_SLOTGATE);
    if (blockIdx.x == 0 && threadIdx.x < NE) { const int e = threadIdx.x; int base = 0, nt0 = 0;
        for (int q = 0; q < e; ++q) { const int n = (ctl[CW_CNT + q] + ETILE - 1) / ETILE; nt0 += n; base += n * ETILE; }
        const int n = (ctl[CW_CNT + e] + ETILE - 1) / ETILE; for (int q = 0; q < n; ++q) ctl[CW_TILE_E + nt0 + q] = e;
        ctl[CW_BASE + e] = base; if (e == NE - 1) { ctl[CW_BASE + NE] = base + n * ETILE; ctl[CW_NTILES] = nt0 + n; } }
    for (size_t i = gtid(); i < (size_t)T * 2; i += gnth()) { const int e = EXPERT[i]; int base = 0;
        for (int q = 0; q < e; ++q) base += ((ctl[CW_CNT + q] + ETILE - 1) / ETILE) * ETILE;
        const int dst = base + SLOTPOS[i]; SLOTTOK[dst] = (int)(i >> 1); SLOTGATE[dst] = GATE[i]; SLOTPOS[i] = dst; }
}
__device__ __forceinline__ void fast_moe_gather(const Ctx& c) {
    const int* SLOTPOS = WSP(int, WS_SMALL + SM_SLOTPOS); const bf16* Y = WSP(bf16, WS_C);
#ifdef DIAG
    const float dsc = 1.0f + WSP(float, WS_CTL)[CW_DIAG];
#endif
    const int lane = threadIdx.x & 63, gw = blockIdx.x * 8 + (threadIdx.x >> 6), NGW = gridDim.x * 8;
    for (int t = gw; t < T; t += NGW) { const int s0 = SLOTPOS[2 * t], s1 = SLOTPOS[2 * t + 1];
        const u32x4* y0 = (const u32x4*)(Y + (size_t)s0 * D); const u32x4* y1 = (const u32x4*)(Y + (size_t)s1 * D); f32x4* o = (f32x4*)(c.out + (size_t)t * D);
#pragma unroll
        for (int q = 0; q < 4; ++q) { const u32x4 a = y0[lane + 64 * q], b2 = y1[lane + 64 * q]; f32x4 v0 = o[2 * (lane + 64 * q)], v1 = o[2 * (lane + 64 * q) + 1];
            v0[0] += __uint_as_float(a.x << 16) + __uint_as_float(b2.x << 16); v0[1] += __uint_as_float(a.x & 0xffff0000u) + __uint_as_float(b2.x & 0xffff0000u);
            v0[2] += __uint_as_float(a.y << 16) + __uint_as_float(b2.y << 16); v0[3] += __uint_as_float(a.y & 0xffff0000u) + __uint_as_float(b2.y & 0xffff0000u);
            v1[0] += __uint_as_float(a.z << 16) + __uint_as_float(b2.z << 16); v1[1] += __uint_as_float(a.z & 0xffff0000u) + __uint_as_float(b2.z & 0xffff0000u);
            v1[2] += __uint_as_float(a.w << 16) + __uint_as_float(b2.w << 16); v1[3] += __uint_as_float(a.w & 0xffff0000u) + __uint_as_float(b2.w & 0xffff0000u);
#ifdef DIAG
            v0 *= dsc; v1 *= dsc;
#endif
            o[2 * (lane + 64 * q)] = v0; o[2 * (lane + 64 * q) + 1] = v1; } }
}
#endif
#ifdef HOST_EMU
#define FAST_P0 0
#define FAST_P1 0
#define FAST_P6 0
#define FAST_P13 0
#define FAST_MOE 0
#define FAST_ATT 0
#define FAST_GLA 0
#define FAST_CROSS 0
typedef unsigned char* LdsPtr;
#else
#ifndef FAST_P0
#define FAST_P0 1
#endif
#ifndef FAST_P1
#define FAST_P1 1
#endif
#ifndef FAST_P6
#define FAST_P6 1
#endif
#ifndef FAST_P13
#define FAST_P13 1
#endif
#ifndef FAST_ATT
#define FAST_ATT 1
#endif
#ifndef FAST_GLA
#define FAST_GLA 1
#endif
#ifndef FAST_CROSS
#define FAST_CROSS 1
#endif
#ifndef FAST_MOE
#define FAST_MOE 1
#endif
typedef LAS unsigned char* LdsPtr;
#endif
constexpr int N_PHASES = 18;
template <int P, int QPASS = 0> __device__ __forceinline__ void run_phase(const Ctx& c, LdsPtr lds) {
    int* ctl = WSP(int, WS_CTL); float* lamp = (float*)(ctl + 16);
    bf16 *WIN = WSP(bf16, WS_WIN), *WOUT = WSP(bf16, WS_WOUT), *WCQ = WSP(bf16, WS_WCQ), *WCKV = WSP(bf16, WS_WCKV), *WCO = WSP(bf16, WS_WCO);
    bf16 *WGU = WSP(bf16, WS_WGU), *WD = WSP(bf16, WS_WD), *XN = WSP(bf16, WS_XN), *MEMN = WSP(bf16, WS_MEMN);
    float* SSP1 = WSP(float, WS_SMALL + SM_SSP1); float* SSP2 = WSP(float, WS_SMALL + SM_SSP2); (void)SSP1; (void)SSP2;
    float* GLR = WSP(float, WS_SMALL + SM_GLR); float* CQSS = WSP(float, WS_SMALL + SM_CQSS); int* EXPERT = WSP(int, WS_SMALL + SM_EXPERT); float* GATE = WSP(float, WS_SMALL + SM_GATE);
    int* SLOTPOS = WSP(int, WS_SMALL + SM_SLOTPOS); int* SLOTTOK = WSP(int, WS_SMALL + SM_SLOTTOK); float* SLOTGATE = WSP(float, WS_SMALL + SM_SLOTGATE); float* ROPE = WSP(float, WS_SMALL + SM_ROPE);
    bf16 *CKV = WSP(bf16, WS_SMALL + SM_CKV), *CK2 = WSP(bf16, WS_SMALL + SM_CK2), *CVT = WSP(bf16, WS_SMALL + SM_CVT); float* STATS = WSP(float, WS_SMALL + SM_STATS);
    char* rb = c.ws + WS_B;
    bf16 *DQ = (bf16*)(rb + B_DQ), *DK = (bf16*)(rb + B_DK), *DV = (bf16*)(rb + B_DV), *GQ = (bf16*)(rb + B_GQ), *GK = (bf16*)(rb + B_GK), *GV = (bf16*)(rb + B_GV), *GRb = (bf16*)(rb + B_GR);
    bf16 *CQ = (bf16*)(rb + B_CQ), *CO = (bf16*)(rb + B_CO), *HE = (bf16*)(rb + B_HE);
    bf16* MIX = WSP(bf16, WS_C);
    float* TMPQK = WSP(float, WS_C);
    float* PTMP = WSP(float, WS_C);
    float* CUM = WSP(float, WS_D);
    float* OTMPD = WSP(float, WS_D + al256((size_t)T * D));
    float* OTMPG = WSP(float, WS_D + al256((size_t)T * D) * 3);
    float* out = c.out; (void)lds; (void)TMPQK; (void)WIN;
    if constexpr (P == 0) {
#if FAST_P0
        fast_prologue(c, lds);
#else
        nk_conv_win(c.w_in, WIN);
        nk_convT(c.w_out, D, 0, WOUT, D, D); nk_convT(c.w_cq, D, 0, WCQ, D, D); nk_convT(c.w_ckv, 2 * D, 0, WCKV, 2 * D, D); nk_convT(c.w_co, D, 0, WCO, D, D);
        nk_conv_gu(c.w_gate, c.w_up, WGU); nk_conv_d(c.w_down, WD);
        nk_rope_table(c.positions, ROPE); nk_lam(c.lq1, c.lk1, c.lq2, c.lk2, lamp);
        nk_zero_bf16(XN + (size_t)T * D, (size_t)D); nk_moe_init_slots(SLOTTOK, SLOTGATE);
        nk_rmsnorm_rows(c.x, c.g_attn, XN, T, D); nk_rmsnorm_rows(c.mem, c.g_mem, MEMN, B * NMEM, D);
        nk_glr(c.x, c.g_attn, c.w_in, GLR);
#endif
    } else if constexpr (P == 1) {
#if FAST_P1
        pg8::Gemm g{XN, WIN, T, NIN, D}; pg8::StaticOrder S; S.init(T, NIN, (int)gridDim.x, (int)blockIdx.x);
        pg8::EpiInProj E{rb, ROPE, c.q_norm_g, c.k_norm_g};
        pg8::gemm_phase<pg8::EpiInProj, pg8::StaticOrder, true, true>(lds, g, S, E);
#else
        { GemmP p{XN, WIN, T, NIN, D, 0, TMPQK, nullptr, (bf16*)rb, nullptr}; nk_gemm<0>(p); }
#endif
    } else if constexpr (P == 2) {
#if !FAST_P1
        nk_qk_post(TMPQK, c.q_norm_g, c.k_norm_g, ROPE, DQ, DK);
#endif
#if FAST_CROSS && FAST_GLA && FAST_ATT
#elif FAST_CROSS
        { pg8::Gemm g{MEMN, WCKV, B * NMEM, 2 * D, D}; pg8::StaticOrder S; S.init(B * NMEM, 2 * D, (int)gridDim.x, (int)blockIdx.x);
          pg8::EpiPlain E{CKV, 2 * D}; pg8::gemm_phase<pg8::EpiPlain, pg8::StaticOrder, true, true>(lds, g, S, E); }
#else
        { GemmP p{MEMN, WCKV, B * NMEM, 2 * D, D, 0, nullptr, nullptr, CKV, nullptr}; nk_gemm<2>(p); }
#endif
    } else if constexpr (P == 3) {
#if FAST_CROSS && FAST_GLA && FAST_ATT
#elif FAST_CROSS
        fast_ckv_fix(c);
#else
        nk_ckv_fix(CKV, c.cq_g, c.ck_g, CK2, CVT);
#endif
#if FAST_GLA
        fast_gla_prep(c, lds);
#else
        nk_gla_cum(GLR, c.w_a2, c.b_a, CUM);
#endif
#if !FAST_ATT
        nk_diff_stats(DQ, DK, STATS);
#endif
    } else if constexpr (P == 4) {
#if FAST_ATT
        { const float lam = lamp[0], mref = lamp[1];
#if FAST_GLA
          LAS int* qslot = (LAS int*)(lds + 143360);
          for (;;) {
              if (threadIdx.x == 0) *qslot = atomicAdd(&ctl[CW_QUEUE + 64 * QPASS], 1);
              __syncthreads(); const int item = *qslot; __syncthreads();
              if (item >= 8 + 512) break;
              if (item < 8) fg::gla_seq(item >> 2, item & 3, GQ, (const bf16*)CUM, GV, GRb, WSP(float, WS_SMALL + SM_DEC), c.gla_out_g, MIX, lds);
              else { const int u = item - 8, jq = 31 - (u >> 4), bh = u & 15;
                  if (mref <= 24.0f) fa::attn_unit<false>(bh >> 3, bh & 7, jq, DQ, DK, DV, MIX, c.subln_g, lam, mref, lds);
                  else fa::attn_unit<true>(bh >> 3, bh & 7, jq, DQ, DK, DV, MIX, c.subln_g, lam, mref, lds); } }
          if (QPASS == 0) {
              if (threadIdx.x == 0) *qslot = atomicAdd(&ctl[CW_QUEUE + 192], 1);
              __syncthreads(); const int kvu = *qslot; __syncthreads();
              if (kvu < 32) { pg8::Gemm g{MEMN, WCKV, B * NMEM, 2 * D, D}; pg8::OneUnit S{kvu >> 4, kvu & 15}; pg8::EpiPlain E{CKV, 2 * D};
                  pg8::gemm_phase<pg8::EpiPlain, pg8::OneUnit, true, true>(lds, g, S, E); __syncthreads(); }
              for (;;) {
                  if (threadIdx.x == 0) *qslot = atomicAdd(&ctl[CW_QUEUE + 128], 1);
                  __syncthreads(); const int item = *qslot; __syncthreads();
                  if (item * 64 >= EXP_ITEMS) break;
                  f0_expert_items(c, lds, item * 64, 64); } }
#else
          const int G = (int)gridDim.x;
          for (int pi = (int)blockIdx.x; pi < 256; pi += G) { const int vcu = (pi & 7) * 32 + (pi >> 3), bh = vcu >> 4, pr = vcu & 15;
              for (int k2 = 0; k2 < 2; ++k2) { const int jq = k2 ? pr : 31 - pr;
                  if (mref <= 24.0f) fa::attn_unit<false>(bh >> 3, bh & 7, jq, DQ, DK, DV, MIX, c.subln_g, lam, mref, lds);
                  else fa::attn_unit<true>(bh >> 3, bh & 7, jq, DQ, DK, DV, MIX, c.subln_g, lam, mref, lds); } }
#endif
        }
#else
        nk_diff_pv(DQ, DK, DV, STATS, lamp, OTMPD);
#endif
#if !FAST_GLA
        nk_gla_run(GQ, GK, GV, CUM, OTMPG);
#endif
    } else if constexpr (P == 5) {
#if !FAST_ATT
        nk_diff_norm(OTMPD, c.subln_g, MIX);
#endif
#if !FAST_GLA
        nk_gla_norm(OTMPG, c.gla_out_g, GRb, MIX);
#endif
    } else if constexpr (P == 6) {
#if FAST_P6
#if FAST_CROSS && FAST_GLA && FAST_ATT
        fast_ckv_fix(c);
#endif
        pg8::Gemm g{MIX, WOUT, T, D, D}; pg8::StaticOrder S; S.init(T, D, (int)gridDim.x, (int)blockIdx.x);
        pg8::EpiResid E{c.x, out, XN, c.g_cross, SSP1};
        pg8::gemm_phase<pg8::EpiResid, pg8::StaticOrder, true, true>(lds, g, S, E);
#else
        GemmP p{MIX, WOUT, T, D, D, 0, out, nullptr, nullptr, c.x}; nk_gemm<1>(p);
#endif
    } else if constexpr (P == 7) {
#if !FAST_P6
        nk_rmsnorm_rows(out, c.g_cross, XN, T, D);
#endif
    } else if constexpr (P == 8) {
#if FAST_P6
        pg8::Gemm g{XN, WCQ, T, D, D}; pg8::StaticOrder S; S.init(T, D, (int)gridDim.x, (int)blockIdx.x);
        pg8::EpiCq E{SSP1, CQ, CQSS};
        pg8::gemm_phase<pg8::EpiCq, pg8::StaticOrder, true, true>(lds, g, S, E);
#else
        GemmP p{XN, WCQ, T, D, D, 0, nullptr, nullptr, CQ, nullptr}; nk_gemm<2>(p);
#endif
    } else if constexpr (P == 9) {
#if !FAST_P6
        nk_cqss(CQ, CQSS);
#endif
    } else if constexpr (P == 10) {
#if FAST_CROSS
        for (int u = (int)blockIdx.x; u < B * CH * (SEQ / 128); u += (int)gridDim.x) { const int v = (u & 7) * 32 + (u >> 3);
            fc::cross_unit(v >> 7, (v >> 5) & 3, v & 31, CQ, CQSS, CK2, CVT, CO, lds); }
#else
        nk_cross_scores(CQ, CQSS, CK2, PTMP);
#endif
    } else if constexpr (P == 11) {
#if !FAST_CROSS
        nk_cross_softmax(PTMP);
#endif
    } else if constexpr (P == 12) {
#if !FAST_CROSS
        nk_cross_pv(PTMP, CVT, CO);
#endif
    } else if constexpr (P == 13) {
#if FAST_P13
        pg8::Gemm g{CO, WCO, T, D, D}; pg8::StaticOrder S; S.init(T, D, (int)gridDim.x, (int)blockIdx.x);
        pg8::EpiResid E{out, out, XN, c.g_ffn, SSP2};
        pg8::gemm_phase<pg8::EpiResid, pg8::StaticOrder, true, true>(lds, g, S, E);
#else
        GemmP p{CO, WCO, T, D, D, 0, out, nullptr, nullptr, nullptr}; nk_gemm<4>(p);
#endif
    } else if constexpr (P == 14) {
#if FAST_MOE
        fast_router(c, lds);
#else
        nk_router(out, c.g_ffn, c.w_rg, c.b_rg, c.w_re, c.b_re, XN, EXPERT, GATE, SLOTPOS, ctl);
#endif
    } else if constexpr (P == 15) {
#if !FAST_MOE
        nk_moe_offsets(ctl);
#endif
    } else if constexpr (P == 16) {
#if FAST_MOE
        fast_moe_fill(c);
#else
        nk_moe_fill(EXPERT, GATE, SLOTPOS, ctl, SLOTTOK, SLOTGATE);
#endif
    } else if constexpr (P == 17) {
#if FAST_MOE
        pg8::Gemm g{XN, WGU, PMAX, NE * 2 * DE, D}; pg8::MoeOrder S{ctl, 4, (int)gridDim.x, (int)blockIdx.x};
        pg8::EpiGU E{SLOTTOK, SSP2, HE};
        pg8::gemm_phase_gather<pg8::EpiGU, pg8::MoeOrder, true>(lds, g, SLOTTOK, S, E);
#else
        nk_moe_gu(XN, WGU, SLOTTOK, ctl, HE);
#endif
    }
}
template <int P> __device__ __forceinline__ void run_phase_last(const Ctx& c, LdsPtr lds) {
    int* ctl = WSP(int, WS_CTL); bf16* WD = WSP(bf16, WS_WD); int* SLOTTOK = WSP(int, WS_SMALL + SM_SLOTTOK); float* SLOTGATE = WSP(float, WS_SMALL + SM_SLOTGATE); bf16* HE = (bf16*)(c.ws + WS_B + B_HE); (void)lds;
#if FAST_MOE
    pg8::Gemm g{HE, WD, PMAX, NE * D, DE}; pg8::MoeOrder S{ctl, 8, (int)gridDim.x, (int)blockIdx.x};
    pg8::EpiDown E{SLOTGATE, WSP(bf16, WS_C)};
    pg8::gemm_phase<pg8::EpiDown, pg8::MoeOrder, true, true>(lds, g, S, E);
#else
    nk_moe_down(HE, WD, SLOTTOK, SLOTGATE, ctl, c.out);
#endif
}

#ifndef HOST_EMU
#define XB_TMO      128
#define XB_XCNT(j)  (256  + 64 * (j))
#define XB_XSUB(j)  (1280 + 64 * (j))
#define XB_XGEN(j)  (2304 + 64 * (j))
#define XB_TOP      3328
#define XB_TOPGEN   3392
#define XCD_BAR_WORDS 3456
#define XB_SPIN_CAP (1u << 20)

__device__ __forceinline__ unsigned xb_ld(unsigned* p)              { return __hip_atomic_load(p, __ATOMIC_RELAXED, __HIP_MEMORY_SCOPE_AGENT); }
__device__ __forceinline__ unsigned xb_add(unsigned* p, unsigned v) { return __hip_atomic_fetch_add(p, v, __ATOMIC_RELAXED, __HIP_MEMORY_SCOPE_AGENT); }
__device__ __forceinline__ unsigned xb_xcc_id() { return (unsigned)__builtin_amdgcn_s_getreg((3 << 11) | 20) & 0xFu; }
#define XB_SPIN(cond, bar) do { unsigned _sp = 0; while (cond) { __builtin_amdgcn_s_sleep(1); \
    if ((++_sp & 255u) == 0u) { if (xb_ld(&(bar)[XB_TMO])) break; if (_sp > XB_SPIN_CAP) { atomicAdd(&(bar)[XB_TMO], 1u); break; } } } } while (0)

struct XcdBarrier {
    unsigned* bar; unsigned x;
    volatile LAS unsigned* st;
};
__device__ __forceinline__ XcdBarrier xcd_barrier_post(unsigned* bar, volatile LAS unsigned* st) {
    XcdBarrier b; b.bar = bar; b.x = xb_xcc_id(); b.st = st;
    if (threadIdx.x == 0) (void)xb_add(&bar[XB_XCNT(b.x)], 1u);
    return b;
}
__device__ __forceinline__ void xcd_barrier_complete(unsigned* bar, unsigned x, unsigned& nloc, unsigned& nx) {
    const unsigned G = gridDim.x * gridDim.y * gridDim.z;
    unsigned sum, cnt, mine, sp = 0u;
    for (;;) {
        sum = 0u; cnt = 0u; mine = 0u;
#pragma unroll
        for (unsigned j = 0; j < 16; ++j) { const unsigned c = xb_ld(&bar[XB_XCNT(j)]); sum += c; cnt += (c > 0u) ? 1u : 0u; mine = (j == x) ? c : mine; }
        if (sum == G) break;
        __builtin_amdgcn_s_sleep(1);
        if ((++sp & 255u) == 0u) { if (xb_ld(&bar[XB_TMO])) break; if (sp > XB_SPIN_CAP) { atomicAdd(&bar[XB_TMO], 1u); break; } }
    }
    nloc = mine > 0u ? mine : 1u; nx = cnt > 0u ? cnt : 1u;
}
__device__ __forceinline__ void xcd_barrier(const XcdBarrier& b) {
    asm volatile("s_waitcnt vmcnt(0)" ::: "memory");
    __syncthreads();
    if (threadIdx.x == 0) {
        unsigned* bar = b.bar;
        __builtin_amdgcn_s_waitcnt(0);
        unsigned nloc = b.st[0], nx = b.st[1];
        if (nloc == 0u) { xcd_barrier_complete(bar, b.x, nloc, nx); b.st[0] = nloc; b.st[1] = nx; }
        const unsigned old = xb_add(&bar[XB_XSUB(b.x)], 1u);
        const unsigned gen = old / nloc;
        if (old + 1u == (gen + 1u) * nloc) {
            __builtin_amdgcn_fence(__ATOMIC_RELEASE, "agent");
            asm volatile("s_waitcnt vmcnt(0)" ::: "memory");
            const unsigned og = xb_add(&bar[XB_TOP], 1u);
            const unsigned tg = og / nx;
            if (og + 1u == (tg + 1u) * nx) xb_add(&bar[XB_TOPGEN], 1u);
            else XB_SPIN(xb_ld(&bar[XB_TOPGEN]) == tg, bar);
            __builtin_amdgcn_fence(__ATOMIC_ACQUIRE, "agent");
            xb_add(&bar[XB_XGEN(b.x)], 1u);
            asm volatile("s_waitcnt vmcnt(0)" ::: "memory");
        } else {
            XB_SPIN(xb_ld(&bar[XB_XGEN(b.x)]) == gen, bar);
            __builtin_amdgcn_fence(__ATOMIC_ACQUIRE, "agent");
            asm volatile("s_waitcnt vmcnt(0)" ::: "memory");
        }
    }
    __syncthreads();
}

constexpr int NTHREADS = 512;
constexpr int LDS_BYTES = 147456;
constexpr int LDSCTL_OFF = 143360, MISC_OFF = LDSCTL_OFF + 64;
__global__ void __launch_bounds__(NTHREADS, 2) fwd_kernel(Ctx c) {
    extern __shared__ __attribute__((aligned(16))) unsigned char lds[];
    LAS unsigned char* l3 = (LAS unsigned char*)lds;
    volatile LAS unsigned* MISC = (volatile LAS unsigned*)(l3 + MISC_OFF);
    for (int u = threadIdx.x; u < (LDS_BYTES - LDSCTL_OFF) / 4; u += NTHREADS) ((LAS unsigned*)(l3 + LDSCTL_OFF))[u] = 0u;
    __syncthreads();
    XcdBarrier bar = xcd_barrier_post((unsigned*)(c.ws + WS_CTL) + CW_BAR, MISC + 8);
#ifndef PROBE_DOUBLE
#define PROBE_DOUBLE -1
#endif
#ifndef PROBE_SPLIT4
#define PROBE_SPLIT4 0
#endif
#define PH(k) if (PROBE_SPLIT4 && k == 4) { run_phase<k, 2>(c, l3); xcd_barrier(bar); run_phase<k, 3>(c, l3); xcd_barrier(bar); } else { run_phase<k>(c, l3); xcd_barrier(bar); } if (PROBE_DOUBLE == k) { run_phase<k, 1>(c, l3); xcd_barrier(bar); }
#if FAST_P0 && FAST_P1 && FAST_P6 && FAST_P13 && FAST_ATT && FAST_GLA && FAST_CROSS && FAST_MOE
    PH(0) PH(1) PH(3) PH(4) PH(6) PH(8) PH(10) PH(13) PH(14) PH(16) PH(17)
    run_phase_last<0>(c, l3); xcd_barrier(bar);
    fast_moe_gather(c);
#else
    PH(0) PH(1) PH(2) PH(3) PH(4) PH(5) PH(6) PH(7) PH(8) PH(9) PH(10) PH(11) PH(12) PH(13) PH(14) PH(15) PH(16) PH(17)
    run_phase_last<0>(c, l3);
#if FAST_MOE
    xcd_barrier(bar); fast_moe_gather(c);
#endif
#endif
#undef PH
}
#endif

#ifdef HOST_EMU
template <int P> static void emu_phase(const Ctx& c) { const size_t nth = 4096; emu_nth = nth; for (size_t t = 0; t < nth; ++t) { emu_tid = t; run_phase<P>(c, nullptr); } }
template <int... Ps> static void emu_all(const Ctx& c, std::integer_sequence<int, Ps...>) { (emu_phase<Ps>(c), ...); }
#endif

extern "C" void kernel_launch(void* const* d_in, const int* in_sizes, int n_in, void* d_out, int out_size, void* d_ws, size_t ws_size, hipStream_t stream) {
    if (n_in != 31 || out_size != T * D || ws_size < WS_END) { fprintf(stderr, "kernel_launch: unexpected shapes (n_in %d out %d ws %zu need %zu)\n", n_in, out_size, ws_size, (size_t)WS_END); return; }
    (void)in_sizes;
    Ctx c{};
    const float** fp = (const float**)&c.x;
    c.x = (const float*)d_in[0]; c.mem = (const float*)d_in[1]; c.positions = (const int*)d_in[2];
    c.g_attn = (const float*)d_in[3]; c.w_in = (const float*)d_in[4]; c.q_norm_g = (const float*)d_in[5]; c.k_norm_g = (const float*)d_in[6];
    c.lq1 = (const float*)d_in[7]; c.lk1 = (const float*)d_in[8]; c.lq2 = (const float*)d_in[9]; c.lk2 = (const float*)d_in[10];
    c.subln_g = (const float*)d_in[11]; c.w_a2 = (const float*)d_in[12]; c.b_a = (const float*)d_in[13]; c.gla_out_g = (const float*)d_in[14];
    c.w_out = (const float*)d_in[15]; c.g_cross = (const float*)d_in[16]; c.g_mem = (const float*)d_in[17]; c.w_cq = (const float*)d_in[18];
    c.w_ckv = (const float*)d_in[19]; c.cq_g = (const float*)d_in[20]; c.ck_g = (const float*)d_in[21]; c.w_co = (const float*)d_in[22];
    c.g_ffn = (const float*)d_in[23]; c.w_rg = (const float*)d_in[24]; c.b_rg = (const float*)d_in[25]; c.w_re = (const float*)d_in[26];
    c.b_re = (const float*)d_in[27]; c.w_gate = (const float*)d_in[28]; c.w_up = (const float*)d_in[29]; c.w_down = (const float*)d_in[30];
    c.out = (float*)d_out; c.ws = (char*)d_ws; (void)fp;
#ifdef HOST_EMU
    memset(c.ws + WS_CTL, 0, CTL_BYTES);
    emu_all(c, std::make_integer_sequence<int, N_PHASES>{});
    { const size_t nth = 4096; emu_nth = nth; for (size_t t = 0; t < nth; ++t) { emu_tid = t; run_phase_last<0>(c, nullptr); } }
#else
    static int grid = 0;
    if (grid == 0) {
        int dev = 0, cus = 0, per_cu = 0;
        if (hipGetDevice(&dev) != hipSuccess || hipDeviceGetAttribute(&cus, hipDeviceAttributeMultiprocessorCount, dev) != hipSuccess) { fprintf(stderr, "kernel_launch: device query failed\n"); grid = -1; return; }
        if (hipFuncSetAttribute((const void*)fwd_kernel, hipFuncAttributeMaxDynamicSharedMemorySize, LDS_BYTES) != hipSuccess) { fprintf(stderr, "kernel_launch: hipFuncSetAttribute failed\n"); grid = -1; return; }
        if (hipOccupancyMaxActiveBlocksPerMultiprocessor(&per_cu, (const void*)fwd_kernel, NTHREADS, LDS_BYTES) != hipSuccess || per_cu < 1) { fprintf(stderr, "kernel_launch: occupancy query says %d blocks per CU\n", per_cu); }
        (void)hipGetLastError();
        grid = cus;
    }
    if (grid < 0) return;
    (void)hipMemsetAsync(c.ws + WS_CTL, 0, CTL_BYTES, stream);
    hipLaunchKernelGGL(fwd_kernel, dim3(grid), dim3(NTHREADS), LDS_BYTES, stream, c);
#endif
}
```
